# Optimizing an MI355X kernel written in HIP

```python
import math
import jax, jax.numpy as jnp
from jax import lax
import numpy as np

D_MODEL = 1024
BATCH = 2
SEQ = 8192
DEPTH = 4
DEC_BATCH = 32
DEC_SEQ = 1
PAST_LEN = 8192
PAGE_SIZE = 128

N_A_LAYERS = (DEPTH + 1) // 2
N_C_LAYERS = DEPTH // 2
NORM_EPS = 1e-6
N_MOD = 6
SSD_D_INNER = D_MODEL
SSD_HEAD_DIM = 64
SSD_HEADS = SSD_D_INNER // SSD_HEAD_DIM
SSD_GROUPS = 2
SSD_STATE = 128
SSD_CONV = 4
SSD_CHUNK = 128
SSD_CONV_DIM = SSD_D_INNER + 2 * SSD_GROUPS * SSD_STATE
RWKV_DIM = D_MODEL
RWKV_HEAD_DIM = 64
RWKV_HEADS = RWKV_DIM // RWKV_HEAD_DIM
RWKV_W_RANK = 64
RWKV_A_RANK = 64
RWKV_G_RANK = 128
RWKV_COLS = 3 * RWKV_DIM + RWKV_W_RANK + RWKV_A_RANK + RWKV_G_RANK
RWKV_LN_EPS = 64e-5
HYB_IN_COLS = SSD_D_INNER + SSD_CONV_DIM + SSD_HEADS + RWKV_COLS
HYB_OUT_DIM = SSD_D_INNER + RWKV_DIM
ATT_GROUPS = ((128, 1), (512, 4), (2048, 16))
ATT_HEADS = 8
ATT_HEAD_DIM = 64
ATT_DIM = ATT_HEADS * ATT_HEAD_DIM
ATT_QKV_COLS = len(ATT_GROUPS) * 3 * ATT_DIM
ATT_Q_BLOCK = 128
ROPE_THETA = 500000.0
ROPE_DIM = ATT_HEAD_DIM // 4
MLP_HIDDEN = 4 * D_MODEL

kernel_name = 'hybrid_ssd_rwkv7_dilated_adaln_step'


def rmsnorm(x, g, eps=NORM_EPS):
    xf = x.astype(jnp.float32)
    y = xf * lax.rsqrt(jnp.mean(xf * xf, axis=-1, keepdims=True) + eps)
    return (y * g.astype(jnp.float32)).astype(x.dtype)


def modulate(x, g, shift, scale):
    return rmsnorm(x, g) * (1.0 + scale[:, None, :]) + shift[:, None, :]


def block_size(L, pref):
    return pref if L % pref == 0 else L


def causal_conv(u, buf, w, b):
    L = u.shape[1]
    K = w.shape[0]
    ext = jnp.concatenate([buf.astype(u.dtype), u], axis=1)
    y = b + sum(ext[:, j:j + L] * w[j] for j in range(K))
    return y, ext[:, L:]


def ssd_scan(x, dt, A, B, C, s0, chunk):
    f32 = jnp.float32
    b, L, H, P = x.shape
    G, N = B.shape[2], B.shape[3]
    Hg = H // G
    nc = L // chunk
    xc = x.astype(f32).reshape(b, nc, chunk, G, Hg, P)
    dtc = dt.astype(f32).reshape(b, nc, chunk, G, Hg)
    Bc = B.astype(f32).reshape(b, nc, chunk, G, N)
    Cc = C.astype(f32).reshape(b, nc, chunk, G, N)
    acs = jnp.cumsum(dtc * A.reshape(G, Hg), axis=2)
    causal = np.tril(np.ones((chunk, chunk), dtype=bool))
    seg = acs[:, :, :, None] - acs[:, :, None, :]
    decay_ls = jnp.exp(jnp.where(causal[:, :, None, None], seg, -jnp.inf))
    cb = jnp.einsum('bclgn,bcsgn->bclsg', Cc, Bc)
    scores = cb[..., None] * decay_ls
    y_diag = jnp.einsum('bclsgh,bcsghp->bclghp', scores, dtc[..., None] * xc)
    decay_end = jnp.exp(acs[:, :, -1:] - acs)
    chunk_states = jnp.einsum('bclgn,bclgh,bclghp->bcghpn', Bc, decay_end * dtc, xc)
    chunk_decay = jnp.exp(acs[:, :, -1])

    def step(S, inp):
        dec, st = inp
        return S * dec[..., None, None] + st, S

    s_final, s_in = lax.scan(step, s0.astype(f32).reshape(b, G, Hg, P, N),
                             (jnp.moveaxis(chunk_decay, 1, 0), jnp.moveaxis(chunk_states, 1, 0)))
    s_in = jnp.moveaxis(s_in, 0, 1)
    y_off = jnp.einsum('bclgn,bcghpn,bclgh->bclghp', Cc, s_in, jnp.exp(acs))
    y = (y_diag + y_off).reshape(b, L, H, P)
    return y, s_final.reshape(b, H, P, N)


def wkv7_scan(r, w, k, v, kk, a, s0):
    def step(S, inp):
        r_t, w_t, k_t, v_t, kk_t, a_t = inp
        sa = jnp.einsum('bhvk,bhk->bhv', S, -kk_t)
        S = (S * w_t[:, :, None, :] + sa[..., None] * (kk_t * a_t)[:, :, None, :]
             + v_t[..., None] * k_t[:, :, None, :])
        return S, jnp.einsum('bhvk,bhk->bhv', S, r_t)

    xs = tuple(jnp.moveaxis(t, 1, 0) for t in (r, w, k, v, kk, a))
    S, out = lax.scan(step, s0, xs)
    return jnp.moveaxis(out, 0, 1), S


def hybrid_mixer(h, ssd_state, conv_buf, wkv_state, shift_buf, w_in, w_out, conv_w, conv_b,
                 dt_bias, a_log, d_skip, ssd_norm_w, mu, w0, w2, a0, a2, g2, k_k, k_a, r_k,
                 ln_w, ln_b):
    f32 = jnp.float32
    b, L, _ = h.shape
    u = h @ w_in
    z, xbc, dt_raw, rw = jnp.split(
        u, [SSD_D_INNER, SSD_D_INNER + SSD_CONV_DIM, SSD_D_INNER + SSD_CONV_DIM + SSD_HEADS], axis=-1)
    xbc, new_conv = causal_conv(xbc, conv_buf, conv_w, conv_b)
    xbc = jax.nn.silu(xbc)
    xs, Bm, Cm = jnp.split(xbc, [SSD_D_INNER, SSD_D_INNER + SSD_GROUPS * SSD_STATE], axis=-1)
    xs = xs.reshape(b, L, SSD_HEADS, SSD_HEAD_DIM)
    Bm = Bm.reshape(b, L, SSD_GROUPS, SSD_STATE)
    Cm = Cm.reshape(b, L, SSD_GROUPS, SSD_STATE)
    dt = jax.nn.softplus((dt_raw + dt_bias).astype(f32))
    A = -jnp.exp(a_log.astype(f32))
    y, new_ssd = ssd_scan(xs, dt, A, Bm, Cm, ssd_state, block_size(L, SSD_CHUNK))
    y = y + d_skip.astype(f32)[:, None] * xs.astype(f32)
    y = y.reshape(b, L, SSD_D_INNER) * jax.nn.silu(z.astype(f32))
    yg = y.reshape(b, L, SSD_GROUPS, SSD_D_INNER // SSD_GROUPS)
    yg = yg * lax.rsqrt(jnp.mean(yg * yg, axis=-1, keepdims=True) + NORM_EPS)
    y_ssd = (yg.reshape(b, L, SSD_D_INNER) * ssd_norm_w.astype(f32)).astype(h.dtype)
    rw_prev = jnp.concatenate([shift_buf[:, None].astype(rw.dtype), rw[:, :-1]], axis=1)
    rw_mix = rw + (rw_prev - rw) * mu
    new_shift = rw[:, -1]
    r, k, v, xw, xa, xg = jnp.split(
        rw_mix, [RWKV_DIM, 2 * RWKV_DIM, 3 * RWKV_DIM, 3 * RWKV_DIM + RWKV_W_RANK,
                 3 * RWKV_DIM + RWKV_W_RANK + RWKV_A_RANK], axis=-1)
    wlog = -jax.nn.softplus(-(w0 + jnp.tanh(xw) @ w2).astype(f32)) - 0.5
    decay = jnp.exp(-jnp.exp(wlog))
    a = jax.nn.sigmoid((a0 + xa @ a2).astype(f32))
    g = jax.nn.sigmoid(xg) @ g2

    def heads(t):
        return t.astype(f32).reshape(b, L, RWKV_HEADS, RWKV_HEAD_DIM)

    r, k, v, decay, a = heads(r), heads(k), heads(v), heads(decay), heads(a)
    kk = k * k_k.astype(f32).reshape(RWKV_HEADS, RWKV_HEAD_DIM)
    kk = kk / jnp.maximum(jnp.linalg.norm(kk, axis=-1, keepdims=True), 1e-12)
    k = k * (1.0 + (a - 1.0) * k_a.astype(f32).reshape(RWKV_HEADS, RWKV_HEAD_DIM))
    o, new_wkv = wkv7_scan(r, decay, k, v, kk, a, wkv_state.astype(f32))
    mean = jnp.mean(o, axis=-1, keepdims=True)
    var = jnp.mean(jnp.square(o - mean), axis=-1, keepdims=True)
    o = ((o - mean) * lax.rsqrt(var + RWKV_LN_EPS)).reshape(b, L, RWKV_DIM)
    o = o * ln_w.astype(f32) + ln_b.astype(f32)
    bonus = jnp.sum(r * k * r_k.astype(f32), axis=-1, keepdims=True) * v
    o = o + bonus.reshape(b, L, RWKV_DIM)
    y_rwkv = (o * g.astype(f32)).astype(h.dtype)
    out = jnp.concatenate([y_ssd, y_rwkv], axis=-1) @ w_out
    return out, new_ssd, new_conv, new_wkv, new_shift


def rope(x, pos):
    f32 = jnp.float32
    half = ROPE_DIM // 2
    inv = ROPE_THETA ** (-jnp.arange(half, dtype=f32) * 2.0 / ROPE_DIM)
    ang = pos.astype(f32)[:, None] * inv
    cos = jnp.cos(ang)[None, :, None, :]
    sin = jnp.sin(ang)[None, :, None, :]
    xf = x.astype(f32)
    x1, x2 = xf[..., :half], xf[..., half:ROPE_DIM]
    rot = jnp.concatenate([x1 * cos - x2 * sin, x2 * cos + x1 * sin], axis=-1).astype(x.dtype)
    return jnp.concatenate([rot, x[..., ROPE_DIM:]], axis=-1)


def dilated_attention(q, kv_ext, window, dilation, n_invalid, qb):
    b, L, H, hd = q.shape
    nk = window // dilation + 1
    rel = window + np.arange(qb)[:, None] - dilation * np.arange(nk)[None, :]
    scale = hd ** -0.5

    def block(i):
        start = i * qb
        q_blk = lax.dynamic_slice_in_dim(q, start, qb, axis=1)
        span = lax.dynamic_slice_in_dim(kv_ext, start, window + qb, axis=1)
        kv = jnp.take(span, rel, axis=1)
        s = jnp.einsum('bqhd,bqkhd->bhqk', q_blk, kv[:, :, :, 0]).astype(jnp.float32) * scale
        valid = (start + rel) >= n_invalid
        s = jnp.where(valid, s, -jnp.inf)
        lse = jax.nn.logsumexp(s, axis=-1)
        p = jnp.exp(s - lse[..., None]).astype(q.dtype)
        o = jnp.einsum('bhqk,bqkhd->bqhd', p, kv[:, :, :, 1])
        return o, jnp.moveaxis(lse, 1, 2)

    o, lse = lax.map(block, jnp.arange(L // qb))
    o = jnp.moveaxis(o, 0, 1).reshape(b, L, H, hd)
    lse = jnp.moveaxis(lse, 0, 1).reshape(b, L, H)
    return o, lse


def dilated_mixer(h, pos0, bufs, keep_lens, w_qkv, w_out):
    b, L, _ = h.shape
    qkv = (h @ w_qkv).reshape(b, L, len(ATT_GROUPS), 3, ATT_HEADS, ATT_HEAD_DIM)
    pos = pos0 + jnp.arange(L)
    outs, lses, new_bufs = [], [], []
    for gi, (window, dilation) in enumerate(ATT_GROUPS):
        q = rope(qkv[:, :, gi, 0], pos)
        k = rope(qkv[:, :, gi, 1], pos)
        kv_new = jnp.stack([k, qkv[:, :, gi, 2]], axis=2)
        past = bufs[gi].astype(kv_new.dtype)
        n_past = past.shape[1]
        kv_all = jnp.concatenate([past, kv_new], axis=1)
        new_bufs.append(kv_all[:, kv_all.shape[1] - keep_lens[gi]:])
        pad = jnp.zeros((b, window - n_past) + kv_new.shape[2:], kv_new.dtype)
        kv_ext = jnp.concatenate([pad, kv_all], axis=1)
        o, lse = dilated_attention(q, kv_ext, window, dilation, window - n_past,
                                   block_size(L, ATT_Q_BLOCK))
        outs.append(o)
        lses.append(lse)
    alpha = jax.nn.softmax(jnp.stack(lses), axis=0)
    o = jnp.einsum('gblh,gblhd->blhd', alpha.astype(h.dtype), jnp.stack(outs))
    return o.reshape(b, L, ATT_DIM) @ w_out, new_bufs


def setup_inputs(seed: int = 0) -> dict:
    key = jax.random.key(seed)
    ks = list(jax.random.split(key, 48))
    f32 = jnp.float32

    def nrm(shape, scale):
        return scale * jax.random.normal(ks.pop(), shape, f32)

    def unif(shape, lo, hi):
        return jax.random.uniform(ks.pop(), shape, f32, minval=lo, maxval=hi)

    NA, NC = N_A_LAYERS, N_C_LAYERS
    inp = {}
    inp['x_prompt'] = nrm((BATCH, SEQ, D_MODEL), 1.0)
    inp['x_sample'] = nrm((DEC_BATCH, DEC_SEQ, D_MODEL), 1.0)
    inp['state_ssd'] = nrm((NA, DEC_BATCH, SSD_HEADS, SSD_HEAD_DIM, SSD_STATE), 0.1)
    inp['state_ssd_conv'] = nrm((NA, DEC_BATCH, SSD_CONV - 1, SSD_CONV_DIM), 1.0)
    inp['state_wkv'] = nrm((NA, DEC_BATCH, RWKV_HEADS, RWKV_HEAD_DIM, RWKV_HEAD_DIM), 0.1)
    inp['state_wkv_shift'] = nrm((NA, DEC_BATCH, RWKV_COLS), 1.0)
    for gi, (window, _) in enumerate(ATT_GROUPS):
        inp['cache_win%d' % gi] = nrm((NC, DEC_BATCH, min(window, PAST_LEN), 2, ATT_HEADS, ATT_HEAD_DIM), 1.0)
    inp['c_prompt'] = nrm((BATCH, D_MODEL), 1.0)
    inp['c_sample'] = nrm((DEC_BATCH, D_MODEL), 1.0)
    inp['norm_mix'] = 1.0 + nrm((DEPTH, D_MODEL), 0.1)
    inp['norm_mlp'] = 1.0 + nrm((DEPTH, D_MODEL), 0.1)
    inp['norm_final'] = 1.0 + nrm((D_MODEL,), 0.1)
    inp['ada_w'] = nrm((DEPTH, D_MODEL, N_MOD * D_MODEL), 0.5 * D_MODEL ** -0.5)
    inp['ada_b'] = nrm((DEPTH, N_MOD * D_MODEL), 0.02)
    inp['mlp_w1'] = nrm((DEPTH, D_MODEL, MLP_HIDDEN), D_MODEL ** -0.5)
    inp['mlp_w2'] = nrm((DEPTH, MLP_HIDDEN, D_MODEL), MLP_HIDDEN ** -0.5)
    inp['hyb_w_in'] = nrm((NA, D_MODEL, HYB_IN_COLS), D_MODEL ** -0.5)
    inp['hyb_w_out'] = nrm((NA, HYB_OUT_DIM, D_MODEL), HYB_OUT_DIM ** -0.5)
    inp['ssd_conv_w'] = nrm((NA, SSD_CONV, SSD_CONV_DIM), SSD_CONV ** -0.5)
    inp['ssd_conv_b'] = nrm((NA, SSD_CONV_DIM), 0.02)
    dt0 = jnp.exp(unif((NA, SSD_HEADS), math.log(1e-3), math.log(1e-1)))
    inp['ssd_dt_bias'] = dt0 + jnp.log(-jnp.expm1(-dt0))
    inp['ssd_a_log'] = jnp.log(unif((NA, SSD_HEADS), 1.0, 16.0))
    inp['ssd_d'] = 1.0 + nrm((NA, SSD_HEADS), 0.1)
    inp['ssd_norm_w'] = 1.0 + nrm((NA, SSD_D_INNER), 0.1)
    inp['rwkv_mu'] = unif((NA, RWKV_COLS), 0.0, 1.0)
    inp['rwkv_w0'] = nrm((NA, RWKV_DIM), 0.5)
    inp['rwkv_w2'] = nrm((NA, RWKV_W_RANK, RWKV_DIM), RWKV_W_RANK ** -0.5)
    inp['rwkv_a0'] = nrm((NA, RWKV_DIM), 0.1)
    inp['rwkv_a2'] = nrm((NA, RWKV_A_RANK, RWKV_DIM), RWKV_A_RANK ** -0.5)
    inp['rwkv_g2'] = nrm((NA, RWKV_G_RANK, RWKV_DIM), RWKV_G_RANK ** -0.5)
    inp['rwkv_k_k'] = 0.85 + nrm((NA, RWKV_DIM), 0.05)
    inp['rwkv_k_a'] = 1.0 + nrm((NA, RWKV_DIM), 0.05)
    inp['rwkv_r_k'] = nrm((NA, RWKV_HEADS, RWKV_HEAD_DIM), 0.1)
    inp['rwkv_ln_w'] = 1.0 + nrm((NA, RWKV_DIM), 0.1)
    inp['rwkv_ln_b'] = nrm((NA, RWKV_DIM), 0.02)
    inp['att_w_qkv'] = nrm((NC, D_MODEL, ATT_QKV_COLS), D_MODEL ** -0.5)
    inp['att_w_out'] = nrm((NC, ATT_DIM, D_MODEL), ATT_DIM ** -0.5)
    return inp


def reference(x_prompt, x_sample, state_ssd, state_ssd_conv, state_wkv, state_wkv_shift,
              cache_win0, cache_win1, cache_win2, c_prompt, c_sample,
              norm_mix, norm_mlp, norm_final, ada_w, ada_b, mlp_w1, mlp_w2,
              hyb_w_in, hyb_w_out, ssd_conv_w, ssd_conv_b, ssd_dt_bias, ssd_a_log, ssd_d,
              ssd_norm_w, rwkv_mu, rwkv_w0, rwkv_w2, rwkv_a0, rwkv_a2, rwkv_g2, rwkv_k_k,
              rwkv_k_a, rwkv_r_k, rwkv_ln_w, rwkv_ln_b, att_w_qkv, att_w_out):

    def run_group(x, c, ssd_st, conv_st, wkv_st, shift_st, wins, pos0, keep_lens):
        ssd_new, conv_new, wkv_new, shift_new = [], [], [], []
        win_new = [[] for _ in ATT_GROUPS]
        for l in range(DEPTH):
            mod = jax.nn.silu(c) @ ada_w[l] + ada_b[l]
            sh1, sc1, gt1, sh2, sc2, gt2 = jnp.split(mod, N_MOD, axis=-1)
            h = modulate(x, norm_mix[l], sh1, sc1)
            i = l // 2
            if l % 2 == 0:
                out, s_ssd, s_conv, s_wkv, s_shift = hybrid_mixer(
                    h, ssd_st[i], conv_st[i], wkv_st[i], shift_st[i], hyb_w_in[i], hyb_w_out[i],
                    ssd_conv_w[i], ssd_conv_b[i], ssd_dt_bias[i], ssd_a_log[i], ssd_d[i],
                    ssd_norm_w[i], rwkv_mu[i], rwkv_w0[i], rwkv_w2[i], rwkv_a0[i], rwkv_a2[i],
                    rwkv_g2[i], rwkv_k_k[i], rwkv_k_a[i], rwkv_r_k[i], rwkv_ln_w[i], rwkv_ln_b[i])
                ssd_new.append(s_ssd)
                conv_new.append(s_conv)
                wkv_new.append(s_wkv)
                shift_new.append(s_shift)
            else:
                out, bufs = dilated_mixer(h, pos0, [w[i] for w in wins], keep_lens,
                                          att_w_qkv[i], att_w_out[i])
                for g, bnew in enumerate(bufs):
                    win_new[g].append(bnew)
            x = x + gt1[:, None, :] * out
            h = modulate(x, norm_mlp[l], sh2, sc2)
            x = x + gt2[:, None, :] * (jnp.square(jax.nn.relu(h @ mlp_w1[l])) @ mlp_w2[l])
        y = rmsnorm(x, norm_final)
        return (y, jnp.stack(ssd_new), jnp.stack(conv_new), jnp.stack(wkv_new),
                jnp.stack(shift_new), jnp.stack(win_new[0]), jnp.stack(win_new[1]),
                jnp.stack(win_new[2]))

    bp, lp = x_prompt.shape[0], x_prompt.shape[1]
    dtp = x_prompt.dtype
    zs_ssd = jnp.zeros((N_A_LAYERS, bp, SSD_HEADS, SSD_HEAD_DIM, SSD_STATE), dtp)
    zs_conv = jnp.zeros((N_A_LAYERS, bp, SSD_CONV - 1, SSD_CONV_DIM), dtp)
    zs_wkv = jnp.zeros((N_A_LAYERS, bp, RWKV_HEADS, RWKV_HEAD_DIM, RWKV_HEAD_DIM), dtp)
    zs_shift = jnp.zeros((N_A_LAYERS, bp, RWKV_COLS), dtp)
    zs_wins = [jnp.zeros((N_C_LAYERS, bp, 0, 2, ATT_HEADS, ATT_HEAD_DIM), dtp) for _ in ATT_GROUPS]
    keep_p = tuple(min(w, lp) for w, _ in ATT_GROUPS)
    keep_s = (cache_win0.shape[2], cache_win1.shape[2], cache_win2.shape[2])

    y_p, ssd_p, conv_p, wkv_p, shift_p, win0_p, win1_p, win2_p = run_group(
        x_prompt, c_prompt, zs_ssd, zs_conv, zs_wkv, zs_shift, zs_wins, 0, keep_p)
    y_s, ssd_s, conv_s, wkv_s, shift_s, win0_s, win1_s, win2_s = run_group(
        x_sample, c_sample, state_ssd, state_ssd_conv, state_wkv, state_wkv_shift,
        [cache_win0, cache_win1, cache_win2], PAST_LEN, keep_s)
    return (y_p, y_s, ssd_p, ssd_s, conv_p, conv_s, wkv_p, wkv_s, shift_p, shift_s,
            win0_p, win0_s, win1_p, win1_s, win2_p, win2_s)
```

```cpp
#include <hip/hip_runtime.h>
#include <cstdio>
#include <cstdint>
#include <cstring>
namespace pg8 {
#define PG8_LAS __attribute__((address_space(3)))
typedef unsigned short bf16_t;
typedef short bf16x8 __attribute__((ext_vector_type(8)));
typedef float f32x4 __attribute__((ext_vector_type(4)));
typedef unsigned u32x4 __attribute__((ext_vector_type(4)));
constexpr int BM = 256, BK = 64, HALF = 128, HTB = HALF * BK * 2  , STAGE_BYTES = 8 * HTB, NXCD = 8, WGM = 8;

__host__ __device__ __forceinline__ int lds_byte(int r, int c) { const int st = (r >> 4) * 2 + (c >> 5), rr = r & 15, cc = c & 31, ob = rr * 64 + cc * 2; return st * 1024 + (ob ^ (((ob >> 9) & 1) << 5)); }
__host__ __device__ __forceinline__ void stage_rc(int b, int& R, int& C) { const int st = b / 1024, sb = b % 1024, swz = sb ^ (((sb >> 9) & 1) << 5); R = (st >> 1) * 16 + swz / 64; C = (st & 1) * 32 + (swz % 64) / 2; }
__host__ __device__ __forceinline__ int perm32(int rho) { const int n = rho >> 4, i = rho & 15; return 8 * (i >> 2) + 4 * n + (i & 3); }

struct Unit { int pm, pn; };
struct Gemm { const bf16_t* A; const bf16_t* Bt; int M, N, K; };

struct StaticOrder {
    int nM, nN, nwg, G, c;
    __host__ __device__ void init(int M, int N, int G_, int c_) { nM = M / BM; nN = N / BM; nwg = nM * nN; G = G_; c = c_; }
    __host__ __device__ bool next(int i, Unit& u) const {
        const long L = (long)i * G + c; if (L >= nwg) return false;
        int wgid = (int)L; { const int q = nwg / NXCD, r = nwg % NXCD, xcd = wgid % NXCD, off = wgid / NXCD; wgid = (xcd < r ? xcd * (q + 1) : r * (q + 1) + (xcd - r) * q) + off; }
        const int nig = WGM * nN, gid = wgid / nig, fm = gid * WGM, gsz = (nM - fm) < WGM ? (nM - fm) : WGM;
        u.pm = fm + ((wgid % nig) % gsz); u.pn = (wgid % nig) / gsz; return true;
    }
    __device__ __forceinline__ void a_ready(const Unit&) const {}
    __device__ __forceinline__ void done(const Unit&) const {}
};
template <class Epi, class Sched, bool STAMP = false>
__device__ __forceinline__ void gemm_phase(PG8_LAS unsigned char* lds, const Gemm g, const Sched& S, const Epi& E, unsigned long long* stamps) {
    int tid_ = threadIdx.x; asm volatile("" : "+v"(tid_));
    const int tid = tid_, wid = __builtin_amdgcn_readfirstlane(tid >> 6), lane = tid & 63, wr = wid >> 2, wc = wid & 3, fr = lane & 15, fq = lane >> 4;
    const int K = g.K, nt = K / BK;
    int ts_lo = 0, ts_hi = 0, nts = 0; const unsigned long long rt_entry = STAMP ? (unsigned long long)wall_clock64() : 0ull;
#define PG8_STAMP() do { if (STAMP && wid == 0 && nts < 64) { const unsigned long long _c = (unsigned long long)clock64(); \
        ts_lo = (lane == nts) ? (int)(unsigned)_c : ts_lo; ts_hi = (lane == nts) ? (int)(unsigned)(_c >> 32) : ts_hi; ++nts; } } while (0)
    PG8_STAMP();
    unsigned voffA[2], voffB[2];
#pragma unroll
    for (int i = 0; i < 2; ++i) { int R, C; stage_rc(tid * 16 + i * 8192, R, C); const int Rb = Epi::PERM ? ((R & ~31) + perm32(R & 31)) : R;
        voffA[i] = (unsigned)(R * K + C) * 2u; voffB[i] = (unsigned)(Rb * K + C) * 2u; }
    const size_t kstep = (size_t)(BK * 2);
    const size_t hstep = (size_t)HALF * K * 2;
    const size_t tstep = 2 * hstep;
    const unsigned ldsw = (unsigned)wid * 1024u;
    const int aoff = lds_byte(wr * 64 + fr, fq * 8), boff = lds_byte(wc * 32 + fr, fq * 8);
#define PG8_SA(b, h) (((b) * 2 + (h)) * HTB)
#define PG8_SB(b, h) ((4 + (b) * 2 + (h)) * HTB)
#define PG8_STAGE(bufoff, gbase, voff) do { _Pragma("unroll") for (int _i = 0; _i < 2; ++_i) \
        __builtin_amdgcn_global_load_lds((const unsigned*)((const char*)(gbase) + (voff)[_i]), (PG8_LAS unsigned*)(lds + (bufoff) + ldsw + _i * 8192), 16, 0, 0); } while (0)
#define PG8_LDA(dst, b, h) do { _Pragma("unroll") for (int m = 0; m < 4; ++m) _Pragma("unroll") for (int k = 0; k < 2; ++k) dst[m][k] = *(const PG8_LAS bf16x8*)(lds + PG8_SA(b, h) + aoff + m * 2048 + k * 1024); } while (0)
#define PG8_LDB(dst, b, h) do { _Pragma("unroll") for (int n = 0; n < 2; ++n) _Pragma("unroll") for (int k = 0; k < 2; ++k) dst[n][k] = *(const PG8_LAS bf16x8*)(lds + PG8_SB(b, h) + boff + n * 2048 + k * 1024); } while (0)
#define PG8_MMA(ai, bj, At, Bt) do { __builtin_amdgcn_s_setprio(1); _Pragma("unroll") for (int m = 0; m < 4; ++m) _Pragma("unroll") for (int n = 0; n < 2; ++n) _Pragma("unroll") for (int k = 0; k < 2; ++k) \
        acc[ai][bj][m][n] = __builtin_amdgcn_mfma_f32_16x16x32_bf16(Bt[n][k], At[m][k], acc[ai][bj][m][n], 0, 0, 0); __builtin_amdgcn_s_setprio(0); } while (0)
#define PG8_WAIT_V(n) asm volatile("s_waitcnt vmcnt(" #n ")" ::: "memory")
#define PG8_WAIT_L(n) asm volatile("s_waitcnt lgkmcnt(" #n ")" ::: "memory")
#define PG8_BAR __builtin_amdgcn_s_barrier()
#define PG8_SCHED __builtin_amdgcn_sched_barrier(0)
    Unit cur, nxt; int ui = 0;
    if (!S.next(0, cur)) return;
    f32x4 acc[2][2][4][2];
#pragma unroll
    for (int a = 0; a < 2; ++a)
#pragma unroll
        for (int b = 0; b < 2; ++b)
#pragma unroll
            for (int m = 0; m < 4; ++m)
#pragma unroll
                for (int n = 0; n < 2; ++n) acc[a][b][m][n] = (f32x4){0.f, 0.f, 0.f, 0.f};
    bf16x8 At[4][2], B0[2][2], B1[2][2];
    const char* cA = (const char*)g.A + (size_t)cur.pm * tstep; const char* cB = (const char*)g.Bt + (size_t)cur.pn * tstep;
    S.a_ready(cur);
    PG8_STAGE(PG8_SB(0, 0), cB, voffB); PG8_STAGE(PG8_SA(0, 0), cA, voffA); PG8_STAGE(PG8_SB(0, 1), cB + hstep, voffB); PG8_STAGE(PG8_SA(0, 1), cA + hstep, voffA);
    if (wr == 1) PG8_BAR;
    PG8_WAIT_V(4); PG8_BAR;
    PG8_STAGE(PG8_SB(1, 0), cB + kstep, voffB); PG8_STAGE(PG8_SA(1, 0), cA + kstep, voffA); PG8_STAGE(PG8_SB(1, 1), cB + hstep + kstep, voffB);
    PG8_WAIT_V(6); PG8_BAR;
    PG8_STAMP();
    for (;;) {
        const bool has_next = S.next(ui + 1, nxt);
        const char* nA = has_next ? (const char*)g.A + (size_t)nxt.pm * tstep : cA; const char* nB = has_next ? (const char*)g.Bt + (size_t)nxt.pn * tstep : cB;
        for (int t = 0; t < nt; t += 2) {
            const bool last = (t == nt - 2);
            const char* a1 = cA + (size_t)(t + 1) * kstep;
            const char* a2 = last ? nA : cA + (size_t)(t + 2) * kstep; const char* b2 = last ? nB : cB + (size_t)(t + 2) * kstep;
            const char* a3 = a2 + kstep; const char* b3 = b2 + kstep;
            if (last && has_next) S.a_ready(nxt);
            PG8_LDB(B0, 0, 0); PG8_SCHED; PG8_LDA(At, 0, 0); PG8_STAGE(PG8_SA(1, 1), a1 + hstep, voffA);
            PG8_WAIT_L(8); PG8_BAR; PG8_WAIT_L(0); PG8_MMA(0, 0, At, B0); PG8_BAR; PG8_SCHED;
            PG8_LDB(B1, 0, 1); PG8_STAGE(PG8_SB(0, 0), b2, voffB);
            PG8_BAR; PG8_WAIT_L(0); PG8_MMA(0, 1, At, B1); PG8_BAR;
            PG8_LDA(At, 0, 1); PG8_STAGE(PG8_SA(0, 0), a2, voffA);
            PG8_BAR; PG8_WAIT_L(0); PG8_MMA(1, 0, At, B0); PG8_BAR; PG8_SCHED;
            PG8_STAGE(PG8_SB(0, 1), b2 + hstep, voffB);
            PG8_WAIT_V(6); PG8_BAR; PG8_MMA(1, 1, At, B1); PG8_BAR;
            PG8_LDB(B0, 1, 0); PG8_SCHED; PG8_LDA(At, 1, 0); PG8_STAGE(PG8_SA(0, 1), a2 + hstep, voffA);
            PG8_WAIT_L(8); PG8_BAR; PG8_WAIT_L(0); PG8_MMA(0, 0, At, B0); PG8_BAR; PG8_SCHED;
            PG8_LDB(B1, 1, 1); PG8_STAGE(PG8_SB(1, 0), b3, voffB);
            PG8_BAR; PG8_WAIT_L(0); PG8_MMA(0, 1, At, B1); PG8_BAR;
            PG8_LDA(At, 1, 1); PG8_STAGE(PG8_SA(1, 0), a3, voffA);
            PG8_BAR; PG8_WAIT_L(0); PG8_MMA(1, 0, At, B0); PG8_BAR; PG8_SCHED;
            PG8_STAGE(PG8_SB(1, 1), b3 + hstep, voffB);
            PG8_WAIT_V(6); PG8_BAR; PG8_MMA(1, 1, At, B1); PG8_BAR;
        }
        PG8_STAMP();
        if constexpr (!Epi::AFTER_DRAIN) { E(acc, cur, wr, wc, fr, fq); S.done(cur); }
        PG8_STAMP();
        if (!has_next) break;
#pragma unroll
        for (int a = 0; a < 2; ++a)
#pragma unroll
            for (int b = 0; b < 2; ++b)
#pragma unroll
                for (int m = 0; m < 4; ++m)
#pragma unroll
                    for (int n = 0; n < 2; ++n) acc[a][b][m][n] = (f32x4){0.f, 0.f, 0.f, 0.f};
        cur = nxt; cA = nA; cB = nB; ++ui;
    }
    PG8_WAIT_V(0);
    if (wr == 0) PG8_BAR;
    PG8_BAR;
    if constexpr (Epi::AFTER_DRAIN) { E.fused(acc, cur, wr, wc, fr, fq, lds, wid, lane); S.done(cur); }
    PG8_STAMP();
    if (STAMP && wid == 0) { stamps[lane] = lane < nts ? (((unsigned long long)(unsigned)ts_hi << 32) | (unsigned)ts_lo) : 0ull;
        if (lane == 62) stamps[62] = rt_entry; if (lane == 63) stamps[63] = (unsigned long long)wall_clock64(); }
#undef PG8_STAMP
#undef PG8_SA
#undef PG8_SB
#undef PG8_STAGE
#undef PG8_LDA
#undef PG8_LDB
#undef PG8_MMA
#undef PG8_WAIT_V
#undef PG8_WAIT_L
#undef PG8_BAR
#undef PG8_SCHED
}
}
#define XB_TMO      128
#define XB_XCNT(j)  (256  + 64 * (j))
#define XB_XSUB(j)  (1280 + 64 * (j))
#define XB_XGEN(j)  (2304 + 64 * (j))
#define XB_TOP      3328
#define XB_TOPGEN   3392
#define XCD_BAR_WORDS 3456
#define XB_SPIN_CAP (1u << 18)
#define LAS __attribute__((address_space(3)))

__device__ __forceinline__ unsigned xb_ld(unsigned* p)              { return __hip_atomic_load(p, __ATOMIC_RELAXED, __HIP_MEMORY_SCOPE_AGENT); }
__device__ __forceinline__ unsigned xb_add(unsigned* p, unsigned v) { return __hip_atomic_fetch_add(p, v, __ATOMIC_RELAXED, __HIP_MEMORY_SCOPE_AGENT); }
__device__ __forceinline__ unsigned xb_xcc_id() { return (unsigned)__builtin_amdgcn_s_getreg((3 << 11) | 20) & 0xFu; }
#define XB_SPIN(cond, bar) do { unsigned _sp = 0; while (cond) { __builtin_amdgcn_s_sleep(1); \
    if ((++_sp & 255u) == 0u) { if (xb_ld(&(bar)[XB_TMO])) break; if (_sp > XB_SPIN_CAP) { atomicAdd(&(bar)[XB_TMO], 1u); break; } } } } while (0)

struct XcdBarrier {
    unsigned* bar; unsigned x;
    volatile LAS unsigned* st;
};

__device__ __forceinline__ XcdBarrier xcd_barrier_post(unsigned* bar, volatile LAS unsigned* st) {
    XcdBarrier b; b.bar = bar; b.x = xb_xcc_id(); b.st = st;
    if (threadIdx.x == 0) (void)xb_add(&bar[XB_XCNT(b.x)], 1u);
    return b;
}
__device__ __forceinline__ void xcd_barrier_complete(unsigned* bar, unsigned x, unsigned& nloc, unsigned& nx) {
    const unsigned G = gridDim.x * gridDim.y * gridDim.z;
    unsigned sum, cnt, mine, sp = 0u;
    for (;;) {
        sum = 0u; cnt = 0u; mine = 0u;
#pragma unroll
        for (unsigned j = 0; j < 16; ++j) { const unsigned c = xb_ld(&bar[XB_XCNT(j)]); sum += c; cnt += (c > 0u) ? 1u : 0u; mine = (j == x) ? c : mine; }
        if (sum == G) break;
        __builtin_amdgcn_s_sleep(1);
        if ((++sp & 255u) == 0u) { if (xb_ld(&bar[XB_TMO])) break; if (sp > XB_SPIN_CAP) { atomicAdd(&bar[XB_TMO], 1u); break; } }
    }
    nloc = mine > 0u ? mine : 1u; nx = cnt > 0u ? cnt : 1u;
}

__device__ __forceinline__ void xcd_barrier(const XcdBarrier& b) {
    asm volatile("s_waitcnt vmcnt(0)" ::: "memory");
    __syncthreads();
    if (threadIdx.x == 0) {
        unsigned* bar = b.bar;
        __builtin_amdgcn_s_waitcnt(0);
        unsigned nloc = b.st[0], nx = b.st[1];
        if (nloc == 0u) { xcd_barrier_complete(bar, b.x, nloc, nx); b.st[0] = nloc; b.st[1] = nx; }
        const unsigned old = xb_add(&bar[XB_XSUB(b.x)], 1u);
        const unsigned gen = old / nloc;
        if (old + 1u == (gen + 1u) * nloc) {
            __builtin_amdgcn_fence(__ATOMIC_RELEASE, "agent");
            asm volatile("s_waitcnt vmcnt(0)" ::: "memory");
            const unsigned og = xb_add(&bar[XB_TOP], 1u);
            const unsigned tg = og / nx;
            if (og + 1u == (tg + 1u) * nx) xb_add(&bar[XB_TOPGEN], 1u);
            else XB_SPIN(xb_ld(&bar[XB_TOPGEN]) == tg, bar);
            __builtin_amdgcn_fence(__ATOMIC_ACQUIRE, "agent");
            xb_add(&bar[XB_XGEN(b.x)], 1u);
            asm volatile("s_waitcnt vmcnt(0)" ::: "memory");
        } else {
            XB_SPIN(xb_ld(&bar[XB_XGEN(b.x)]) == gen, bar);
            __builtin_amdgcn_fence(__ATOMIC_ACQUIRE, "agent");
            asm volatile("s_waitcnt vmcnt(0)" ::: "memory");
        }
    }
    __syncthreads();
}

namespace mk {
#define LAS __attribute__((address_space(3)))
typedef unsigned short bf16;
typedef short bf16x8 __attribute__((ext_vector_type(8)));
typedef float f32x4 __attribute__((ext_vector_type(4)));
typedef float f32x2 __attribute__((ext_vector_type(2)));
typedef float f32x16 __attribute__((ext_vector_type(16)));
typedef unsigned u32x4 __attribute__((ext_vector_type(4)));
typedef unsigned u32x2 __attribute__((ext_vector_type(2)));

constexpr int T = 16384, SEQ = 8192, NS = 32, D = 1024, NSEQ = 34, NT = 512;
constexpr int HYB_NP = 6144, HYB_N = 5904, QKV_N = 4608, FF = 4096;
constexpr int U_XBC = 1024, U_DT = 2560, U_RW = 2576, RWC = 3328;
constexpr float EPS = 1e-6f, LN_EPS = 64e-5f;
constexpr size_t MiB = 1u << 20;
constexpr size_t WS_CTL = 0, CTL_BYTES = MiB;
constexpr size_t WS_WIN = 2 * MiB, WS_WOUT = 26 * MiB, WS_WQKV = 34 * MiB, WS_WAO = 52 * MiB, WS_W1 = 54 * MiB, WS_W2 = 86 * MiB, WS_LORA = 118 * MiB;
constexpr size_t WS_MOD = 119 * MiB, WS_ROPE = 123 * MiB, WS_SMALL = 124 * MiB, WS_X = 128 * MiB, WS_XN = 193 * MiB, WS_U = 226 * MiB;
constexpr size_t WS_DT = 418 * MiB, WS_DTS = 419 * MiB, WS_ACS = 420 * MiB, WS_REC = 421 * MiB, WS_G = 805 * MiB, WS_XT = 837 * MiB, WS_BC = 869 * MiB;
constexpr size_t WS_CS = 885 * MiB, WS_QO = 949 * MiB, WS_SL = 1077 * MiB, WS_SST = 1141 * MiB, WS_YCAT = 1173 * MiB, WS_QKV = 1238 * MiB;
constexpr size_t WS_OG = 1382 * MiB, WS_LSE = 1430 * MiB, WS_AO = 1432 * MiB, WS_HID = 1449 * MiB, WS_END = 1578 * MiB;
constexpr size_t O_YP = 0, O_YS = O_YP + (size_t)T * D, O_SSDP = O_YS + 32 * 1024, O_SSDS = O_SSDP + 2 * 2 * 16 * 8192, O_CONVP = O_SSDS + (size_t)2 * 32 * 16 * 8192;
constexpr size_t O_CONVS = O_CONVP + 2 * 2 * 3 * 1536, O_WKVP = O_CONVS + 2 * 32 * 3 * 1536, O_WKVS = O_WKVP + 2 * 2 * 16 * 4096, O_SHP = O_WKVS + (size_t)2 * 32 * 16 * 4096;
constexpr size_t O_SHS = O_SHP + 2 * 2 * 3328, O_W0P = O_SHS + 2 * 32 * 3328, O_W0S = O_W0P + (size_t)2 * 2 * 128 * 1024, O_W1P = O_W0S + (size_t)2 * 32 * 128 * 1024;
constexpr size_t O_W1S = O_W1P + (size_t)2 * 2 * 512 * 1024, O_W2P = O_W1S + (size_t)2 * 32 * 512 * 1024, O_W2S = O_W2P + (size_t)2 * 2 * 2048 * 1024;
constexpr size_t O_END = O_W2S + (size_t)2 * 32 * 2048 * 1024;
static_assert(O_END == 217889792ull, "output size");
constexpr int LDS_RING = 131072, LDS_MISC = LDS_RING + 320, LDS_BYTES = 147456;

struct Params { const float* in[39]; float* out; unsigned char* ws; };

__device__ __forceinline__ unsigned pk2(float lo, float hi) { unsigned r; asm volatile("v_cvt_pk_bf16_f32 %0, %1, %2" : "=v"(r) : "v"(lo), "v"(hi)); return r; }
__device__ __forceinline__ float bflo(unsigned u) { return __uint_as_float(u << 16); }
__device__ __forceinline__ float bfhi(unsigned u) { return __uint_as_float(u & 0xffff0000u); }
__device__ __forceinline__ float bf1(bf16 h) { return __uint_as_float(((unsigned)h) << 16); }
__device__ __forceinline__ f32x4 bf4(u32x2 v) { return (f32x4){bflo(v.x), bfhi(v.x), bflo(v.y), bfhi(v.y)}; }
__device__ __forceinline__ u32x2 pk4(f32x4 v) { u32x2 r; r.x = pk2(v[0], v[1]); r.y = pk2(v[2], v[3]); return r; }
__device__ __forceinline__ float siluf_(float x) { return x / (1.f + __expf(-x)); }
__device__ __forceinline__ float sigm_(float x) { return 1.f / (1.f + __expf(-x)); }
__device__ __forceinline__ float softplus_(float x) { return fmaxf(x, 0.f) + log1pf(__expf(-fabsf(x))); }
__device__ __forceinline__ float wave_sum(float v) {
#pragma unroll
    for (int o = 1; o < 64; o <<= 1) v += __shfl_xor(v, o);
    return v;
}
__device__ __forceinline__ float wave_max(float v) {
#pragma unroll
    for (int o = 1; o < 64; o <<= 1) v = fmaxf(v, __shfl_xor(v, o));
    return v;
}
__device__ __forceinline__ f32x4 mfma16(bf16x8 a, bf16x8 b, f32x4 c) { return __builtin_amdgcn_mfma_f32_16x16x32_bf16(a, b, c, 0, 0, 0); }
#define LDSW() asm volatile("s_waitcnt lgkmcnt(0)" ::: "memory")

#define CAS __attribute__((address_space(4)))
struct Ctx {
    LAS unsigned char* lds; int tid, lane, wave, G, bid;
    const CAS Params* PP;
};
#define WSP(type, off) ((type*)((C.PP->ws) + (off)))
#define INP(i) (C.PP->in[i])
enum { I_XP = 0, I_XS, I_SSD, I_CONV, I_WKV, I_SHIFT, I_C0, I_C1, I_C2, I_CP, I_CS, I_NMIX, I_NMLP, I_NFIN, I_ADAW, I_ADAB, I_W1, I_W2, I_HIN, I_HOUT, I_CONVW, I_CONVB,
       I_DTB, I_ALOG, I_SSDD, I_SNW, I_MU, I_RW0, I_RW2, I_RA0, I_RA2, I_RG2, I_KK, I_KA, I_RK, I_LNW, I_LNB, I_AQKV, I_AOUT };

__device__ __forceinline__ void transpose_item(const float* W, int K, int N, bf16* WT, LAS float* scr, int item, int lane) {
    const int nblk = (N + 31) / 32, kb = item / nblk, nb = item % nblk, k0 = 64 * kb, n0 = 32 * nb;
    const int nn = n0 + (lane & 31);
#pragma unroll 8
    for (int i = 0; i < 32; ++i) { const int kk = 2 * i + (lane >> 5); scr[kk * 33 + (lane & 31)] = nn < N ? W[(size_t)(k0 + kk) * N + nn] : 0.f; }
    LDSW();
    const int c = lane & 7;
#pragma unroll
    for (int j = 0; j < 4; ++j) { const int n = (lane >> 3) + 8 * j; const LAS float* s = scr + (8 * c) * 33 + n;
        u32x4 o; o.x = pk2(s[0 * 33], s[1 * 33]); o.y = pk2(s[2 * 33], s[3 * 33]); o.z = pk2(s[4 * 33], s[5 * 33]); o.w = pk2(s[6 * 33], s[7 * 33]);
        *(u32x4*)(WT + (size_t)(n0 + n) * K + k0 + 8 * c) = o; }
    LDSW();
}

__device__ __forceinline__ void p0_weights(const Ctx& C) {
    LAS float* scr = (LAS float*)(C.lds + C.wave * 16384);
    const int gw = C.bid * 8 + C.wave, NGW = C.G * 8;
    constexpr int N_IN = 16 * 185, N_OUT = 32 * 32, N_QKV = 16 * 144, N_AO = 8 * 32, N_1 = 16 * 128, N_2 = 64 * 32, N_L64 = 32, N_L128 = 64;
    constexpr int TOTAL = 2 * N_IN + 2 * N_OUT + 2 * N_QKV + 2 * N_AO + 4 * N_1 + 4 * N_2 + 2 * (2 * N_L64 + N_L128);
    for (int it = gw; it < TOTAL; it += NGW) {
        int r = it;
        if (r < 2 * N_IN) { const int i = r / N_IN; transpose_item(INP(I_HIN) + (size_t)i * 1024 * HYB_N, 1024, HYB_N, WSP(bf16, WS_WIN) + (size_t)i * HYB_NP * 1024, scr, r % N_IN, C.lane); continue; } r -= 2 * N_IN;
        if (r < 2 * N_OUT) { const int i = r / N_OUT; transpose_item(INP(I_HOUT) + (size_t)i * 2048 * 1024, 2048, 1024, WSP(bf16, WS_WOUT) + (size_t)i * 1024 * 2048, scr, r % N_OUT, C.lane); continue; } r -= 2 * N_OUT;
        if (r < 2 * N_QKV) { const int i = r / N_QKV; transpose_item(INP(I_AQKV) + (size_t)i * 1024 * QKV_N, 1024, QKV_N, WSP(bf16, WS_WQKV) + (size_t)i * QKV_N * 1024, scr, r % N_QKV, C.lane); continue; } r -= 2 * N_QKV;
        if (r < 2 * N_AO) { const int i = r / N_AO; transpose_item(INP(I_AOUT) + (size_t)i * 512 * 1024, 512, 1024, WSP(bf16, WS_WAO) + (size_t)i * 1024 * 512, scr, r % N_AO, C.lane); continue; } r -= 2 * N_AO;
        if (r < 4 * N_1) { const int i = r / N_1; transpose_item(INP(I_W1) + (size_t)i * 1024 * FF, 1024, FF, WSP(bf16, WS_W1) + (size_t)i * FF * 1024, scr, r % N_1, C.lane); continue; } r -= 4 * N_1;
        if (r < 4 * N_2) { const int i = r / N_2; transpose_item(INP(I_W2) + (size_t)i * FF * 1024, FF, 1024, WSP(bf16, WS_W2) + (size_t)i * 1024 * FF, scr, r % N_2, C.lane); continue; } r -= 4 * N_2;
        { const int i = r / (2 * N_L64 + N_L128); int q = r % (2 * N_L64 + N_L128); bf16* lb = WSP(bf16, WS_LORA) + (size_t)i * 262144;
          if (q < N_L64) { transpose_item(INP(I_RW2) + (size_t)i * 64 * 1024, 64, 1024, lb, scr, q, C.lane); continue; } q -= N_L64;
          if (q < N_L64) { transpose_item(INP(I_RA2) + (size_t)i * 64 * 1024, 64, 1024, lb + 65536, scr, q, C.lane); continue; } q -= N_L64;
          transpose_item(INP(I_RG2) + (size_t)i * 128 * 1024, 128, 1024, lb + 131072, scr, q, C.lane); }
    }
    const int gt = C.bid * NT + C.tid, NGT = C.G * NT;
    for (int i = gt; i < 2 * 224 * 128; i += NGT) { const int l = i / (224 * 128), r = i % (224 * 128); ((u32x4*)(WSP(bf16, WS_WIN) + (size_t)l * HYB_NP * 1024 + (size_t)5920 * 1024))[r] = (u32x4){0u, 0u, 0u, 0u}; }
    for (int i = gt; i < 8193 * 8; i += NGT) { const int t = i >> 3, k = i & 7; const double inv = pow(500000.0, -(double)k / 8.0), ang = (double)t * inv;
        WSP(float, WS_ROPE)[t * 16 + k] = (float)cos(ang); WSP(float, WS_ROPE)[t * 16 + 8 + k] = (float)sin(ang); }
}

__device__ __forceinline__ void p0_cache_roll(const Ctx& C) {
    const size_t gt = (size_t)C.bid * NT + C.tid, NGT = (size_t)C.G * NT;
#pragma unroll
    for (int g = 0; g < 3; ++g) {
        const int W = 128 << (2 * g); const size_t per = (size_t)(W - 1) * 256, tot = 64 * per;
        const f32x4* src = (const f32x4*)INP(I_C0 + g); f32x4* dst = (f32x4*)((C.PP->out) + (g == 0 ? O_W0S : g == 1 ? O_W1S : O_W2S));
        for (size_t i = gt; i < tot; i += NGT) { const size_t ib = i / per, rem = i - ib * per; const f32x4 v = __builtin_nontemporal_load(src + (ib * W + 1) * 256 + rem); __builtin_nontemporal_store(v, dst + ib * W * 256 + rem); }
    }
}

__device__ __forceinline__ void p0_mod(const Ctx& C) {
    LAS f32x4* red = (LAS f32x4*)C.lds;
    const int q = C.lane >> 4, i = C.lane & 15;
    for (int u = C.bid; u < 384; u += C.G) {
        const int l = u / 96, n0 = (u % 96) * 64;
        const float* W = INP(I_ADAW) + (size_t)l * 1024 * 6144;
        f32x4 acc[3][4];
#pragma unroll
        for (int t = 0; t < 3; ++t)
#pragma unroll
            for (int n = 0; n < 4; ++n) acc[t][n] = (f32x4){0.f, 0.f, 0.f, 0.f};
        for (int kg = 0; kg < 8; ++kg) {
            const int k0 = 128 * C.wave + 16 * kg + 4 * q;
            f32x4 av[3], wv[4];
#pragma unroll
            for (int t = 0; t < 3; ++t) { const int s = 16 * t + i; av[t] = (f32x4){0.f, 0.f, 0.f, 0.f};
                if (s < NSEQ) { const float* cp = s < 2 ? INP(I_CP) + s * 1024 : INP(I_CS) + (s - 2) * 1024; const f32x4 v = *(const f32x4*)(cp + k0);
                    av[t] = (f32x4){siluf_(v[0]), siluf_(v[1]), siluf_(v[2]), siluf_(v[3])}; } }
#pragma unroll
            for (int m = 0; m < 4; ++m) wv[m] = *(const f32x4*)(W + (size_t)(k0 + m) * 6144 + n0 + 4 * i);
#pragma unroll
            for (int m = 0; m < 4; ++m)
#pragma unroll
                for (int t = 0; t < 3; ++t)
#pragma unroll
                    for (int n = 0; n < 4; ++n) acc[t][n] = __builtin_amdgcn_mfma_f32_16x16x4f32(av[t][m], wv[m][n], acc[t][n], 0, 0, 0);
        }
#pragma unroll
        for (int t = 0; t < 3; ++t)
#pragma unroll
            for (int r = 0; r < 4; ++r) red[(C.wave * 12 + t * 4 + r) * 64 + C.lane] = (f32x4){acc[t][0][r], acc[t][1][r], acc[t][2][r], acc[t][3][r]};
        __syncthreads();
        for (int e = C.tid; e < 768; e += NT) { const int slot = e >> 6, ln = e & 63; f32x4 s = red[slot * 64 + ln];
#pragma unroll
            for (int w = 1; w < 8; ++w) s += red[(w * 12 + slot) * 64 + ln];
            const int srow = 16 * (slot >> 2) + 4 * (ln >> 4) + (slot & 3), n = n0 + 4 * (ln & 15);
            if (srow < NSEQ) *(f32x4*)(WSP(float, WS_MOD) + ((size_t)l * NSEQ + srow) * 6144 + n) = s + *(const f32x4*)(INP(I_ADAB) + l * 6144 + n); }
        __syncthreads();
    }
}

__device__ __forceinline__ void norm_phase(const Ctx& C, int l, int which, bool from_input) {
    const int gw = C.bid * 8 + C.wave, NGW = C.G * 8;
    const float* g = INP(which ? I_NMLP : I_NMIX) + l * 1024;
    const int off_sh = which ? 3072 : 0, off_sc = which ? 4096 : 1024;
    for (int row = gw; row < T + NS; row += NGW) {
        const float* xr = from_input ? (row < T ? INP(I_XP) + (size_t)row * D : INP(I_XS) + (size_t)(row - T) * D) : WSP(float, WS_X) + (size_t)row * D;
        const int s = row < T ? (row >> 13) : 2 + row - T;
        const float* mod = WSP(float, WS_MOD) + ((size_t)l * NSEQ + s) * 6144;
        f32x4 v[4]; float ss = 0.f;
#pragma unroll
        for (int j = 0; j < 4; ++j) { v[j] = *(const f32x4*)(xr + 4 * C.lane + 256 * j); ss += (v[j][0] * v[j][0] + v[j][1] * v[j][1]) + (v[j][2] * v[j][2] + v[j][3] * v[j][3]); }
        const float rinv = rsqrtf(wave_sum(ss) * (1.f / D) + EPS);
#pragma unroll
        for (int j = 0; j < 4; ++j) { const int c = 4 * C.lane + 256 * j; const f32x4 gg = *(const f32x4*)(g + c), sh = *(const f32x4*)(mod + off_sh + c), sc = *(const f32x4*)(mod + off_sc + c);
            const f32x4 y = v[j] * rinv * gg * (sc + 1.f) + sh; *(u32x2*)(WSP(bf16, WS_XN) + (size_t)row * D + c) = pk4(y); }
    }
}
__device__ __forceinline__ void final_norm_phase(const Ctx& C) {
    const int gw = C.bid * 8 + C.wave, NGW = C.G * 8;
    const float* g = INP(I_NFIN);
    for (int row = gw; row < T + NS; row += NGW) {
        const float* xr = WSP(float, WS_X) + (size_t)row * D; float* o = (C.PP->out) + (row < T ? O_YP + (size_t)row * D : O_YS + (size_t)(row - T) * D);
        f32x4 v[4]; float ss = 0.f;
#pragma unroll
        for (int j = 0; j < 4; ++j) { v[j] = *(const f32x4*)(xr + 4 * C.lane + 256 * j); ss += (v[j][0] * v[j][0] + v[j][1] * v[j][1]) + (v[j][2] * v[j][2] + v[j][3] * v[j][3]); }
        const float rinv = rsqrtf(wave_sum(ss) * (1.f / D) + EPS);
#pragma unroll
        for (int j = 0; j < 4; ++j) { const int c = 4 * C.lane + 256 * j; *(f32x4*)(o + c) = v[j] * rinv * *(const f32x4*)(g + c); }
    }
}

using pg8::Unit;
struct EpiIn {
    static constexpr bool PERM = true, AFTER_DRAIN = false;
    bf16* U; float* DT;
    __device__ __forceinline__ void operator()(const f32x4 (&acc)[2][2][4][2], const Unit& u, int wr, int wc, int fr, int fq) const {
        const int row0 = u.pm * 256 + wr * 64 + fr, col0 = u.pn * 256 + wc * 32 + 8 * fq;
#pragma unroll
        for (int ai = 0; ai < 2; ++ai)
#pragma unroll
            for (int m = 0; m < 4; ++m) { const int row = row0 + ai * 128 + m * 16; bf16* rowp = U + (size_t)row * HYB_NP + col0;
#pragma unroll
                for (int bj = 0; bj < 2; ++bj) { const f32x4 v0 = acc[ai][bj][m][0], v1 = acc[ai][bj][m][1];
                    u32x4 w; w.x = pk2(v0[0], v0[1]); w.y = pk2(v0[2], v0[3]); w.z = pk2(v1[0], v1[1]); w.w = pk2(v1[2], v1[3]); *(u32x4*)(rowp + bj * 128) = w; }
                if (u.pn == 10 && wc == 0 && fq < 2) { *(f32x4*)(DT + (size_t)row * 16 + 8 * fq) = acc[ai][0][m][0]; *(f32x4*)(DT + (size_t)row * 16 + 8 * fq + 4) = acc[ai][0][m][1]; } }
    }
};
struct EpiRes {
    static constexpr bool PERM = false, AFTER_DRAIN = false;
    const float* xin; float* xout; const float* gate;
    __device__ __forceinline__ void operator()(const f32x4 (&acc)[2][2][4][2], const Unit& u, int wr, int wc, int fr, int fq) const {
        const int row0 = u.pm * 256 + wr * 64 + fr, col0 = u.pn * 256 + wc * 32 + 4 * fq;
#pragma unroll
        for (int ai = 0; ai < 2; ++ai)
#pragma unroll
            for (int m = 0; m < 4; ++m) { const int row = row0 + ai * 128 + m * 16; const float* gp = gate + (size_t)(row >> 13) * 6144 + col0; const size_t off = (size_t)row * D + col0;
#pragma unroll
                for (int bj = 0; bj < 2; ++bj)
#pragma unroll
                    for (int n = 0; n < 2; ++n) { const int o = bj * 128 + n * 16; *(f32x4*)(xout + off + o) = *(const f32x4*)(xin + off + o) + *(const f32x4*)(gp + o) * acc[ai][bj][m][n]; } }
    }
};
struct EpiMlp1 {
    static constexpr bool PERM = true, AFTER_DRAIN = false;
    bf16* H;
    __device__ __forceinline__ void operator()(const f32x4 (&acc)[2][2][4][2], const Unit& u, int wr, int wc, int fr, int fq) const {
        const int row0 = u.pm * 256 + wr * 64 + fr, col0 = u.pn * 256 + wc * 32 + 8 * fq;
#pragma unroll
        for (int ai = 0; ai < 2; ++ai)
#pragma unroll
            for (int m = 0; m < 4; ++m) { bf16* rowp = H + (size_t)(row0 + ai * 128 + m * 16) * FF + col0;
#pragma unroll
                for (int bj = 0; bj < 2; ++bj) { f32x4 v0 = acc[ai][bj][m][0], v1 = acc[ai][bj][m][1];
#pragma unroll
                    for (int j = 0; j < 4; ++j) { const float a = fmaxf(v0[j], 0.f), b = fmaxf(v1[j], 0.f); v0[j] = a * a; v1[j] = b * b; }
                    u32x4 w; w.x = pk2(v0[0], v0[1]); w.y = pk2(v0[2], v0[3]); w.z = pk2(v1[0], v1[1]); w.w = pk2(v1[2], v1[3]); *(u32x4*)(rowp + bj * 128) = w; } }
    }
};
struct EpiQkv {
    static constexpr bool PERM = true, AFTER_DRAIN = false;
    bf16* QKV; const float* rope; float* out; int li;
    __device__ __forceinline__ void operator()(const f32x4 (&acc)[2][2][4][2], const Unit& u, int wr, int wc, int fr, int fq) const {
        const int row0 = u.pm * 256 + wr * 64 + fr, colt = u.pn * 256, col0 = colt + wc * 32 + 8 * fq;
        const int grp = colt / 1536, s = (colt % 1536) / 512;
        const bool do_rope = (s < 2) && ((wc & 1) == 0);
        const int W = 128 << (2 * grp);
        float* wout = out + (grp == 0 ? O_W0P : grp == 1 ? O_W1P : O_W2P);
#pragma unroll
        for (int ai = 0; ai < 2; ++ai)
#pragma unroll
            for (int m = 0; m < 4; ++m) { const int row = row0 + ai * 128 + m * 16, t = row & 8191, b = row >> 13;
#pragma unroll
                for (int bj = 0; bj < 2; ++bj) { f32x4 v0 = acc[ai][bj][m][0], v1 = acc[ai][bj][m][1];
                    if (do_rope) {
                        f32x4 p0, p1;
#pragma unroll
                        for (int j = 0; j < 4; ++j) { p0[j] = __shfl_xor(v0[j], 16); p1[j] = __shfl_xor(v1[j], 16); }
                        if (fq < 2) { const f32x4 c0 = *(const f32x4*)(rope + t * 16), c1 = *(const f32x4*)(rope + t * 16 + 4), s0 = *(const f32x4*)(rope + t * 16 + 8), s1 = *(const f32x4*)(rope + t * 16 + 12);
                            if (fq == 0) { v0 = v0 * c0 - p0 * s0; v1 = v1 * c1 - p1 * s1; } else { v0 = v0 * c0 + p0 * s0; v1 = v1 * c1 + p1 * s1; } }
                    }
                    if (s == 0) { v0 *= 0.125f; v1 *= 0.125f; }
                    const int c = col0 + bj * 128;
                    u32x4 w; w.x = pk2(v0[0], v0[1]); w.y = pk2(v0[2], v0[3]); w.z = pk2(v1[0], v1[1]); w.w = pk2(v1[2], v1[3]); *(u32x4*)(QKV + (size_t)row * QKV_N + c) = w;
                    if (s >= 1 && t >= SEQ - W) { const int cc = c - grp * 1536 - s * 512; float* o = wout + ((size_t)(li * 2 + b) * W + (t - (SEQ - W))) * 1024 + (s - 1) * 512 + cc;
                        *(f32x4*)o = v0; *(f32x4*)(o + 4) = v1; }
                } }
    }
};

template <class F> __device__ __forceinline__ void small_gemm(const Ctx& C, const bf16* A, const bf16* Wt, int N, int K, F&& epi) {
    LAS float* red = (LAS float*)C.lds;
    const int kw = K / 8, steps = kw / 16;
    for (int u = C.G - 1 - (int)C.bid; u < N / 32; u += C.G) {
        const int n0 = 32 * u;
        f32x16 acc;
#pragma unroll
        for (int r = 0; r < 16; ++r) acc[r] = 0.f;
        const bf16* wp = Wt + (size_t)(n0 + (C.lane & 31)) * K + C.wave * kw + 8 * (C.lane >> 5);
        const bf16* ap = A + (size_t)(C.lane & 31) * K + C.wave * kw + 8 * (C.lane >> 5);
        for (int ks = 0; ks < steps; ++ks) { const bf16x8 wf = *(const bf16x8*)(wp + 16 * ks), af = *(const bf16x8*)(ap + 16 * ks); acc = __builtin_amdgcn_mfma_f32_32x32x16_bf16(wf, af, acc, 0, 0, 0); }
#pragma unroll
        for (int r = 0; r < 16; ++r) red[(C.wave * 16 + r) * 64 + C.lane] = acc[r];
        __syncthreads();
#pragma unroll
        for (int e2 = 0; e2 < 2; ++e2) { const int e = C.tid + e2 * NT, r = e >> 6, ln = e & 63; float s = 0.f;
#pragma unroll
            for (int w = 0; w < 8; ++w) s += red[(w * 16 + r) * 64 + ln];
            epi(ln & 31, n0 + (r & 3) + 8 * (r >> 2) + 4 * (ln >> 5), s); }
        __syncthreads();
    }
}

__device__ __forceinline__ void rwkv_prep_unit(const Ctx& C, int li, int tile) {
    const int t0 = tile * 64, tl0 = t0 & 8191, b = t0 >> 13, q = C.lane >> 4, fr = C.lane & 15;
    LAS bf16* TXW = (LAS bf16*)C.lds; LAS bf16* XA = TXW + 64 * 72; LAS bf16* SXG = XA + 64 * 72;
    const float* mu = INP(I_MU) + li * RWC;
    {
        const int i = C.tid >> 3, part = C.tid & 7; const bool first = (tl0 + i) == 0;
        const bf16* cur = WSP(bf16, WS_U) + (size_t)(t0 + i) * HYB_NP + U_RW + 3072 + part * 32;
#pragma unroll
        for (int e = 0; e < 4; ++e) { const u32x4 cv = *(const u32x4*)(cur + 8 * e); u32x4 pv = (u32x4){0u, 0u, 0u, 0u}; if (!first) pv = *(const u32x4*)(cur - HYB_NP + 8 * e);
            const float* mp = mu + 3072 + part * 32 + 8 * e; float o[8];
#pragma unroll
            for (int j = 0; j < 4; ++j) { const float c0 = bflo(cv[j]), c1 = bfhi(cv[j]), p0 = bflo(pv[j]), p1 = bfhi(pv[j]); o[2 * j] = c0 + (p0 - c0) * mp[2 * j]; o[2 * j + 1] = c1 + (p1 - c1) * mp[2 * j + 1]; }
            if (part < 2) {
#pragma unroll
                for (int j = 0; j < 8; ++j) o[j] = tanhf(o[j]);
                *(LAS u32x4*)(TXW + i * 72 + part * 32 + 8 * e) = (u32x4){pk2(o[0], o[1]), pk2(o[2], o[3]), pk2(o[4], o[5]), pk2(o[6], o[7])};
            } else if (part < 4) {
                *(LAS u32x4*)(XA + i * 72 + (part - 2) * 32 + 8 * e) = (u32x4){pk2(o[0], o[1]), pk2(o[2], o[3]), pk2(o[4], o[5]), pk2(o[6], o[7])};
            } else {
#pragma unroll
                for (int j = 0; j < 8; ++j) o[j] = sigm_(o[j]);
                *(LAS u32x4*)(SXG + i * 136 + (part - 4) * 32 + 8 * e) = (u32x4){pk2(o[0], o[1]), pk2(o[2], o[3]), pk2(o[4], o[5]), pk2(o[6], o[7])};
            } }
    }
    __syncthreads();
    const bf16* w2t = WSP(bf16, WS_LORA) + (size_t)li * 262144; const bf16* a2t = w2t + 65536; const bf16* g2t = w2t + 131072;
    const float* w0 = INP(I_RW0) + li * 1024; const float* a0 = INP(I_RA0) + li * 1024; const float* kkw = INP(I_KK) + li * 1024; const float* kaw = INP(I_KA) + li * 1024;
    bf16* G = WSP(bf16, WS_G);
    for (int hh = 0; hh < 2; ++hh) { const int h = 2 * C.wave + hh;
        for (int tm = 0; tm < 4; ++tm) {
            bf16x8 fw[2], fa[2], fg[4];
            const int trow = 16 * tm + fr;
#pragma unroll
            for (int ks = 0; ks < 2; ++ks) { fw[ks] = *(const LAS bf16x8*)(TXW + trow * 72 + ks * 32 + 8 * q); fa[ks] = *(const LAS bf16x8*)(XA + trow * 72 + ks * 32 + 8 * q); }
#pragma unroll
            for (int ks = 0; ks < 4; ++ks) fg[ks] = *(const LAS bf16x8*)(SXG + trow * 136 + ks * 32 + 8 * q);
            const int t = t0 + trow, tl = tl0 + trow; const bool first = tl == 0;
            const bf16* urow = WSP(bf16, WS_U) + (size_t)t * HYB_NP + U_RW;
            f32x4 kx[4]; float ssq = 0.f;
#pragma unroll
            for (int tn = 0; tn < 4; ++tn) { const int c = h * 64 + 16 * tn + 4 * q;
                const f32x4 ck = bf4(*(const u32x2*)(urow + 1024 + c)); f32x4 pk = (f32x4){0.f, 0.f, 0.f, 0.f};
                if (!first) pk = bf4(*(const u32x2*)(urow - HYB_NP + 1024 + c));
                kx[tn] = ck + (pk - ck) * *(const f32x4*)(mu + 1024 + c);
                const f32x4 kkv = kx[tn] * *(const f32x4*)(kkw + c);
                ssq += (kkv[0] * kkv[0] + kkv[1] * kkv[1]) + (kkv[2] * kkv[2] + kkv[3] * kkv[3]); }
            ssq += __shfl_xor(ssq, 16); ssq += __shfl_xor(ssq, 32);
            const float inv = 1.f / fmaxf(sqrtf(ssq), 1e-12f);
            float* rec = WSP(float, WS_REC) + ((size_t)(b * 16 + h) * SEQ + tl) * 384 + 4 * q;
#pragma unroll 1
            for (int tn = 0; tn < 4; ++tn) { const int c = h * 64 + 16 * tn + 4 * q, nrow = h * 64 + 16 * tn + fr;
                f32x4 xw = (f32x4){0.f, 0.f, 0.f, 0.f}, xa = xw, xg = xw;
#pragma unroll
                for (int ks = 0; ks < 2; ++ks) { xw = mfma16(*(const bf16x8*)(w2t + nrow * 64 + ks * 32 + 8 * q), fw[ks], xw); xa = mfma16(*(const bf16x8*)(a2t + nrow * 64 + ks * 32 + 8 * q), fa[ks], xa); }
#pragma unroll
                for (int ks = 0; ks < 4; ++ks) xg = mfma16(*(const bf16x8*)(g2t + nrow * 128 + ks * 32 + 8 * q), fg[ks], xg);
                const f32x4 cr = bf4(*(const u32x2*)(urow + c)), cv = bf4(*(const u32x2*)(urow + 2048 + c));
                f32x4 pr = (f32x4){0.f, 0.f, 0.f, 0.f}, pv = pr;
                if (!first) { pr = bf4(*(const u32x2*)(urow - HYB_NP + c)); pv = bf4(*(const u32x2*)(urow - HYB_NP + 2048 + c)); }
                const f32x4 rr = cr + (pr - cr) * *(const f32x4*)(mu + c), vv = cv + (pv - cv) * *(const f32x4*)(mu + 2048 + c);
                const f32x4 wl = *(const f32x4*)(w0 + c) + xw, al = *(const f32x4*)(a0 + c) + xa;
                f32x4 wd, av;
#pragma unroll
                for (int j = 0; j < 4; ++j) { const float wlog = -softplus_(-wl[j]) - 0.5f; wd[j] = __expf(-__expf(wlog)); av[j] = sigm_(al[j]); }
                const f32x4 kk4 = (tn == 0 ? kx[0] : tn == 1 ? kx[1] : tn == 2 ? kx[2] : kx[3]);
                const f32x4 kkn = kk4 * *(const f32x4*)(kkw + c) * inv; const f32x4 kp = kk4 * ((av - 1.f) * *(const f32x4*)(kaw + c) + 1.f);
                float* rp = rec + 16 * tn;
                *(f32x4*)(rp) = rr; *(f32x4*)(rp + 64) = wd; *(f32x4*)(rp + 128) = kp; *(f32x4*)(rp + 192) = vv; *(f32x4*)(rp + 256) = -kkn; *(f32x4*)(rp + 320) = kkn * av;
                *(u32x2*)(G + (size_t)t * 1024 + c) = pk4(xg); }
        }
    }
    if ((tile & 127) == 127) { float* o = (C.PP->out) + O_SHP + (size_t)(li * 2 + b) * RWC; const bf16* ur = WSP(bf16, WS_U) + (size_t)(t0 + 63) * HYB_NP + U_RW;
        for (int c = C.tid; c < RWC; c += NT) o[c] = bf1(ur[c]); }
    __syncthreads();
}

__device__ __forceinline__ void ssd_a_unit(const Ctx& C, int li, int u) {
    const int g = u & 1, c = (u >> 1) & 63, b = u >> 7, t0 = b * SEQ + c * 128, q = C.lane >> 4, fr = C.lane & 15;
    LAS float* SC = (LAS float*)C.lds;
    LAS bf16* BT = (LAS bf16*)(C.lds + 4096);
    LAS bf16* XTs = (LAS bf16*)(C.lds + 4096 + 34816);
    const float* DTr = WSP(float, WS_DT); float* DTS = WSP(float, WS_DTS); float* ACS = WSP(float, WS_ACS);
    bf16* XTg = WSP(bf16, WS_XT) + ((size_t)(b * 64 + c) * 1024) * 128; bf16* BCg = WSP(bf16, WS_BC); float* CS = WSP(float, WS_CS);
    {
        const int h = g * 8 + C.wave; const float bias = INP(I_DTB)[li * 16 + h], A = -__expf(INP(I_ALOG)[li * 16 + h]);
        const int l0 = 2 * C.lane; const float d0 = softplus_(DTr[(size_t)(t0 + l0) * 16 + h] + bias), d1 = softplus_(DTr[(size_t)(t0 + l0 + 1) * 16 + h] + bias);
        const float a0 = d0 * A, a1 = d1 * A; float s = a0 + a1;
#pragma unroll
        for (int o = 1; o < 64; o <<= 1) { const float n = __shfl_up(s, o); if (C.lane >= o) s += n; }
        const float acs1 = s, acs0 = s - a1, tot = __shfl(s, 63);
        DTS[(size_t)(t0 + l0) * 16 + h] = d0; DTS[(size_t)(t0 + l0 + 1) * 16 + h] = d1; ACS[(size_t)(t0 + l0) * 16 + h] = acs0; ACS[(size_t)(t0 + l0 + 1) * 16 + h] = acs1;
        SC[C.wave * 128 + l0] = __expf(tot - acs0) * d0; SC[C.wave * 128 + l0 + 1] = __expf(tot - acs1) * d1;
    }
    __syncthreads();
    const float* cw = INP(I_CONVW) + (size_t)li * 4 * 1536; const float* cb = INP(I_CONVB) + (size_t)li * 1536;
    for (int pass = 0; pass < 2; ++pass) {
        const int nitems = pass == 0 ? 16 : 8;
        for (int it = C.wave; it < nitems; it += 8) { const int tb = it & 7, cblk = pass == 0 ? (it >> 3) : 2;
            int ch;
            if (cblk == 0) ch = (C.lane < 32 ? 1024 + g * 128 + 4 * C.lane : 1280 + g * 128 + 4 * (C.lane - 32)); else ch = g * 512 + (cblk - 1) * 256 + 4 * C.lane;
            const int tl = c * 128 + tb * 16;
            const bf16* up = WSP(bf16, WS_U) + (size_t)(t0 + tb * 16) * HYB_NP + U_XBC + ch;
            f32x4 uu[19];
#pragma unroll
            for (int k = 0; k < 19; ++k) { uu[k] = (f32x4){0.f, 0.f, 0.f, 0.f}; if (tl + k - 3 >= 0) uu[k] = bf4(*(const u32x2*)(up + (ptrdiff_t)(k - 3) * HYB_NP)); }
            const f32x4 w0 = *(const f32x4*)(cw + ch), w1 = *(const f32x4*)(cw + 1536 + ch), w2 = *(const f32x4*)(cw + 3072 + ch), w3 = *(const f32x4*)(cw + 4608 + ch), bb = *(const f32x4*)(cb + ch);
            if (c == 63 && tb == 7) { float* o = (C.PP->out) + O_CONVP + (size_t)(li * 2 + b) * 3 * 1536 + ch; *(f32x4*)o = uu[16]; *(f32x4*)(o + 1536) = uu[17]; *(f32x4*)(o + 3072) = uu[18]; }
            f32x4 y[16];
#pragma unroll
            for (int k = 0; k < 16; ++k) { f32x4 v = bb + w0 * uu[k] + w1 * uu[k + 1] + w2 * uu[k + 2] + w3 * uu[k + 3];
#pragma unroll
                for (int j = 0; j < 4; ++j) v[j] = siluf_(v[j]);
                y[k] = v; }
            if (cblk == 0) {
                const bool isB = C.lane < 32; const int n = 4 * (C.lane & 31);
#pragma unroll
                for (int k = 0; k < 16; ++k) *(u32x2*)(BCg + (size_t)(t0 + tb * 16 + k) * 512 + (isB ? 0 : 256) + g * 128 + n) = pk4(y[k]);
                if (isB) {
#pragma unroll
                    for (int j = 0; j < 4; ++j) { u32x4 lo, hi;
                        lo.x = pk2(y[0][j], y[1][j]); lo.y = pk2(y[2][j], y[3][j]); lo.z = pk2(y[4][j], y[5][j]); lo.w = pk2(y[6][j], y[7][j]);
                        hi.x = pk2(y[8][j], y[9][j]); hi.y = pk2(y[10][j], y[11][j]); hi.z = pk2(y[12][j], y[13][j]); hi.w = pk2(y[14][j], y[15][j]);
                        *(LAS u32x4*)(BT + (n + j) * 136 + tb * 16) = lo; *(LAS u32x4*)(BT + (n + j) * 136 + tb * 16 + 8) = hi; } }
            } else {
                const int xc = (cblk - 1) * 256 + 4 * C.lane;
                const int hl = xc >> 6;
                const int xl = (pass == 0 ? xc : xc - 256);
                float sc[16];
#pragma unroll
                for (int k = 0; k < 16; ++k) sc[k] = SC[hl * 128 + tb * 16 + k];
#pragma unroll
                for (int j = 0; j < 4; ++j) { u32x4 lo, hi;
                    lo.x = pk2(y[0][j], y[1][j]); lo.y = pk2(y[2][j], y[3][j]); lo.z = pk2(y[4][j], y[5][j]); lo.w = pk2(y[6][j], y[7][j]);
                    hi.x = pk2(y[8][j], y[9][j]); hi.y = pk2(y[10][j], y[11][j]); hi.z = pk2(y[12][j], y[13][j]); hi.w = pk2(y[14][j], y[15][j]);
                    bf16* gp = XTg + (size_t)(g * 512 + xc + j) * 128 + tb * 16; *(u32x4*)gp = lo; *(u32x4*)(gp + 8) = hi;
                    lo.x = pk2(y[0][j] * sc[0], y[1][j] * sc[1]); lo.y = pk2(y[2][j] * sc[2], y[3][j] * sc[3]); lo.z = pk2(y[4][j] * sc[4], y[5][j] * sc[5]); lo.w = pk2(y[6][j] * sc[6], y[7][j] * sc[7]);
                    hi.x = pk2(y[8][j] * sc[8], y[9][j] * sc[9]); hi.y = pk2(y[10][j] * sc[10], y[11][j] * sc[11]); hi.z = pk2(y[12][j] * sc[12], y[13][j] * sc[13]); hi.w = pk2(y[14][j] * sc[14], y[15][j] * sc[15]);
                    *(LAS u32x4*)(XTs + (xl + j) * 136 + tb * 16) = lo; *(LAS u32x4*)(XTs + (xl + j) * 136 + tb * 16 + 8) = hi; }
            }
        }
        __syncthreads();
        { const int hl = C.wave >> 1, h = g * 8 + pass * 4 + hl;
          float* csp = CS + (((size_t)(b * 64 + c) * 16 + h) * 64) * 128;
#pragma unroll
          for (int tmi = 0; tmi < 2; ++tmi) { const int tm = (C.wave & 1) * 2 + tmi; bf16x8 xf[4];
#pragma unroll
              for (int ks = 0; ks < 4; ++ks) xf[ks] = *(const LAS bf16x8*)(XTs + (hl * 64 + 16 * tm + fr) * 136 + ks * 32 + 8 * q);
#pragma unroll
              for (int tn = 0; tn < 8; ++tn) { f32x4 acc = (f32x4){0.f, 0.f, 0.f, 0.f};
#pragma unroll
                  for (int ks = 0; ks < 4; ++ks) acc = mfma16(*(const LAS bf16x8*)(BT + (16 * tn + fr) * 136 + ks * 32 + 8 * q), xf[ks], acc);
                  *(f32x4*)(csp + (size_t)(16 * tm + fr) * 128 + 16 * tn + 4 * q) = acc; } }
        }
        __syncthreads();
    }
}

__device__ __forceinline__ void rwkv_scan_unit(const Ctx& C, int unit) {
    const int bh = unit >> 3, c = (unit & 7) * 8 + C.wave, lane = C.lane;
    const float* rec = WSP(float, WS_REC) + ((size_t)bh * SEQ + c * 128) * 384;
    float* qo = WSP(float, WS_QO) + ((size_t)bh * SEQ + c * 128) * 128;
    LAS float* buf = (LAS float*)(C.lds + C.wave * 12288);
    f32x2 Sl[32], Pm[32];
    int lopq = lane; asm volatile("" : "+v"(lopq));
#pragma unroll
    for (int j = 0; j < 32; ++j) { Sl[j] = (f32x2){0.f, 0.f}; Pm[j] = (f32x2){(2 * j == lopq) ? 1.f : 0.f, (2 * j + 1 == lopq) ? 1.f : 0.f}; }
#define RW_DMA(src, dst) do { _Pragma("unroll") for (int _i = 0; _i < 6; ++_i) __builtin_amdgcn_global_load_lds((const unsigned*)((src) + (_i * 64 + lane) * 4), (LAS unsigned*)((dst) + _i * 256), 16, 0, 0); } while (0)
    RW_DMA(rec, buf);
    asm volatile("s_waitcnt vmcnt(0)" ::: "memory");
    float sa_s = 0.f, sa_p = buf[256 + lane];
    for (int sb = 0; sb < 32; ++sb) {
        LAS float* cb = buf + (sb & 1) * 1536; LAS float* nb = buf + ((sb + 1) & 1) * 1536;
        if (sb + 1 < 32) RW_DMA(rec + (size_t)(sb + 1) * 1536, nb);
        for (int st = 0; st < 4; ++st) {
            if (st == 3) asm volatile("s_waitcnt vmcnt(0)" ::: "memory");
            const LAS float* v = cb + st * 384; const LAS float* nx = (st < 3) ? v + 384 : nb;
            const float vv = v[192 + lane];
            const f32x2 vv2 = (f32x2){vv, vv}, sas = (f32x2){sa_s, sa_s}, sap = (f32x2){sa_p, sa_p};
            f32x2 o2a = (f32x2){0.f, 0.f}, o2b = o2a, q2a = o2a, q2b = o2a, ns2a = o2a, ns2b = o2a, np2a = o2a, np2b = o2a;
            f32x4 r4 = *(const LAS f32x4*)(v), w4 = *(const LAS f32x4*)(v + 64), k4 = *(const LAS f32x4*)(v + 128), b4 = *(const LAS f32x4*)(v + 320), n4 = *(const LAS f32x4*)(nx + 256);
#pragma unroll
            for (int j = 0; j < 16; ++j) {
                f32x4 r4n = r4, w4n = w4, k4n = k4, b4n = b4, n4n = n4;
                if (j < 15) { r4n = *(const LAS f32x4*)(v + 4 * j + 4); w4n = *(const LAS f32x4*)(v + 64 + 4 * j + 4); k4n = *(const LAS f32x4*)(v + 128 + 4 * j + 4); b4n = *(const LAS f32x4*)(v + 320 + 4 * j + 4); n4n = *(const LAS f32x4*)(nx + 256 + 4 * j + 4); }
                {   const f32x2 r2 = (f32x2){r4[0], r4[1]}, w2 = (f32x2){w4[0], w4[1]}, k2 = (f32x2){k4[0], k4[1]}, b2 = (f32x2){b4[0], b4[1]}, n2 = (f32x2){n4[0], n4[1]};
                    f32x2 t = vv2 * k2; t = sas * b2 + t; Sl[2 * j] = Sl[2 * j] * w2 + t; o2a = Sl[2 * j] * r2 + o2a; ns2a = Sl[2 * j] * n2 + ns2a;
                    f32x2 tp = sap * b2; Pm[2 * j] = Pm[2 * j] * w2 + tp; q2a = Pm[2 * j] * r2 + q2a; np2a = Pm[2 * j] * n2 + np2a; }
                {   const f32x2 r2 = (f32x2){r4[2], r4[3]}, w2 = (f32x2){w4[2], w4[3]}, k2 = (f32x2){k4[2], k4[3]}, b2 = (f32x2){b4[2], b4[3]}, n2 = (f32x2){n4[2], n4[3]};
                    f32x2 t = vv2 * k2; t = sas * b2 + t; Sl[2 * j + 1] = Sl[2 * j + 1] * w2 + t; o2b = Sl[2 * j + 1] * r2 + o2b; ns2b = Sl[2 * j + 1] * n2 + ns2b;
                    f32x2 tp = sap * b2; Pm[2 * j + 1] = Pm[2 * j + 1] * w2 + tp; q2b = Pm[2 * j + 1] * r2 + q2b; np2b = Pm[2 * j + 1] * n2 + np2b; }
                r4 = r4n; w4 = w4n; k4 = k4n; b4 = b4n; n4 = n4n;
                __builtin_amdgcn_sched_barrier(0);
            }
            const f32x2 o2 = o2a + o2b, q2 = q2a + q2b, ns2 = ns2a + ns2b, np2 = np2a + np2b;
            float* qp = qo + (size_t)(sb * 4 + st) * 128;
            qp[lane] = o2[0] + o2[1]; qp[64 + lane] = q2[0] + q2[1];
            sa_s = ns2[0] + ns2[1]; sa_p = np2[0] + np2[1];
        }
    }
    float* sl = WSP(float, WS_SL) + ((size_t)(bh * 64 + c) * 2) * 4096 + lane * 64;
#pragma unroll
    for (int j = 0; j < 16; ++j) { *(f32x4*)(sl + 4 * j) = (f32x4){Sl[2 * j][0], Sl[2 * j][1], Sl[2 * j + 1][0], Sl[2 * j + 1][1]}; *(f32x4*)(sl + 4096 + 4 * j) = (f32x4){Pm[2 * j][0], Pm[2 * j][1], Pm[2 * j + 1][0], Pm[2 * j + 1][1]}; }
}

__device__ __forceinline__ void ssd_scan_phase(const Ctx& C, int li) {
    const int gt = C.bid * NT + C.tid;
    if (gt >= 131072) return;
    const int n2 = gt & 63, p = (gt >> 6) & 63, h = (gt >> 12) & 15, b = gt >> 16;
    float* CS = WSP(float, WS_CS); const float* ACS = WSP(float, WS_ACS);
    f32x2 S = (f32x2){0.f, 0.f};
#pragma unroll 4
    for (int c = 0; c < 64; ++c) { float* ptr = CS + (((size_t)(b * 64 + c) * 16 + h) * 64 + p) * 128 + 2 * n2; const f32x2 v = *(const f32x2*)ptr; *(f32x2*)ptr = S;
        const float dec = __expf(ACS[(size_t)(b * SEQ + c * 128 + 127) * 16 + h]); S = S * dec + v; }
    *(f32x2*)((C.PP->out) + O_SSDP + ((size_t)((li * 2 + b) * 16 + h) * 64 + p) * 128 + 2 * n2) = S;
}

__device__ __forceinline__ void rwkv_combine_unit(const Ctx& C, int li, int bh) {
    LAS float* Ss = (LAS float*)C.lds;
    LAS float* Ps = Ss + 64 * 65;
    const int q = C.lane >> 4, fr = C.lane & 15, tm = C.wave >> 1, tnb = (C.wave & 1) * 2;
    const float* SL = WSP(float, WS_SL) + (size_t)bh * 64 * 2 * 4096; float* SST = WSP(float, WS_SST) + (size_t)bh * 64 * 4096;
    for (int e = C.tid; e < 64 * 65; e += NT) Ss[e] = 0.f;
    __syncthreads();
    for (int c = 0; c < 64; ++c) {
        const float* Lc = SL + (size_t)c * 8192; const float* Pc = Lc + 4096;
        for (int e = C.tid; e < 1024; e += NT) { const int r = e >> 4, c4 = (e & 15) * 4; const f32x4 pv = *(const f32x4*)(Pc + r * 64 + c4); *(LAS f32x4*)(Ps + r * 72 + c4) = pv;
            f32x4 sv; sv[0] = Ss[r * 65 + c4]; sv[1] = Ss[r * 65 + c4 + 1]; sv[2] = Ss[r * 65 + c4 + 2]; sv[3] = Ss[r * 65 + c4 + 3]; *(f32x4*)(SST + (size_t)c * 4096 + r * 64 + c4) = sv; }
        __syncthreads();
        f32x4 acc[2];
#pragma unroll
        for (int t2 = 0; t2 < 2; ++t2) { const int tn = tnb + t2;
#pragma unroll
            for (int r = 0; r < 4; ++r) acc[t2][r] = Lc[(16 * tm + 4 * q + r) * 64 + 16 * tn + fr]; }
#pragma unroll 4
        for (int k0 = 0; k0 < 64; k0 += 4) { const float a = Ss[(16 * tm + fr) * 65 + k0 + q];
#pragma unroll
            for (int t2 = 0; t2 < 2; ++t2) acc[t2] = __builtin_amdgcn_mfma_f32_16x16x4f32(a, Ps[(k0 + q) * 72 + 16 * (tnb + t2) + fr], acc[t2], 0, 0, 0); }
        __syncthreads();
#pragma unroll
        for (int t2 = 0; t2 < 2; ++t2)
#pragma unroll
            for (int r = 0; r < 4; ++r) Ss[(16 * tm + 4 * q + r) * 65 + 16 * (tnb + t2) + fr] = acc[t2][r];
        __syncthreads();
    }
    float* o = (C.PP->out) + O_WKVP + (size_t)(li * 32 + bh) * 4096;
    for (int e = C.tid; e < 4096; e += NT) o[e] = Ss[(e >> 6) * 65 + (e & 63)];
    __syncthreads();
}

__device__ __forceinline__ void ssd_c_unit(const Ctx& C, int li, int u) {
    const int g = u & 1, c = (u >> 1) & 63, b = u >> 7, t0 = b * SEQ + c * 128, q = C.lane >> 4, fr = C.lane & 15, w = C.wave;
    LAS bf16* Cb = (LAS bf16*)C.lds;
    LAS bf16* Bb = Cb + 128 * 136;
    LAS bf16* XTh = Bb; LAS bf16* SINh = Bb + 64 * 136;
    LAS bf16* Mw = Bb + 128 * 136 + w * (16 * 136);
    LAS float* AD = (LAS float*)(Bb + 128 * 136 + 8 * 16 * 136);
    const bf16* BCg = WSP(bf16, WS_BC); const float* DTS = WSP(float, WS_DTS); const float* ACS = WSP(float, WS_ACS);
    const bf16* XTg = WSP(bf16, WS_XT) + ((size_t)(b * 64 + c) * 1024 + g * 512) * 128; const float* CS = WSP(float, WS_CS) + ((size_t)(b * 64 + c) * 16 + g * 8) * 8192;
    bf16* Y = WSP(bf16, WS_YCAT);
    for (int e = C.tid; e < 4096; e += NT) { const int r = e >> 5, cc = e & 31, isC = cc >> 4, c8 = (cc & 15) * 8;
        const u32x4 v = *(const u32x4*)(BCg + (size_t)(t0 + r) * 512 + (isC ? 256 : 0) + g * 128 + c8); *(LAS u32x4*)((isC ? Cb : Bb) + r * 136 + c8) = v; }
    __syncthreads();
    f32x4 cbv[8]; bf16x8 cf[4];
#pragma unroll
    for (int ks = 0; ks < 4; ++ks) cf[ks] = *(const LAS bf16x8*)(Cb + (16 * w + fr) * 136 + ks * 32 + 8 * q);
#pragma unroll
    for (int tn = 0; tn < 8; ++tn) { cbv[tn] = (f32x4){0.f, 0.f, 0.f, 0.f};
        if (tn <= w) {
#pragma unroll
            for (int ks = 0; ks < 4; ++ks) cbv[tn] = mfma16(*(const LAS bf16x8*)(Bb + (16 * tn + fr) * 136 + ks * 32 + 8 * q), cf[ks], cbv[tn]); } }
    __syncthreads();
    float ssq = 0.f;
    const int l = 16 * w + fr;
    bf16* yrow = Y + (size_t)(t0 + l) * 2048 + g * 512;
#pragma unroll 1
    for (int hh = 0; hh < 8; ++hh) { const int h = g * 8 + hh;
        for (int e = C.tid; e < 1024; e += NT) { const int r = e >> 4, c8 = (e & 15) * 8;
            *(LAS u32x4*)(XTh + r * 136 + c8) = *(const u32x4*)(XTg + (size_t)(hh * 64 + r) * 128 + c8);
            const float* sp = CS + (size_t)hh * 8192 + r * 128 + c8; const f32x4 s0 = *(const f32x4*)sp, s1 = *(const f32x4*)(sp + 4);
            *(LAS u32x4*)(SINh + r * 136 + c8) = (u32x4){pk2(s0[0], s0[1]), pk2(s0[2], s0[3]), pk2(s1[0], s1[1]), pk2(s1[2], s1[3])}; }
        if (C.tid < 128) { AD[C.tid] = ACS[(size_t)(t0 + C.tid) * 16 + h]; AD[128 + C.tid] = DTS[(size_t)(t0 + C.tid) * 16 + h]; }
        __syncthreads();
        const float acl = AD[l];
#pragma unroll
        for (int tn = 0; tn < 8; ++tn) { f32x4 mv = (f32x4){0.f, 0.f, 0.f, 0.f};
            if (tn <= w) { const f32x4 as = *(const LAS f32x4*)(AD + 16 * tn + 4 * q), ds = *(const LAS f32x4*)(AD + 128 + 16 * tn + 4 * q);
#pragma unroll
                for (int j = 0; j < 4; ++j) { const int s = 16 * tn + 4 * q + j; mv[j] = (s <= l) ? cbv[tn][j] * __expf(acl - as[j]) * ds[j] : 0.f; } }
            *(LAS u32x2*)(Mw + fr * 136 + 16 * tn + 4 * q) = pk4(mv); }
        LDSW();
        const float eal = __expf(acl), Dh = INP(I_SSDD)[li * 16 + h];
        const int nks = (w + 2) >> 1;
#pragma unroll
        for (int tp = 0; tp < 4; ++tp) { f32x4 a1 = (f32x4){0.f, 0.f, 0.f, 0.f}, a2 = a1;
            for (int ks = 0; ks < nks; ++ks) a1 = mfma16(*(const LAS bf16x8*)(XTh + (16 * tp + fr) * 136 + ks * 32 + 8 * q), *(const LAS bf16x8*)(Mw + fr * 136 + ks * 32 + 8 * q), a1);
#pragma unroll
            for (int ks = 0; ks < 4; ++ks) a2 = mfma16(*(const LAS bf16x8*)(SINh + (16 * tp + fr) * 136 + ks * 32 + 8 * q), cf[ks], a2);
            const int p0 = 16 * tp + 4 * q;
            const f32x4 z = bf4(*(const u32x2*)(WSP(bf16, WS_U) + (size_t)(t0 + l) * HYB_NP + h * 64 + p0));
            f32x4 y;
#pragma unroll
            for (int j = 0; j < 4; ++j) { const float xv = bf1(XTh[(p0 + j) * 136 + l]); y[j] = (a1[j] + eal * a2[j] + Dh * xv) * siluf_(z[j]); }
            const u32x2 yp = pk4(y); const f32x4 yr = bf4(yp); ssq += (yr[0] * yr[0] + yr[1] * yr[1]) + (yr[2] * yr[2] + yr[3] * yr[3]);
            *(u32x2*)(yrow + hh * 64 + p0) = yp; }
        __syncthreads();
    }
    ssq += __shfl_xor(ssq, 16); ssq += __shfl_xor(ssq, 32);
    const float rinv = rsqrtf(ssq * (1.f / 512.f) + EPS);
    const float* nw = INP(I_SNW) + li * 1024 + g * 512;
    asm volatile("s_waitcnt vmcnt(0)" ::: "memory");
#pragma unroll 1
    for (int hh = 0; hh < 8; ++hh)
#pragma unroll
        for (int tp = 0; tp < 4; ++tp) { const int cc = hh * 64 + 16 * tp + 4 * q; const f32x4 y = bf4(*(volatile u32x2*)(yrow + cc)) * rinv * *(const f32x4*)(nw + cc);
            *(u32x2*)(yrow + cc) = pk4(y); }
}

__device__ __forceinline__ void rwkv_out_unit(const Ctx& C, int li, int u) {
    const int c = u & 63, bh = u >> 6, h = bh & 15, b = bh >> 4, t0 = b * SEQ + c * 128, q = C.lane >> 4, fr = C.lane & 15, w = C.wave;
    LAS bf16* Qb = (LAS bf16*)C.lds;
    LAS bf16* Sb = Qb + 128 * 72;
    const float* qo = WSP(float, WS_QO) + ((size_t)bh * SEQ + c * 128) * 128; const float* sst = WSP(float, WS_SST) + (size_t)(bh * 64 + c) * 4096;
    const float* rec = WSP(float, WS_REC) + ((size_t)bh * SEQ + c * 128) * 384;
    for (int e = C.tid; e < 2048; e += NT) { const int r = e >> 4, c4 = (e & 15) * 4; *(LAS u32x2*)(Qb + r * 72 + c4) = pk4(*(const f32x4*)(qo + (size_t)r * 128 + 64 + c4)); }
    for (int e = C.tid; e < 1024; e += NT) { const int r = e >> 4, c4 = (e & 15) * 4; *(LAS u32x2*)(Sb + r * 72 + c4) = pk4(*(const f32x4*)(sst + r * 64 + c4)); }
    __syncthreads();
    const int tr = 16 * w + fr;
    bf16x8 qf[2];
#pragma unroll
    for (int ks = 0; ks < 2; ++ks) qf[ks] = *(const LAS bf16x8*)(Qb + tr * 72 + ks * 32 + 8 * q);
    f32x4 o[4]; float sum = 0.f, rk = 0.f;
    const float* rp = rec + (size_t)tr * 384;
    const float* rkw = INP(I_RK) + li * 1024 + h * 64;
#pragma unroll
    for (int tn = 0; tn < 4; ++tn) { f32x4 a = *(const f32x4*)(qo + (size_t)tr * 128 + 16 * tn + 4 * q);
#pragma unroll
        for (int ks = 0; ks < 2; ++ks) a = mfma16(*(const LAS bf16x8*)(Sb + (16 * tn + fr) * 72 + ks * 32 + 8 * q), qf[ks], a);
        o[tn] = a; sum += (a[0] + a[1]) + (a[2] + a[3]);
        const f32x4 r4 = *(const f32x4*)(rp + 16 * tn + 4 * q), k4 = *(const f32x4*)(rp + 128 + 16 * tn + 4 * q), w4 = *(const f32x4*)(rkw + 16 * tn + 4 * q);
        rk += (r4[0] * k4[0] * w4[0] + r4[1] * k4[1] * w4[1]) + (r4[2] * k4[2] * w4[2] + r4[3] * k4[3] * w4[3]); }
    sum += __shfl_xor(sum, 16); sum += __shfl_xor(sum, 32); rk += __shfl_xor(rk, 16); rk += __shfl_xor(rk, 32);
    const float mean = sum * (1.f / 64.f); float var = 0.f;
#pragma unroll
    for (int tn = 0; tn < 4; ++tn) { const f32x4 d = o[tn] - mean; var += (d[0] * d[0] + d[1] * d[1]) + (d[2] * d[2] + d[3] * d[3]); }
    var += __shfl_xor(var, 16); var += __shfl_xor(var, 32);
    const float rstd = rsqrtf(var * (1.f / 64.f) + LN_EPS);
    const float* lw = INP(I_LNW) + li * 1024 + h * 64; const float* lb = INP(I_LNB) + li * 1024 + h * 64;
    const bf16* G = WSP(bf16, WS_G) + (size_t)(t0 + tr) * 1024 + h * 64; bf16* Y = WSP(bf16, WS_YCAT) + (size_t)(t0 + tr) * 2048 + 1024 + h * 64;
#pragma unroll
    for (int tn = 0; tn < 4; ++tn) { const int cc = 16 * tn + 4 * q; const f32x4 vv = *(const f32x4*)(rp + 192 + cc), gg = bf4(*(const u32x2*)(G + cc));
        const f32x4 y = ((o[tn] - mean) * rstd * *(const f32x4*)(lw + cc) + *(const f32x4*)(lb + cc) + vv * rk) * gg; *(u32x2*)(Y + cc) = pk4(y); }
    __syncthreads();
}

__device__ __forceinline__ void attn_tile_unit(const Ctx& C, int u) {
    const int g = u >> 10, r = u & 1023, b = r >> 9, h = (r >> 6) & 7, qt = r & 63, q = C.lane >> 4, fr = C.lane & 15, w = C.wave;
    const int dsh = 2 * g, tpr = 64 >> dsh, rho = qt / tpr, i0 = (qt % tpr) * 128;
    LAS bf16* Qs = (LAS bf16*)C.lds;
    LAS bf16* Ks = Qs + 128 * 72;
    LAS bf16* VT = Ks + 256 * 72;
    const bf16* QKV = WSP(bf16, WS_QKV) + (size_t)b * SEQ * QKV_N + g * 1536 + h * 64;
    for (int e = C.tid; e < 1024; e += NT) { const int rr = e >> 3, c8 = (e & 7) * 8; const int t = rho + ((i0 + rr) << dsh); *(LAS u32x4*)(Qs + rr * 72 + c8) = *(const u32x4*)(QKV + (size_t)t * QKV_N + c8); }
    for (int e = C.tid; e < 2048; e += NT) { const int kk = e >> 3, c8 = (e & 7) * 8; const int idx = i0 - 128 + kk; u32x4 kv = (u32x4){0u, 0u, 0u, 0u}, vv = kv;
        if (idx >= 0) { const bf16* p = QKV + (size_t)(rho + (idx << dsh)) * QKV_N + c8; kv = *(const u32x4*)(p + 512); vv = *(const u32x4*)(p + 1024); }
        *(LAS u32x4*)(Ks + kk * 72 + c8) = kv;
#pragma unroll
        for (int j = 0; j < 4; ++j) { VT[(c8 + 2 * j) * 264 + kk] = (bf16)(vv[j] & 0xffffu); VT[(c8 + 2 * j + 1) * 264 + kk] = (bf16)(vv[j] >> 16); } }
    __syncthreads();
    bf16x8 qf[2];
#pragma unroll
    for (int ks = 0; ks < 2; ++ks) qf[ks] = *(const LAS bf16x8*)(Qs + (16 * w + fr) * 72 + ks * 32 + 8 * q);
    const int ql = 16 * w + fr, kmin = (i0 == 0) ? 128 : 0;
    f32x4 s[10]; float mx = -3.0e38f;
#pragma unroll
    for (int kt = 0; kt < 10; ++kt) { s[kt] = (f32x4){0.f, 0.f, 0.f, 0.f};
        if (kt < 9) {
#pragma unroll
            for (int ks = 0; ks < 2; ++ks) s[kt] = mfma16(*(const LAS bf16x8*)(Ks + (16 * (w + kt) + fr) * 72 + ks * 32 + 8 * q), qf[ks], s[kt]); }
#pragma unroll
        for (int j = 0; j < 4; ++j) { const int kk = 16 * (w + kt) + 4 * q + j; const bool ok = (kt < 9) && kk >= ql && kk <= ql + 128 && kk >= kmin; s[kt][j] = ok ? s[kt][j] : -3.0e38f; mx = fmaxf(mx, s[kt][j]); } }
    mx = fmaxf(mx, __shfl_xor(mx, 16)); mx = fmaxf(mx, __shfl_xor(mx, 32));
    float lsum = 0.f;
#pragma unroll
    for (int kt = 0; kt < 10; ++kt)
#pragma unroll
        for (int j = 0; j < 4; ++j) { const float p = (s[kt][j] > -1.0e38f) ? __expf(s[kt][j] - mx) : 0.f; s[kt][j] = p; lsum += p; }
    lsum += __shfl_xor(lsum, 16); lsum += __shfl_xor(lsum, 32);
    f32x4 od[4];
#pragma unroll
    for (int tn = 0; tn < 4; ++tn) od[tn] = (f32x4){0.f, 0.f, 0.f, 0.f};
#pragma unroll
    for (int pr = 0; pr < 5; ++pr) { const int ta = w + 2 * pr, tb = (w + 2 * pr + 1 > 15) ? 15 : (w + 2 * pr + 1);
        const u32x2 pa = pk4(s[2 * pr]), pb = pk4(s[2 * pr + 1]); const u32x4 pw = (u32x4){pa.x, pa.y, pb.x, pb.y}; const bf16x8 pf = __builtin_bit_cast(bf16x8, pw);
#pragma unroll
        for (int tn = 0; tn < 4; ++tn) { const LAS bf16* vp = VT + (16 * tn + fr) * 264 + 4 * q; const u32x2 va = *(const LAS u32x2*)(vp + 16 * ta), vb = *(const LAS u32x2*)(vp + 16 * tb);
            const u32x4 vw = (u32x4){va.x, va.y, vb.x, vb.y}; od[tn] = mfma16(__builtin_bit_cast(bf16x8, vw), pf, od[tn]); } }
    const float il = 1.f / lsum; const int t = b * SEQ + rho + ((i0 + ql) << dsh);
    bf16* og = WSP(bf16, WS_OG) + ((size_t)g * T + t) * 512 + h * 64;
#pragma unroll
    for (int tn = 0; tn < 4; ++tn) *(u32x2*)(og + 16 * tn + 4 * q) = pk4(od[tn] * il);
    if (q == 0) WSP(float, WS_LSE)[((size_t)g * T + t) * 8 + h] = mx + __logf(lsum);
    __syncthreads();
}

__device__ __forceinline__ void attn_merge_phase(const Ctx& C) {
    const bf16* OG = WSP(bf16, WS_OG); const float* LSE = WSP(float, WS_LSE); bf16* AO = WSP(bf16, WS_AO);
    for (size_t e = (size_t)C.bid * NT + C.tid; e < (size_t)T * 64; e += (size_t)C.G * NT) { const size_t t = e >> 6; const int c8 = (int)(e & 63) * 8, h = c8 >> 6;
        const float l0 = LSE[t * 8 + h], l1 = LSE[((size_t)T + t) * 8 + h], l2 = LSE[((size_t)2 * T + t) * 8 + h]; const float m = fmaxf(l0, fmaxf(l1, l2));
        float a0 = __expf(l0 - m), a1 = __expf(l1 - m), a2 = __expf(l2 - m); const float inv = 1.f / (a0 + a1 + a2); a0 *= inv; a1 *= inv; a2 *= inv;
        const u32x4 v0 = *(const u32x4*)(OG + t * 512 + c8), v1 = *(const u32x4*)(OG + ((size_t)T + t) * 512 + c8), v2 = *(const u32x4*)(OG + ((size_t)2 * T + t) * 512 + c8); u32x4 o;
#pragma unroll
        for (int j = 0; j < 4; ++j) o[j] = pk2(a0 * bflo(v0[j]) + a1 * bflo(v1[j]) + a2 * bflo(v2[j]), a0 * bfhi(v0[j]) + a1 * bfhi(v1[j]) + a2 * bfhi(v2[j]));
        *(u32x4*)(AO + t * 512 + c8) = o; }
}

__device__ __forceinline__ void s_ssd_unit(const Ctx& C, int li, int u) {
    const int b = u >> 1, g = u & 1, hh = C.wave, h = g * 8 + hh, lane = C.lane;
    LAS float* xs = (LAS float*)(C.lds + hh * 2048);
    LAS float* Bs = xs + 64; LAS float* Cs = xs + 192;
    LAS float* ys = (LAS float*)(C.lds + 16384);
    LAS float* rs = ys + 512;
    const float* us = WSP(float, WS_SMALL) + (size_t)b * HYB_NP;
    const float* cst = INP(I_CONV) + ((size_t)(li * 32 + b) * 3) * 1536;
    const float* cw = INP(I_CONVW) + (size_t)li * 4 * 1536; const float* cb = INP(I_CONVB) + (size_t)li * 1536;
    auto conv = [&](int ch) { return siluf_(cb[ch] + cw[ch] * cst[ch] + cw[1536 + ch] * cst[1536 + ch] + cw[3072 + ch] * cst[3072 + ch] + cw[4608 + ch] * us[U_XBC + ch]); };
    xs[lane] = conv(h * 64 + lane);
    Bs[lane] = conv(1024 + g * 128 + lane); Bs[64 + lane] = conv(1024 + g * 128 + 64 + lane);
    Cs[lane] = conv(1280 + g * 128 + lane); Cs[64 + lane] = conv(1280 + g * 128 + 64 + lane);
    { float* co = (C.PP->out) + O_CONVS + ((size_t)(li * 32 + b) * 3) * 1536;
      for (int e = C.tid; e < 768; e += NT) { const int ch = e < 512 ? g * 512 + e : (e < 640 ? 1024 + g * 128 + (e - 512) : 1280 + g * 128 + (e - 640));
          co[ch] = cst[1536 + ch]; co[1536 + ch] = cst[3072 + ch]; co[3072 + ch] = us[U_XBC + ch]; } }
    LDSW();
    const float dt = softplus_(us[U_DT + h] + INP(I_DTB)[li * 16 + h]), dA = __expf(-dt * __expf(INP(I_ALOG)[li * 16 + h])), Dh = INP(I_SSDD)[li * 16 + h];
    const int pp = lane >> 3, nn = (lane & 7) * 16;
    f32x4 Bv[4], Cv[4];
#pragma unroll
    for (int j = 0; j < 4; ++j) { Bv[j] = *(const LAS f32x4*)(Bs + nn + 4 * j); Cv[j] = *(const LAS f32x4*)(Cs + nn + 4 * j); }
    const float* sin_ = INP(I_SSD) + ((size_t)(li * 32 + b) * 16 + h) * 8192; float* sout = (C.PP->out) + O_SSDS + ((size_t)(li * 32 + b) * 16 + h) * 8192;
    float yv = 0.f;
#pragma unroll
    for (int it = 0; it < 8; ++it) { const int p = it * 8 + pp; const float xp = xs[p], dx = dt * xp; float part = 0.f;
#pragma unroll
        for (int j = 0; j < 4; ++j) { f32x4 s = *(const f32x4*)(sin_ + p * 128 + nn + 4 * j); s = s * dA + Bv[j] * dx; *(f32x4*)(sout + p * 128 + nn + 4 * j) = s;
            part += (s[0] * Cv[j][0] + s[1] * Cv[j][1]) + (s[2] * Cv[j][2] + s[3] * Cv[j][3]); }
        part += __shfl_xor(part, 1); part += __shfl_xor(part, 2); part += __shfl_xor(part, 4);
        if ((lane & 7) == it) yv = part + Dh * xp; }
    { const int p = (lane & 7) * 8 + (lane >> 3); const float z = us[h * 64 + p]; const float y = yv * siluf_(z); ys[hh * 64 + p] = y; const float ss = wave_sum(y * y); if (lane == 0) rs[hh] = ss; }
    __syncthreads();
    { float tot = 0.f;
#pragma unroll
      for (int j = 0; j < 8; ++j) tot += rs[j];
      const float rinv = rsqrtf(tot * (1.f / 512.f) + EPS); const int cc = C.tid;
      WSP(bf16, WS_YCAT)[(size_t)(T + b) * 2048 + g * 512 + cc] = (bf16)(pk2(ys[cc] * rinv * INP(I_SNW)[li * 1024 + g * 512 + cc], 0.f) & 0xffffu); }
    __syncthreads();
}

__device__ __forceinline__ void s_rwkv_unit(const Ctx& C, int li, int b) {
    const int lane = C.lane, tid = C.tid;
    LAS float* mix = (LAS float*)C.lds;
    LAS float* act = mix + 3328;
    LAS float* vec = act + 256;
    LAS float* hv = vec + 3072;
    const float* us = WSP(float, WS_SMALL) + (size_t)b * HYB_NP + U_RW;
    const float* sst = INP(I_SHIFT) + (size_t)(li * 32 + b) * RWC; const float* mu = INP(I_MU) + li * RWC;
    float* sho = (C.PP->out) + O_SHS + (size_t)(li * 32 + b) * RWC;
    for (int c = tid; c < RWC; c += NT) { const float cur = us[c]; mix[c] = cur + (sst[c] - cur) * mu[c]; sho[c] = cur; }
    __syncthreads();
    if (tid < 256) { const float x = mix[3072 + tid]; act[tid] = tid < 64 ? tanhf(x) : (tid < 128 ? x : sigm_(x)); }
    __syncthreads();
    const float* w2 = INP(I_RW2) + (size_t)li * 64 * 1024; const float* a2 = INP(I_RA2) + (size_t)li * 64 * 1024; const float* g2 = INP(I_RG2) + (size_t)li * 128 * 1024;
    for (int c = tid; c < 1024; c += NT) { float wl = INP(I_RW0)[li * 1024 + c], al = INP(I_RA0)[li * 1024 + c], gl = 0.f;
        for (int j = 0; j < 64; ++j) { wl += act[j] * w2[j * 1024 + c]; al += act[64 + j] * a2[j * 1024 + c]; }
        for (int j = 0; j < 128; ++j) gl += act[128 + j] * g2[j * 1024 + c];
        vec[c] = __expf(-__expf(-softplus_(-wl) - 0.5f)); vec[1024 + c] = sigm_(al); vec[2048 + c] = gl; }
    __syncthreads();
    LAS float* my = hv + C.wave * 192;
    for (int hh = 0; hh < 2; ++hh) { const int h = 2 * C.wave + hh, c = h * 64 + lane;
        const float r = mix[c], k = mix[1024 + c], v = mix[2048 + c], w = vec[c], a = vec[1024 + c], gt = vec[2048 + c];
        const float kk = k * INP(I_KK)[li * 1024 + c]; const float inv = 1.f / fmaxf(sqrtf(wave_sum(kk * kk)), 1e-12f); const float kkn = kk * inv;
        const float kp = k * (1.f + (a - 1.f) * INP(I_KA)[li * 1024 + c]);
        my[lane] = -kkn; my[64 + lane] = kkn * a; my[128 + lane] = kp; LDSW();
        const float* sin_ = INP(I_WKV) + ((size_t)(li * 32 + b) * 16 + h) * 4096 + lane * 64; float* sout = (C.PP->out) + O_WKVS + ((size_t)(li * 32 + b) * 16 + h) * 4096 + lane * 64;
        f32x4 S[16]; float sa = 0.f;
#pragma unroll
        for (int j = 0; j < 16; ++j) { S[j] = *(const f32x4*)(sin_ + 4 * j); const f32x4 n4 = *(const LAS f32x4*)(my + 4 * j); sa += (S[j][0] * n4[0] + S[j][1] * n4[1]) + (S[j][2] * n4[2] + S[j][3] * n4[3]); }
        float o = 0.f;
#pragma unroll
        for (int j = 0; j < 16; ++j) { const f32x4 b4 = *(const LAS f32x4*)(my + 64 + 4 * j), k4 = *(const LAS f32x4*)(my + 128 + 4 * j), w4 = *(const LAS f32x4*)(vec + h * 64 + 4 * j), r4 = *(const LAS f32x4*)(mix + h * 64 + 4 * j);
            S[j] = S[j] * w4 + b4 * sa + k4 * v; *(f32x4*)(sout + 4 * j) = S[j]; o += (S[j][0] * r4[0] + S[j][1] * r4[1]) + (S[j][2] * r4[2] + S[j][3] * r4[3]); }
        const float mean = wave_sum(o) * (1.f / 64.f), d = o - mean, var = wave_sum(d * d) * (1.f / 64.f);
        float y = d * rsqrtf(var + LN_EPS) * INP(I_LNW)[li * 1024 + c] + INP(I_LNB)[li * 1024 + c];
        const float rk = wave_sum(r * kp * INP(I_RK)[li * 1024 + c]);
        y = (y + rk * v) * gt;
        WSP(bf16, WS_YCAT)[(size_t)(T + b) * 2048 + 1024 + c] = (bf16)(pk2(y, 0.f) & 0xffffu);
        LDSW();
    }
    __syncthreads();
}

__device__ __forceinline__ void s_attn_unit(const Ctx& C, int li, int u) {
    const int task = u * 8 + C.wave, b = task >> 3, h = task & 7, lane = C.lane;
    LAS float* qs = (LAS float*)(C.lds + C.wave * 1024);
    const float* qkv = WSP(float, WS_SMALL) + MiB / 4 + (size_t)b * QKV_N;
    const float* rp = WSP(float, WS_ROPE) + 8192 * 16;
    float og[3], lse[3];
#pragma unroll
    for (int g = 0; g < 3; ++g) {
        const int W = 128 << (2 * g), dsh = 2 * g;
        const float* base = qkv + g * 1536 + h * 64;
        float qv = base[lane], kv = base[512 + lane], vv = base[1024 + lane];
        {
            const float qo_ = __shfl_xor(qv, 8), ko_ = __shfl_xor(kv, 8);
            if (lane < 16) { const float cs = rp[lane & 7], sn = rp[8 + (lane & 7)]; if (lane < 8) { qv = qv * cs - qo_ * sn; kv = kv * cs - ko_ * sn; } else { qv = qv * cs + qo_ * sn; kv = kv * cs + ko_ * sn; } }
        }
        qv *= 0.125f;
        float* wo = (C.PP->out) + (g == 0 ? O_W0S : g == 1 ? O_W1S : O_W2S) + ((size_t)(li * 32 + b) * W + (W - 1)) * 1024;
        wo[h * 64 + lane] = kv; wo[512 + h * 64 + lane] = vv;
        qs[lane] = qv; LDSW();
        f32x4 q4[16];
#pragma unroll
        for (int j = 0; j < 16; ++j) q4[j] = *(const LAS f32x4*)(qs + 4 * j);
        const float* cache = INP(I_C0 + g) + ((size_t)(li * 32 + b) * W) * 1024 + h * 64;
        float sc0, sc1;
        { const float* k0 = cache + (size_t)(W - ((lane + 1) << dsh)) * 1024; const float* k1 = cache + (size_t)(W - ((lane + 65) << dsh)) * 1024; float a0 = 0.f, a1 = 0.f;
#pragma unroll
          for (int j = 0; j < 16; ++j) { const f32x4 x0 = *(const f32x4*)(k0 + 4 * j), x1 = *(const f32x4*)(k1 + 4 * j);
              a0 += (x0[0] * q4[j][0] + x0[1] * q4[j][1]) + (x0[2] * q4[j][2] + x0[3] * q4[j][3]); a1 += (x1[0] * q4[j][0] + x1[1] * q4[j][1]) + (x1[2] * q4[j][2] + x1[3] * q4[j][3]); }
          sc0 = a0; sc1 = a1; }
        const float ss = wave_sum(qv * kv);
        const float m = fmaxf(ss, wave_max(fmaxf(sc0, sc1)));
        const float p0 = __expf(sc0 - m), p1 = __expf(sc1 - m), ps = __expf(ss - m);
        const float l = wave_sum(p0 + p1) + ps;
        float o = ps * vv;
        for (int j = 0; j < 64; ++j) { const float pj0 = __shfl(p0, j), pj1 = __shfl(p1, j);
            o += pj0 * cache[(size_t)(W - ((j + 1) << dsh)) * 1024 + 512 + lane] + pj1 * cache[(size_t)(W - ((j + 65) << dsh)) * 1024 + 512 + lane]; }
        og[g] = o / l; lse[g] = m + __logf(l);
        LDSW();
    }
    const float m = fmaxf(lse[0], fmaxf(lse[1], lse[2])); float a0 = __expf(lse[0] - m), a1 = __expf(lse[1] - m), a2 = __expf(lse[2] - m); const float inv = 1.f / (a0 + a1 + a2);
    const float o = (a0 * og[0] + a1 * og[1] + a2 * og[2]) * inv;
    WSP(bf16, WS_AO)[(size_t)(T + b) * 512 + h * 64 + lane] = (bf16)(pk2(o, 0.f) & 0xffffu);
}

__global__ void __launch_bounds__(512, 2) mk_fwd(Params P) {
    extern __shared__ __attribute__((aligned(16))) unsigned char lds_raw[];
    Ctx C;
    C.lds = (LAS unsigned char*)lds_raw;
#define PHASE() do { unsigned long long _k = (unsigned long long)__builtin_amdgcn_kernarg_segment_ptr(); int _t = threadIdx.x, _b = blockIdx.x, _g = gridDim.x; asm volatile("" : "+s"(_k), "+v"(_t), "+s"(_b), "+s"(_g)); \
        C.PP = (const CAS Params*)_k; C.tid = _t; C.lane = _t & 63; C.wave = __builtin_amdgcn_readfirstlane(_t >> 6); C.G = _g; C.bid = _b; } while (0)
    PHASE();
    for (int u = C.tid; u < (LDS_BYTES - LDS_RING) / 4; u += NT) ((LAS unsigned*)(C.lds + LDS_RING))[u] = 0u;
    __syncthreads();
    (void)xcd_barrier_post((unsigned*)((C.PP->ws) + WS_CTL) + 4096, (volatile LAS unsigned*)(C.lds + LDS_MISC) + 8);
#define GRID_BAR() do { XcdBarrier _b; _b.bar = (unsigned*)((C.PP->ws) + WS_CTL) + 4096; _b.x = xb_xcc_id(); _b.st = (volatile LAS unsigned*)(C.lds + LDS_MISC) + 8; xcd_barrier(_b); PHASE(); } while (0)
    LAS unsigned char* ring = C.lds;

    p0_weights(C);
    __syncthreads(); PHASE();
    p0_mod(C);
    PHASE();
    p0_cache_roll(C);
    GRID_BAR();

    for (int l = 0; l < 4; ++l) {
        const int li = l >> 1;
#define modl (WSP(float, WS_MOD) + (size_t)l * NSEQ * 6144)
        norm_phase(C, l, 0, l == 0);
        GRID_BAR();
        if ((l & 1) == 0) {
            { pg8::Gemm g{WSP(bf16, WS_XN), WSP(bf16, WS_WIN) + (size_t)li * HYB_NP * 1024, T, HYB_NP, 1024}; pg8::StaticOrder S; S.init(T, HYB_NP, C.G, C.bid);
              EpiIn E{WSP(bf16, WS_U), WSP(float, WS_DT)}; pg8::gemm_phase<EpiIn, pg8::StaticOrder>(ring, g, S, E, nullptr); }
            PHASE();
            { float* US = WSP(float, WS_SMALL); small_gemm(C, WSP(bf16, WS_XN) + (size_t)T * D, WSP(bf16, WS_WIN) + (size_t)li * HYB_NP * 1024, HYB_NP, 1024, [&](int r, int c, float v) { US[(size_t)r * HYB_NP + c] = v; }); }
            GRID_BAR();
            for (int u = C.bid; u < 256; u += C.G) rwkv_prep_unit(C, li, u);
            PHASE();
            for (int u = C.bid; u < 256; u += C.G) ssd_a_unit(C, li, u);
            PHASE();
            for (int u = (C.bid + 192) % C.G; u < 64; u += C.G) s_ssd_unit(C, li, u);
            PHASE();
            for (int u = (C.bid + 128) % C.G; u < 32; u += C.G) s_rwkv_unit(C, li, u);
            GRID_BAR();
            for (int u = C.bid; u < 256; u += C.G) rwkv_scan_unit(C, u);
            PHASE();
            ssd_scan_phase(C, li);
            GRID_BAR();
            if (C.G >= 64) { if (C.bid < 32) { PHASE(); rwkv_combine_unit(C, li, C.bid); } else { PHASE(); for (int u = C.bid - 32; u < 256; u += C.G - 32) ssd_c_unit(C, li, u); } }
            else { for (int u = C.bid; u < 32; u += C.G) rwkv_combine_unit(C, li, u); PHASE(); for (int u = C.bid; u < 256; u += C.G) ssd_c_unit(C, li, u); }
            GRID_BAR();
            for (int u = C.bid; u < 2048; u += C.G) rwkv_out_unit(C, li, u);
            GRID_BAR();
            { const float* xin = l == 0 ? INP(I_XP) : WSP(float, WS_X); const float* xsin = l == 0 ? INP(I_XS) : WSP(float, WS_X) + (size_t)T * D; const float* gate = modl + 2048;
              pg8::Gemm g{WSP(bf16, WS_YCAT), WSP(bf16, WS_WOUT) + (size_t)li * 1024 * 2048, T, 1024, 2048}; pg8::StaticOrder S; S.init(T, 1024, C.G, C.bid);
              EpiRes E{xin, WSP(float, WS_X), gate}; pg8::gemm_phase<EpiRes, pg8::StaticOrder>(ring, g, S, E, nullptr); PHASE();
              float* XS = WSP(float, WS_X) + (size_t)T * D;
              small_gemm(C, WSP(bf16, WS_YCAT) + (size_t)T * 2048, WSP(bf16, WS_WOUT) + (size_t)li * 1024 * 2048, 1024, 2048, [&](int r, int c, float v) { XS[(size_t)r * D + c] = xsin[(size_t)r * D + c] + gate[(size_t)(2 + r) * 6144 + c] * v; }); }
            GRID_BAR();
        } else {
            { pg8::Gemm g{WSP(bf16, WS_XN), WSP(bf16, WS_WQKV) + (size_t)li * QKV_N * 1024, T, QKV_N, 1024}; pg8::StaticOrder S; S.init(T, QKV_N, C.G, C.bid);
              EpiQkv E{WSP(bf16, WS_QKV), WSP(float, WS_ROPE), (C.PP->out), li}; pg8::gemm_phase<EpiQkv, pg8::StaticOrder>(ring, g, S, E, nullptr); PHASE();
              float* QS = WSP(float, WS_SMALL) + MiB / 4;
              small_gemm(C, WSP(bf16, WS_XN) + (size_t)T * D, WSP(bf16, WS_WQKV) + (size_t)li * QKV_N * 1024, QKV_N, 1024, [&](int r, int c, float v) { QS[(size_t)r * QKV_N + c] = v; }); }
            GRID_BAR();
            for (int u = C.bid; u < 3072; u += C.G) attn_tile_unit(C, u);
            PHASE();
            for (int u = C.bid; u < 32; u += C.G) s_attn_unit(C, li, u);
            GRID_BAR();
            attn_merge_phase(C);
            GRID_BAR();
            { const float* gate = modl + 2048;
              pg8::Gemm g{WSP(bf16, WS_AO), WSP(bf16, WS_WAO) + (size_t)li * 1024 * 512, T, 1024, 512}; pg8::StaticOrder S; S.init(T, 1024, C.G, C.bid);
              EpiRes E{WSP(float, WS_X), WSP(float, WS_X), gate}; pg8::gemm_phase<EpiRes, pg8::StaticOrder>(ring, g, S, E, nullptr); PHASE();
              float* XS = WSP(float, WS_X) + (size_t)T * D;
              small_gemm(C, WSP(bf16, WS_AO) + (size_t)T * 512, WSP(bf16, WS_WAO) + (size_t)li * 1024 * 512, 1024, 512, [&](int r, int c, float v) { XS[(size_t)r * D + c] += gate[(size_t)(2 + r) * 6144 + c] * v; }); }
            GRID_BAR();
        }
        norm_phase(C, l, 1, false);
        GRID_BAR();
        { pg8::Gemm g{WSP(bf16, WS_XN), WSP(bf16, WS_W1) + (size_t)l * FF * 1024, T, FF, 1024}; pg8::StaticOrder S; S.init(T, FF, C.G, C.bid);
          EpiMlp1 E{WSP(bf16, WS_HID)}; pg8::gemm_phase<EpiMlp1, pg8::StaticOrder>(ring, g, S, E, nullptr); PHASE();
          bf16* HS = WSP(bf16, WS_HID) + (size_t)T * FF;
          small_gemm(C, WSP(bf16, WS_XN) + (size_t)T * D, WSP(bf16, WS_W1) + (size_t)l * FF * 1024, FF, 1024, [&](int r, int c, float v) { const float a = fmaxf(v, 0.f); HS[(size_t)r * FF + c] = (bf16)(pk2(a * a, 0.f) & 0xffffu); }); }
        GRID_BAR();
        { const float* gate = modl + 5120;
          pg8::Gemm g{WSP(bf16, WS_HID), WSP(bf16, WS_W2) + (size_t)l * 1024 * FF, T, 1024, FF}; pg8::StaticOrder S; S.init(T, 1024, C.G, C.bid);
          EpiRes E{WSP(float, WS_X), WSP(float, WS_X), gate}; pg8::gemm_phase<EpiRes, pg8::StaticOrder>(ring, g, S, E, nullptr); PHASE();
          float* XS = WSP(float, WS_X) + (size_t)T * D;
          small_gemm(C, WSP(bf16, WS_HID) + (size_t)T * FF, WSP(bf16, WS_W2) + (size_t)l * 1024 * FF, 1024, FF, [&](int r, int c, float v) { XS[(size_t)r * D + c] += gate[(size_t)(2 + r) * 6144 + c] * v; }); }
        GRID_BAR();
    }
    final_norm_phase(C);
}
}

extern "C" void kernel_launch(void* const* d_in, const int* in_sizes, int n_in, void* d_out, int out_size, void* d_ws, size_t ws_size, hipStream_t stream) {
    static int grid = 0;
    if (grid == 0) {
        int dev = 0, cus = 0, per_cu = 0;
        if (hipGetDevice(&dev) != hipSuccess || hipDeviceGetAttribute(&cus, hipDeviceAttributeMultiprocessorCount, dev) != hipSuccess) { fprintf(stderr, "kernel_launch: device query failed\n"); grid = -1; return; }
        if (hipFuncSetAttribute((const void*)mk::mk_fwd, hipFuncAttributeMaxDynamicSharedMemorySize, mk::LDS_BYTES) != hipSuccess) { fprintf(stderr, "kernel_launch: hipFuncSetAttribute failed\n"); grid = -1; return; }
        if (hipOccupancyMaxActiveBlocksPerMultiprocessor(&per_cu, (const void*)mk::mk_fwd, 512, mk::LDS_BYTES) != hipSuccess || per_cu < 1) fprintf(stderr, "kernel_launch: occupancy query reports %d\n", per_cu);
        if (n_in != 39 || (size_t)out_size != mk::O_END || ws_size < mk::WS_END) { fprintf(stderr, "kernel_launch: unexpected sizes n_in %d out %d ws %zu\n", n_in, out_size, ws_size); grid = -1; return; }
        grid = cus;
    }
    if (grid < 0) return;
    hipMemsetAsync((char*)d_ws + mk::WS_CTL, 0, mk::CTL_BYTES, stream);
    mk::Params p; memset(&p, 0, sizeof(p));
    for (int i = 0; i < 39; ++i) p.in[i] = (const float*)d_in[i];
    p.out = (float*)d_out; p.ws = (unsigned char*)d_ws;
    hipLaunchKernelGGL(mk::mk_fwd, dim3(grid), dim3(512), mk::LDS_BYTES, stream, p);
}
```

```cpp
#include <hip/hip_runtime.h>
#include <cstdio>
#include <cstdint>
#include <cstring>
namespace pg8 {
#define PG8_LAS __attribute__((address_space(3)))
typedef unsigned short bf16_t;
typedef short bf16x8 __attribute__((ext_vector_type(8)));
typedef float f32x4 __attribute__((ext_vector_type(4)));
typedef unsigned u32x4 __attribute__((ext_vector_type(4)));
constexpr int BM = 256, BK = 64, HALF = 128, HTB = HALF * BK * 2  , STAGE_BYTES = 8 * HTB, NXCD = 8, WGM = 8;

__host__ __device__ __forceinline__ int lds_byte(int r, int c) { const int st = (r >> 4) * 2 + (c >> 5), rr = r & 15, cc = c & 31, ob = rr * 64 + cc * 2; return st * 1024 + (ob ^ (((ob >> 9) & 1) << 5)); }
__host__ __device__ __forceinline__ void stage_rc(int b, int& R, int& C) { const int st = b / 1024, sb = b % 1024, swz = sb ^ (((sb >> 9) & 1) << 5); R = (st >> 1) * 16 + swz / 64; C = (st & 1) * 32 + (swz % 64) / 2; }
__host__ __device__ __forceinline__ int perm32(int rho) { const int n = rho >> 4, i = rho & 15; return 8 * (i >> 2) + 4 * n + (i & 3); }

struct Unit { int pm, pn; };
struct Gemm { const bf16_t* A; const bf16_t* Bt; int M, N, K; };

struct StaticOrder {
    int nM, nN, nwg, G, c;
    __host__ __device__ void init(int M, int N, int G_, int c_) { nM = M / BM; nN = N / BM; nwg = nM * nN; G = G_; c = c_; }
    __host__ __device__ bool next(int i, Unit& u) const {
        const long L = (long)i * G + c; if (L >= nwg) return false;
        int wgid = (int)L; { const int q = nwg / NXCD, r = nwg % NXCD, xcd = wgid % NXCD, off = wgid / NXCD; wgid = (xcd < r ? xcd * (q + 1) : r * (q + 1) + (xcd - r) * q) + off; }
        const int nig = WGM * nN, gid = wgid / nig, fm = gid * WGM, gsz = (nM - fm) < WGM ? (nM - fm) : WGM;
        u.pm = fm + ((wgid % nig) % gsz); u.pn = (wgid % nig) / gsz; return true;
    }
    __device__ __forceinline__ void a_ready(const Unit&) const {}
    __device__ __forceinline__ void done(const Unit&) const {}
};
template <class Epi, class Sched, bool STAMP = false>
__device__ __forceinline__ void gemm_phase(PG8_LAS unsigned char* lds, const Gemm g, const Sched& S, const Epi& E, unsigned long long* stamps) {
    int tid_ = threadIdx.x; asm volatile("" : "+v"(tid_));
    const int tid = tid_, wid = __builtin_amdgcn_readfirstlane(tid >> 6), lane = tid & 63, wr = wid >> 2, wc = wid & 3, fr = lane & 15, fq = lane >> 4;
    const int K = g.K, nt = K / BK;
    int ts_lo = 0, ts_hi = 0, nts = 0; const unsigned long long rt_entry = STAMP ? (unsigned long long)wall_clock64() : 0ull;
#define PG8_STAMP() do { if (STAMP && wid == 0 && nts < 64) { const unsigned long long _c = (unsigned long long)clock64(); \
        ts_lo = (lane == nts) ? (int)(unsigned)_c : ts_lo; ts_hi = (lane == nts) ? (int)(unsigned)(_c >> 32) : ts_hi; ++nts; } } while (0)
    PG8_STAMP();
    unsigned voffA[2], voffB[2];
#pragma unroll
    for (int i = 0; i < 2; ++i) { int R, C; stage_rc(tid * 16 + i * 8192, R, C); const int Rb = Epi::PERM ? ((R & ~31) + perm32(R & 31)) : R;
        voffA[i] = (unsigned)(R * K + C) * 2u; voffB[i] = (unsigned)(Rb * K + C) * 2u; }
    const size_t kstep = (size_t)(BK * 2);
    const size_t hstep = (size_t)HALF * K * 2;
    const size_t tstep = 2 * hstep;
    const unsigned ldsw = (unsigned)wid * 1024u;
    const int aoff = lds_byte(wr * 64 + fr, fq * 8), boff = lds_byte(wc * 32 + fr, fq * 8);
#define PG8_SA(b, h) (((b) * 2 + (h)) * HTB)
#define PG8_SB(b, h) ((4 + (b) * 2 + (h)) * HTB)
#define PG8_STAGE(bufoff, gbase, voff) do { _Pragma("unroll") for (int _i = 0; _i < 2; ++_i) \
        __builtin_amdgcn_global_load_lds((const unsigned*)((const char*)(gbase) + (voff)[_i]), (PG8_LAS unsigned*)(lds + (bufoff) + ldsw + _i * 8192), 16, 0, 0); } while (0)
#define PG8_LDA(dst, b, h) do { _Pragma("unroll") for (int m = 0; m < 4; ++m) _Pragma("unroll") for (int k = 0; k < 2; ++k) dst[m][k] = *(const PG8_LAS bf16x8*)(lds + PG8_SA(b, h) + aoff + m * 2048 + k * 1024); } while (0)
#define PG8_LDB(dst, b, h) do { _Pragma("unroll") for (int n = 0; n < 2; ++n) _Pragma("unroll") for (int k = 0; k < 2; ++k) dst[n][k] = *(const PG8_LAS bf16x8*)(lds + PG8_SB(b, h) + boff + n * 2048 + k * 1024); } while (0)
#define PG8_MMA(ai, bj, At, Bt) do { __builtin_amdgcn_s_setprio(1); _Pragma("unroll") for (int m = 0; m < 4; ++m) _Pragma("unroll") for (int n = 0; n < 2; ++n) _Pragma("unroll") for (int k = 0; k < 2; ++k) \
        acc[ai][bj][m][n] = __builtin_amdgcn_mfma_f32_16x16x32_bf16(Bt[n][k], At[m][k], acc[ai][bj][m][n], 0, 0, 0); __builtin_amdgcn_s_setprio(0); } while (0)
#define PG8_WAIT_V(n) asm volatile("s_waitcnt vmcnt(" #n ")" ::: "memory")
#define PG8_WAIT_L(n) asm volatile("s_waitcnt lgkmcnt(" #n ")" ::: "memory")
#define PG8_BAR __builtin_amdgcn_s_barrier()
#define PG8_SCHED __builtin_amdgcn_sched_barrier(0)
    Unit cur, nxt; int ui = 0;
    if (!S.next(0, cur)) return;
    f32x4 acc[2][2][4][2];
#pragma unroll
    for (int a = 0; a < 2; ++a)
#pragma unroll
        for (int b = 0; b < 2; ++b)
#pragma unroll
            for (int m = 0; m < 4; ++m)
#pragma unroll
                for (int n = 0; n < 2; ++n) acc[a][b][m][n] = (f32x4){0.f, 0.f, 0.f, 0.f};
    bf16x8 At[4][2], B0[2][2], B1[2][2];
    const char* cA = (const char*)g.A + (size_t)cur.pm * tstep; const char* cB = (const char*)g.Bt + (size_t)cur.pn * tstep;
    S.a_ready(cur);
    PG8_STAGE(PG8_SB(0, 0), cB, voffB); PG8_STAGE(PG8_SA(0, 0), cA, voffA); PG8_STAGE(PG8_SB(0, 1), cB + hstep, voffB); PG8_STAGE(PG8_SA(0, 1), cA + hstep, voffA);
    if (wr == 1) PG8_BAR;
    PG8_WAIT_V(4); PG8_BAR;
    PG8_STAGE(PG8_SB(1, 0), cB + kstep, voffB); PG8_STAGE(PG8_SA(1, 0), cA + kstep, voffA); PG8_STAGE(PG8_SB(1, 1), cB + hstep + kstep, voffB);
    PG8_WAIT_V(6); PG8_BAR;
    PG8_STAMP();
    for (;;) {
        const bool has_next = S.next(ui + 1, nxt);
        const char* nA = has_next ? (const char*)g.A + (size_t)nxt.pm * tstep : cA; const char* nB = has_next ? (const char*)g.Bt + (size_t)nxt.pn * tstep : cB;
        for (int t = 0; t < nt; t += 2) {
            const bool last = (t == nt - 2);
            const char* a1 = cA + (size_t)(t + 1) * kstep;
            const char* a2 = last ? nA : cA + (size_t)(t + 2) * kstep; const char* b2 = last ? nB : cB + (size_t)(t + 2) * kstep;
            const char* a3 = a2 + kstep; const char* b3 = b2 + kstep;
            if (last && has_next) S.a_ready(nxt);
            PG8_LDB(B0, 0, 0); PG8_SCHED; PG8_LDA(At, 0, 0); PG8_STAGE(PG8_SA(1, 1), a1 + hstep, voffA);
            PG8_WAIT_L(8); PG8_BAR; PG8_WAIT_L(0); PG8_MMA(0, 0, At, B0); PG8_BAR; PG8_SCHED;
            PG8_LDB(B1, 0, 1); PG8_STAGE(PG8_SB(0, 0), b2, voffB);
            PG8_BAR; PG8_WAIT_L(0); PG8_MMA(0, 1, At, B1); PG8_BAR;
            PG8_LDA(At, 0, 1); PG8_STAGE(PG8_SA(0, 0), a2, voffA);
            PG8_BAR; PG8_WAIT_L(0); PG8_MMA(1, 0, At, B0); PG8_BAR; PG8_SCHED;
            PG8_STAGE(PG8_SB(0, 1), b2 + hstep, voffB);
            PG8_WAIT_V(6); PG8_BAR; PG8_MMA(1, 1, At, B1); PG8_BAR;
            PG8_LDB(B0, 1, 0); PG8_SCHED; PG8_LDA(At, 1, 0); PG8_STAGE(PG8_SA(0, 1), a2 + hstep, voffA);
            PG8_WAIT_L(8); PG8_BAR; PG8_WAIT_L(0); PG8_MMA(0, 0, At, B0); PG8_BAR; PG8_SCHED;
            PG8_LDB(B1, 1, 1); PG8_STAGE(PG8_SB(1, 0), b3, voffB);
            PG8_BAR; PG8_WAIT_L(0); PG8_MMA(0, 1, At, B1); PG8_BAR;
            PG8_LDA(At, 1, 1); PG8_STAGE(PG8_SA(1, 0), a3, voffA);
            PG8_BAR; PG8_WAIT_L(0); PG8_MMA(1, 0, At, B0); PG8_BAR; PG8_SCHED;
            PG8_STAGE(PG8_SB(1, 1), b3 + hstep, voffB);
            PG8_WAIT_V(6); PG8_BAR; PG8_MMA(1, 1, At, B1); PG8_BAR;
        }
        PG8_STAMP();
        if constexpr (!Epi::AFTER_DRAIN) { E(acc, cur, wr, wc, fr, fq); S.done(cur); }
        PG8_STAMP();
        if (!has_next) break;
#pragma unroll
        for (int a = 0; a < 2; ++a)
#pragma unroll
            for (int b = 0; b < 2; ++b)
#pragma unroll
                for (int m = 0; m < 4; ++m)
#pragma unroll
                    for (int n = 0; n < 2; ++n) acc[a][b][m][n] = (f32x4){0.f, 0.f, 0.f, 0.f};
        cur = nxt; cA = nA; cB = nB; ++ui;
    }
    PG8_WAIT_V(0);
    if (wr == 0) PG8_BAR;
    PG8_BAR;
    if constexpr (Epi::AFTER_DRAIN) { E.fused(acc, cur, wr, wc, fr, fq, lds, wid, lane); S.done(cur); }
    PG8_STAMP();
    if (STAMP && wid == 0) { stamps[lane] = lane < nts ? (((unsigned long long)(unsigned)ts_hi << 32) | (unsigned)ts_lo) : 0ull;
        if (lane == 62) stamps[62] = rt_entry; if (lane == 63) stamps[63] = (unsigned long long)wall_clock64(); }
#undef PG8_STAMP
#undef PG8_SA
#undef PG8_SB
#undef PG8_STAGE
#undef PG8_LDA
#undef PG8_LDB
#undef PG8_MMA
#undef PG8_WAIT_V
#undef PG8_WAIT_L
#undef PG8_BAR
#undef PG8_SCHED
}
}
#define XB_TMO      128
#define XB_XCNT(j)  (256  + 64 * (j))
#define XB_XSUB(j)  (1280 + 64 * (j))
#define XB_XGEN(j)  (2304 + 64 * (j))
#define XB_TOP      3328
#define XB_TOPGEN   3392
#define XCD_BAR_WORDS 3456
#define XB_SPIN_CAP (1u << 18)
#define LAS __attribute__((address_space(3)))

__device__ __forceinline__ unsigned xb_ld(unsigned* p)              { return __hip_atomic_load(p, __ATOMIC_RELAXED, __HIP_MEMORY_SCOPE_AGENT); }
__device__ __forceinline__ unsigned xb_add(unsigned* p, unsigned v) { return __hip_atomic_fetch_add(p, v, __ATOMIC_RELAXED, __HIP_MEMORY_SCOPE_AGENT); }
__device__ __forceinline__ unsigned xb_xcc_id() { return (unsigned)__builtin_amdgcn_s_getreg((3 << 11) | 20) & 0xFu; }
#define XB_SPIN(cond, bar) do { unsigned _sp = 0; while (cond) { __builtin_amdgcn_s_sleep(1); \
    if ((++_sp & 255u) == 0u) { if (xb_ld(&(bar)[XB_TMO])) break; if (_sp > XB_SPIN_CAP) { atomicAdd(&(bar)[XB_TMO], 1u); break; } } } } while (0)

struct XcdBarrier {
    unsigned* bar; unsigned x;
    volatile LAS unsigned* st;
};

__device__ __forceinline__ XcdBarrier xcd_barrier_post(unsigned* bar, volatile LAS unsigned* st) {
    XcdBarrier b; b.bar = bar; b.x = xb_xcc_id(); b.st = st;
    if (threadIdx.x == 0) (void)xb_add(&bar[XB_XCNT(b.x)], 1u);
    return b;
}
__device__ __forceinline__ void xcd_barrier_complete(unsigned* bar, unsigned x, unsigned& nloc, unsigned& nx) {
    const unsigned G = gridDim.x * gridDim.y * gridDim.z;
    unsigned sum, cnt, mine, sp = 0u;
    for (;;) {
        sum = 0u; cnt = 0u; mine = 0u;
#pragma unroll
        for (unsigned j = 0; j < 16; ++j) { const unsigned c = xb_ld(&bar[XB_XCNT(j)]); sum += c; cnt += (c > 0u) ? 1u : 0u; mine = (j == x) ? c : mine; }
        if (sum == G) break;
        __builtin_amdgcn_s_sleep(1);
        if ((++sp & 255u) == 0u) { if (xb_ld(&bar[XB_TMO])) break; if (sp > XB_SPIN_CAP) { atomicAdd(&bar[XB_TMO], 1u); break; } }
    }
    nloc = mine > 0u ? mine : 1u; nx = cnt > 0u ? cnt : 1u;
}

__device__ __forceinline__ void xcd_barrier(const XcdBarrier& b) {
    asm volatile("s_waitcnt vmcnt(0)" ::: "memory");
    __syncthreads();
    if (threadIdx.x == 0) {
        unsigned* bar = b.bar;
        __builtin_amdgcn_s_waitcnt(0);
        unsigned nloc = b.st[0], nx = b.st[1];
        if (nloc == 0u) { xcd_barrier_complete(bar, b.x, nloc, nx); b.st[0] = nloc; b.st[1] = nx; }
        const unsigned old = xb_add(&bar[XB_XSUB(b.x)], 1u);
        const unsigned gen = old / nloc;
        if (old + 1u == (gen + 1u) * nloc) {
            __builtin_amdgcn_fence(__ATOMIC_RELEASE, "agent");
            asm volatile("s_waitcnt vmcnt(0)" ::: "memory");
            const unsigned og = xb_add(&bar[XB_TOP], 1u);
            const unsigned tg = og / nx;
            if (og + 1u == (tg + 1u) * nx) xb_add(&bar[XB_TOPGEN], 1u);
            else XB_SPIN(xb_ld(&bar[XB_TOPGEN]) == tg, bar);
            __builtin_amdgcn_fence(__ATOMIC_ACQUIRE, "agent");
            xb_add(&bar[XB_XGEN(b.x)], 1u);
            asm volatile("s_waitcnt vmcnt(0)" ::: "memory");
        } else {
            XB_SPIN(xb_ld(&bar[XB_XGEN(b.x)]) == gen, bar);
            __builtin_amdgcn_fence(__ATOMIC_ACQUIRE, "agent");
            asm volatile("s_waitcnt vmcnt(0)" ::: "memory");
        }
    }
    __syncthreads();
}

namespace mk {
#define LAS __attribute__((address_space(3)))
typedef unsigned short bf16;
typedef short bf16x8 __attribute__((ext_vector_type(8)));
typedef float f32x4 __attribute__((ext_vector_type(4)));
typedef float f32x2 __attribute__((ext_vector_type(2)));
typedef float f32x16 __attribute__((ext_vector_type(16)));
typedef unsigned u32x4 __attribute__((ext_vector_type(4)));
typedef unsigned u32x2 __attribute__((ext_vector_type(2)));

constexpr int T = 16384, SEQ = 8192, NS = 32, D = 1024, NSEQ = 34, NT = 512;
constexpr int HYB_NP = 6144, HYB_N = 5904, QKV_N = 4608, FF = 4096;
constexpr int U_XBC = 1024, U_DT = 2560, U_RW = 2576, RWC = 3328;
constexpr float EPS = 1e-6f, LN_EPS = 64e-5f;
constexpr size_t MiB = 1u << 20;
constexpr size_t WS_CTL = 0, CTL_BYTES = MiB;
constexpr size_t WS_WIN = 2 * MiB, WS_WOUT = 26 * MiB, WS_WQKV = 34 * MiB, WS_WAO = 52 * MiB, WS_W1 = 54 * MiB, WS_W2 = 86 * MiB, WS_LORA = 118 * MiB;
constexpr size_t WS_MOD = 119 * MiB, WS_ROPE = 123 * MiB, WS_SMALL = 124 * MiB, WS_X = 128 * MiB, WS_XN = 193 * MiB, WS_U = 226 * MiB;
constexpr size_t WS_DT = 418 * MiB, WS_DTS = 419 * MiB, WS_ACS = 420 * MiB, WS_REC = 421 * MiB, WS_G = 805 * MiB, WS_XT = 837 * MiB, WS_BC = 869 * MiB;
constexpr size_t WS_CS = 885 * MiB, WS_QO = 949 * MiB, WS_SL = 1077 * MiB, WS_SST = 1141 * MiB, WS_YCAT = 1173 * MiB, WS_QKV = 1238 * MiB;
constexpr size_t WS_OG = 1382 * MiB, WS_LSE = 1430 * MiB, WS_AO = 1432 * MiB, WS_HID = 1449 * MiB, WS_END = 1578 * MiB;
constexpr size_t O_YP = 0, O_YS = O_YP + (size_t)T * D, O_SSDP = O_YS + 32 * 1024, O_SSDS = O_SSDP + 2 * 2 * 16 * 8192, O_CONVP = O_SSDS + (size_t)2 * 32 * 16 * 8192;
constexpr size_t O_CONVS = O_CONVP + 2 * 2 * 3 * 1536, O_WKVP = O_CONVS + 2 * 32 * 3 * 1536, O_WKVS = O_WKVP + 2 * 2 * 16 * 4096, O_SHP = O_WKVS + (size_t)2 * 32 * 16 * 4096;
constexpr size_t O_SHS = O_SHP + 2 * 2 * 3328, O_W0P = O_SHS + 2 * 32 * 3328, O_W0S = O_W0P + (size_t)2 * 2 * 128 * 1024, O_W1P = O_W0S + (size_t)2 * 32 * 128 * 1024;
constexpr size_t O_W1S = O_W1P + (size_t)2 * 2 * 512 * 1024, O_W2P = O_W1S + (size_t)2 * 32 * 512 * 1024, O_W2S = O_W2P + (size_t)2 * 2 * 2048 * 1024;
constexpr size_t O_END = O_W2S + (size_t)2 * 32 * 2048 * 1024;
static_assert(O_END == 217889792ull, "output size");
constexpr int LDS_RING = 131072, LDS_MISC = LDS_RING + 320, LDS_BYTES = 147456;

struct Params { const float* in[39]; float* out; unsigned char* ws; };

__device__ __forceinline__ unsigned pk2(float lo, float hi) { unsigned r; asm volatile("v_cvt_pk_bf16_f32 %0, %1, %2" : "=v"(r) : "v"(lo), "v"(hi)); return r; }
__device__ __forceinline__ float bflo(unsigned u) { return __uint_as_float(u << 16); }
__device__ __forceinline__ float bfhi(unsigned u) { return __uint_as_float(u & 0xffff0000u); }
__device__ __forceinline__ float bf1(bf16 h) { return __uint_as_float(((unsigned)h) << 16); }
__device__ __forceinline__ f32x4 bf4(u32x2 v) { return (f32x4){bflo(v.x), bfhi(v.x), bflo(v.y), bfhi(v.y)}; }
__device__ __forceinline__ u32x2 pk4(f32x4 v) { u32x2 r; r.x = pk2(v[0], v[1]); r.y = pk2(v[2], v[3]); return r; }
__device__ __forceinline__ float siluf_(float x) { return x / (1.f + __expf(-x)); }
__device__ __forceinline__ float sigm_(float x) { return 1.f / (1.f + __expf(-x)); }
__device__ __forceinline__ float softplus_(float x) { return fmaxf(x, 0.f) + log1pf(__expf(-fabsf(x))); }
__device__ __forceinline__ float wave_sum(float v) {
#pragma unroll
    for (int o = 1; o < 64; o <<= 1) v += __shfl_xor(v, o);
    return v;
}
__device__ __forceinline__ float wave_max(float v) {
#pragma unroll
    for (int o = 1; o < 64; o <<= 1) v = fmaxf(v, __shfl_xor(v, o));
    return v;
}
__device__ __forceinline__ f32x4 mfma16(bf16x8 a, bf16x8 b, f32x4 c) { return __builtin_amdgcn_mfma_f32_16x16x32_bf16(a, b, c, 0, 0, 0); }
#define LDSW() asm volatile("s_waitcnt lgkmcnt(0)" ::: "memory")

#define CAS __attribute__((address_space(4)))
struct Ctx {
    LAS unsigned char* lds; int tid, lane, wave, G, bid;
    const CAS Params* PP;
};
#define WSP(type, off) ((type*)((C.PP->ws) + (off)))
#define INP(i) (C.PP->in[i])
enum { I_XP = 0, I_XS, I_SSD, I_CONV, I_WKV, I_SHIFT, I_C0, I_C1, I_C2, I_CP, I_CS, I_NMIX, I_NMLP, I_NFIN, I_ADAW, I_ADAB, I_W1, I_W2, I_HIN, I_HOUT, I_CONVW, I_CONVB,
       I_DTB, I_ALOG, I_SSDD, I_SNW, I_MU, I_RW0, I_RW2, I_RA0, I_RA2, I_RG2, I_KK, I_KA, I_RK, I_LNW, I_LNB, I_AQKV, I_AOUT };

__device__ __forceinline__ void transpose_item(const float* W, int K, int N, bf16* WT, LAS float* scr, int item, int lane) {
    const int nblk = (N + 31) / 32, kb = item / nblk, nb = item % nblk, k0 = 64 * kb, n0 = 32 * nb;
    const int nn = n0 + (lane & 31);
#pragma unroll 8
    for (int i = 0; i < 32; ++i) { const int kk = 2 * i + (lane >> 5); scr[kk * 33 + (lane & 31)] = nn < N ? W[(size_t)(k0 + kk) * N + nn] : 0.f; }
    LDSW();
    const int c = lane & 7;
#pragma unroll
    for (int j = 0; j < 4; ++j) { const int n = (lane >> 3) + 8 * j; const LAS float* s = scr + (8 * c) * 33 + n;
        u32x4 o; o.x = pk2(s[0 * 33], s[1 * 33]); o.y = pk2(s[2 * 33], s[3 * 33]); o.z = pk2(s[4 * 33], s[5 * 33]); o.w = pk2(s[6 * 33], s[7 * 33]);
        *(u32x4*)(WT + (size_t)(n0 + n) * K + k0 + 8 * c) = o; }
    LDSW();
}

__device__ __forceinline__ void p0_weights(const Ctx& C) {
    LAS float* scr = (LAS float*)(C.lds + C.wave * 16384);
    const int gw = C.bid * 8 + C.wave, NGW = C.G * 8;
    constexpr int N_IN = 16 * 185, N_OUT = 32 * 32, N_QKV = 16 * 144, N_AO = 8 * 32, N_1 = 16 * 128, N_2 = 64 * 32, N_L64 = 32, N_L128 = 64;
    constexpr int TOTAL = 2 * N_IN + 2 * N_OUT + 2 * N_QKV + 2 * N_AO + 4 * N_1 + 4 * N_2 + 2 * (2 * N_L64 + N_L128);
    for (int it = gw; it < TOTAL; it += NGW) {
        int r = it;
        if (r < 2 * N_IN) { const int i = r / N_IN; transpose_item(INP(I_HIN) + (size_t)i * 1024 * HYB_N, 1024, HYB_N, WSP(bf16, WS_WIN) + (size_t)i * HYB_NP * 1024, scr, r % N_IN, C.lane); continue; } r -= 2 * N_IN;
        if (r < 2 * N_OUT) { const int i = r / N_OUT; transpose_item(INP(I_HOUT) + (size_t)i * 2048 * 1024, 2048, 1024, WSP(bf16, WS_WOUT) + (size_t)i * 1024 * 2048, scr, r % N_OUT, C.lane); continue; } r -= 2 * N_OUT;
        if (r < 2 * N_QKV) { const int i = r / N_QKV; transpose_item(INP(I_AQKV) + (size_t)i * 1024 * QKV_N, 1024, QKV_N, WSP(bf16, WS_WQKV) + (size_t)i * QKV_N * 1024, scr, r % N_QKV, C.lane); continue; } r -= 2 * N_QKV;
        if (r < 2 * N_AO) { const int i = r / N_AO; transpose_item(INP(I_AOUT) + (size_t)i * 512 * 1024, 512, 1024, WSP(bf16, WS_WAO) + (size_t)i * 1024 * 512, scr, r % N_AO, C.lane); continue; } r -= 2 * N_AO;
        if (r < 4 * N_1) { const int i = r / N_1; transpose_item(INP(I_W1) + (size_t)i * 1024 * FF, 1024, FF, WSP(bf16, WS_W1) + (size_t)i * FF * 1024, scr, r % N_1, C.lane); continue; } r -= 4 * N_1;
        if (r < 4 * N_2) { const int i = r / N_2; transpose_item(INP(I_W2) + (size_t)i * FF * 1024, FF, 1024, WSP(bf16, WS_W2) + (size_t)i * 1024 * FF, scr, r % N_2, C.lane); continue; } r -= 4 * N_2;
        { const int i = r / (2 * N_L64 + N_L128); int q = r % (2 * N_L64 + N_L128); bf16* lb = WSP(bf16, WS_LORA) + (size_t)i * 262144;
          if (q < N_L64) { transpose_item(INP(I_RW2) + (size_t)i * 64 * 1024, 64, 1024, lb, scr, q, C.lane); continue; } q -= N_L64;
          if (q < N_L64) { transpose_item(INP(I_RA2) + (size_t)i * 64 * 1024, 64, 1024, lb + 65536, scr, q, C.lane); continue; } q -= N_L64;
          transpose_item(INP(I_RG2) + (size_t)i * 128 * 1024, 128, 1024, lb + 131072, scr, q, C.lane); }
    }
    const int gt = C.bid * NT + C.tid, NGT = C.G * NT;
    for (int i = gt; i < 2 * 224 * 128; i += NGT) { const int l = i / (224 * 128), r = i % (224 * 128); ((u32x4*)(WSP(bf16, WS_WIN) + (size_t)l * HYB_NP * 1024 + (size_t)5920 * 1024))[r] = (u32x4){0u, 0u, 0u, 0u}; }
    for (int i = gt; i < 8193 * 8; i += NGT) { const int t = i >> 3, k = i & 7; const double inv = pow(500000.0, -(double)k / 8.0), ang = (double)t * inv;
        WSP(float, WS_ROPE)[t * 16 + k] = (float)cos(ang); WSP(float, WS_ROPE)[t * 16 + 8 + k] = (float)sin(ang); }
}

__device__ __forceinline__ void cache_roll_slice(const Ctx& C, int part, int nparts, int wk, int nwk) {
    if (wk < 0 || wk >= nwk) return;
#pragma unroll
    for (int g = 0; g < 3; ++g) {
        const int W = 128 << (2 * g); const size_t per = (size_t)(W - 1) * 256, tot = 64 * per, lo = tot * part / nparts, hi = tot * (part + 1) / nparts;
        const f32x4* src = (const f32x4*)INP(I_C0 + g); f32x4* dst = (f32x4*)((C.PP->out) + (g == 0 ? O_W0S : g == 1 ? O_W1S : O_W2S));
        for (size_t i = lo + (size_t)wk * NT + C.tid; i < hi; i += (size_t)nwk * NT) { const size_t ib = i / per, rem = i - ib * per; const f32x4 v = __builtin_nontemporal_load(src + (ib * W + 1) * 256 + rem); __builtin_nontemporal_store(v, dst + ib * W * 256 + rem); }
    }
}

__device__ __forceinline__ void p0_mod(const Ctx& C) {
    LAS f32x4* red = (LAS f32x4*)C.lds;
    const int q = C.lane >> 4, i = C.lane & 15;
    for (int u = C.bid; u < 384; u += C.G) {
        const int l = u / 96, n0 = (u % 96) * 64;
        const float* W = INP(I_ADAW) + (size_t)l * 1024 * 6144;
        f32x4 acc[3][4];
#pragma unroll
        for (int t = 0; t < 3; ++t)
#pragma unroll
            for (int n = 0; n < 4; ++n) acc[t][n] = (f32x4){0.f, 0.f, 0.f, 0.f};
        for (int kg = 0; kg < 8; ++kg) {
            const int k0 = 128 * C.wave + 16 * kg + 4 * q;
            f32x4 av[3], wv[4];
#pragma unroll
            for (int t = 0; t < 3; ++t) { const int s = 16 * t + i; av[t] = (f32x4){0.f, 0.f, 0.f, 0.f};
                if (s < NSEQ) { const float* cp = s < 2 ? INP(I_CP) + s * 1024 : INP(I_CS) + (s - 2) * 1024; const f32x4 v = *(const f32x4*)(cp + k0);
                    av[t] = (f32x4){siluf_(v[0]), siluf_(v[1]), siluf_(v[2]), siluf_(v[3])}; } }
#pragma unroll
            for (int m = 0; m < 4; ++m) wv[m] = *(const f32x4*)(W + (size_t)(k0 + m) * 6144 + n0 + 4 * i);
#pragma unroll
            for (int m = 0; m < 4; ++m)
#pragma unroll
                for (int t = 0; t < 3; ++t)
#pragma unroll
                    for (int n = 0; n < 4; ++n) acc[t][n] = __builtin_amdgcn_mfma_f32_16x16x4f32(av[t][m], wv[m][n], acc[t][n], 0, 0, 0);
        }
#pragma unroll
        for (int t = 0; t < 3; ++t)
#pragma unroll
            for (int r = 0; r < 4; ++r) red[(C.wave * 12 + t * 4 + r) * 64 + C.lane] = (f32x4){acc[t][0][r], acc[t][1][r], acc[t][2][r], acc[t][3][r]};
        __syncthreads();
        for (int e = C.tid; e < 768; e += NT) { const int slot = e >> 6, ln = e & 63; f32x4 s = red[slot * 64 + ln];
#pragma unroll
            for (int w = 1; w < 8; ++w) s += red[(w * 12 + slot) * 64 + ln];
            const int srow = 16 * (slot >> 2) + 4 * (ln >> 4) + (slot & 3), n = n0 + 4 * (ln & 15);
            if (srow < NSEQ) *(f32x4*)(WSP(float, WS_MOD) + ((size_t)l * NSEQ + srow) * 6144 + n) = s + *(const f32x4*)(INP(I_ADAB) + l * 6144 + n); }
        __syncthreads();
    }
}

__device__ __forceinline__ void norm_phase(const Ctx& C, int l, int which, bool from_input) {
    const int gw = C.bid * 8 + C.wave, NGW = C.G * 8;
    const float* g = INP(which ? I_NMLP : I_NMIX) + l * 1024;
    const int off_sh = which ? 3072 : 0, off_sc = which ? 4096 : 1024;
    for (int row = gw; row < T + NS; row += NGW) {
        const float* xr = from_input ? (row < T ? INP(I_XP) + (size_t)row * D : INP(I_XS) + (size_t)(row - T) * D) : WSP(float, WS_X) + (size_t)row * D;
        const int s = row < T ? (row >> 13) : 2 + row - T;
        const float* mod = WSP(float, WS_MOD) + ((size_t)l * NSEQ + s) * 6144;
        f32x4 v[4]; float ss = 0.f;
#pragma unroll
        for (int j = 0; j < 4; ++j) { v[j] = *(const f32x4*)(xr + 4 * C.lane + 256 * j); ss += (v[j][0] * v[j][0] + v[j][1] * v[j][1]) + (v[j][2] * v[j][2] + v[j][3] * v[j][3]); }
        const float rinv = rsqrtf(wave_sum(ss) * (1.f / D) + EPS);
#pragma unroll
        for (int j = 0; j < 4; ++j) { const int c = 4 * C.lane + 256 * j; const f32x4 gg = *(const f32x4*)(g + c), sh = *(const f32x4*)(mod + off_sh + c), sc = *(const f32x4*)(mod + off_sc + c);
            const f32x4 y = v[j] * rinv * gg * (sc + 1.f) + sh; *(u32x2*)(WSP(bf16, WS_XN) + (size_t)row * D + c) = pk4(y); }
    }
}
__device__ __forceinline__ void final_norm_phase(const Ctx& C) {
    const int gw = C.bid * 8 + C.wave, NGW = C.G * 8;
    const float* g = INP(I_NFIN);
    for (int row = gw; row < T + NS; row += NGW) {
        const float* xr = WSP(float, WS_X) + (size_t)row * D; float* o = (C.PP->out) + (row < T ? O_YP + (size_t)row * D : O_YS + (size_t)(row - T) * D);
        f32x4 v[4]; float ss = 0.f;
#pragma unroll
        for (int j = 0; j < 4; ++j) { v[j] = *(const f32x4*)(xr + 4 * C.lane + 256 * j); ss += (v[j][0] * v[j][0] + v[j][1] * v[j][1]) + (v[j][2] * v[j][2] + v[j][3] * v[j][3]); }
        const float rinv = rsqrtf(wave_sum(ss) * (1.f / D) + EPS);
#pragma unroll
        for (int j = 0; j < 4; ++j) { const int c = 4 * C.lane + 256 * j; *(f32x4*)(o + c) = v[j] * rinv * *(const f32x4*)(g + c); }
    }
}

using pg8::Unit;
struct EpiIn {
    static constexpr bool PERM = true, AFTER_DRAIN = false;
    bf16* U; float* DT;
    __device__ __forceinline__ void operator()(const f32x4 (&acc)[2][2][4][2], const Unit& u, int wr, int wc, int fr, int fq) const {
        const int row0 = u.pm * 256 + wr * 64 + fr, col0 = u.pn * 256 + wc * 32 + 8 * fq;
#pragma unroll
        for (int ai = 0; ai < 2; ++ai)
#pragma unroll
            for (int m = 0; m < 4; ++m) { const int row = row0 + ai * 128 + m * 16; bf16* rowp = U + (size_t)row * HYB_NP + col0;
#pragma unroll
                for (int bj = 0; bj < 2; ++bj) { const f32x4 v0 = acc[ai][bj][m][0], v1 = acc[ai][bj][m][1];
                    u32x4 w; w.x = pk2(v0[0], v0[1]); w.y = pk2(v0[2], v0[3]); w.z = pk2(v1[0], v1[1]); w.w = pk2(v1[2], v1[3]); *(u32x4*)(rowp + bj * 128) = w; }
                if (u.pn == 10 && wc == 0 && fq < 2) { *(f32x4*)(DT + (size_t)row * 16 + 8 * fq) = acc[ai][0][m][0]; *(f32x4*)(DT + (size_t)row * 16 + 8 * fq + 4) = acc[ai][0][m][1]; } }
    }
};
struct EpiRes {
    static constexpr bool PERM = false, AFTER_DRAIN = false;
    const float* xin; float* xout; const float* gate;
    __device__ __forceinline__ void operator()(const f32x4 (&acc)[2][2][4][2], const Unit& u, int wr, int wc, int fr, int fq) const {
        const int row0 = u.pm * 256 + wr * 64 + fr, col0 = u.pn * 256 + wc * 32 + 4 * fq;
#pragma unroll
        for (int ai = 0; ai < 2; ++ai)
#pragma unroll
            for (int m = 0; m < 4; ++m) { const int row = row0 + ai * 128 + m * 16; const float* gp = gate + (size_t)(row >> 13) * 6144 + col0; const size_t off = (size_t)row * D + col0;
#pragma unroll
                for (int bj = 0; bj < 2; ++bj)
#pragma unroll
                    for (int n = 0; n < 2; ++n) { const int o = bj * 128 + n * 16; *(f32x4*)(xout + off + o) = *(const f32x4*)(xin + off + o) + *(const f32x4*)(gp + o) * acc[ai][bj][m][n]; } }
    }
};
struct EpiMlp1 {
    static constexpr bool PERM = true, AFTER_DRAIN = false;
    bf16* H;
    __device__ __forceinline__ void operator()(const f32x4 (&acc)[2][2][4][2], const Unit& u, int wr, int wc, int fr, int fq) const {
        const int row0 = u.pm * 256 + wr * 64 + fr, col0 = u.pn * 256 + wc * 32 + 8 * fq;
#pragma unroll
        for (int ai = 0; ai < 2; ++ai)
#pragma unroll
            for (int m = 0; m < 4; ++m) { bf16* rowp = H + (size_t)(row0 + ai * 128 + m * 16) * FF + col0;
#pragma unroll
                for (int bj = 0; bj < 2; ++bj) { f32x4 v0 = acc[ai][bj][m][0], v1 = acc[ai][bj][m][1];
#pragma unroll
                    for (int j = 0; j < 4; ++j) { const float a = fmaxf(v0[j], 0.f), b = fmaxf(v1[j], 0.f); v0[j] = a * a; v1[j] = b * b; }
                    u32x4 w; w.x = pk2(v0[0], v0[1]); w.y = pk2(v0[2], v0[3]); w.z = pk2(v1[0], v1[1]); w.w = pk2(v1[2], v1[3]); *(u32x4*)(rowp + bj * 128) = w; } }
    }
};
struct EpiQkv {
    static constexpr bool PERM = true, AFTER_DRAIN = false;
    bf16* QKV; const float* rope; float* out; int li;
    __device__ __forceinline__ void operator()(const f32x4 (&acc)[2][2][4][2], const Unit& u, int wr, int wc, int fr, int fq) const {
        const int row0 = u.pm * 256 + wr * 64 + fr, colt = u.pn * 256, col0 = colt + wc * 32 + 8 * fq;
        const int grp = colt / 1536, s = (colt % 1536) / 512;
        const bool do_rope = (s < 2) && ((wc & 1) == 0);
        const int W = 128 << (2 * grp);
        float* wout = out + (grp == 0 ? O_W0P : grp == 1 ? O_W1P : O_W2P);
#pragma unroll
        for (int ai = 0; ai < 2; ++ai)
#pragma unroll
            for (int m = 0; m < 4; ++m) { const int row = row0 + ai * 128 + m * 16, t = row & 8191, b = row >> 13;
#pragma unroll
                for (int bj = 0; bj < 2; ++bj) { f32x4 v0 = acc[ai][bj][m][0], v1 = acc[ai][bj][m][1];
                    if (do_rope) {
                        f32x4 p0, p1;
#pragma unroll
                        for (int j = 0; j < 4; ++j) { p0[j] = __shfl_xor(v0[j], 16); p1[j] = __shfl_xor(v1[j], 16); }
                        if (fq < 2) { const f32x4 c0 = *(const f32x4*)(rope + t * 16), c1 = *(const f32x4*)(rope + t * 16 + 4), s0 = *(const f32x4*)(rope + t * 16 + 8), s1 = *(const f32x4*)(rope + t * 16 + 12);
                            if (fq == 0) { v0 = v0 * c0 - p0 * s0; v1 = v1 * c1 - p1 * s1; } else { v0 = v0 * c0 + p0 * s0; v1 = v1 * c1 + p1 * s1; } }
                    }
                    if (s == 0) { v0 *= 0.125f; v1 *= 0.125f; }
                    const int c = col0 + bj * 128;
                    u32x4 w; w.x = pk2(v0[0], v0[1]); w.y = pk2(v0[2], v0[3]); w.z = pk2(v1[0], v1[1]); w.w = pk2(v1[2], v1[3]); *(u32x4*)(QKV + (size_t)row * QKV_N + c) = w;
                    if (s >= 1 && t >= SEQ - W) { const int cc = c - grp * 1536 - s * 512; float* o = wout + ((size_t)(li * 2 + b) * W + (t - (SEQ - W))) * 1024 + (s - 1) * 512 + cc;
                        *(f32x4*)o = v0; *(f32x4*)(o + 4) = v1; }
                } }
    }
};

template <class F> __device__ __forceinline__ void small_gemm(const Ctx& C, const bf16* A, const bf16* Wt, int N, int K, F&& epi) {
    LAS float* red = (LAS float*)C.lds;
    const int kw = K / 8, steps = kw / 16;
    for (int u = C.G - 1 - (int)C.bid; u < N / 32; u += C.G) {
        const int n0 = 32 * u;
        f32x16 acc;
#pragma unroll
        for (int r = 0; r < 16; ++r) acc[r] = 0.f;
        const bf16* wp = Wt + (size_t)(n0 + (C.lane & 31)) * K + C.wave * kw + 8 * (C.lane >> 5);
        const bf16* ap = A + (size_t)(C.lane & 31) * K + C.wave * kw + 8 * (C.lane >> 5);
        for (int ks = 0; ks < steps; ++ks) { const bf16x8 wf = *(const bf16x8*)(wp + 16 * ks), af = *(const bf16x8*)(ap + 16 * ks); acc = __builtin_amdgcn_mfma_f32_32x32x16_bf16(wf, af, acc, 0, 0, 0); }
#pragma unroll
        for (int r = 0; r < 16; ++r) red[(C.wave * 16 + r) * 64 + C.lane] = acc[r];
        __syncthreads();
#pragma unroll
        for (int e2 = 0; e2 < 2; ++e2) { const int e = C.tid + e2 * NT, r = e >> 6, ln = e & 63; float s = 0.f;
#pragma unroll
            for (int w = 0; w < 8; ++w) s += red[(w * 16 + r) * 64 + ln];
            epi(ln & 31, n0 + (r & 3) + 8 * (r >> 2) + 4 * (ln >> 5), s); }
        __syncthreads();
    }
}

__device__ __forceinline__ void rwkv_prep_unit(const Ctx& C, int li, int tile) {
    const int t0 = tile * 64, tl0 = t0 & 8191, b = t0 >> 13, q = C.lane >> 4, fr = C.lane & 15;
    LAS bf16* TXW = (LAS bf16*)C.lds; LAS bf16* XA = TXW + 64 * 72; LAS bf16* SXG = XA + 64 * 72;
    const float* mu = INP(I_MU) + li * RWC;
    {
        const int i = C.tid >> 3, part = C.tid & 7; const bool first = (tl0 + i) == 0;
        const bf16* cur = WSP(bf16, WS_U) + (size_t)(t0 + i) * HYB_NP + U_RW + 3072 + part * 32;
#pragma unroll
        for (int e = 0; e < 4; ++e) { const u32x4 cv = *(const u32x4*)(cur + 8 * e); u32x4 pv = (u32x4){0u, 0u, 0u, 0u}; if (!first) pv = *(const u32x4*)(cur - HYB_NP + 8 * e);
            const float* mp = mu + 3072 + part * 32 + 8 * e; float o[8];
#pragma unroll
            for (int j = 0; j < 4; ++j) { const float c0 = bflo(cv[j]), c1 = bfhi(cv[j]), p0 = bflo(pv[j]), p1 = bfhi(pv[j]); o[2 * j] = c0 + (p0 - c0) * mp[2 * j]; o[2 * j + 1] = c1 + (p1 - c1) * mp[2 * j + 1]; }
            if (part < 2) {
#pragma unroll
                for (int j = 0; j < 8; ++j) o[j] = tanhf(o[j]);
                *(LAS u32x4*)(TXW + i * 72 + part * 32 + 8 * e) = (u32x4){pk2(o[0], o[1]), pk2(o[2], o[3]), pk2(o[4], o[5]), pk2(o[6], o[7])};
            } else if (part < 4) {
                *(LAS u32x4*)(XA + i * 72 + (part - 2) * 32 + 8 * e) = (u32x4){pk2(o[0], o[1]), pk2(o[2], o[3]), pk2(o[4], o[5]), pk2(o[6], o[7])};
            } else {
#pragma unroll
                for (int j = 0; j < 8; ++j) o[j] = sigm_(o[j]);
                *(LAS u32x4*)(SXG + i * 136 + (part - 4) * 32 + 8 * e) = (u32x4){pk2(o[0], o[1]), pk2(o[2], o[3]), pk2(o[4], o[5]), pk2(o[6], o[7])};
            } }
    }
    __syncthreads();
    const bf16* w2t = WSP(bf16, WS_LORA) + (size_t)li * 262144; const bf16* a2t = w2t + 65536; const bf16* g2t = w2t + 131072;
    const float* w0 = INP(I_RW0) + li * 1024; const float* a0 = INP(I_RA0) + li * 1024; const float* kkw = INP(I_KK) + li * 1024; const float* kaw = INP(I_KA) + li * 1024;
    bf16* G = WSP(bf16, WS_G);
    for (int hh = 0; hh < 2; ++hh) { const int h = 2 * C.wave + hh;
        for (int tm = 0; tm < 4; ++tm) {
            bf16x8 fw[2], fa[2], fg[4];
            const int trow = 16 * tm + fr;
#pragma unroll
            for (int ks = 0; ks < 2; ++ks) { fw[ks] = *(const LAS bf16x8*)(TXW + trow * 72 + ks * 32 + 8 * q); fa[ks] = *(const LAS bf16x8*)(XA + trow * 72 + ks * 32 + 8 * q); }
#pragma unroll
            for (int ks = 0; ks < 4; ++ks) fg[ks] = *(const LAS bf16x8*)(SXG + trow * 136 + ks * 32 + 8 * q);
            const int t = t0 + trow, tl = tl0 + trow; const bool first = tl == 0;
            const bf16* urow = WSP(bf16, WS_U) + (size_t)t * HYB_NP + U_RW;
            f32x4 kx[4]; float ssq = 0.f;
#pragma unroll
            for (int tn = 0; tn < 4; ++tn) { const int c = h * 64 + 16 * tn + 4 * q;
                const f32x4 ck = bf4(*(const u32x2*)(urow + 1024 + c)); f32x4 pk = (f32x4){0.f, 0.f, 0.f, 0.f};
                if (!first) pk = bf4(*(const u32x2*)(urow - HYB_NP + 1024 + c));
                kx[tn] = ck + (pk - ck) * *(const f32x4*)(mu + 1024 + c);
                const f32x4 kkv = kx[tn] * *(const f32x4*)(kkw + c);
                ssq += (kkv[0] * kkv[0] + kkv[1] * kkv[1]) + (kkv[2] * kkv[2] + kkv[3] * kkv[3]); }
            ssq += __shfl_xor(ssq, 16); ssq += __shfl_xor(ssq, 32);
            const float inv = 1.f / fmaxf(sqrtf(ssq), 1e-12f);
            float* rec = WSP(float, WS_REC) + ((size_t)(b * 16 + h) * SEQ + tl) * 384 + 4 * q;
#pragma unroll 1
            for (int tn = 0; tn < 4; ++tn) { const int c = h * 64 + 16 * tn + 4 * q, nrow = h * 64 + 16 * tn + fr;
                f32x4 xw = (f32x4){0.f, 0.f, 0.f, 0.f}, xa = xw, xg = xw;
#pragma unroll
                for (int ks = 0; ks < 2; ++ks) { xw = mfma16(*(const bf16x8*)(w2t + nrow * 64 + ks * 32 + 8 * q), fw[ks], xw); xa = mfma16(*(const bf16x8*)(a2t + nrow * 64 + ks * 32 + 8 * q), fa[ks], xa); }
#pragma unroll
                for (int ks = 0; ks < 4; ++ks) xg = mfma16(*(const bf16x8*)(g2t + nrow * 128 + ks * 32 + 8 * q), fg[ks], xg);
                const f32x4 cr = bf4(*(const u32x2*)(urow + c)), cv = bf4(*(const u32x2*)(urow + 2048 + c));
                f32x4 pr = (f32x4){0.f, 0.f, 0.f, 0.f}, pv = pr;
                if (!first) { pr = bf4(*(const u32x2*)(urow - HYB_NP + c)); pv = bf4(*(const u32x2*)(urow - HYB_NP + 2048 + c)); }
                const f32x4 rr = cr + (pr - cr) * *(const f32x4*)(mu + c), vv = cv + (pv - cv) * *(const f32x4*)(mu + 2048 + c);
                const f32x4 wl = *(const f32x4*)(w0 + c) + xw, al = *(const f32x4*)(a0 + c) + xa;
                f32x4 wd, av;
#pragma unroll
                for (int j = 0; j < 4; ++j) { const float wlog = -softplus_(-wl[j]) - 0.5f; wd[j] = __expf(-__expf(wlog)); av[j] = sigm_(al[j]); }
                const f32x4 kk4 = (tn == 0 ? kx[0] : tn == 1 ? kx[1] : tn == 2 ? kx[2] : kx[3]);
                const f32x4 kkn = kk4 * *(const f32x4*)(kkw + c) * inv; const f32x4 kp = kk4 * ((av - 1.f) * *(const f32x4*)(kaw + c) + 1.f);
                float* rp = rec + 16 * tn;
                *(f32x4*)(rp) = rr; *(f32x4*)(rp + 64) = wd; *(f32x4*)(rp + 128) = kp; *(f32x4*)(rp + 192) = vv; *(f32x4*)(rp + 256) = -kkn; *(f32x4*)(rp + 320) = kkn * av;
                *(u32x2*)(G + (size_t)t * 1024 + c) = pk4(xg); }
        }
    }
    if ((tile & 127) == 127) { float* o = (C.PP->out) + O_SHP + (size_t)(li * 2 + b) * RWC; const bf16* ur = WSP(bf16, WS_U) + (size_t)(t0 + 63) * HYB_NP + U_RW;
        for (int c = C.tid; c < RWC; c += NT) o[c] = bf1(ur[c]); }
    __syncthreads();
}

__device__ __forceinline__ void ssd_a_unit(const Ctx& C, int li, int u) {
    const int g = u & 1, c = (u >> 1) & 63, b = u >> 7, t0 = b * SEQ + c * 128, q = C.lane >> 4, fr = C.lane & 15;
    LAS float* SC = (LAS float*)C.lds;
    LAS bf16* BT = (LAS bf16*)(C.lds + 4096);
    LAS bf16* XTs = (LAS bf16*)(C.lds + 4096 + 34816);
    const float* DTr = WSP(float, WS_DT); float* DTS = WSP(float, WS_DTS); float* ACS = WSP(float, WS_ACS);
    bf16* XTg = WSP(bf16, WS_XT) + ((size_t)(b * 64 + c) * 1024) * 128; bf16* BCg = WSP(bf16, WS_BC); float* CS = WSP(float, WS_CS);
    {
        const int h = g * 8 + C.wave; const float bias = INP(I_DTB)[li * 16 + h], A = -__expf(INP(I_ALOG)[li * 16 + h]);
        const int l0 = 2 * C.lane; const float d0 = softplus_(DTr[(size_t)(t0 + l0) * 16 + h] + bias), d1 = softplus_(DTr[(size_t)(t0 + l0 + 1) * 16 + h] + bias);
        const float a0 = d0 * A, a1 = d1 * A; float s = a0 + a1;
#pragma unroll
        for (int o = 1; o < 64; o <<= 1) { const float n = __shfl_up(s, o); if (C.lane >= o) s += n; }
        const float acs1 = s, acs0 = s - a1, tot = __shfl(s, 63);
        DTS[(size_t)(t0 + l0) * 16 + h] = d0; DTS[(size_t)(t0 + l0 + 1) * 16 + h] = d1; ACS[(size_t)(t0 + l0) * 16 + h] = acs0; ACS[(size_t)(t0 + l0 + 1) * 16 + h] = acs1;
        SC[C.wave * 128 + l0] = __expf(tot - acs0) * d0; SC[C.wave * 128 + l0 + 1] = __expf(tot - acs1) * d1;
    }
    __syncthreads();
    const float* cw = INP(I_CONVW) + (size_t)li * 4 * 1536; const float* cb = INP(I_CONVB) + (size_t)li * 1536;
    for (int pass = 0; pass < 2; ++pass) {
        const int nitems = pass == 0 ? 16 : 8;
        for (int it = C.wave; it < nitems; it += 8) { const int tb = it & 7, cblk = pass == 0 ? (it >> 3) : 2;
            int ch;
            if (cblk == 0) ch = (C.lane < 32 ? 1024 + g * 128 + 4 * C.lane : 1280 + g * 128 + 4 * (C.lane - 32)); else ch = g * 512 + (cblk - 1) * 256 + 4 * C.lane;
            const int tl = c * 128 + tb * 16;
            const bf16* up = WSP(bf16, WS_U) + (size_t)(t0 + tb * 16) * HYB_NP + U_XBC + ch;
            f32x4 uu[19];
#pragma unroll
            for (int k = 0; k < 19; ++k) { uu[k] = (f32x4){0.f, 0.f, 0.f, 0.f}; if (tl + k - 3 >= 0) uu[k] = bf4(*(const u32x2*)(up + (ptrdiff_t)(k - 3) * HYB_NP)); }
            const f32x4 w0 = *(const f32x4*)(cw + ch), w1 = *(const f32x4*)(cw + 1536 + ch), w2 = *(const f32x4*)(cw + 3072 + ch), w3 = *(const f32x4*)(cw + 4608 + ch), bb = *(const f32x4*)(cb + ch);
            if (c == 63 && tb == 7) { float* o = (C.PP->out) + O_CONVP + (size_t)(li * 2 + b) * 3 * 1536 + ch; *(f32x4*)o = uu[16]; *(f32x4*)(o + 1536) = uu[17]; *(f32x4*)(o + 3072) = uu[18]; }
            f32x4 y[16];
#pragma unroll
            for (int k = 0; k < 16; ++k) { f32x4 v = bb + w0 * uu[k] + w1 * uu[k + 1] + w2 * uu[k + 2] + w3 * uu[k + 3];
#pragma unroll
                for (int j = 0; j < 4; ++j) v[j] = siluf_(v[j]);
                y[k] = v; }
            if (cblk == 0) {
                const bool isB = C.lane < 32; const int n = 4 * (C.lane & 31);
#pragma unroll
                for (int k = 0; k < 16; ++k) *(u32x2*)(BCg + (size_t)(t0 + tb * 16 + k) * 512 + (isB ? 0 : 256) + g * 128 + n) = pk4(y[k]);
                if (isB) {
#pragma unroll
                    for (int j = 0; j < 4; ++j) { u32x4 lo, hi;
                        lo.x = pk2(y[0][j], y[1][j]); lo.y = pk2(y[2][j], y[3][j]); lo.z = pk2(y[4][j], y[5][j]); lo.w = pk2(y[6][j], y[7][j]);
                        hi.x = pk2(y[8][j], y[9][j]); hi.y = pk2(y[10][j], y[11][j]); hi.z = pk2(y[12][j], y[13][j]); hi.w = pk2(y[14][j], y[15][j]);
                        *(LAS u32x4*)(BT + (n + j) * 136 + tb * 16) = lo; *(LAS u32x4*)(BT + (n + j) * 136 + tb * 16 + 8) = hi; } }
            } else {
                const int xc = (cblk - 1) * 256 + 4 * C.lane;
                const int hl = xc >> 6;
                const int xl = (pass == 0 ? xc : xc - 256);
                float sc[16];
#pragma unroll
                for (int k = 0; k < 16; ++k) sc[k] = SC[hl * 128 + tb * 16 + k];
#pragma unroll
                for (int j = 0; j < 4; ++j) { u32x4 lo, hi;
                    lo.x = pk2(y[0][j], y[1][j]); lo.y = pk2(y[2][j], y[3][j]); lo.z = pk2(y[4][j], y[5][j]); lo.w = pk2(y[6][j], y[7][j]);
                    hi.x = pk2(y[8][j], y[9][j]); hi.y = pk2(y[10][j], y[11][j]); hi.z = pk2(y[12][j], y[13][j]); hi.w = pk2(y[14][j], y[15][j]);
                    bf16* gp = XTg + (size_t)(g * 512 + xc + j) * 128 + tb * 16; *(u32x4*)gp = lo; *(u32x4*)(gp + 8) = hi;
                    lo.x = pk2(y[0][j] * sc[0], y[1][j] * sc[1]); lo.y = pk2(y[2][j] * sc[2], y[3][j] * sc[3]); lo.z = pk2(y[4][j] * sc[4], y[5][j] * sc[5]); lo.w = pk2(y[6][j] * sc[6], y[7][j] * sc[7]);
                    hi.x = pk2(y[8][j] * sc[8], y[9][j] * sc[9]); hi.y = pk2(y[10][j] * sc[10], y[11][j] * sc[11]); hi.z = pk2(y[12][j] * sc[12], y[13][j] * sc[13]); hi.w = pk2(y[14][j] * sc[14], y[15][j] * sc[15]);
                    *(LAS u32x4*)(XTs + (xl + j) * 136 + tb * 16) = lo; *(LAS u32x4*)(XTs + (xl + j) * 136 + tb * 16 + 8) = hi; }
            }
        }
        __syncthreads();
        { const int hl = C.wave >> 1, h = g * 8 + pass * 4 + hl;
          float* csp = CS + (((size_t)(b * 64 + c) * 16 + h) * 64) * 128;
#pragma unroll
          for (int tmi = 0; tmi < 2; ++tmi) { const int tm = (C.wave & 1) * 2 + tmi; bf16x8 xf[4];
#pragma unroll
              for (int ks = 0; ks < 4; ++ks) xf[ks] = *(const LAS bf16x8*)(XTs + (hl * 64 + 16 * tm + fr) * 136 + ks * 32 + 8 * q);
#pragma unroll
              for (int tn = 0; tn < 8; ++tn) { f32x4 acc = (f32x4){0.f, 0.f, 0.f, 0.f};
#pragma unroll
                  for (int ks = 0; ks < 4; ++ks) acc = mfma16(*(const LAS bf16x8*)(BT + (16 * tn + fr) * 136 + ks * 32 + 8 * q), xf[ks], acc);
                  *(f32x4*)(csp + (size_t)(16 * tm + fr) * 128 + 16 * tn + 4 * q) = acc; } }
        }
        __syncthreads();
    }
}

__device__ __forceinline__ void rwkv_scan_unit(const Ctx& C, int unit) {
    const int bh = unit >> 3, c = (unit & 7) * 8 + C.wave, lane = C.lane;
    const float* rec = WSP(float, WS_REC) + ((size_t)bh * SEQ + c * 128) * 384;
    float* qo = WSP(float, WS_QO) + ((size_t)bh * SEQ + c * 128) * 128;
    LAS float* buf = (LAS float*)(C.lds + C.wave * 12288);
    f32x2 Sl[32], Pm[32];
    int lopq = lane; asm volatile("" : "+v"(lopq));
#pragma unroll
    for (int j = 0; j < 32; ++j) { Sl[j] = (f32x2){0.f, 0.f}; Pm[j] = (f32x2){(2 * j == lopq) ? 1.f : 0.f, (2 * j + 1 == lopq) ? 1.f : 0.f}; }
#define RW_DMA(src, dst) do { _Pragma("unroll") for (int _i = 0; _i < 6; ++_i) __builtin_amdgcn_global_load_lds((const unsigned*)((src) + (_i * 64 + lane) * 4), (LAS unsigned*)((dst) + _i * 256), 16, 0, 0); } while (0)
    RW_DMA(rec, buf);
    asm volatile("s_waitcnt vmcnt(0)" ::: "memory");
    float sa_s = 0.f, sa_p = buf[256 + lane];
    for (int sb = 0; sb < 32; ++sb) {
        LAS float* cb = buf + (sb & 1) * 1536; LAS float* nb = buf + ((sb + 1) & 1) * 1536;
        if (sb + 1 < 32) RW_DMA(rec + (size_t)(sb + 1) * 1536, nb);
        for (int st = 0; st < 4; ++st) {
            if (st == 3) asm volatile("s_waitcnt vmcnt(0)" ::: "memory");
            const LAS float* v = cb + st * 384; const LAS float* nx = (st < 3) ? v + 384 : nb;
            const float vv = v[192 + lane];
            const f32x2 vv2 = (f32x2){vv, vv}, sas = (f32x2){sa_s, sa_s}, sap = (f32x2){sa_p, sa_p};
            f32x2 o2a = (f32x2){0.f, 0.f}, o2b = o2a, q2a = o2a, q2b = o2a, ns2a = o2a, ns2b = o2a, np2a = o2a, np2b = o2a;
            f32x4 r4 = *(const LAS f32x4*)(v), w4 = *(const LAS f32x4*)(v + 64), k4 = *(const LAS f32x4*)(v + 128), b4 = *(const LAS f32x4*)(v + 320), n4 = *(const LAS f32x4*)(nx + 256);
#pragma unroll
            for (int j = 0; j < 16; ++j) {
                f32x4 r4n = r4, w4n = w4, k4n = k4, b4n = b4, n4n = n4;
                if (j < 15) { r4n = *(const LAS f32x4*)(v + 4 * j + 4); w4n = *(const LAS f32x4*)(v + 64 + 4 * j + 4); k4n = *(const LAS f32x4*)(v + 128 + 4 * j + 4); b4n = *(const LAS f32x4*)(v + 320 + 4 * j + 4); n4n = *(const LAS f32x4*)(nx + 256 + 4 * j + 4); }
                {   const f32x2 r2 = (f32x2){r4[0], r4[1]}, w2 = (f32x2){w4[0], w4[1]}, k2 = (f32x2){k4[0], k4[1]}, b2 = (f32x2){b4[0], b4[1]}, n2 = (f32x2){n4[0], n4[1]};
                    f32x2 t = vv2 * k2; t = sas * b2 + t; Sl[2 * j] = Sl[2 * j] * w2 + t; o2a = Sl[2 * j] * r2 + o2a; ns2a = Sl[2 * j] * n2 + ns2a;
                    f32x2 tp = sap * b2; Pm[2 * j] = Pm[2 * j] * w2 + tp; q2a = Pm[2 * j] * r2 + q2a; np2a = Pm[2 * j] * n2 + np2a; }
                {   const f32x2 r2 = (f32x2){r4[2], r4[3]}, w2 = (f32x2){w4[2], w4[3]}, k2 = (f32x2){k4[2], k4[3]}, b2 = (f32x2){b4[2], b4[3]}, n2 = (f32x2){n4[2], n4[3]};
                    f32x2 t = vv2 * k2; t = sas * b2 + t; Sl[2 * j + 1] = Sl[2 * j + 1] * w2 + t; o2b = Sl[2 * j + 1] * r2 + o2b; ns2b = Sl[2 * j + 1] * n2 + ns2b;
                    f32x2 tp = sap * b2; Pm[2 * j + 1] = Pm[2 * j + 1] * w2 + tp; q2b = Pm[2 * j + 1] * r2 + q2b; np2b = Pm[2 * j + 1] * n2 + np2b; }
                r4 = r4n; w4 = w4n; k4 = k4n; b4 = b4n; n4 = n4n;
                __builtin_amdgcn_sched_barrier(0);
            }
            const f32x2 o2 = o2a + o2b, q2 = q2a + q2b, ns2 = ns2a + ns2b, np2 = np2a + np2b;
            float* qp = qo + (size_t)(sb * 4 + st) * 128;
            qp[lane] = o2[0] + o2[1]; qp[64 + lane] = q2[0] + q2[1];
            sa_s = ns2[0] + ns2[1]; sa_p = np2[0] + np2[1];
        }
    }
    float* sl = WSP(float, WS_SL) + ((size_t)(bh * 64 + c) * 2) * 4096 + lane * 64;
#pragma unroll
    for (int j = 0; j < 16; ++j) { *(f32x4*)(sl + 4 * j) = (f32x4){Sl[2 * j][0], Sl[2 * j][1], Sl[2 * j + 1][0], Sl[2 * j + 1][1]}; *(f32x4*)(sl + 4096 + 4 * j) = (f32x4){Pm[2 * j][0], Pm[2 * j][1], Pm[2 * j + 1][0], Pm[2 * j + 1][1]}; }
}

__device__ __forceinline__ void ssd_scan_phase(const Ctx& C, int li) {
    const int gt = C.bid * NT + C.tid;
    if (gt >= 131072) return;
    const int n2 = gt & 63, p = (gt >> 6) & 63, h = (gt >> 12) & 15, b = gt >> 16;
    float* CS = WSP(float, WS_CS); const float* ACS = WSP(float, WS_ACS);
    f32x2 S = (f32x2){0.f, 0.f};
#pragma unroll 4
    for (int c = 0; c < 64; ++c) { float* ptr = CS + (((size_t)(b * 64 + c) * 16 + h) * 64 + p) * 128 + 2 * n2; const f32x2 v = *(const f32x2*)ptr; *(f32x2*)ptr = S;
        const float dec = __expf(ACS[(size_t)(b * SEQ + c * 128 + 127) * 16 + h]); S = S * dec + v; }
    *(f32x2*)((C.PP->out) + O_SSDP + ((size_t)((li * 2 + b) * 16 + h) * 64 + p) * 128 + 2 * n2) = S;
}

__device__ __forceinline__ void rwkv_combine_unit(const Ctx& C, int li, int bh) {
    LAS float* Ss = (LAS float*)C.lds;
    LAS float* Ps = Ss + 64 * 65;
    const int q = C.lane >> 4, fr = C.lane & 15, tm = C.wave >> 1, tnb = (C.wave & 1) * 2;
    const float* SL = WSP(float, WS_SL) + (size_t)bh * 64 * 2 * 4096; float* SST = WSP(float, WS_SST) + (size_t)bh * 64 * 4096;
    for (int e = C.tid; e < 64 * 65; e += NT) Ss[e] = 0.f;
    __syncthreads();
    for (int c = 0; c < 64; ++c) {
        const float* Lc = SL + (size_t)c * 8192; const float* Pc = Lc + 4096;
        for (int e = C.tid; e < 1024; e += NT) { const int r = e >> 4, c4 = (e & 15) * 4; const f32x4 pv = *(const f32x4*)(Pc + r * 64 + c4); *(LAS f32x4*)(Ps + r * 72 + c4) = pv;
            f32x4 sv; sv[0] = Ss[r * 65 + c4]; sv[1] = Ss[r * 65 + c4 + 1]; sv[2] = Ss[r * 65 + c4 + 2]; sv[3] = Ss[r * 65 + c4 + 3]; *(f32x4*)(SST + (size_t)c * 4096 + r * 64 + c4) = sv; }
        __syncthreads();
        f32x4 acc[2];
#pragma unroll
        for (int t2 = 0; t2 < 2; ++t2) { const int tn = tnb + t2;
#pragma unroll
            for (int r = 0; r < 4; ++r) acc[t2][r] = Lc[(16 * tm + 4 * q + r) * 64 + 16 * tn + fr]; }
#pragma unroll 4
        for (int k0 = 0; k0 < 64; k0 += 4) { const float a = Ss[(16 * tm + fr) * 65 + k0 + q];
#pragma unroll
            for (int t2 = 0; t2 < 2; ++t2) acc[t2] = __builtin_amdgcn_mfma_f32_16x16x4f32(a, Ps[(k0 + q) * 72 + 16 * (tnb + t2) + fr], acc[t2], 0, 0, 0); }
        __syncthreads();
#pragma unroll
        for (int t2 = 0; t2 < 2; ++t2)
#pragma unroll
            for (int r = 0; r < 4; ++r) Ss[(16 * tm + 4 * q + r) * 65 + 16 * (tnb + t2) + fr] = acc[t2][r];
        __syncthreads();
    }
    float* o = (C.PP->out) + O_WKVP + (size_t)(li * 32 + bh) * 4096;
    for (int e = C.tid; e < 4096; e += NT) o[e] = Ss[(e >> 6) * 65 + (e & 63)];
    __syncthreads();
}

__device__ __forceinline__ void ssd_c_unit(const Ctx& C, int li, int u) {
    const int g = u & 1, c = (u >> 1) & 63, b = u >> 7, t0 = b * SEQ + c * 128, q = C.lane >> 4, fr = C.lane & 15, w = C.wave;
    LAS bf16* Cb = (LAS bf16*)C.lds;
    LAS bf16* Bb = Cb + 128 * 136;
    LAS bf16* XTh = Bb; LAS bf16* SINh = Bb + 64 * 136;
    LAS bf16* Mw = Bb + 128 * 136 + w * (16 * 136);
    LAS float* AD = (LAS float*)(Bb + 128 * 136 + 8 * 16 * 136);
    const bf16* BCg = WSP(bf16, WS_BC); const float* DTS = WSP(float, WS_DTS); const float* ACS = WSP(float, WS_ACS);
    const bf16* XTg = WSP(bf16, WS_XT) + ((size_t)(b * 64 + c) * 1024 + g * 512) * 128; const float* CS = WSP(float, WS_CS) + ((size_t)(b * 64 + c) * 16 + g * 8) * 8192;
    bf16* Y = WSP(bf16, WS_YCAT);
    for (int e = C.tid; e < 4096; e += NT) { const int r = e >> 5, cc = e & 31, isC = cc >> 4, c8 = (cc & 15) * 8;
        const u32x4 v = *(const u32x4*)(BCg + (size_t)(t0 + r) * 512 + (isC ? 256 : 0) + g * 128 + c8); *(LAS u32x4*)((isC ? Cb : Bb) + r * 136 + c8) = v; }
    __syncthreads();
    f32x4 cbv[8]; bf16x8 cf[4];
#pragma unroll
    for (int ks = 0; ks < 4; ++ks) cf[ks] = *(const LAS bf16x8*)(Cb + (16 * w + fr) * 136 + ks * 32 + 8 * q);
#pragma unroll
    for (int tn = 0; tn < 8; ++tn) { cbv[tn] = (f32x4){0.f, 0.f, 0.f, 0.f};
        if (tn <= w) {
#pragma unroll
            for (int ks = 0; ks < 4; ++ks) cbv[tn] = mfma16(*(const LAS bf16x8*)(Bb + (16 * tn + fr) * 136 + ks * 32 + 8 * q), cf[ks], cbv[tn]); } }
    __syncthreads();
    float ssq = 0.f;
    const int l = 16 * w + fr;
    bf16* yrow = Y + (size_t)(t0 + l) * 2048 + g * 512;
#pragma unroll 1
    for (int hh = 0; hh < 8; ++hh) { const int h = g * 8 + hh;
        for (int e = C.tid; e < 1024; e += NT) { const int r = e >> 4, c8 = (e & 15) * 8;
            *(LAS u32x4*)(XTh + r * 136 + c8) = *(const u32x4*)(XTg + (size_t)(hh * 64 + r) * 128 + c8);
            const float* sp = CS + (size_t)hh * 8192 + r * 128 + c8; const f32x4 s0 = *(const f32x4*)sp, s1 = *(const f32x4*)(sp + 4);
            *(LAS u32x4*)(SINh + r * 136 + c8) = (u32x4){pk2(s0[0], s0[1]), pk2(s0[2], s0[3]), pk2(s1[0], s1[1]), pk2(s1[2], s1[3])}; }
        if (C.tid < 128) { AD[C.tid] = ACS[(size_t)(t0 + C.tid) * 16 + h]; AD[128 + C.tid] = DTS[(size_t)(t0 + C.tid) * 16 + h]; }
        __syncthreads();
        const float acl = AD[l];
#pragma unroll
        for (int tn = 0; tn < 8; ++tn) { f32x4 mv = (f32x4){0.f, 0.f, 0.f, 0.f};
            if (tn <= w) { const f32x4 as = *(const LAS f32x4*)(AD + 16 * tn + 4 * q), ds = *(const LAS f32x4*)(AD + 128 + 16 * tn + 4 * q);
#pragma unroll
                for (int j = 0; j < 4; ++j) { const int s = 16 * tn + 4 * q + j; mv[j] = (s <= l) ? cbv[tn][j] * __expf(acl - as[j]) * ds[j] : 0.f; } }
            *(LAS u32x2*)(Mw + fr * 136 + 16 * tn + 4 * q) = pk4(mv); }
        LDSW();
        const float eal = __expf(acl), Dh = INP(I_SSDD)[li * 16 + h];
        const int nks = (w + 2) >> 1;
#pragma unroll
        for (int tp = 0; tp < 4; ++tp) { f32x4 a1 = (f32x4){0.f, 0.f, 0.f, 0.f}, a2 = a1;
            for (int ks = 0; ks < nks; ++ks) a1 = mfma16(*(const LAS bf16x8*)(XTh + (16 * tp + fr) * 136 + ks * 32 + 8 * q), *(const LAS bf16x8*)(Mw + fr * 136 + ks * 32 + 8 * q), a1);
#pragma unroll
            for (int ks = 0; ks < 4; ++ks) a2 = mfma16(*(const LAS bf16x8*)(SINh + (16 * tp + fr) * 136 + ks * 32 + 8 * q), cf[ks], a2);
            const int p0 = 16 * tp + 4 * q;
            const f32x4 z = bf4(*(const u32x2*)(WSP(bf16, WS_U) + (size_t)(t0 + l) * HYB_NP + h * 64 + p0));
            f32x4 y;
#pragma unroll
            for (int j = 0; j < 4; ++j) { const float xv = bf1(XTh[(p0 + j) * 136 + l]); y[j] = (a1[j] + eal * a2[j] + Dh * xv) * siluf_(z[j]); }
            const u32x2 yp = pk4(y); const f32x4 yr = bf4(yp); ssq += (yr[0] * yr[0] + yr[1] * yr[1]) + (yr[2] * yr[2] + yr[3] * yr[3]);
            *(u32x2*)(yrow + hh * 64 + p0) = yp; }
        __syncthreads();
    }
    ssq += __shfl_xor(ssq, 16); ssq += __shfl_xor(ssq, 32);
    const float rinv = rsqrtf(ssq * (1.f / 512.f) + EPS);
    const float* nw = INP(I_SNW) + li * 1024 + g * 512;
    asm volatile("s_waitcnt vmcnt(0)" ::: "memory");
#pragma unroll 1
    for (int hh = 0; hh < 8; ++hh)
#pragma unroll
        for (int tp = 0; tp < 4; ++tp) { const int cc = hh * 64 + 16 * tp + 4 * q; const f32x4 y = bf4(*(volatile u32x2*)(yrow + cc)) * rinv * *(const f32x4*)(nw + cc);
            *(u32x2*)(yrow + cc) = pk4(y); }
}

__device__ __forceinline__ void rwkv_out_unit(const Ctx& C, int li, int u) {
    const int c = u & 63, bh = u >> 6, h = bh & 15, b = bh >> 4, t0 = b * SEQ + c * 128, q = C.lane >> 4, fr = C.lane & 15, w = C.wave;
    LAS bf16* Qb = (LAS bf16*)C.lds;
    LAS bf16* Sb = Qb + 128 * 72;
    const float* qo = WSP(float, WS_QO) + ((size_t)bh * SEQ + c * 128) * 128; const float* sst = WSP(float, WS_SST) + (size_t)(bh * 64 + c) * 4096;
    const float* rec = WSP(float, WS_REC) + ((size_t)bh * SEQ + c * 128) * 384;
    for (int e = C.tid; e < 2048; e += NT) { const int r = e >> 4, c4 = (e & 15) * 4; *(LAS u32x2*)(Qb + r * 72 + c4) = pk4(*(const f32x4*)(qo + (size_t)r * 128 + 64 + c4)); }
    for (int e = C.tid; e < 1024; e += NT) { const int r = e >> 4, c4 = (e & 15) * 4; *(LAS u32x2*)(Sb + r * 72 + c4) = pk4(*(const f32x4*)(sst + r * 64 + c4)); }
    __syncthreads();
    const int tr = 16 * w + fr;
    bf16x8 qf[2];
#pragma unroll
    for (int ks = 0; ks < 2; ++ks) qf[ks] = *(const LAS bf16x8*)(Qb + tr * 72 + ks * 32 + 8 * q);
    f32x4 o[4]; float sum = 0.f, rk = 0.f;
    const float* rp = rec + (size_t)tr * 384;
    const float* rkw = INP(I_RK) + li * 1024 + h * 64;
#pragma unroll
    for (int tn = 0; tn < 4; ++tn) { f32x4 a = *(const f32x4*)(qo + (size_t)tr * 128 + 16 * tn + 4 * q);
#pragma unroll
        for (int ks = 0; ks < 2; ++ks) a = mfma16(*(const LAS bf16x8*)(Sb + (16 * tn + fr) * 72 + ks * 32 + 8 * q), qf[ks], a);
        o[tn] = a; sum += (a[0] + a[1]) + (a[2] + a[3]);
        const f32x4 r4 = *(const f32x4*)(rp + 16 * tn + 4 * q), k4 = *(const f32x4*)(rp + 128 + 16 * tn + 4 * q), w4 = *(const f32x4*)(rkw + 16 * tn + 4 * q);
        rk += (r4[0] * k4[0] * w4[0] + r4[1] * k4[1] * w4[1]) + (r4[2] * k4[2] * w4[2] + r4[3] * k4[3] * w4[3]); }
    sum += __shfl_xor(sum, 16); sum += __shfl_xor(sum, 32); rk += __shfl_xor(rk, 16); rk += __shfl_xor(rk, 32);
    const float mean = sum * (1.f / 64.f); float var = 0.f;
#pragma unroll
    for (int tn = 0; tn < 4; ++tn) { const f32x4 d = o[tn] - mean; var += (d[0] * d[0] + d[1] * d[1]) + (d[2] * d[2] + d[3] * d[3]); }
    var += __shfl_xor(var, 16); var += __shfl_xor(var, 32);
    const float rstd = rsqrtf(var * (1.f / 64.f) + LN_EPS);
    const float* lw = INP(I_LNW) + li * 1024 + h * 64; const float* lb = INP(I_LNB) + li * 1024 + h * 64;
    const bf16* G = WSP(bf16, WS_G) + (size_t)(t0 + tr) * 1024 + h * 64; bf16* Y = WSP(bf16, WS_YCAT) + (size_t)(t0 + tr) * 2048 + 1024 + h * 64;
#pragma unroll
    for (int tn = 0; tn < 4; ++tn) { const int cc = 16 * tn + 4 * q; const f32x4 vv = *(const f32x4*)(rp + 192 + cc), gg = bf4(*(const u32x2*)(G + cc));
        const f32x4 y = ((o[tn] - mean) * rstd * *(const f32x4*)(lw + cc) + *(const f32x4*)(lb + cc) + vv * rk) * gg; *(u32x2*)(Y + cc) = pk4(y); }
    __syncthreads();
}

__device__ __forceinline__ void attn_tile_unit(const Ctx& C, int u) {
    const int g = u >> 10, r = u & 1023, b = r >> 9, h = (r >> 6) & 7, qt = r & 63, q = C.lane >> 4, fr = C.lane & 15, w = C.wave;
    const int dsh = 2 * g, tpr = 64 >> dsh, rho = qt / tpr, i0 = (qt % tpr) * 128;
    LAS bf16* Qs = (LAS bf16*)C.lds;
    LAS bf16* Ks = Qs + 128 * 72;
    LAS bf16* VT = Ks + 256 * 72;
    const bf16* QKV = WSP(bf16, WS_QKV) + (size_t)b * SEQ * QKV_N + g * 1536 + h * 64;
    for (int e = C.tid; e < 1024; e += NT) { const int rr = e >> 3, c8 = (e & 7) * 8; const int t = rho + ((i0 + rr) << dsh); *(LAS u32x4*)(Qs + rr * 72 + c8) = *(const u32x4*)(QKV + (size_t)t * QKV_N + c8); }
    for (int e = C.tid; e < 2048; e += NT) { const int kk = e >> 3, c8 = (e & 7) * 8; const int idx = i0 - 128 + kk; u32x4 kv = (u32x4){0u, 0u, 0u, 0u}, vv = kv;
        if (idx >= 0) { const bf16* p = QKV + (size_t)(rho + (idx << dsh)) * QKV_N + c8; kv = *(const u32x4*)(p + 512); vv = *(const u32x4*)(p + 1024); }
        *(LAS u32x4*)(Ks + kk * 72 + c8) = kv;
#pragma unroll
        for (int j = 0; j < 4; ++j) { VT[(c8 + 2 * j) * 264 + kk] = (bf16)(vv[j] & 0xffffu); VT[(c8 + 2 * j + 1) * 264 + kk] = (bf16)(vv[j] >> 16); } }
    __syncthreads();
    bf16x8 qf[2];
#pragma unroll
    for (int ks = 0; ks < 2; ++ks) qf[ks] = *(const LAS bf16x8*)(Qs + (16 * w + fr) * 72 + ks * 32 + 8 * q);
    const int ql = 16 * w + fr, kmin = (i0 == 0) ? 128 : 0;
    f32x4 s[10]; float mx = -3.0e38f;
#pragma unroll
    for (int kt = 0; kt < 10; ++kt) { s[kt] = (f32x4){0.f, 0.f, 0.f, 0.f};
        if (kt < 9) {
#pragma unroll
            for (int ks = 0; ks < 2; ++ks) s[kt] = mfma16(*(const LAS bf16x8*)(Ks + (16 * (w + kt) + fr) * 72 + ks * 32 + 8 * q), qf[ks], s[kt]); }
#pragma unroll
        for (int j = 0; j < 4; ++j) { const int kk = 16 * (w + kt) + 4 * q + j; const bool ok = (kt < 9) && kk >= ql && kk <= ql + 128 && kk >= kmin; s[kt][j] = ok ? s[kt][j] : -3.0e38f; mx = fmaxf(mx, s[kt][j]); } }
    mx = fmaxf(mx, __shfl_xor(mx, 16)); mx = fmaxf(mx, __shfl_xor(mx, 32));
    float lsum = 0.f;
#pragma unroll
    for (int kt = 0; kt < 10; ++kt)
#pragma unroll
        for (int j = 0; j < 4; ++j) { const float p = (s[kt][j] > -1.0e38f) ? __expf(s[kt][j] - mx) : 0.f; s[kt][j] = p; lsum += p; }
    lsum += __shfl_xor(lsum, 16); lsum += __shfl_xor(lsum, 32);
    f32x4 od[4];
#pragma unroll
    for (int tn = 0; tn < 4; ++tn) od[tn] = (f32x4){0.f, 0.f, 0.f, 0.f};
#pragma unroll
    for (int pr = 0; pr < 5; ++pr) { const int ta = w + 2 * pr, tb = (w + 2 * pr + 1 > 15) ? 15 : (w + 2 * pr + 1);
        const u32x2 pa = pk4(s[2 * pr]), pb = pk4(s[2 * pr + 1]); const u32x4 pw = (u32x4){pa.x, pa.y, pb.x, pb.y}; const bf16x8 pf = __builtin_bit_cast(bf16x8, pw);
#pragma unroll
        for (int tn = 0; tn < 4; ++tn) { const LAS bf16* vp = VT + (16 * tn + fr) * 264 + 4 * q; const u32x2 va = *(const LAS u32x2*)(vp + 16 * ta), vb = *(const LAS u32x2*)(vp + 16 * tb);
            const u32x4 vw = (u32x4){va.x, va.y, vb.x, vb.y}; od[tn] = mfma16(__builtin_bit_cast(bf16x8, vw), pf, od[tn]); } }
    const float il = 1.f / lsum; const int t = b * SEQ + rho + ((i0 + ql) << dsh);
    bf16* og = WSP(bf16, WS_OG) + ((size_t)g * T + t) * 512 + h * 64;
#pragma unroll
    for (int tn = 0; tn < 4; ++tn) *(u32x2*)(og + 16 * tn + 4 * q) = pk4(od[tn] * il);
    if (q == 0) WSP(float, WS_LSE)[((size_t)g * T + t) * 8 + h] = mx + __logf(lsum);
    __syncthreads();
}

__device__ __forceinline__ void attn_merge_phase(const Ctx& C) {
    const bf16* OG = WSP(bf16, WS_OG); const float* LSE = WSP(float, WS_LSE); bf16* AO = WSP(bf16, WS_AO);
    for (size_t e = (size_t)C.bid * NT + C.tid; e < (size_t)T * 64; e += (size_t)C.G * NT) { const size_t t = e >> 6; const int c8 = (int)(e & 63) * 8, h = c8 >> 6;
        const float l0 = LSE[t * 8 + h], l1 = LSE[((size_t)T + t) * 8 + h], l2 = LSE[((size_t)2 * T + t) * 8 + h]; const float m = fmaxf(l0, fmaxf(l1, l2));
        float a0 = __expf(l0 - m), a1 = __expf(l1 - m), a2 = __expf(l2 - m); const float inv = 1.f / (a0 + a1 + a2); a0 *= inv; a1 *= inv; a2 *= inv;
        const u32x4 v0 = *(const u32x4*)(OG + t * 512 + c8), v1 = *(const u32x4*)(OG + ((size_t)T + t) * 512 + c8), v2 = *(const u32x4*)(OG + ((size_t)2 * T + t) * 512 + c8); u32x4 o;
#pragma unroll
        for (int j = 0; j < 4; ++j) o[j] = pk2(a0 * bflo(v0[j]) + a1 * bflo(v1[j]) + a2 * bflo(v2[j]), a0 * bfhi(v0[j]) + a1 * bfhi(v1[j]) + a2 * bfhi(v2[j]));
        *(u32x4*)(AO + t * 512 + c8) = o; }
}

__device__ __forceinline__ void s_ssd_unit(const Ctx& C, int li, int u) {
    const int b = u >> 1, g = u & 1, hh = C.wave, h = g * 8 + hh, lane = C.lane;
    LAS float* xs = (LAS float*)(C.lds + hh * 2048);
    LAS float* Bs = xs + 64; LAS float* Cs = xs + 192;
    LAS float* ys = (LAS float*)(C.lds + 16384);
    LAS float* rs = ys + 512;
    const float* us = WSP(float, WS_SMALL) + (size_t)b * HYB_NP;
    const float* cst = INP(I_CONV) + ((size_t)(li * 32 + b) * 3) * 1536;
    const float* cw = INP(I_CONVW) + (size_t)li * 4 * 1536; const float* cb = INP(I_CONVB) + (size_t)li * 1536;
    auto conv = [&](int ch) { return siluf_(cb[ch] + cw[ch] * cst[ch] + cw[1536 + ch] * cst[1536 + ch] + cw[3072 + ch] * cst[3072 + ch] + cw[4608 + ch] * us[U_XBC + ch]); };
    xs[lane] = conv(h * 64 + lane);
    Bs[lane] = conv(1024 + g * 128 + lane); Bs[64 + lane] = conv(1024 + g * 128 + 64 + lane);
    Cs[lane] = conv(1280 + g * 128 + lane); Cs[64 + lane] = conv(1280 + g * 128 + 64 + lane);
    { float* co = (C.PP->out) + O_CONVS + ((size_t)(li * 32 + b) * 3) * 1536;
      for (int e = C.tid; e < 768; e += NT) { const int ch = e < 512 ? g * 512 + e : (e < 640 ? 1024 + g * 128 + (e - 512) : 1280 + g * 128 + (e - 640));
          co[ch] = cst[1536 + ch]; co[1536 + ch] = cst[3072 + ch]; co[3072 + ch] = us[U_XBC + ch]; } }
    LDSW();
    const float dt = softplus_(us[U_DT + h] + INP(I_DTB)[li * 16 + h]), dA = __expf(-dt * __expf(INP(I_ALOG)[li * 16 + h])), Dh = INP(I_SSDD)[li * 16 + h];
    const int pp = lane >> 3, nn = (lane & 7) * 16;
    f32x4 Bv[4], Cv[4];
#pragma unroll
    for (int j = 0; j < 4; ++j) { Bv[j] = *(const LAS f32x4*)(Bs + nn + 4 * j); Cv[j] = *(const LAS f32x4*)(Cs + nn + 4 * j); }
    const float* sin_ = INP(I_SSD) + ((size_t)(li * 32 + b) * 16 + h) * 8192; float* sout = (C.PP->out) + O_SSDS + ((size_t)(li * 32 + b) * 16 + h) * 8192;
    float yv = 0.f;
#pragma unroll
    for (int it = 0; it < 8; ++it) { const int p = it * 8 + pp; const float xp = xs[p], dx = dt * xp; float part = 0.f;
#pragma unroll
        for (int j = 0; j < 4; ++j) { f32x4 s = *(const f32x4*)(sin_ + p * 128 + nn + 4 * j); s = s * dA + Bv[j] * dx; *(f32x4*)(sout + p * 128 + nn + 4 * j) = s;
            part += (s[0] * Cv[j][0] + s[1] * Cv[j][1]) + (s[2] * Cv[j][2] + s[3] * Cv[j][3]); }
        part += __shfl_xor(part, 1); part += __shfl_xor(part, 2); part += __shfl_xor(part, 4);
        if ((lane & 7) == it) yv = part + Dh * xp; }
    { const int p = (lane & 7) * 8 + (lane >> 3); const float z = us[h * 64 + p]; const float y = yv * siluf_(z); ys[hh * 64 + p] = y; const float ss = wave_sum(y * y); if (lane == 0) rs[hh] = ss; }
    __syncthreads();
    { float tot = 0.f;
#pragma unroll
      for (int j = 0; j < 8; ++j) tot += rs[j];
      const float rinv = rsqrtf(tot * (1.f / 512.f) + EPS); const int cc = C.tid;
      WSP(bf16, WS_YCAT)[(size_t)(T + b) * 2048 + g * 512 + cc] = (bf16)(pk2(ys[cc] * rinv * INP(I_SNW)[li * 1024 + g * 512 + cc], 0.f) & 0xffffu); }
    __syncthreads();
}

__device__ __forceinline__ void s_rwkv_unit(const Ctx& C, int li, int b) {
    const int lane = C.lane, tid = C.tid;
    LAS float* mix = (LAS float*)C.lds;
    LAS float* act = mix + 3328;
    LAS float* vec = act + 256;
    LAS float* hv = vec + 3072;
    const float* us = WSP(float, WS_SMALL) + (size_t)b * HYB_NP + U_RW;
    const float* sst = INP(I_SHIFT) + (size_t)(li * 32 + b) * RWC; const float* mu = INP(I_MU) + li * RWC;
    float* sho = (C.PP->out) + O_SHS + (size_t)(li * 32 + b) * RWC;
    for (int c = tid; c < RWC; c += NT) { const float cur = us[c]; mix[c] = cur + (sst[c] - cur) * mu[c]; sho[c] = cur; }
    __syncthreads();
    if (tid < 256) { const float x = mix[3072 + tid]; act[tid] = tid < 64 ? tanhf(x) : (tid < 128 ? x : sigm_(x)); }
    __syncthreads();
    const float* w2 = INP(I_RW2) + (size_t)li * 64 * 1024; const float* a2 = INP(I_RA2) + (size_t)li * 64 * 1024; const float* g2 = INP(I_RG2) + (size_t)li * 128 * 1024;
    {   LAS float* part = hv + 8 * 192;
        const int cq = tid & 63, sl = tid >> 6;
        for (int cb = 0; cb < 4; ++cb) { const int c = cb * 256 + cq * 4;
            f32x4 aw = (f32x4){0.f, 0.f, 0.f, 0.f}, aa = aw, ag = aw;
#pragma unroll
            for (int j = 0; j < 8; ++j) { const int r = sl * 8 + j; aw += *(const f32x4*)(w2 + (size_t)r * 1024 + c) * act[r]; aa += *(const f32x4*)(a2 + (size_t)r * 1024 + c) * act[64 + r]; }
#pragma unroll
            for (int j = 0; j < 16; ++j) { const int r = sl * 16 + j; ag += *(const f32x4*)(g2 + (size_t)r * 1024 + c) * act[128 + r]; }
            *(LAS f32x4*)(part + (sl * 3 + 0) * 1024 + c) = aw; *(LAS f32x4*)(part + (sl * 3 + 1) * 1024 + c) = aa; *(LAS f32x4*)(part + (sl * 3 + 2) * 1024 + c) = ag; }
        __syncthreads();
        for (int c = tid; c < 1024; c += NT) { float wl = INP(I_RW0)[li * 1024 + c], al = INP(I_RA0)[li * 1024 + c], gl = 0.f;
#pragma unroll
            for (int k = 0; k < 8; ++k) { wl += part[(k * 3 + 0) * 1024 + c]; al += part[(k * 3 + 1) * 1024 + c]; gl += part[(k * 3 + 2) * 1024 + c]; }
            vec[c] = __expf(-__expf(-softplus_(-wl) - 0.5f)); vec[1024 + c] = sigm_(al); vec[2048 + c] = gl; }
    }
    __syncthreads();
    LAS float* my = hv + C.wave * 192;
    for (int hh = 0; hh < 2; ++hh) { const int h = 2 * C.wave + hh, c = h * 64 + lane;
        const float r = mix[c], k = mix[1024 + c], v = mix[2048 + c], w = vec[c], a = vec[1024 + c], gt = vec[2048 + c];
        const float kk = k * INP(I_KK)[li * 1024 + c]; const float inv = 1.f / fmaxf(sqrtf(wave_sum(kk * kk)), 1e-12f); const float kkn = kk * inv;
        const float kp = k * (1.f + (a - 1.f) * INP(I_KA)[li * 1024 + c]);
        my[lane] = -kkn; my[64 + lane] = kkn * a; my[128 + lane] = kp; LDSW();
        const float* sin_ = INP(I_WKV) + ((size_t)(li * 32 + b) * 16 + h) * 4096 + lane * 64; float* sout = (C.PP->out) + O_WKVS + ((size_t)(li * 32 + b) * 16 + h) * 4096 + lane * 64;
        f32x4 S[16]; float sa = 0.f;
#pragma unroll
        for (int j = 0; j < 16; ++j) { S[j] = *(const f32x4*)(sin_ + 4 * j); const f32x4 n4 = *(const LAS f32x4*)(my + 4 * j); sa += (S[j][0] * n4[0] + S[j][1] * n4[1]) + (S[j][2] * n4[2] + S[j][3] * n4[3]); }
        float o = 0.f;
#pragma unroll
        for (int j = 0; j < 16; ++j) { const f32x4 b4 = *(const LAS f32x4*)(my + 64 + 4 * j), k4 = *(const LAS f32x4*)(my + 128 + 4 * j), w4 = *(const LAS f32x4*)(vec + h * 64 + 4 * j), r4 = *(const LAS f32x4*)(mix + h * 64 + 4 * j);
            S[j] = S[j] * w4 + b4 * sa + k4 * v; *(f32x4*)(sout + 4 * j) = S[j]; o += (S[j][0] * r4[0] + S[j][1] * r4[1]) + (S[j][2] * r4[2] + S[j][3] * r4[3]); }
        const float mean = wave_sum(o) * (1.f / 64.f), d = o - mean, var = wave_sum(d * d) * (1.f / 64.f);
        float y = d * rsqrtf(var + LN_EPS) * INP(I_LNW)[li * 1024 + c] + INP(I_LNB)[li * 1024 + c];
        const float rk = wave_sum(r * kp * INP(I_RK)[li * 1024 + c]);
        y = (y + rk * v) * gt;
        WSP(bf16, WS_YCAT)[(size_t)(T + b) * 2048 + 1024 + c] = (bf16)(pk2(y, 0.f) & 0xffffu);
        LDSW();
    }
    __syncthreads();
}

__device__ __forceinline__ void s_attn_unit(const Ctx& C, int li, int u) {
    const int task = u * 8 + C.wave, b = task >> 3, h = task & 7, lane = C.lane;
    LAS float* qs = (LAS float*)(C.lds + C.wave * 1024);
    const float* qkv = WSP(float, WS_SMALL) + MiB / 4 + (size_t)b * QKV_N;
    const float* rp = WSP(float, WS_ROPE) + 8192 * 16;
    float og[3], lse[3];
#pragma unroll
    for (int g = 0; g < 3; ++g) {
        const int W = 128 << (2 * g), dsh = 2 * g;
        const float* base = qkv + g * 1536 + h * 64;
        float qv = base[lane], kv = base[512 + lane], vv = base[1024 + lane];
        {
            const float qo_ = __shfl_xor(qv, 8), ko_ = __shfl_xor(kv, 8);
            if (lane < 16) { const float cs = rp[lane & 7], sn = rp[8 + (lane & 7)]; if (lane < 8) { qv = qv * cs - qo_ * sn; kv = kv * cs - ko_ * sn; } else { qv = qv * cs + qo_ * sn; kv = kv * cs + ko_ * sn; } }
        }
        qv *= 0.125f;
        float* wo = (C.PP->out) + (g == 0 ? O_W0S : g == 1 ? O_W1S : O_W2S) + ((size_t)(li * 32 + b) * W + (W - 1)) * 1024;
        wo[h * 64 + lane] = kv; wo[512 + h * 64 + lane] = vv;
        qs[lane] = qv; LDSW();
        f32x4 q4[16];
#pragma unroll
        for (int j = 0; j < 16; ++j) q4[j] = *(const LAS f32x4*)(qs + 4 * j);
        const float* cache = INP(I_C0 + g) + ((size_t)(li * 32 + b) * W) * 1024 + h * 64;
        float sc0, sc1;
        { const float* k0 = cache + (size_t)(W - ((lane + 1) << dsh)) * 1024; const float* k1 = cache + (size_t)(W - ((lane + 65) << dsh)) * 1024; float a0 = 0.f, a1 = 0.f;
#pragma unroll
          for (int j = 0; j < 16; ++j) { const f32x4 x0 = *(const f32x4*)(k0 + 4 * j), x1 = *(const f32x4*)(k1 + 4 * j);
              a0 += (x0[0] * q4[j][0] + x0[1] * q4[j][1]) + (x0[2] * q4[j][2] + x0[3] * q4[j][3]); a1 += (x1[0] * q4[j][0] + x1[1] * q4[j][1]) + (x1[2] * q4[j][2] + x1[3] * q4[j][3]); }
          sc0 = a0; sc1 = a1; }
        const float ss = wave_sum(qv * kv);
        const float m = fmaxf(ss, wave_max(fmaxf(sc0, sc1)));
        const float p0 = __expf(sc0 - m), p1 = __expf(sc1 - m), ps = __expf(ss - m);
        const float l = wave_sum(p0 + p1) + ps;
        float o = ps * vv;
#pragma unroll 16
        for (int j = 0; j < 64; ++j) { const float pj0 = __shfl(p0, j), pj1 = __shfl(p1, j);
            o += pj0 * cache[(size_t)(W - ((j + 1) << dsh)) * 1024 + 512 + lane] + pj1 * cache[(size_t)(W - ((j + 65) << dsh)) * 1024 + 512 + lane]; }
        og[g] = o / l; lse[g] = m + __logf(l);
        LDSW();
    }
    const float m = fmaxf(lse[0], fmaxf(lse[1], lse[2])); float a0 = __expf(lse[0] - m), a1 = __expf(lse[1] - m), a2 = __expf(lse[2] - m); const float inv = 1.f / (a0 + a1 + a2);
    const float o = (a0 * og[0] + a1 * og[1] + a2 * og[2]) * inv;
    WSP(bf16, WS_AO)[(size_t)(T + b) * 512 + h * 64 + lane] = (bf16)(pk2(o, 0.f) & 0xffffu);
}

#ifndef PROBE_DUP
#define PROBE_DUP 0
#endif
__global__ void __launch_bounds__(512, 2) mk_fwd(Params P) {
    extern __shared__ __attribute__((aligned(16))) unsigned char lds_raw[];
    Ctx C;
    C.lds = (LAS unsigned char*)lds_raw;
#define PHASE() do { unsigned long long _k = (unsigned long long)__builtin_amdgcn_kernarg_segment_ptr(); int _t = threadIdx.x, _b = blockIdx.x, _g = gridDim.x; asm volatile("" : "+s"(_k), "+v"(_t), "+s"(_b), "+s"(_g)); \
        C.PP = (const CAS Params*)_k; C.tid = _t; C.lane = _t & 63; C.wave = __builtin_amdgcn_readfirstlane(_t >> 6); C.G = _g; C.bid = _b; } while (0)
    PHASE();
    for (int u = C.tid; u < (LDS_BYTES - LDS_RING) / 4; u += NT) ((LAS unsigned*)(C.lds + LDS_RING))[u] = 0u;
    __syncthreads();
    (void)xcd_barrier_post((unsigned*)((C.PP->ws) + WS_CTL) + 4096, (volatile LAS unsigned*)(C.lds + LDS_MISC) + 8);
#define GRID_BAR() do { XcdBarrier _b; _b.bar = (unsigned*)((C.PP->ws) + WS_CTL) + 4096; _b.x = xb_xcc_id(); _b.st = (volatile LAS unsigned*)(C.lds + LDS_MISC) + 8; xcd_barrier(_b); PHASE(); } while (0)
    LAS unsigned char* ring = C.lds;

    p0_weights(C);
    __syncthreads(); PHASE();
    p0_mod(C);
    GRID_BAR();
#if PROBE_DUP & 1
    p0_weights(C); __syncthreads(); PHASE(); p0_mod(C); GRID_BAR();
#endif

    for (int l = 0; l < 4; ++l) {
        const int li = l >> 1;
#define modl (WSP(float, WS_MOD) + (size_t)l * NSEQ * 6144)
        norm_phase(C, l, 0, l == 0);
        GRID_BAR();
        if ((l & 1) == 0) {
            { pg8::Gemm g{WSP(bf16, WS_XN), WSP(bf16, WS_WIN) + (size_t)li * HYB_NP * 1024, T, HYB_NP, 1024}; pg8::StaticOrder S; S.init(T, HYB_NP, C.G, C.bid);
              EpiIn E{WSP(bf16, WS_U), WSP(float, WS_DT)}; pg8::gemm_phase<EpiIn, pg8::StaticOrder>(ring, g, S, E, nullptr); }
            PHASE();
            { float* US = WSP(float, WS_SMALL); small_gemm(C, WSP(bf16, WS_XN) + (size_t)T * D, WSP(bf16, WS_WIN) + (size_t)li * HYB_NP * 1024, HYB_NP, 1024, [&](int r, int c, float v) { US[(size_t)r * HYB_NP + c] = v; }); }
            GRID_BAR();
            for (int u = C.bid; u < 256; u += C.G) rwkv_prep_unit(C, li, u);
            PHASE();
            for (int u = C.bid; u < 256; u += C.G) ssd_a_unit(C, li, u);
            PHASE();
            for (int u = (C.bid + 192) % C.G; u < 64; u += C.G) s_ssd_unit(C, li, u);
            PHASE();
            for (int u = (C.bid + 128) % C.G; u < 32; u += C.G) s_rwkv_unit(C, li, u);
            GRID_BAR();
#if PROBE_DUP & 2
            for (int u = C.bid; u < 256; u += C.G) rwkv_prep_unit(C, li, u);
            PHASE();
            for (int u = C.bid; u < 256; u += C.G) ssd_a_unit(C, li, u);
            PHASE();
            for (int u = (C.bid + 192) % C.G; u < 64; u += C.G) s_ssd_unit(C, li, u);
            PHASE();
            for (int u = (C.bid + 128) % C.G; u < 32; u += C.G) s_rwkv_unit(C, li, u);
            GRID_BAR();
#endif
            for (int u = C.bid; u < 256; u += C.G) rwkv_scan_unit(C, u);
            PHASE();
#if PROBE_DUP & 4
            GRID_BAR(); for (int u = C.bid; u < 256; u += C.G) rwkv_scan_unit(C, u); PHASE();
#endif
            ssd_scan_phase(C, li);
            GRID_BAR();
            if (C.G >= 64) { if (C.bid < 32) { PHASE(); rwkv_combine_unit(C, li, C.bid); } else { PHASE(); for (int u = C.bid - 32; u < 256; u += C.G - 32) ssd_c_unit(C, li, u); PHASE(); cache_roll_slice(C, li, 2, C.bid - 32, C.G - 32); } }
            else { for (int u = C.bid; u < 32; u += C.G) rwkv_combine_unit(C, li, u); PHASE(); for (int u = C.bid; u < 256; u += C.G) ssd_c_unit(C, li, u); PHASE(); cache_roll_slice(C, li, 2, C.bid, C.G); }
            GRID_BAR();
#if PROBE_DUP & 8
            if (C.G >= 64) { if (C.bid < 32) { PHASE(); rwkv_combine_unit(C, li, C.bid); } else { PHASE(); for (int u = C.bid - 32; u < 256; u += C.G - 32) ssd_c_unit(C, li, u); } }
            else { for (int u = C.bid; u < 32; u += C.G) rwkv_combine_unit(C, li, u); PHASE(); for (int u = C.bid; u < 256; u += C.G) ssd_c_unit(C, li, u); }
            GRID_BAR();
#endif
            for (int u = C.bid; u < 2048; u += C.G) rwkv_out_unit(C, li, u);
            GRID_BAR();
#if PROBE_DUP & 16
            for (int u = C.bid; u < 2048; u += C.G) rwkv_out_unit(C, li, u);
            GRID_BAR();
#endif
            { const float* xin = l == 0 ? INP(I_XP) : WSP(float, WS_X); const float* xsin = l == 0 ? INP(I_XS) : WSP(float, WS_X) + (size_t)T * D; const float* gate = modl + 2048;
              pg8::Gemm g{WSP(bf16, WS_YCAT), WSP(bf16, WS_WOUT) + (size_t)li * 1024 * 2048, T, 1024, 2048}; pg8::StaticOrder S; S.init(T, 1024, C.G, C.bid);
              EpiRes E{xin, WSP(float, WS_X), gate}; pg8::gemm_phase<EpiRes, pg8::StaticOrder>(ring, g, S, E, nullptr); PHASE();
              float* XS = WSP(float, WS_X) + (size_t)T * D;
              small_gemm(C, WSP(bf16, WS_YCAT) + (size_t)T * 2048, WSP(bf16, WS_WOUT) + (size_t)li * 1024 * 2048, 1024, 2048, [&](int r, int c, float v) { XS[(size_t)r * D + c] = xsin[(size_t)r * D + c] + gate[(size_t)(2 + r) * 6144 + c] * v; }); }
            GRID_BAR();
        } else {
            { pg8::Gemm g{WSP(bf16, WS_XN), WSP(bf16, WS_WQKV) + (size_t)li * QKV_N * 1024, T, QKV_N, 1024}; pg8::StaticOrder S; S.init(T, QKV_N, C.G, C.bid);
              EpiQkv E{WSP(bf16, WS_QKV), WSP(float, WS_ROPE), (C.PP->out), li}; pg8::gemm_phase<EpiQkv, pg8::StaticOrder>(ring, g, S, E, nullptr); PHASE();
              float* QS = WSP(float, WS_SMALL) + MiB / 4;
              small_gemm(C, WSP(bf16, WS_XN) + (size_t)T * D, WSP(bf16, WS_WQKV) + (size_t)li * QKV_N * 1024, QKV_N, 1024, [&](int r, int c, float v) { QS[(size_t)r * QKV_N + c] = v; }); }
            GRID_BAR();
            for (int u = C.bid; u < 3072; u += C.G) attn_tile_unit(C, u);
            PHASE();
            for (int u = C.bid; u < 32; u += C.G) s_attn_unit(C, li, u);
            GRID_BAR();
#if PROBE_DUP & 32
            for (int u = C.bid; u < 3072; u += C.G) attn_tile_unit(C, u);
            PHASE();
            for (int u = C.bid; u < 32; u += C.G) s_attn_unit(C, li, u);
            GRID_BAR();
#endif
            attn_merge_phase(C);
            GRID_BAR();
            { const float* gate = modl + 2048;
              pg8::Gemm g{WSP(bf16, WS_AO), WSP(bf16, WS_WAO) + (size_t)li * 1024 * 512, T, 1024, 512}; pg8::StaticOrder S; S.init(T, 1024, C.G, C.bid);
              EpiRes E{WSP(float, WS_X), WSP(float, WS_X), gate}; pg8::gemm_phase<EpiRes, pg8::StaticOrder>(ring, g, S, E, nullptr); PHASE();
              float* XS = WSP(float, WS_X) + (size_t)T * D;
              small_gemm(C, WSP(bf16, WS_AO) + (size_t)T * 512, WSP(bf16, WS_WAO) + (size_t)li * 1024 * 512, 1024, 512, [&](int r, int c, float v) { XS[(size_t)r * D + c] += gate[(size_t)(2 + r) * 6144 + c] * v; }); }
            GRID_BAR();
        }
        norm_phase(C, l, 1, false);
        GRID_BAR();
#if PROBE_DUP & 64
        norm_phase(C, l, 1, false);
        GRID_BAR();
#endif
#if PROBE_DUP & 128
        { pg8::Gemm g{WSP(bf16, WS_XN), WSP(bf16, WS_W1) + (size_t)l * FF * 1024, T, FF, 1024}; pg8::StaticOrder S; S.init(T, FF, C.G, C.bid);
          EpiMlp1 E{WSP(bf16, WS_HID)}; pg8::gemm_phase<EpiMlp1, pg8::StaticOrder>(ring, g, S, E, nullptr); } GRID_BAR();
#endif
        { pg8::Gemm g{WSP(bf16, WS_XN), WSP(bf16, WS_W1) + (size_t)l * FF * 1024, T, FF, 1024}; pg8::StaticOrder S; S.init(T, FF, C.G, C.bid);
          EpiMlp1 E{WSP(bf16, WS_HID)}; pg8::gemm_phase<EpiMlp1, pg8::StaticOrder>(ring, g, S, E, nullptr); PHASE();
          bf16* HS = WSP(bf16, WS_HID) + (size_t)T * FF;
          small_gemm(C, WSP(bf16, WS_XN) + (size_t)T * D, WSP(bf16, WS_W1) + (size_t)l * FF * 1024, FF, 1024, [&](int r, int c, float v) { const float a = fmaxf(v, 0.f); HS[(size_t)r * FF + c] = (bf16)(pk2(a * a, 0.f) & 0xffffu); }); }
        GRID_BAR();
        { const float* gate = modl + 5120;
          pg8::Gemm g{WSP(bf16, WS_HID), WSP(bf16, WS_W2) + (size_t)l * 1024 * FF, T, 1024, FF}; pg8::StaticOrder S; S.init(T, 1024, C.G, C.bid);
          EpiRes E{WSP(float, WS_X), WSP(float, WS_X), gate}; pg8::gemm_phase<EpiRes, pg8::StaticOrder>(ring, g, S, E, nullptr); PHASE();
          float* XS = WSP(float, WS_X) + (size_t)T * D;
          small_gemm(C, WSP(bf16, WS_HID) + (size_t)T * FF, WSP(bf16, WS_W2) + (size_t)l * 1024 * FF, 1024, FF, [&](int r, int c, float v) { XS[(size_t)r * D + c] += gate[(size_t)(2 + r) * 6144 + c] * v; }); }
        GRID_BAR();
    }
    final_norm_phase(C);
}
}

extern "C" void kernel_launch(void* const* d_in, const int* in_sizes, int n_in, void* d_out, int out_size, void* d_ws, size_t ws_size, hipStream_t stream) {
    static int grid = 0;
    if (grid == 0) {
        int dev = 0, cus = 0, per_cu = 0;
        if (hipGetDevice(&dev) != hipSuccess || hipDeviceGetAttribute(&cus, hipDeviceAttributeMultiprocessorCount, dev) != hipSuccess) { fprintf(stderr, "kernel_launch: device query failed\n"); grid = -1; return; }
        if (hipFuncSetAttribute((const void*)mk::mk_fwd, hipFuncAttributeMaxDynamicSharedMemorySize, mk::LDS_BYTES) != hipSuccess) { fprintf(stderr, "kernel_launch: hipFuncSetAttribute failed\n"); grid = -1; return; }
        if (hipOccupancyMaxActiveBlocksPerMultiprocessor(&per_cu, (const void*)mk::mk_fwd, 512, mk::LDS_BYTES) != hipSuccess || per_cu < 1) fprintf(stderr, "kernel_launch: occupancy query reports %d\n", per_cu);
        if (n_in != 39 || (size_t)out_size != mk::O_END || ws_size < mk::WS_END) { fprintf(stderr, "kernel_launch: unexpected sizes n_in %d out %d ws %zu\n", n_in, out_size, ws_size); grid = -1; return; }
        grid = cus;
    }
    if (grid < 0) return;
    hipMemsetAsync((char*)d_ws + mk::WS_CTL, 0, mk::CTL_BYTES, stream);
    mk::Params p; memset(&p, 0, sizeof(p));
    for (int i = 0; i < 39; ++i) p.in[i] = (const float*)d_in[i];
    p.out = (float*)d_out; p.ws = (unsigned char*)d_ws;
    hipLaunchKernelGGL(mk::mk_fwd, dim3(grid), dim3(512), mk::LDS_BYTES, stream, p);
}
```

```cpp
#include <hip/hip_runtime.h>
#include <cstdio>
#include <cstdint>
#include <cstring>
namespace pg8 {
#define PG8_LAS __attribute__((address_space(3)))
typedef unsigned short bf16_t;
typedef short bf16x8 __attribute__((ext_vector_type(8)));
typedef float f32x4 __attribute__((ext_vector_type(4)));
typedef unsigned u32x4 __attribute__((ext_vector_type(4)));
constexpr int BM = 256, BK = 64, HALF = 128, HTB = HALF * BK * 2  , STAGE_BYTES = 8 * HTB, NXCD = 8, WGM = 8;

__host__ __device__ __forceinline__ int lds_byte(int r, int c) { const int st = (r >> 4) * 2 + (c >> 5), rr = r & 15, cc = c & 31, ob = rr * 64 + cc * 2; return st * 1024 + (ob ^ (((ob >> 9) & 1) << 5)); }
__host__ __device__ __forceinline__ void stage_rc(int b, int& R, int& C) { const int st = b / 1024, sb = b % 1024, swz = sb ^ (((sb >> 9) & 1) << 5); R = (st >> 1) * 16 + swz / 64; C = (st & 1) * 32 + (swz % 64) / 2; }
__host__ __device__ __forceinline__ int perm32(int rho) { const int n = rho >> 4, i = rho & 15; return 8 * (i >> 2) + 4 * n + (i & 3); }

struct Unit { int pm, pn; };
struct Gemm { const bf16_t* A; const bf16_t* Bt; int M, N, K; };

struct StaticOrder {
    int nM, nN, nwg, G, c;
    __host__ __device__ void init(int M, int N, int G_, int c_) { nM = M / BM; nN = N / BM; nwg = nM * nN; G = G_; c = c_; }
    __host__ __device__ bool next(int i, Unit& u) const {
        const long L = (long)i * G + c; if (L >= nwg) return false;
        int wgid = (int)L; { const int q = nwg / NXCD, r = nwg % NXCD, xcd = wgid % NXCD, off = wgid / NXCD; wgid = (xcd < r ? xcd * (q + 1) : r * (q + 1) + (xcd - r) * q) + off; }
        const int nig = WGM * nN, gid = wgid / nig, fm = gid * WGM, gsz = (nM - fm) < WGM ? (nM - fm) : WGM;
        u.pm = fm + ((wgid % nig) % gsz); u.pn = (wgid % nig) / gsz; return true;
    }
    __device__ __forceinline__ void a_ready(const Unit&) const {}
    __device__ __forceinline__ void done(const Unit&) const {}
};
template <class Epi, class Sched, bool STAMP = false>
__device__ __forceinline__ void gemm_phase(PG8_LAS unsigned char* lds, const Gemm g, const Sched& S, const Epi& E, unsigned long long* stamps) {
    int tid_ = threadIdx.x; asm volatile("" : "+v"(tid_));
    const int tid = tid_, wid = __builtin_amdgcn_readfirstlane(tid >> 6), lane = tid & 63, wr = wid >> 2, wc = wid & 3, fr = lane & 15, fq = lane >> 4;
    const int K = g.K, nt = K / BK;
    int ts_lo = 0, ts_hi = 0, nts = 0; const unsigned long long rt_entry = STAMP ? (unsigned long long)wall_clock64() : 0ull;
#define PG8_STAMP() do { if (STAMP && wid == 0 && nts < 64) { const unsigned long long _c = (unsigned long long)clock64(); \
        ts_lo = (lane == nts) ? (int)(unsigned)_c : ts_lo; ts_hi = (lane == nts) ? (int)(unsigned)(_c >> 32) : ts_hi; ++nts; } } while (0)
    PG8_STAMP();
    unsigned voffA[2], voffB[2];
#pragma unroll
    for (int i = 0; i < 2; ++i) { int R, C; stage_rc(tid * 16 + i * 8192, R, C); const int Rb = Epi::PERM ? ((R & ~31) + perm32(R & 31)) : R;
        voffA[i] = (unsigned)(R * K + C) * 2u; voffB[i] = (unsigned)(Rb * K + C) * 2u; }
    const size_t kstep = (size_t)(BK * 2);
    const size_t hstep = (size_t)HALF * K * 2;
    const size_t tstep = 2 * hstep;
    const unsigned ldsw = (unsigned)wid * 1024u;
    const int aoff = lds_byte(wr * 64 + fr, fq * 8), boff = lds_byte(wc * 32 + fr, fq * 8);
#define PG8_SA(b, h) (((b) * 2 + (h)) * HTB)
#define PG8_SB(b, h) ((4 + (b) * 2 + (h)) * HTB)
#define PG8_STAGE(bufoff, gbase, voff) do { _Pragma("unroll") for (int _i = 0; _i < 2; ++_i) \
        __builtin_amdgcn_global_load_lds((const unsigned*)((const char*)(gbase) + (voff)[_i]), (PG8_LAS unsigned*)(lds + (bufoff) + ldsw + _i * 8192), 16, 0, 0); } while (0)
#define PG8_LDA(dst, b, h) do { _Pragma("unroll") for (int m = 0; m < 4; ++m) _Pragma("unroll") for (int k = 0; k < 2; ++k) dst[m][k] = *(const PG8_LAS bf16x8*)(lds + PG8_SA(b, h) + aoff + m * 2048 + k * 1024); } while (0)
#define PG8_LDB(dst, b, h) do { _Pragma("unroll") for (int n = 0; n < 2; ++n) _Pragma("unroll") for (int k = 0; k < 2; ++k) dst[n][k] = *(const PG8_LAS bf16x8*)(lds + PG8_SB(b, h) + boff + n * 2048 + k * 1024); } while (0)
#define PG8_MMA(ai, bj, At, Bt) do { __builtin_amdgcn_s_setprio(1); _Pragma("unroll") for (int m = 0; m < 4; ++m) _Pragma("unroll") for (int n = 0; n < 2; ++n) _Pragma("unroll") for (int k = 0; k < 2; ++k) \
        acc[ai][bj][m][n] = __builtin_amdgcn_mfma_f32_16x16x32_bf16(Bt[n][k], At[m][k], acc[ai][bj][m][n], 0, 0, 0); __builtin_amdgcn_s_setprio(0); } while (0)
#define PG8_WAIT_V(n) asm volatile("s_waitcnt vmcnt(" #n ")" ::: "memory")
#define PG8_WAIT_L(n) asm volatile("s_waitcnt lgkmcnt(" #n ")" ::: "memory")
#define PG8_BAR __builtin_amdgcn_s_barrier()
#define PG8_SCHED __builtin_amdgcn_sched_barrier(0)
    Unit cur, nxt; int ui = 0;
    if (!S.next(0, cur)) return;
    f32x4 acc[2][2][4][2];
#pragma unroll
    for (int a = 0; a < 2; ++a)
#pragma unroll
        for (int b = 0; b < 2; ++b)
#pragma unroll
            for (int m = 0; m < 4; ++m)
#pragma unroll
                for (int n = 0; n < 2; ++n) acc[a][b][m][n] = (f32x4){0.f, 0.f, 0.f, 0.f};
    bf16x8 At[4][2], B0[2][2], B1[2][2];
    const char* cA = (const char*)g.A + (size_t)cur.pm * tstep; const char* cB = (const char*)g.Bt + (size_t)cur.pn * tstep;
    S.a_ready(cur);
    PG8_STAGE(PG8_SB(0, 0), cB, voffB); PG8_STAGE(PG8_SA(0, 0), cA, voffA); PG8_STAGE(PG8_SB(0, 1), cB + hstep, voffB); PG8_STAGE(PG8_SA(0, 1), cA + hstep, voffA);
    if (wr == 1) PG8_BAR;
    PG8_WAIT_V(4); PG8_BAR;
    PG8_STAGE(PG8_SB(1, 0), cB + kstep, voffB); PG8_STAGE(PG8_SA(1, 0), cA + kstep, voffA); PG8_STAGE(PG8_SB(1, 1), cB + hstep + kstep, voffB);
    PG8_WAIT_V(6); PG8_BAR;
    PG8_STAMP();
    for (;;) {
        const bool has_next = S.next(ui + 1, nxt);
        const char* nA = has_next ? (const char*)g.A + (size_t)nxt.pm * tstep : cA; const char* nB = has_next ? (const char*)g.Bt + (size_t)nxt.pn * tstep : cB;
        for (int t = 0; t < nt; t += 2) {
            const bool last = (t == nt - 2);
            const char* a1 = cA + (size_t)(t + 1) * kstep;
            const char* a2 = last ? nA : cA + (size_t)(t + 2) * kstep; const char* b2 = last ? nB : cB + (size_t)(t + 2) * kstep;
            const char* a3 = a2 + kstep; const char* b3 = b2 + kstep;
            if (last && has_next) S.a_ready(nxt);
            PG8_LDB(B0, 0, 0); PG8_SCHED; PG8_LDA(At, 0, 0); PG8_STAGE(PG8_SA(1, 1), a1 + hstep, voffA);
            PG8_WAIT_L(8); PG8_BAR; PG8_WAIT_L(0); PG8_MMA(0, 0, At, B0); PG8_BAR; PG8_SCHED;
            PG8_LDB(B1, 0, 1); PG8_STAGE(PG8_SB(0, 0), b2, voffB);
            PG8_BAR; PG8_WAIT_L(0); PG8_MMA(0, 1, At, B1); PG8_BAR;
            PG8_LDA(At, 0, 1); PG8_STAGE(PG8_SA(0, 0), a2, voffA);
            PG8_BAR; PG8_WAIT_L(0); PG8_MMA(1, 0, At, B0); PG8_BAR; PG8_SCHED;
            PG8_STAGE(PG8_SB(0, 1), b2 + hstep, voffB);
            PG8_WAIT_V(6); PG8_BAR; PG8_MMA(1, 1, At, B1); PG8_BAR;
            PG8_LDB(B0, 1, 0); PG8_SCHED; PG8_LDA(At, 1, 0); PG8_STAGE(PG8_SA(0, 1), a2 + hstep, voffA);
            PG8_WAIT_L(8); PG8_BAR; PG8_WAIT_L(0); PG8_MMA(0, 0, At, B0); PG8_BAR; PG8_SCHED;
            PG8_LDB(B1, 1, 1); PG8_STAGE(PG8_SB(1, 0), b3, voffB);
            PG8_BAR; PG8_WAIT_L(0); PG8_MMA(0, 1, At, B1); PG8_BAR;
            PG8_LDA(At, 1, 1); PG8_STAGE(PG8_SA(1, 0), a3, voffA);
            PG8_BAR; PG8_WAIT_L(0); PG8_MMA(1, 0, At, B0); PG8_BAR; PG8_SCHED;
            PG8_STAGE(PG8_SB(1, 1), b3 + hstep, voffB);
            PG8_WAIT_V(6); PG8_BAR; PG8_MMA(1, 1, At, B1); PG8_BAR;
        }
        PG8_STAMP();
        if constexpr (!Epi::AFTER_DRAIN) { E(acc, cur, wr, wc, fr, fq); S.done(cur); }
        PG8_STAMP();
        if (!has_next) break;
#pragma unroll
        for (int a = 0; a < 2; ++a)
#pragma unroll
            for (int b = 0; b < 2; ++b)
#pragma unroll
                for (int m = 0; m < 4; ++m)
#pragma unroll
                    for (int n = 0; n < 2; ++n) acc[a][b][m][n] = (f32x4){0.f, 0.f, 0.f, 0.f};
        cur = nxt; cA = nA; cB = nB; ++ui;
    }
    PG8_WAIT_V(0);
    if (wr == 0) PG8_BAR;
    PG8_BAR;
    if constexpr (Epi::AFTER_DRAIN) { E.fused(acc, cur, wr, wc, fr, fq, lds, wid, lane); S.done(cur); }
    PG8_STAMP();
    if (STAMP && wid == 0) { stamps[lane] = lane < nts ? (((unsigned long long)(unsigned)ts_hi << 32) | (unsigned)ts_lo) : 0ull;
        if (lane == 62) stamps[62] = rt_entry; if (lane == 63) stamps[63] = (unsigned long long)wall_clock64(); }
#undef PG8_STAMP
#undef PG8_SA
#undef PG8_SB
#undef PG8_STAGE
#undef PG8_LDA
#undef PG8_LDB
#undef PG8_MMA
#undef PG8_WAIT_V
#undef PG8_WAIT_L
#undef PG8_BAR
#undef PG8_SCHED
}
}
#define XB_TMO      128
#define XB_XCNT(j)  (256  + 64 * (j))
#define XB_XSUB(j)  (1280 + 64 * (j))
#define XB_XGEN(j)  (2304 + 64 * (j))
#define XB_TOP      3328
#define XB_TOPGEN   3392
#define XCD_BAR_WORDS 3456
#define XB_SPIN_CAP (1u << 18)
#define LAS __attribute__((address_space(3)))

__device__ __forceinline__ unsigned xb_ld(unsigned* p)              { return __hip_atomic_load(p, __ATOMIC_RELAXED, __HIP_MEMORY_SCOPE_AGENT); }
__device__ __forceinline__ unsigned xb_add(unsigned* p, unsigned v) { return __hip_atomic_fetch_add(p, v, __ATOMIC_RELAXED, __HIP_MEMORY_SCOPE_AGENT); }
__device__ __forceinline__ unsigned xb_xcc_id() { return (unsigned)__builtin_amdgcn_s_getreg((3 << 11) | 20) & 0xFu; }
#define XB_SPIN(cond, bar) do { unsigned _sp = 0; while (cond) { __builtin_amdgcn_s_sleep(1); \
    if ((++_sp & 255u) == 0u) { if (xb_ld(&(bar)[XB_TMO])) break; if (_sp > XB_SPIN_CAP) { atomicAdd(&(bar)[XB_TMO], 1u); break; } } } } while (0)

struct XcdBarrier {
    unsigned* bar; unsigned x;
    volatile LAS unsigned* st;
};

__device__ __forceinline__ XcdBarrier xcd_barrier_post(unsigned* bar, volatile LAS unsigned* st) {
    XcdBarrier b; b.bar = bar; b.x = xb_xcc_id(); b.st = st;
    if (threadIdx.x == 0) (void)xb_add(&bar[XB_XCNT(b.x)], 1u);
    return b;
}
__device__ __forceinline__ void xcd_barrier_complete(unsigned* bar, unsigned x, unsigned& nloc, unsigned& nx) {
    const unsigned G = gridDim.x * gridDim.y * gridDim.z;
    unsigned sum, cnt, mine, sp = 0u;
    for (;;) {
        sum = 0u; cnt = 0u; mine = 0u;
#pragma unroll
        for (unsigned j = 0; j < 16; ++j) { const unsigned c = xb_ld(&bar[XB_XCNT(j)]); sum += c; cnt += (c > 0u) ? 1u : 0u; mine = (j == x) ? c : mine; }
        if (sum == G) break;
        __builtin_amdgcn_s_sleep(1);
        if ((++sp & 255u) == 0u) { if (xb_ld(&bar[XB_TMO])) break; if (sp > XB_SPIN_CAP) { atomicAdd(&bar[XB_TMO], 1u); break; } }
    }
    nloc = mine > 0u ? mine : 1u; nx = cnt > 0u ? cnt : 1u;
}

__device__ __forceinline__ void xcd_barrier(const XcdBarrier& b) {
    asm volatile("s_waitcnt vmcnt(0)" ::: "memory");
    __syncthreads();
    if (threadIdx.x == 0) {
        unsigned* bar = b.bar;
        __builtin_amdgcn_s_waitcnt(0);
        unsigned nloc = b.st[0], nx = b.st[1];
        if (nloc == 0u) { xcd_barrier_complete(bar, b.x, nloc, nx); b.st[0] = nloc; b.st[1] = nx; }
        const unsigned old = xb_add(&bar[XB_XSUB(b.x)], 1u);
        const unsigned gen = old / nloc;
        if (old + 1u == (gen + 1u) * nloc) {
            __builtin_amdgcn_fence(__ATOMIC_RELEASE, "agent");
            asm volatile("s_waitcnt vmcnt(0)" ::: "memory");
            const unsigned og = xb_add(&bar[XB_TOP], 1u);
            const unsigned tg = og / nx;
            if (og + 1u == (tg + 1u) * nx) xb_add(&bar[XB_TOPGEN], 1u);
            else XB_SPIN(xb_ld(&bar[XB_TOPGEN]) == tg, bar);
            __builtin_amdgcn_fence(__ATOMIC_ACQUIRE, "agent");
            xb_add(&bar[XB_XGEN(b.x)], 1u);
            asm volatile("s_waitcnt vmcnt(0)" ::: "memory");
        } else {
            XB_SPIN(xb_ld(&bar[XB_XGEN(b.x)]) == gen, bar);
            __builtin_amdgcn_fence(__ATOMIC_ACQUIRE, "agent");
            asm volatile("s_waitcnt vmcnt(0)" ::: "memory");
        }
    }
    __syncthreads();
}

namespace mk {
#define LAS __attribute__((address_space(3)))
typedef unsigned short bf16;
typedef short bf16x8 __attribute__((ext_vector_type(8)));
typedef float f32x4 __attribute__((ext_vector_type(4)));
typedef float f32x2 __attribute__((ext_vector_type(2)));
typedef float f32x16 __attribute__((ext_vector_type(16)));
typedef unsigned u32x4 __attribute__((ext_vector_type(4)));
typedef unsigned u32x2 __attribute__((ext_vector_type(2)));

constexpr int T = 16384, SEQ = 8192, NS = 32, D = 1024, NSEQ = 34, NT = 512;
constexpr int HYB_NP = 6144, HYB_N = 5904, QKV_N = 4608, FF = 4096;
constexpr int U_XBC = 1024, U_DT = 2560, U_RW = 2576, RWC = 3328;
constexpr float EPS = 1e-6f, LN_EPS = 64e-5f;
constexpr size_t MiB = 1u << 20;
constexpr size_t WS_CTL = 0, CTL_BYTES = MiB;
constexpr size_t WS_WIN = 2 * MiB, WS_WOUT = 26 * MiB, WS_WQKV = 34 * MiB, WS_WAO = 52 * MiB, WS_W1 = 54 * MiB, WS_W2 = 86 * MiB, WS_LORA = 118 * MiB;
constexpr size_t WS_MOD = 119 * MiB, WS_ROPE = 123 * MiB, WS_SMALL = 124 * MiB, WS_X = 128 * MiB, WS_XN = 193 * MiB, WS_U = 226 * MiB;
constexpr int RECB = 896;
constexpr size_t WS_DT = 418 * MiB, WS_DTS = 419 * MiB, WS_ACS = 420 * MiB, WS_REC = 421 * MiB, WS_G = 805 * MiB, WS_XT = 837 * MiB, WS_BC = 869 * MiB;
constexpr size_t WS_CS = 885 * MiB, WS_QO = 949 * MiB, WS_SL = 1077 * MiB, WS_SST = 1141 * MiB, WS_YCAT = 1173 * MiB, WS_QKV = 1238 * MiB;
constexpr size_t WS_OG = 1382 * MiB, WS_LSE = 1430 * MiB, WS_AO = 1432 * MiB, WS_HID = 1449 * MiB, WS_END = 1578 * MiB;
constexpr size_t O_YP = 0, O_YS = O_YP + (size_t)T * D, O_SSDP = O_YS + 32 * 1024, O_SSDS = O_SSDP + 2 * 2 * 16 * 8192, O_CONVP = O_SSDS + (size_t)2 * 32 * 16 * 8192;
constexpr size_t O_CONVS = O_CONVP + 2 * 2 * 3 * 1536, O_WKVP = O_CONVS + 2 * 32 * 3 * 1536, O_WKVS = O_WKVP + 2 * 2 * 16 * 4096, O_SHP = O_WKVS + (size_t)2 * 32 * 16 * 4096;
constexpr size_t O_SHS = O_SHP + 2 * 2 * 3328, O_W0P = O_SHS + 2 * 32 * 3328, O_W0S = O_W0P + (size_t)2 * 2 * 128 * 1024, O_W1P = O_W0S + (size_t)2 * 32 * 128 * 1024;
constexpr size_t O_W1S = O_W1P + (size_t)2 * 2 * 512 * 1024, O_W2P = O_W1S + (size_t)2 * 32 * 512 * 1024, O_W2S = O_W2P + (size_t)2 * 2 * 2048 * 1024;
constexpr size_t O_END = O_W2S + (size_t)2 * 32 * 2048 * 1024;
static_assert(O_END == 217889792ull, "output size");
constexpr int LDS_RING = 131072, LDS_MISC = LDS_RING + 320, LDS_BYTES = 147456;

struct Params { const float* in[39]; float* out; unsigned char* ws; };

__device__ __forceinline__ unsigned pk2(float lo, float hi) { unsigned r; asm volatile("v_cvt_pk_bf16_f32 %0, %1, %2" : "=v"(r) : "v"(lo), "v"(hi)); return r; }
__device__ __forceinline__ float bflo(unsigned u) { return __uint_as_float(u << 16); }
__device__ __forceinline__ float bfhi(unsigned u) { return __uint_as_float(u & 0xffff0000u); }
__device__ __forceinline__ float bf1(bf16 h) { return __uint_as_float(((unsigned)h) << 16); }
__device__ __forceinline__ f32x4 bf4(u32x2 v) { return (f32x4){bflo(v.x), bfhi(v.x), bflo(v.y), bfhi(v.y)}; }
__device__ __forceinline__ u32x2 pk4(f32x4 v) { u32x2 r; r.x = pk2(v[0], v[1]); r.y = pk2(v[2], v[3]); return r; }
__device__ __forceinline__ float siluf_(float x) { return x * __builtin_amdgcn_rcpf(1.f + __expf(-x)); }
__device__ __forceinline__ float sigm_(float x) { return __builtin_amdgcn_rcpf(1.f + __expf(-x)); }
__device__ __forceinline__ float softplus_(float x) { return fmaxf(x, 0.f) + __logf(1.f + __expf(-fabsf(x))); }
__device__ __forceinline__ float tanh_(float x) { const float t = __expf(-2.f * fabsf(x)); const float r = (1.f - t) * __builtin_amdgcn_rcpf(1.f + t); return x < 0.f ? -r : r; }
__device__ __forceinline__ float wave_sum(float v) {
#pragma unroll
    for (int o = 1; o < 64; o <<= 1) v += __shfl_xor(v, o);
    return v;
}
__device__ __forceinline__ float wave_max(float v) {
#pragma unroll
    for (int o = 1; o < 64; o <<= 1) v = fmaxf(v, __shfl_xor(v, o));
    return v;
}
__device__ __forceinline__ f32x4 mfma16(bf16x8 a, bf16x8 b, f32x4 c) { return __builtin_amdgcn_mfma_f32_16x16x32_bf16(a, b, c, 0, 0, 0); }
#define LDSW() asm volatile("s_waitcnt lgkmcnt(0)" ::: "memory")
#define LDS_BARRIER() do { asm volatile("s_waitcnt lgkmcnt(0)" ::: "memory"); __builtin_amdgcn_s_barrier(); asm volatile("" ::: "memory"); } while (0)

#define CAS __attribute__((address_space(4)))
struct Ctx {
    LAS unsigned char* lds; int tid, lane, wave, G, bid;
    const CAS Params* PP;
};
#define WSP(type, off) ((type*)((C.PP->ws) + (off)))
#define INP(i) (C.PP->in[i])
enum { I_XP = 0, I_XS, I_SSD, I_CONV, I_WKV, I_SHIFT, I_C0, I_C1, I_C2, I_CP, I_CS, I_NMIX, I_NMLP, I_NFIN, I_ADAW, I_ADAB, I_W1, I_W2, I_HIN, I_HOUT, I_CONVW, I_CONVB,
       I_DTB, I_ALOG, I_SSDD, I_SNW, I_MU, I_RW0, I_RW2, I_RA0, I_RA2, I_RG2, I_KK, I_KA, I_RK, I_LNW, I_LNB, I_AQKV, I_AOUT };

__device__ __forceinline__ void transpose_item(const float* W, int K, int N, bf16* WT, LAS float* scr, int item, int lane) {
    const int nblk = (N + 31) / 32, kb = item / nblk, nb = item % nblk, k0 = 64 * kb, n0 = 32 * nb;
    const int nn = n0 + (lane & 31);
#pragma unroll 8
    for (int i = 0; i < 32; ++i) { const int kk = 2 * i + (lane >> 5); scr[kk * 33 + (lane & 31)] = nn < N ? W[(size_t)(k0 + kk) * N + nn] : 0.f; }
    LDSW();
    const int c = lane & 7;
#pragma unroll
    for (int j = 0; j < 4; ++j) { const int n = (lane >> 3) + 8 * j; const LAS float* s = scr + (8 * c) * 33 + n;
        u32x4 o; o.x = pk2(s[0 * 33], s[1 * 33]); o.y = pk2(s[2 * 33], s[3 * 33]); o.z = pk2(s[4 * 33], s[5 * 33]); o.w = pk2(s[6 * 33], s[7 * 33]);
        *(u32x4*)(WT + (size_t)(n0 + n) * K + k0 + 8 * c) = o; }
    LDSW();
}

__device__ __forceinline__ void p0_weights(const Ctx& C) {
    LAS float* scr = (LAS float*)(C.lds + C.wave * 16384);
    const int gw = C.bid * 8 + C.wave, NGW = C.G * 8;
    constexpr int N_IN = 16 * 185, N_OUT = 32 * 32, N_QKV = 16 * 144, N_AO = 8 * 32, N_1 = 16 * 128, N_2 = 64 * 32, N_L64 = 32, N_L128 = 64;
    constexpr int TOTAL = 2 * N_IN + 2 * N_OUT + 2 * N_QKV + 2 * N_AO + 4 * N_1 + 4 * N_2 + 2 * (2 * N_L64 + N_L128);
    for (int it = gw; it < TOTAL; it += NGW) {
        int r = it;
        if (r < 2 * N_IN) { const int i = r / N_IN; transpose_item(INP(I_HIN) + (size_t)i * 1024 * HYB_N, 1024, HYB_N, WSP(bf16, WS_WIN) + (size_t)i * HYB_NP * 1024, scr, r % N_IN, C.lane); continue; } r -= 2 * N_IN;
        if (r < 2 * N_OUT) { const int i = r / N_OUT; transpose_item(INP(I_HOUT) + (size_t)i * 2048 * 1024, 2048, 1024, WSP(bf16, WS_WOUT) + (size_t)i * 1024 * 2048, scr, r % N_OUT, C.lane); continue; } r -= 2 * N_OUT;
        if (r < 2 * N_QKV) { const int i = r / N_QKV; transpose_item(INP(I_AQKV) + (size_t)i * 1024 * QKV_N, 1024, QKV_N, WSP(bf16, WS_WQKV) + (size_t)i * QKV_N * 1024, scr, r % N_QKV, C.lane); continue; } r -= 2 * N_QKV;
        if (r < 2 * N_AO) { const int i = r / N_AO; transpose_item(INP(I_AOUT) + (size_t)i * 512 * 1024, 512, 1024, WSP(bf16, WS_WAO) + (size_t)i * 1024 * 512, scr, r % N_AO, C.lane); continue; } r -= 2 * N_AO;
        if (r < 4 * N_1) { const int i = r / N_1; transpose_item(INP(I_W1) + (size_t)i * 1024 * FF, 1024, FF, WSP(bf16, WS_W1) + (size_t)i * FF * 1024, scr, r % N_1, C.lane); continue; } r -= 4 * N_1;
        if (r < 4 * N_2) { const int i = r / N_2; transpose_item(INP(I_W2) + (size_t)i * FF * 1024, FF, 1024, WSP(bf16, WS_W2) + (size_t)i * 1024 * FF, scr, r % N_2, C.lane); continue; } r -= 4 * N_2;
        { const int i = r / (2 * N_L64 + N_L128); int q = r % (2 * N_L64 + N_L128); bf16* lb = WSP(bf16, WS_LORA) + (size_t)i * 262144;
          if (q < N_L64) { transpose_item(INP(I_RW2) + (size_t)i * 64 * 1024, 64, 1024, lb, scr, q, C.lane); continue; } q -= N_L64;
          if (q < N_L64) { transpose_item(INP(I_RA2) + (size_t)i * 64 * 1024, 64, 1024, lb + 65536, scr, q, C.lane); continue; } q -= N_L64;
          transpose_item(INP(I_RG2) + (size_t)i * 128 * 1024, 128, 1024, lb + 131072, scr, q, C.lane); }
    }
    const int gt = C.bid * NT + C.tid, NGT = C.G * NT;
    for (int i = gt; i < 2 * 224 * 128; i += NGT) { const int l = i / (224 * 128), r = i % (224 * 128); ((u32x4*)(WSP(bf16, WS_WIN) + (size_t)l * HYB_NP * 1024 + (size_t)5920 * 1024))[r] = (u32x4){0u, 0u, 0u, 0u}; }
    for (int i = gt; i < 8193 * 8; i += NGT) { const int t = i >> 3, k = i & 7; const double inv = pow(500000.0, -(double)k / 8.0), ang = (double)t * inv;
        WSP(float, WS_ROPE)[t * 16 + k] = (float)cos(ang); WSP(float, WS_ROPE)[t * 16 + 8 + k] = (float)sin(ang); }
}

__device__ __forceinline__ void cache_roll_slice(const Ctx& C, int part, int nparts, int wk, int nwk) {
    if (wk < 0 || wk >= nwk) return;
#pragma unroll
    for (int g = 0; g < 3; ++g) {
        const int W = 128 << (2 * g); const size_t per = (size_t)(W - 1) * 256, tot = 64 * per, lo = tot * part / nparts, hi = tot * (part + 1) / nparts;
        const f32x4* src = (const f32x4*)INP(I_C0 + g); f32x4* dst = (f32x4*)((C.PP->out) + (g == 0 ? O_W0S : g == 1 ? O_W1S : O_W2S));
        for (size_t i = lo + (size_t)wk * NT + C.tid; i < hi; i += (size_t)nwk * NT) { const size_t ib = i / per, rem = i - ib * per; const f32x4 v = __builtin_nontemporal_load(src + (ib * W + 1) * 256 + rem); __builtin_nontemporal_store(v, dst + ib * W * 256 + rem); }
    }
}

__device__ __forceinline__ void p0_mod(const Ctx& C) {
    LAS f32x4* red = (LAS f32x4*)C.lds;
    const int q = C.lane >> 4, i = C.lane & 15;
    for (int u = C.bid; u < 384; u += C.G) {
        const int l = u / 96, n0 = (u % 96) * 64;
        const float* W = INP(I_ADAW) + (size_t)l * 1024 * 6144;
        f32x4 acc[3][4];
#pragma unroll
        for (int t = 0; t < 3; ++t)
#pragma unroll
            for (int n = 0; n < 4; ++n) acc[t][n] = (f32x4){0.f, 0.f, 0.f, 0.f};
        for (int kg = 0; kg < 8; ++kg) {
            const int k0 = 128 * C.wave + 16 * kg + 4 * q;
            f32x4 av[3], wv[4];
#pragma unroll
            for (int t = 0; t < 3; ++t) { const int s = 16 * t + i; av[t] = (f32x4){0.f, 0.f, 0.f, 0.f};
                if (s < NSEQ) { const float* cp = s < 2 ? INP(I_CP) + s * 1024 : INP(I_CS) + (s - 2) * 1024; const f32x4 v = *(const f32x4*)(cp + k0);
                    av[t] = (f32x4){siluf_(v[0]), siluf_(v[1]), siluf_(v[2]), siluf_(v[3])}; } }
#pragma unroll
            for (int m = 0; m < 4; ++m) wv[m] = *(const f32x4*)(W + (size_t)(k0 + m) * 6144 + n0 + 4 * i);
#pragma unroll
            for (int m = 0; m < 4; ++m)
#pragma unroll
                for (int t = 0; t < 3; ++t)
#pragma unroll
                    for (int n = 0; n < 4; ++n) acc[t][n] = __builtin_amdgcn_mfma_f32_16x16x4f32(av[t][m], wv[m][n], acc[t][n], 0, 0, 0);
        }
#pragma unroll
        for (int t = 0; t < 3; ++t)
#pragma unroll
            for (int r = 0; r < 4; ++r) red[(C.wave * 12 + t * 4 + r) * 64 + C.lane] = (f32x4){acc[t][0][r], acc[t][1][r], acc[t][2][r], acc[t][3][r]};
        __syncthreads();
        for (int e = C.tid; e < 768; e += NT) { const int slot = e >> 6, ln = e & 63; f32x4 s = red[slot * 64 + ln];
#pragma unroll
            for (int w = 1; w < 8; ++w) s += red[(w * 12 + slot) * 64 + ln];
            const int srow = 16 * (slot >> 2) + 4 * (ln >> 4) + (slot & 3), n = n0 + 4 * (ln & 15);
            if (srow < NSEQ) *(f32x4*)(WSP(float, WS_MOD) + ((size_t)l * NSEQ + srow) * 6144 + n) = s + *(const f32x4*)(INP(I_ADAB) + l * 6144 + n); }
        __syncthreads();
    }
}

__device__ __forceinline__ void norm_phase(const Ctx& C, int l, int which, bool from_input) {
    const int gw = C.bid * 8 + C.wave, NGW = C.G * 8;
    const float* g = INP(which ? I_NMLP : I_NMIX) + l * 1024;
    const int off_sh = which ? 3072 : 0, off_sc = which ? 4096 : 1024;
    for (int row = gw; row < T + NS; row += NGW) {
        const float* xr = from_input ? (row < T ? INP(I_XP) + (size_t)row * D : INP(I_XS) + (size_t)(row - T) * D) : WSP(float, WS_X) + (size_t)row * D;
        const int s = row < T ? (row >> 13) : 2 + row - T;
        const float* mod = WSP(float, WS_MOD) + ((size_t)l * NSEQ + s) * 6144;
        f32x4 v[4]; float ss = 0.f;
#pragma unroll
        for (int j = 0; j < 4; ++j) { v[j] = *(const f32x4*)(xr + 4 * C.lane + 256 * j); ss += (v[j][0] * v[j][0] + v[j][1] * v[j][1]) + (v[j][2] * v[j][2] + v[j][3] * v[j][3]); }
        const float rinv = rsqrtf(wave_sum(ss) * (1.f / D) + EPS);
#pragma unroll
        for (int j = 0; j < 4; ++j) { const int c = 4 * C.lane + 256 * j; const f32x4 gg = *(const f32x4*)(g + c), sh = *(const f32x4*)(mod + off_sh + c), sc = *(const f32x4*)(mod + off_sc + c);
            const f32x4 y = v[j] * rinv * gg * (sc + 1.f) + sh; *(u32x2*)(WSP(bf16, WS_XN) + (size_t)row * D + c) = pk4(y); }
    }
}
__device__ __forceinline__ void final_norm_phase(const Ctx& C) {
    const int gw = C.bid * 8 + C.wave, NGW = C.G * 8;
    const float* g = INP(I_NFIN);
    for (int row = gw; row < T + NS; row += NGW) {
        const float* xr = WSP(float, WS_X) + (size_t)row * D; float* o = (C.PP->out) + (row < T ? O_YP + (size_t)row * D : O_YS + (size_t)(row - T) * D);
        f32x4 v[4]; float ss = 0.f;
#pragma unroll
        for (int j = 0; j < 4; ++j) { v[j] = *(const f32x4*)(xr + 4 * C.lane + 256 * j); ss += (v[j][0] * v[j][0] + v[j][1] * v[j][1]) + (v[j][2] * v[j][2] + v[j][3] * v[j][3]); }
        const float rinv = rsqrtf(wave_sum(ss) * (1.f / D) + EPS);
#pragma unroll
        for (int j = 0; j < 4; ++j) { const int c = 4 * C.lane + 256 * j; *(f32x4*)(o + c) = v[j] * rinv * *(const f32x4*)(g + c); }
    }
}

constexpr size_t ROLL_T0 = (size_t)64 * 127 * 256, ROLL_T1 = (size_t)64 * 511 * 256, ROLL_T2 = (size_t)64 * 2047 * 256, ROLL_TOT = ROLL_T0 + ROLL_T1 + ROLL_T2;
constexpr int ROLL_NSL = 28 * 256, ROLL_L = (int)((ROLL_TOT + ROLL_NSL - 1) / ROLL_NSL);
static_assert(ROLL_L <= 12 * 512, "roll slice size");
struct RollArgs { const float* c0; const float* c1; const float* c2; float* out; int slot0; int* cnt; int bid; };
__device__ __forceinline__ void roll_addr(const RollArgs& R, size_t idx, const f32x4*& src, f32x4*& dst) {
    if (idx < ROLL_T0) { const size_t ib = idx / (127 * 256), rem = idx - ib * (127 * 256); src = (const f32x4*)R.c0 + (ib * 128 + 1) * 256 + rem; dst = (f32x4*)(R.out + O_W0S) + ib * 128 * 256 + rem; }
    else if (idx < ROLL_T0 + ROLL_T1) { const size_t j = idx - ROLL_T0, ib = j / (511 * 256), rem = j - ib * (511 * 256); src = (const f32x4*)R.c1 + (ib * 512 + 1) * 256 + rem; dst = (f32x4*)(R.out + O_W1S) + ib * 512 * 256 + rem; }
    else { const size_t j = idx - ROLL_T0 - ROLL_T1, ib = j / (2047 * 256), rem = j - ib * (2047 * 256); src = (const f32x4*)R.c2 + (ib * 2048 + 1) * 256 + rem; dst = (f32x4*)(R.out + O_W2S) + ib * 2048 * 256 + rem; }
}
#define ROLL_LOADS(R, tid) f32x4 _rv[12]; f32x4* _rd[12]; { const int _slice = ((R).slot0 + (*(R).cnt)++) * 256 + (R).bid; const size_t _b = (size_t)_slice * ROLL_L, _e = (_b + ROLL_L < ROLL_TOT) ? _b + ROLL_L : ROLL_TOT; \
    _Pragma("unroll") for (int _k = 0; _k < 12; ++_k) { const size_t _i = _b + (size_t)_k * 512 + (tid); _rd[_k] = nullptr; if (_i < _e) { const f32x4* _s; roll_addr(R, _i, _s, _rd[_k]); _rv[_k] = __builtin_nontemporal_load(_s); } } }
#define ROLL_STORES() do { _Pragma("unroll") for (int _k = 0; _k < 12; ++_k) if (_rd[_k]) __builtin_nontemporal_store(_rv[_k], _rd[_k]); } while (0)

using pg8::Unit;
struct EpiIn {
    static constexpr bool PERM = true, AFTER_DRAIN = false;
    bf16* U; float* DT; RollArgs R; bool roll;
    __device__ __forceinline__ void operator()(const f32x4 (&acc)[2][2][4][2], const Unit& u, int wr, int wc, int fr, int fq) const {
        const int row0 = u.pm * 256 + wr * 64 + fr, col0 = u.pn * 256 + wc * 32 + 8 * fq;
        ROLL_LOADS(R, (roll ? (wr * 4 + wc) * 64 + fq * 16 + fr : 1 << 30));
#pragma unroll
        for (int ai = 0; ai < 2; ++ai)
#pragma unroll
            for (int m = 0; m < 4; ++m) { const int row = row0 + ai * 128 + m * 16; bf16* rowp = U + (size_t)row * HYB_NP + col0;
#pragma unroll
                for (int bj = 0; bj < 2; ++bj) { const f32x4 v0 = acc[ai][bj][m][0], v1 = acc[ai][bj][m][1];
                    u32x4 w; w.x = pk2(v0[0], v0[1]); w.y = pk2(v0[2], v0[3]); w.z = pk2(v1[0], v1[1]); w.w = pk2(v1[2], v1[3]); *(u32x4*)(rowp + bj * 128) = w; }
                if (u.pn == 10 && wc == 0 && fq < 2) { *(f32x4*)(DT + (size_t)row * 16 + 8 * fq) = acc[ai][0][m][0]; *(f32x4*)(DT + (size_t)row * 16 + 8 * fq + 4) = acc[ai][0][m][1]; } }
        ROLL_STORES();
    }
};
struct EpiRes {
    static constexpr bool PERM = false, AFTER_DRAIN = false;
    const float* xin; float* xout; const float* gate;
    __device__ __forceinline__ void operator()(const f32x4 (&acc)[2][2][4][2], const Unit& u, int wr, int wc, int fr, int fq) const {
        const int row0 = u.pm * 256 + wr * 64 + fr, col0 = u.pn * 256 + wc * 32 + 4 * fq;
#pragma unroll
        for (int ai = 0; ai < 2; ++ai)
#pragma unroll
            for (int m = 0; m < 4; ++m) { const int row = row0 + ai * 128 + m * 16; const float* gp = gate + (size_t)(row >> 13) * 6144 + col0; const size_t off = (size_t)row * D + col0;
#pragma unroll
                for (int bj = 0; bj < 2; ++bj)
#pragma unroll
                    for (int n = 0; n < 2; ++n) { const int o = bj * 128 + n * 16; *(f32x4*)(xout + off + o) = *(const f32x4*)(xin + off + o) + *(const f32x4*)(gp + o) * acc[ai][bj][m][n]; } }
    }
};
struct EpiMlp1 {
    static constexpr bool PERM = true, AFTER_DRAIN = false;
    bf16* H; RollArgs R; bool roll;
    __device__ __forceinline__ void operator()(const f32x4 (&acc)[2][2][4][2], const Unit& u, int wr, int wc, int fr, int fq) const {
        const int row0 = u.pm * 256 + wr * 64 + fr, col0 = u.pn * 256 + wc * 32 + 8 * fq;
        ROLL_LOADS(R, (roll ? (wr * 4 + wc) * 64 + fq * 16 + fr : 1 << 30));
#pragma unroll
        for (int ai = 0; ai < 2; ++ai)
#pragma unroll
            for (int m = 0; m < 4; ++m) { bf16* rowp = H + (size_t)(row0 + ai * 128 + m * 16) * FF + col0;
#pragma unroll
                for (int bj = 0; bj < 2; ++bj) { f32x4 v0 = acc[ai][bj][m][0], v1 = acc[ai][bj][m][1];
#pragma unroll
                    for (int j = 0; j < 4; ++j) { const float a = fmaxf(v0[j], 0.f), b = fmaxf(v1[j], 0.f); v0[j] = a * a; v1[j] = b * b; }
                    u32x4 w; w.x = pk2(v0[0], v0[1]); w.y = pk2(v0[2], v0[3]); w.z = pk2(v1[0], v1[1]); w.w = pk2(v1[2], v1[3]); *(u32x4*)(rowp + bj * 128) = w; } }
        ROLL_STORES();
    }
};
struct EpiQkv {
    static constexpr bool PERM = true, AFTER_DRAIN = false;
    bf16* QKV; const float* rope; float* out; int li;
    __device__ __forceinline__ void operator()(const f32x4 (&acc)[2][2][4][2], const Unit& u, int wr, int wc, int fr, int fq) const {
        const int row0 = u.pm * 256 + wr * 64 + fr, colt = u.pn * 256, col0 = colt + wc * 32 + 8 * fq;
        const int grp = colt / 1536, s = (colt % 1536) / 512;
        const bool do_rope = (s < 2) && ((wc & 1) == 0);
        const int W = 128 << (2 * grp);
        float* wout = out + (grp == 0 ? O_W0P : grp == 1 ? O_W1P : O_W2P);
#pragma unroll
        for (int ai = 0; ai < 2; ++ai)
#pragma unroll
            for (int m = 0; m < 4; ++m) { const int row = row0 + ai * 128 + m * 16, t = row & 8191, b = row >> 13;
#pragma unroll
                for (int bj = 0; bj < 2; ++bj) { f32x4 v0 = acc[ai][bj][m][0], v1 = acc[ai][bj][m][1];
                    if (do_rope) {
                        f32x4 p0, p1;
#pragma unroll
                        for (int j = 0; j < 4; ++j) { p0[j] = __shfl_xor(v0[j], 16); p1[j] = __shfl_xor(v1[j], 16); }
                        if (fq < 2) { const f32x4 c0 = *(const f32x4*)(rope + t * 16), c1 = *(const f32x4*)(rope + t * 16 + 4), s0 = *(const f32x4*)(rope + t * 16 + 8), s1 = *(const f32x4*)(rope + t * 16 + 12);
                            if (fq == 0) { v0 = v0 * c0 - p0 * s0; v1 = v1 * c1 - p1 * s1; } else { v0 = v0 * c0 + p0 * s0; v1 = v1 * c1 + p1 * s1; } }
                    }
                    if (s == 0) { v0 *= 0.125f; v1 *= 0.125f; }
                    const int c = col0 + bj * 128;
                    u32x4 w; w.x = pk2(v0[0], v0[1]); w.y = pk2(v0[2], v0[3]); w.z = pk2(v1[0], v1[1]); w.w = pk2(v1[2], v1[3]); *(u32x4*)(QKV + (size_t)row * QKV_N + c) = w;
                    if (s >= 1 && t >= SEQ - W) { const int cc = c - grp * 1536 - s * 512; float* o = wout + ((size_t)(li * 2 + b) * W + (t - (SEQ - W))) * 1024 + (s - 1) * 512 + cc;
                        *(f32x4*)o = v0; *(f32x4*)(o + 4) = v1; }
                } }
    }
};

template <class F> __device__ __forceinline__ void small_gemm(const Ctx& C, const bf16* A, const bf16* Wt, int N, int K, F&& epi) {
    LAS float* red = (LAS float*)C.lds;
    const int kw = K / 8, steps = kw / 16;
    for (int u = C.G - 1 - (int)C.bid; u < N / 32; u += C.G) {
        const int n0 = 32 * u;
        f32x16 acc;
#pragma unroll
        for (int r = 0; r < 16; ++r) acc[r] = 0.f;
        const bf16* wp = Wt + (size_t)(n0 + (C.lane & 31)) * K + C.wave * kw + 8 * (C.lane >> 5);
        const bf16* ap = A + (size_t)(C.lane & 31) * K + C.wave * kw + 8 * (C.lane >> 5);
        for (int ks = 0; ks < steps; ++ks) { const bf16x8 wf = *(const bf16x8*)(wp + 16 * ks), af = *(const bf16x8*)(ap + 16 * ks); acc = __builtin_amdgcn_mfma_f32_32x32x16_bf16(wf, af, acc, 0, 0, 0); }
#pragma unroll
        for (int r = 0; r < 16; ++r) red[(C.wave * 16 + r) * 64 + C.lane] = acc[r];
        __syncthreads();
#pragma unroll
        for (int e2 = 0; e2 < 2; ++e2) { const int e = C.tid + e2 * NT, r = e >> 6, ln = e & 63; float s = 0.f;
#pragma unroll
            for (int w = 0; w < 8; ++w) s += red[(w * 16 + r) * 64 + ln];
            epi(ln & 31, n0 + (r & 3) + 8 * (r >> 2) + 4 * (ln >> 5), s); }
        __syncthreads();
    }
}

__device__ __forceinline__ void rwkv_prep_unit(const Ctx& C, int li, int tile) {
    const int t0 = tile * 64, tl0 = t0 & 8191, b = t0 >> 13, q = C.lane >> 4, fr = C.lane & 15;
    LAS bf16* TXW = (LAS bf16*)C.lds; LAS bf16* XA = TXW + 64 * 72; LAS bf16* SXG = XA + 64 * 72;
    const float* mu = INP(I_MU) + li * RWC;
    {
        const int i = C.tid >> 3, part = C.tid & 7; const bool first = (tl0 + i) == 0;
        const bf16* cur = WSP(bf16, WS_U) + (size_t)(t0 + i) * HYB_NP + U_RW + 3072 + part * 32;
#pragma unroll
        for (int e = 0; e < 4; ++e) { const u32x4 cv = *(const u32x4*)(cur + 8 * e); u32x4 pv = (u32x4){0u, 0u, 0u, 0u}; if (!first) pv = *(const u32x4*)(cur - HYB_NP + 8 * e);
            const float* mp = mu + 3072 + part * 32 + 8 * e; float o[8];
#pragma unroll
            for (int j = 0; j < 4; ++j) { const float c0 = bflo(cv[j]), c1 = bfhi(cv[j]), p0 = bflo(pv[j]), p1 = bfhi(pv[j]); o[2 * j] = c0 + (p0 - c0) * mp[2 * j]; o[2 * j + 1] = c1 + (p1 - c1) * mp[2 * j + 1]; }
            if (part < 2) {
#pragma unroll
                for (int j = 0; j < 8; ++j) o[j] = tanh_(o[j]);
                *(LAS u32x4*)(TXW + i * 72 + part * 32 + 8 * e) = (u32x4){pk2(o[0], o[1]), pk2(o[2], o[3]), pk2(o[4], o[5]), pk2(o[6], o[7])};
            } else if (part < 4) {
                *(LAS u32x4*)(XA + i * 72 + (part - 2) * 32 + 8 * e) = (u32x4){pk2(o[0], o[1]), pk2(o[2], o[3]), pk2(o[4], o[5]), pk2(o[6], o[7])};
            } else {
#pragma unroll
                for (int j = 0; j < 8; ++j) o[j] = sigm_(o[j]);
                *(LAS u32x4*)(SXG + i * 136 + (part - 4) * 32 + 8 * e) = (u32x4){pk2(o[0], o[1]), pk2(o[2], o[3]), pk2(o[4], o[5]), pk2(o[6], o[7])};
            } }
    }
    __syncthreads();
    const bf16* w2t = WSP(bf16, WS_LORA) + (size_t)li * 262144; const bf16* a2t = w2t + 65536; const bf16* g2t = w2t + 131072;
    const float* w0 = INP(I_RW0) + li * 1024; const float* a0 = INP(I_RA0) + li * 1024; const float* kkw = INP(I_KK) + li * 1024; const float* kaw = INP(I_KA) + li * 1024;
    bf16* G = WSP(bf16, WS_G);
    for (int hh = 0; hh < 2; ++hh) { const int h = 2 * C.wave + hh;
        for (int tm = 0; tm < 4; ++tm) {
            bf16x8 fw[2], fa[2], fg[4];
            const int trow = 16 * tm + fr;
#pragma unroll
            for (int ks = 0; ks < 2; ++ks) { fw[ks] = *(const LAS bf16x8*)(TXW + trow * 72 + ks * 32 + 8 * q); fa[ks] = *(const LAS bf16x8*)(XA + trow * 72 + ks * 32 + 8 * q); }
#pragma unroll
            for (int ks = 0; ks < 4; ++ks) fg[ks] = *(const LAS bf16x8*)(SXG + trow * 136 + ks * 32 + 8 * q);
            const int t = t0 + trow, tl = tl0 + trow; const bool first = tl == 0;
            const bf16* urow = WSP(bf16, WS_U) + (size_t)t * HYB_NP + U_RW;
            f32x4 kx[4]; float ssq = 0.f;
#pragma unroll
            for (int tn = 0; tn < 4; ++tn) { const int c = h * 64 + 16 * tn + 4 * q;
                const f32x4 ck = bf4(*(const u32x2*)(urow + 1024 + c)); f32x4 pk = (f32x4){0.f, 0.f, 0.f, 0.f};
                if (!first) pk = bf4(*(const u32x2*)(urow - HYB_NP + 1024 + c));
                kx[tn] = ck + (pk - ck) * *(const f32x4*)(mu + 1024 + c);
                const f32x4 kkv = kx[tn] * *(const f32x4*)(kkw + c);
                ssq += (kkv[0] * kkv[0] + kkv[1] * kkv[1]) + (kkv[2] * kkv[2] + kkv[3] * kkv[3]); }
            ssq += __shfl_xor(ssq, 16); ssq += __shfl_xor(ssq, 32);
            const float inv = 1.f / fmaxf(sqrtf(ssq), 1e-12f);
            unsigned char* rec = WSP(unsigned char, WS_REC) + ((size_t)(b * 16 + h) * SEQ + tl) * RECB;
#pragma unroll 1
            for (int tn = 0; tn < 4; ++tn) { const int c = h * 64 + 16 * tn + 4 * q, nrow = h * 64 + 16 * tn + fr;
                f32x4 xw = (f32x4){0.f, 0.f, 0.f, 0.f}, xa = xw, xg = xw;
#pragma unroll
                for (int ks = 0; ks < 2; ++ks) { xw = mfma16(*(const bf16x8*)(w2t + nrow * 64 + ks * 32 + 8 * q), fw[ks], xw); xa = mfma16(*(const bf16x8*)(a2t + nrow * 64 + ks * 32 + 8 * q), fa[ks], xa); }
#pragma unroll
                for (int ks = 0; ks < 4; ++ks) xg = mfma16(*(const bf16x8*)(g2t + nrow * 128 + ks * 32 + 8 * q), fg[ks], xg);
                const f32x4 cr = bf4(*(const u32x2*)(urow + c)), cv = bf4(*(const u32x2*)(urow + 2048 + c));
                f32x4 pr = (f32x4){0.f, 0.f, 0.f, 0.f}, pv = pr;
                if (!first) { pr = bf4(*(const u32x2*)(urow - HYB_NP + c)); pv = bf4(*(const u32x2*)(urow - HYB_NP + 2048 + c)); }
                const f32x4 rr = cr + (pr - cr) * *(const f32x4*)(mu + c), vv = cv + (pv - cv) * *(const f32x4*)(mu + 2048 + c);
                const f32x4 wl = *(const f32x4*)(w0 + c) + xw, al = *(const f32x4*)(a0 + c) + xa;
                f32x4 wd, av;
#pragma unroll
                for (int j = 0; j < 4; ++j) { const float wlog = -softplus_(-wl[j]) - 0.5f; wd[j] = __expf(-__expf(wlog)); av[j] = sigm_(al[j]); }
                const f32x4 kk4 = (tn == 0 ? kx[0] : tn == 1 ? kx[1] : tn == 2 ? kx[2] : kx[3]);
                const f32x4 kkn = kk4 * *(const f32x4*)(kkw + c) * inv; const f32x4 kp = kk4 * ((av - 1.f) * *(const f32x4*)(kaw + c) + 1.f);
                const int ce = 16 * tn + 4 * q;
                *(f32x4*)(rec + ce * 4) = wd; *(u32x2*)(rec + 256 + ce * 2) = pk4(rr); *(u32x2*)(rec + 384 + ce * 2) = pk4(kp); *(u32x2*)(rec + 512 + ce * 2) = pk4(vv); *(u32x2*)(rec + 640 + ce * 2) = pk4(-kkn); *(u32x2*)(rec + 768 + ce * 2) = pk4(kkn * av);
                *(u32x2*)(G + (size_t)t * 1024 + c) = pk4(xg); }
        }
    }
    if ((tile & 127) == 127) { float* o = (C.PP->out) + O_SHP + (size_t)(li * 2 + b) * RWC; const bf16* ur = WSP(bf16, WS_U) + (size_t)(t0 + 63) * HYB_NP + U_RW;
        for (int c = C.tid; c < RWC; c += NT) o[c] = bf1(ur[c]); }
    __syncthreads();
}

__device__ __forceinline__ void ssd_a_unit(const Ctx& C, int li, int u) {
    const int g = u & 1, c = (u >> 1) & 63, b = u >> 7, t0 = b * SEQ + c * 128, q = C.lane >> 4, fr = C.lane & 15;
    LAS float* SC = (LAS float*)C.lds;
    LAS bf16* BT = (LAS bf16*)(C.lds + 4096);
    LAS bf16* XTs = (LAS bf16*)(C.lds + 4096 + 34816);
    const float* DTr = WSP(float, WS_DT); float* DTS = WSP(float, WS_DTS); float* ACS = WSP(float, WS_ACS);
    bf16* XTg = WSP(bf16, WS_XT) + ((size_t)(b * 64 + c) * 1024) * 128; bf16* BCg = WSP(bf16, WS_BC); float* CS = WSP(float, WS_CS);
    {
        const int h = g * 8 + C.wave; const float bias = INP(I_DTB)[li * 16 + h], A = -__expf(INP(I_ALOG)[li * 16 + h]);
        const int l0 = 2 * C.lane; const float d0 = softplus_(DTr[(size_t)(t0 + l0) * 16 + h] + bias), d1 = softplus_(DTr[(size_t)(t0 + l0 + 1) * 16 + h] + bias);
        const float a0 = d0 * A, a1 = d1 * A; float s = a0 + a1;
#pragma unroll
        for (int o = 1; o < 64; o <<= 1) { const float n = __shfl_up(s, o); if (C.lane >= o) s += n; }
        const float acs1 = s, acs0 = s - a1, tot = __shfl(s, 63);
        DTS[(size_t)(t0 + l0) * 16 + h] = d0; DTS[(size_t)(t0 + l0 + 1) * 16 + h] = d1; ACS[(size_t)(t0 + l0) * 16 + h] = acs0; ACS[(size_t)(t0 + l0 + 1) * 16 + h] = acs1;
        SC[C.wave * 128 + l0] = __expf(tot - acs0) * d0; SC[C.wave * 128 + l0 + 1] = __expf(tot - acs1) * d1;
    }
    __syncthreads();
    const float* cw = INP(I_CONVW) + (size_t)li * 4 * 1536; const float* cb = INP(I_CONVB) + (size_t)li * 1536;
    for (int pass = 0; pass < 2; ++pass) {
        const int nitems = pass == 0 ? 16 : 8;
        for (int it = C.wave; it < nitems; it += 8) { const int tb = it & 7, cblk = pass == 0 ? (it >> 3) : 2;
            int ch;
            if (cblk == 0) ch = (C.lane < 32 ? 1024 + g * 128 + 4 * C.lane : 1280 + g * 128 + 4 * (C.lane - 32)); else ch = g * 512 + (cblk - 1) * 256 + 4 * C.lane;
            const int tl = c * 128 + tb * 16;
            const bf16* up = WSP(bf16, WS_U) + (size_t)(t0 + tb * 16) * HYB_NP + U_XBC + ch;
            f32x4 uu[19];
#pragma unroll
            for (int k = 0; k < 19; ++k) { uu[k] = (f32x4){0.f, 0.f, 0.f, 0.f}; if (tl + k - 3 >= 0) uu[k] = bf4(*(const u32x2*)(up + (ptrdiff_t)(k - 3) * HYB_NP)); }
            const f32x4 w0 = *(const f32x4*)(cw + ch), w1 = *(const f32x4*)(cw + 1536 + ch), w2 = *(const f32x4*)(cw + 3072 + ch), w3 = *(const f32x4*)(cw + 4608 + ch), bb = *(const f32x4*)(cb + ch);
            if (c == 63 && tb == 7) { float* o = (C.PP->out) + O_CONVP + (size_t)(li * 2 + b) * 3 * 1536 + ch; *(f32x4*)o = uu[16]; *(f32x4*)(o + 1536) = uu[17]; *(f32x4*)(o + 3072) = uu[18]; }
            f32x4 y[16];
#pragma unroll
            for (int k = 0; k < 16; ++k) { f32x4 v = bb + w0 * uu[k] + w1 * uu[k + 1] + w2 * uu[k + 2] + w3 * uu[k + 3];
#pragma unroll
                for (int j = 0; j < 4; ++j) v[j] = siluf_(v[j]);
                y[k] = v; }
            if (cblk == 0) {
                const bool isB = C.lane < 32; const int n = 4 * (C.lane & 31);
#pragma unroll
                for (int k = 0; k < 16; ++k) *(u32x2*)(BCg + (size_t)(t0 + tb * 16 + k) * 512 + (isB ? 0 : 256) + g * 128 + n) = pk4(y[k]);
                if (isB) {
#pragma unroll
                    for (int j = 0; j < 4; ++j) { u32x4 lo, hi;
                        lo.x = pk2(y[0][j], y[1][j]); lo.y = pk2(y[2][j], y[3][j]); lo.z = pk2(y[4][j], y[5][j]); lo.w = pk2(y[6][j], y[7][j]);
                        hi.x = pk2(y[8][j], y[9][j]); hi.y = pk2(y[10][j], y[11][j]); hi.z = pk2(y[12][j], y[13][j]); hi.w = pk2(y[14][j], y[15][j]);
                        *(LAS u32x4*)(BT + (n + j) * 136 + tb * 16) = lo; *(LAS u32x4*)(BT + (n + j) * 136 + tb * 16 + 8) = hi; } }
            } else {
                const int xc = (cblk - 1) * 256 + 4 * C.lane;
                const int hl = xc >> 6;
                const int xl = (pass == 0 ? xc : xc - 256);
                float sc[16];
#pragma unroll
                for (int k = 0; k < 16; ++k) sc[k] = SC[hl * 128 + tb * 16 + k];
#pragma unroll
                for (int j = 0; j < 4; ++j) { u32x4 lo, hi;
                    lo.x = pk2(y[0][j], y[1][j]); lo.y = pk2(y[2][j], y[3][j]); lo.z = pk2(y[4][j], y[5][j]); lo.w = pk2(y[6][j], y[7][j]);
                    hi.x = pk2(y[8][j], y[9][j]); hi.y = pk2(y[10][j], y[11][j]); hi.z = pk2(y[12][j], y[13][j]); hi.w = pk2(y[14][j], y[15][j]);
                    bf16* gp = XTg + (size_t)(g * 512 + xc + j) * 128 + tb * 16; *(u32x4*)gp = lo; *(u32x4*)(gp + 8) = hi;
                    lo.x = pk2(y[0][j] * sc[0], y[1][j] * sc[1]); lo.y = pk2(y[2][j] * sc[2], y[3][j] * sc[3]); lo.z = pk2(y[4][j] * sc[4], y[5][j] * sc[5]); lo.w = pk2(y[6][j] * sc[6], y[7][j] * sc[7]);
                    hi.x = pk2(y[8][j] * sc[8], y[9][j] * sc[9]); hi.y = pk2(y[10][j] * sc[10], y[11][j] * sc[11]); hi.z = pk2(y[12][j] * sc[12], y[13][j] * sc[13]); hi.w = pk2(y[14][j] * sc[14], y[15][j] * sc[15]);
                    *(LAS u32x4*)(XTs + (xl + j) * 136 + tb * 16) = lo; *(LAS u32x4*)(XTs + (xl + j) * 136 + tb * 16 + 8) = hi; }
            }
        }
        __syncthreads();
        { const int hl = C.wave >> 1, h = g * 8 + pass * 4 + hl;
          float* csp = CS + (((size_t)(b * 64 + c) * 16 + h) * 64) * 128;
#pragma unroll
          for (int tmi = 0; tmi < 2; ++tmi) { const int tm = (C.wave & 1) * 2 + tmi; bf16x8 xf[4];
#pragma unroll
              for (int ks = 0; ks < 4; ++ks) xf[ks] = *(const LAS bf16x8*)(XTs + (hl * 64 + 16 * tm + fr) * 136 + ks * 32 + 8 * q);
#pragma unroll
              for (int tn = 0; tn < 8; ++tn) { f32x4 acc = (f32x4){0.f, 0.f, 0.f, 0.f};
#pragma unroll
                  for (int ks = 0; ks < 4; ++ks) acc = mfma16(*(const LAS bf16x8*)(BT + (16 * tn + fr) * 136 + ks * 32 + 8 * q), xf[ks], acc);
                  *(f32x4*)(csp + (size_t)(16 * tm + fr) * 128 + 16 * tn + 4 * q) = acc; } }
        }
        __syncthreads();
    }
}

__device__ __forceinline__ void rwkv_scan_unit(const Ctx& C, int unit) {
    const int bh = unit >> 3, c = (unit & 7) * 8 + C.wave, lane = C.lane;
    const unsigned char* rec = WSP(unsigned char, WS_REC) + ((size_t)bh * SEQ + c * 128) * RECB;
    unsigned* qo = WSP(unsigned, WS_QO) + ((size_t)bh * SEQ + c * 128) * 64;
    LAS float* buf = (LAS float*)(C.lds + C.wave * 12288);
    f32x2 Sl[32], Pm[32];
    int lopq = lane; asm volatile("" : "+v"(lopq));
#pragma unroll
    for (int j = 0; j < 32; ++j) { Sl[j] = (f32x2){0.f, 0.f}; Pm[j] = (f32x2){(2 * j == lopq) ? 1.f : 0.f, (2 * j + 1 == lopq) ? 1.f : 0.f}; }
    LAS unsigned char* raw = C.lds + 98304 + C.wave * 3584;
#define RW_LOAD(sbi) do { const unsigned char* _p = rec + (size_t)(sbi) * 3584; \
        __builtin_amdgcn_global_load_lds((const unsigned*)(_p + lane * 16), (LAS unsigned*)raw, 16, 0, 0); __builtin_amdgcn_global_load_lds((const unsigned*)(_p + 1024 + lane * 16), (LAS unsigned*)(raw + 1024), 16, 0, 0); \
        __builtin_amdgcn_global_load_lds((const unsigned*)(_p + 2048 + lane * 16), (LAS unsigned*)(raw + 2048), 16, 0, 0); if (lane < 32) __builtin_amdgcn_global_load_lds((const unsigned*)(_p + 3072 + lane * 16), (LAS unsigned*)(raw + 3072), 16, 0, 0); } while (0)
#define RW_PUT16(dst, o, v4) do { const int _s = (o) / RECB, _f = (o) - _s * RECB; LAS float* _d = (dst) + _s * 384; \
        if (_f < 256) { *(LAS f32x4*)(_d + 64 + (_f >> 2)) = __builtin_bit_cast(f32x4, v4); } \
        else { const int _e = (_f - 256) >> 1, _v = _e >> 6, _i = _e & 63; LAS float* _q = _d + (_v == 0 ? 0 : 64 + 64 * _v) + _i; \
               *(LAS f32x4*)_q = (f32x4){bflo((v4)[0]), bfhi((v4)[0]), bflo((v4)[1]), bfhi((v4)[1])}; *(LAS f32x4*)(_q + 4) = (f32x4){bflo((v4)[2]), bfhi((v4)[2]), bflo((v4)[3]), bfhi((v4)[3])}; } } while (0)
#define RW_STORE(dst) do { asm volatile("s_waitcnt vmcnt(0)" ::: "memory"); { const u32x4 _a = *(const LAS u32x4*)(raw + lane * 16); RW_PUT16(dst, lane * 16, _a); } { const u32x4 _a = *(const LAS u32x4*)(raw + 1024 + lane * 16); RW_PUT16(dst, 1024 + lane * 16, _a); } \
        { const u32x4 _a = *(const LAS u32x4*)(raw + 2048 + lane * 16); RW_PUT16(dst, 2048 + lane * 16, _a); } if (lane < 32) { const u32x4 _a = *(const LAS u32x4*)(raw + 3072 + lane * 16); RW_PUT16(dst, 3072 + lane * 16, _a); } \
        asm volatile("s_waitcnt lgkmcnt(0)" ::: "memory"); } while (0)
    RW_LOAD(0); RW_STORE(buf); RW_LOAD(1);
    float sa_s = 0.f, sa_p = buf[256 + lane];
    for (int sb = 0; sb < 32; ++sb) {
        LAS float* cb = buf + (sb & 1) * 1536; LAS float* nb = buf + ((sb + 1) & 1) * 1536;
        if (sb + 1 < 32) RW_STORE(nb);
        if (sb + 2 < 32) RW_LOAD(sb + 2);
        for (int st = 0; st < 4; ++st) {
            const LAS float* v = cb + st * 384; const LAS float* nx = (st < 3) ? v + 384 : nb;
            const float vv = v[192 + lane];
            const f32x2 vv2 = (f32x2){vv, vv}, sas = (f32x2){sa_s, sa_s}, sap = (f32x2){sa_p, sa_p};
            f32x2 o2a = (f32x2){0.f, 0.f}, o2b = o2a, q2a = o2a, q2b = o2a, ns2a = o2a, ns2b = o2a, np2a = o2a, np2b = o2a;
            f32x4 r4 = *(const LAS f32x4*)(v), w4 = *(const LAS f32x4*)(v + 64), k4 = *(const LAS f32x4*)(v + 128), b4 = *(const LAS f32x4*)(v + 320), n4 = *(const LAS f32x4*)(nx + 256);
#pragma unroll
            for (int j = 0; j < 16; ++j) {
                f32x4 r4n = r4, w4n = w4, k4n = k4, b4n = b4, n4n = n4;
                if (j < 15) { r4n = *(const LAS f32x4*)(v + 4 * j + 4); w4n = *(const LAS f32x4*)(v + 64 + 4 * j + 4); k4n = *(const LAS f32x4*)(v + 128 + 4 * j + 4); b4n = *(const LAS f32x4*)(v + 320 + 4 * j + 4); n4n = *(const LAS f32x4*)(nx + 256 + 4 * j + 4); }
                {   const f32x2 r2 = (f32x2){r4[0], r4[1]}, w2 = (f32x2){w4[0], w4[1]}, k2 = (f32x2){k4[0], k4[1]}, b2 = (f32x2){b4[0], b4[1]}, n2 = (f32x2){n4[0], n4[1]};
                    f32x2 t = vv2 * k2; t = sas * b2 + t; Sl[2 * j] = Sl[2 * j] * w2 + t; o2a = Sl[2 * j] * r2 + o2a; ns2a = Sl[2 * j] * n2 + ns2a;
                    f32x2 tp = sap * b2; Pm[2 * j] = Pm[2 * j] * w2 + tp; q2a = Pm[2 * j] * r2 + q2a; np2a = Pm[2 * j] * n2 + np2a; }
                {   const f32x2 r2 = (f32x2){r4[2], r4[3]}, w2 = (f32x2){w4[2], w4[3]}, k2 = (f32x2){k4[2], k4[3]}, b2 = (f32x2){b4[2], b4[3]}, n2 = (f32x2){n4[2], n4[3]};
                    f32x2 t = vv2 * k2; t = sas * b2 + t; Sl[2 * j + 1] = Sl[2 * j + 1] * w2 + t; o2b = Sl[2 * j + 1] * r2 + o2b; ns2b = Sl[2 * j + 1] * n2 + ns2b;
                    f32x2 tp = sap * b2; Pm[2 * j + 1] = Pm[2 * j + 1] * w2 + tp; q2b = Pm[2 * j + 1] * r2 + q2b; np2b = Pm[2 * j + 1] * n2 + np2b; }
                r4 = r4n; w4 = w4n; k4 = k4n; b4 = b4n; n4 = n4n;
                __builtin_amdgcn_sched_barrier(0);
            }
            const f32x2 o2 = o2a + o2b, q2 = q2a + q2b, ns2 = ns2a + ns2b, np2 = np2a + np2b;
            qo[(size_t)(sb * 4 + st) * 64 + lane] = pk2(o2[0] + o2[1], q2[0] + q2[1]);
            sa_s = ns2[0] + ns2[1]; sa_p = np2[0] + np2[1];
        }
    }
    float* sl = WSP(float, WS_SL) + ((size_t)(bh * 64 + c) * 2) * 4096 + lane * 64;
#pragma unroll
    for (int j = 0; j < 16; ++j) { *(f32x4*)(sl + 4 * j) = (f32x4){Sl[2 * j][0], Sl[2 * j][1], Sl[2 * j + 1][0], Sl[2 * j + 1][1]}; *(f32x4*)(sl + 4096 + 4 * j) = (f32x4){Pm[2 * j][0], Pm[2 * j][1], Pm[2 * j + 1][0], Pm[2 * j + 1][1]}; }
}

__device__ __forceinline__ void ssd_scan_phase(const Ctx& C, int li) {
    const int gt = C.bid * NT + C.tid;
    if (gt >= 131072) return;
    const int n2 = gt & 63, p = (gt >> 6) & 63, h = (gt >> 12) & 15, b = gt >> 16;
    float* CS = WSP(float, WS_CS); const float* ACS = WSP(float, WS_ACS);
    f32x2 S = (f32x2){0.f, 0.f};
#pragma unroll 4
    for (int c = 0; c < 64; ++c) { float* ptr = CS + (((size_t)(b * 64 + c) * 16 + h) * 64 + p) * 128 + 2 * n2; const f32x2 v = *(const f32x2*)ptr; *(f32x2*)ptr = S;
        const float dec = __expf(ACS[(size_t)(b * SEQ + c * 128 + 127) * 16 + h]); S = S * dec + v; }
    *(f32x2*)((C.PP->out) + O_SSDP + ((size_t)((li * 2 + b) * 16 + h) * 64 + p) * 128 + 2 * n2) = S;
}

__device__ __forceinline__ void rwkv_combine_unit(const Ctx& C, int li, int bh) {
    LAS float* Ss = (LAS float*)C.lds;
    LAS float* Ps = Ss + 64 * 68;
    const int q = C.lane >> 4, fr = C.lane & 15, tm = C.wave >> 1, tnb = (C.wave & 1) * 2;
    const float* SL = WSP(float, WS_SL) + (size_t)bh * 64 * 2 * 4096; float* SST = WSP(float, WS_SST) + (size_t)bh * 64 * 4096;
    for (int e = C.tid; e < 64 * 68; e += NT) Ss[e] = 0.f;
    const int r0 = C.tid >> 4, c4 = (C.tid & 15) * 4;
    f32x4 pn0 = *(const f32x4*)(SL + 4096 + r0 * 64 + c4), pn1 = *(const f32x4*)(SL + 4096 + (r0 + 32) * 64 + c4);
    f32x4 ln[2];
#pragma unroll
    for (int t2 = 0; t2 < 2; ++t2)
#pragma unroll
        for (int r = 0; r < 4; ++r) ln[t2][r] = SL[(16 * tm + 4 * q + r) * 64 + 16 * (tnb + t2) + fr];
    __syncthreads();
    for (int c = 0; c < 64; ++c) {
        *(LAS f32x4*)(Ps + r0 * 72 + c4) = pn0; *(LAS f32x4*)(Ps + (r0 + 32) * 72 + c4) = pn1;
        f32x4 acc[2] = {ln[0], ln[1]};
        if (c + 1 < 64) { const float* Ln = SL + (size_t)(c + 1) * 8192; pn0 = *(const f32x4*)(Ln + 4096 + r0 * 64 + c4); pn1 = *(const f32x4*)(Ln + 4096 + (r0 + 32) * 64 + c4);
#pragma unroll
            for (int t2 = 0; t2 < 2; ++t2)
#pragma unroll
                for (int r = 0; r < 4; ++r) ln[t2][r] = Ln[(16 * tm + 4 * q + r) * 64 + 16 * (tnb + t2) + fr]; }
        LDS_BARRIER();
        *(f32x4*)(SST + (size_t)c * 4096 + r0 * 64 + c4) = *(const LAS f32x4*)(Ss + r0 * 68 + c4); *(f32x4*)(SST + (size_t)c * 4096 + (r0 + 32) * 64 + c4) = *(const LAS f32x4*)(Ss + (r0 + 32) * 68 + c4);
        { float av[16], bv[2][16];
#pragma unroll
          for (int k = 0; k < 16; ++k) { av[k] = Ss[(16 * tm + fr) * 68 + 4 * k + q]; bv[0][k] = Ps[(4 * k + q) * 72 + 16 * tnb + fr]; bv[1][k] = Ps[(4 * k + q) * 72 + 16 * (tnb + 1) + fr]; }
#pragma unroll
          for (int k = 0; k < 16; ++k) { acc[0] = __builtin_amdgcn_mfma_f32_16x16x4f32(av[k], bv[0][k], acc[0], 0, 0, 0); acc[1] = __builtin_amdgcn_mfma_f32_16x16x4f32(av[k], bv[1][k], acc[1], 0, 0, 0); } }
        LDS_BARRIER();
#pragma unroll
        for (int t2 = 0; t2 < 2; ++t2)
#pragma unroll
            for (int r = 0; r < 4; ++r) Ss[(16 * tm + 4 * q + r) * 68 + 16 * (tnb + t2) + fr] = acc[t2][r];
        LDS_BARRIER();
    }
    float* o = (C.PP->out) + O_WKVP + (size_t)(li * 32 + bh) * 4096;
    *(f32x4*)(o + r0 * 64 + c4) = *(const LAS f32x4*)(Ss + r0 * 68 + c4); *(f32x4*)(o + (r0 + 32) * 64 + c4) = *(const LAS f32x4*)(Ss + (r0 + 32) * 68 + c4);
    __syncthreads();
}

__device__ __forceinline__ void ssd_c_unit(const Ctx& C, int li, int u) {
    const int g = u & 1, c = (u >> 1) & 63, b = u >> 7, t0 = b * SEQ + c * 128, q = C.lane >> 4, fr = C.lane & 15, w = C.wave;
    LAS bf16* Cb = (LAS bf16*)C.lds;
    LAS bf16* Bb = Cb + 128 * 136;
    LAS bf16* XTh = Bb; LAS bf16* SINh = Bb + 64 * 136;
    LAS bf16* Mw = Bb + 128 * 136 + w * (16 * 136);
    LAS float* AD = (LAS float*)(Bb + 128 * 136 + 8 * 16 * 136);
    const bf16* BCg = WSP(bf16, WS_BC); const float* DTS = WSP(float, WS_DTS); const float* ACS = WSP(float, WS_ACS);
    const bf16* XTg = WSP(bf16, WS_XT) + ((size_t)(b * 64 + c) * 1024 + g * 512) * 128; const float* CS = WSP(float, WS_CS) + ((size_t)(b * 64 + c) * 16 + g * 8) * 8192;
    bf16* Y = WSP(bf16, WS_YCAT);
    for (int e = C.tid; e < 4096; e += NT) { const int r = e >> 5, cc = e & 31, isC = cc >> 4, c8 = (cc & 15) * 8;
        const u32x4 v = *(const u32x4*)(BCg + (size_t)(t0 + r) * 512 + (isC ? 256 : 0) + g * 128 + c8); *(LAS u32x4*)((isC ? Cb : Bb) + r * 136 + c8) = v; }
    __syncthreads();
    f32x4 cbv[8]; bf16x8 cf[4];
#pragma unroll
    for (int ks = 0; ks < 4; ++ks) cf[ks] = *(const LAS bf16x8*)(Cb + (16 * w + fr) * 136 + ks * 32 + 8 * q);
#pragma unroll
    for (int tn = 0; tn < 8; ++tn) { cbv[tn] = (f32x4){0.f, 0.f, 0.f, 0.f};
        if (tn <= w) {
#pragma unroll
            for (int ks = 0; ks < 4; ++ks) cbv[tn] = mfma16(*(const LAS bf16x8*)(Bb + (16 * tn + fr) * 136 + ks * 32 + 8 * q), cf[ks], cbv[tn]); } }
    __syncthreads();
    float ssq = 0.f;
    const int l = 16 * w + fr;
    bf16* yrow = Y + (size_t)(t0 + l) * 2048 + g * 512;
    const int r0 = C.tid >> 4, c8 = (C.tid & 15) * 8;
    u32x4 xq0, xq1; f32x4 sq0, sq1, sq2, sq3; float adq = 0.f;
#define SC_LOAD(hh_) do { const bf16* _x = XTg + (size_t)((hh_) * 64 + r0) * 128 + c8; xq0 = *(const u32x4*)_x; xq1 = *(const u32x4*)(_x + 32 * 128); \
        const float* _s = CS + (size_t)(hh_) * 8192 + r0 * 128 + c8; sq0 = *(const f32x4*)_s; sq1 = *(const f32x4*)(_s + 4); sq2 = *(const f32x4*)(_s + 32 * 128); sq3 = *(const f32x4*)(_s + 32 * 128 + 4); \
        if (C.tid < 256) adq = (C.tid < 128 ? ACS : DTS)[(size_t)(t0 + (C.tid & 127)) * 16 + g * 8 + (hh_)]; } while (0)
    SC_LOAD(0);
#pragma unroll 1
    for (int hh = 0; hh < 8; ++hh) { const int h = g * 8 + hh;
        *(LAS u32x4*)(XTh + r0 * 136 + c8) = xq0; *(LAS u32x4*)(XTh + (r0 + 32) * 136 + c8) = xq1;
        *(LAS u32x4*)(SINh + r0 * 136 + c8) = (u32x4){pk2(sq0[0], sq0[1]), pk2(sq0[2], sq0[3]), pk2(sq1[0], sq1[1]), pk2(sq1[2], sq1[3])};
        *(LAS u32x4*)(SINh + (r0 + 32) * 136 + c8) = (u32x4){pk2(sq2[0], sq2[1]), pk2(sq2[2], sq2[3]), pk2(sq3[0], sq3[1]), pk2(sq3[2], sq3[3])};
        if (C.tid < 256) AD[C.tid] = adq;
        u32x2 zq[4];
#pragma unroll
        for (int tp = 0; tp < 4; ++tp) zq[tp] = *(const u32x2*)(WSP(bf16, WS_U) + (size_t)(t0 + l) * HYB_NP + h * 64 + 16 * tp + 4 * q);
        if (hh + 1 < 8) SC_LOAD(hh + 1);
        LDS_BARRIER();
        const float acl = AD[l];
#pragma unroll
        for (int tn = 0; tn < 8; ++tn) { f32x4 mv = (f32x4){0.f, 0.f, 0.f, 0.f};
            if (tn <= w) { const f32x4 as = *(const LAS f32x4*)(AD + 16 * tn + 4 * q), ds = *(const LAS f32x4*)(AD + 128 + 16 * tn + 4 * q);
#pragma unroll
                for (int j = 0; j < 4; ++j) { const int s = 16 * tn + 4 * q + j; mv[j] = (s <= l) ? cbv[tn][j] * __expf(acl - as[j]) * ds[j] : 0.f; } }
            *(LAS u32x2*)(Mw + fr * 136 + 16 * tn + 4 * q) = pk4(mv); }
        LDSW();
        const float eal = __expf(acl), Dh = INP(I_SSDD)[li * 16 + h];
        const int nks = (w + 2) >> 1;
#pragma unroll
        for (int tp = 0; tp < 4; ++tp) { f32x4 a1 = (f32x4){0.f, 0.f, 0.f, 0.f}, a2 = a1;
            for (int ks = 0; ks < nks; ++ks) a1 = mfma16(*(const LAS bf16x8*)(XTh + (16 * tp + fr) * 136 + ks * 32 + 8 * q), *(const LAS bf16x8*)(Mw + fr * 136 + ks * 32 + 8 * q), a1);
#pragma unroll
            for (int ks = 0; ks < 4; ++ks) a2 = mfma16(*(const LAS bf16x8*)(SINh + (16 * tp + fr) * 136 + ks * 32 + 8 * q), cf[ks], a2);
            const int p0 = 16 * tp + 4 * q;
            const f32x4 z = bf4(zq[tp]);
            f32x4 y;
#pragma unroll
            for (int j = 0; j < 4; ++j) { const float xv = bf1(XTh[(p0 + j) * 136 + l]); y[j] = (a1[j] + eal * a2[j] + Dh * xv) * siluf_(z[j]); }
            const u32x2 yp = pk4(y); const f32x4 yr = bf4(yp); ssq += (yr[0] * yr[0] + yr[1] * yr[1]) + (yr[2] * yr[2] + yr[3] * yr[3]);
            *(u32x2*)(yrow + hh * 64 + p0) = yp; }
        LDS_BARRIER();
    }
#undef SC_LOAD
    ssq += __shfl_xor(ssq, 16); ssq += __shfl_xor(ssq, 32);
    const float rinv = rsqrtf(ssq * (1.f / 512.f) + EPS);
    const float* nw = INP(I_SNW) + li * 1024 + g * 512;
    asm volatile("s_waitcnt vmcnt(0)" ::: "memory");
#pragma unroll 1
    for (int hb = 0; hb < 2; ++hb) { u32x2 yv[16];
#pragma unroll
        for (int k = 0; k < 16; ++k) yv[k] = *(const u32x2*)(yrow + hb * 256 + 16 * k + 4 * q);
#pragma unroll
        for (int k = 0; k < 16; ++k) { const int cc = hb * 256 + 16 * k + 4 * q; *(u32x2*)(yrow + cc) = pk4(bf4(yv[k]) * rinv * *(const f32x4*)(nw + cc)); } }
}

__device__ __forceinline__ void rwkv_out_unit(const Ctx& C, int li, int u) {
    const int c = u & 63, bh = u >> 6, h = bh & 15, b = bh >> 4, t0 = b * SEQ + c * 128, q = C.lane >> 4, fr = C.lane & 15, w = C.wave;
    LAS bf16* Qb = (LAS bf16*)C.lds;
    LAS bf16* Sb = Qb + 128 * 72;
    const unsigned* qo = WSP(unsigned, WS_QO) + ((size_t)bh * SEQ + c * 128) * 64; const float* sst = WSP(float, WS_SST) + (size_t)(bh * 64 + c) * 4096;
    const unsigned char* rec = WSP(unsigned char, WS_REC) + ((size_t)bh * SEQ + c * 128) * RECB;
    for (int e = C.tid; e < 2048; e += NT) { const int r = e >> 4, c4 = (e & 15) * 4; const u32x4 v = *(const u32x4*)(qo + (size_t)r * 64 + c4);
        u32x2 w; w.x = (v[0] >> 16) | (v[1] & 0xffff0000u); w.y = (v[2] >> 16) | (v[3] & 0xffff0000u); *(LAS u32x2*)(Qb + r * 72 + c4) = w; }
    for (int e = C.tid; e < 1024; e += NT) { const int r = e >> 4, c4 = (e & 15) * 4; *(LAS u32x2*)(Sb + r * 72 + c4) = pk4(*(const f32x4*)(sst + r * 64 + c4)); }
    __syncthreads();
    const int tr = 16 * w + fr;
    bf16x8 qf[2];
#pragma unroll
    for (int ks = 0; ks < 2; ++ks) qf[ks] = *(const LAS bf16x8*)(Qb + tr * 72 + ks * 32 + 8 * q);
    f32x4 o[4]; float sum = 0.f, rk = 0.f;
    const unsigned char* rp = rec + (size_t)tr * RECB;
    const float* rkw = INP(I_RK) + li * 1024 + h * 64;
#pragma unroll
    for (int tn = 0; tn < 4; ++tn) { const u32x4 ov = *(const u32x4*)(qo + (size_t)tr * 64 + 16 * tn + 4 * q); f32x4 a = (f32x4){bflo(ov[0]), bflo(ov[1]), bflo(ov[2]), bflo(ov[3])};
#pragma unroll
        for (int ks = 0; ks < 2; ++ks) a = mfma16(*(const LAS bf16x8*)(Sb + (16 * tn + fr) * 72 + ks * 32 + 8 * q), qf[ks], a);
        o[tn] = a; sum += (a[0] + a[1]) + (a[2] + a[3]);
        const f32x4 r4 = bf4(*(const u32x2*)(rp + 256 + (16 * tn + 4 * q) * 2)), k4 = bf4(*(const u32x2*)(rp + 384 + (16 * tn + 4 * q) * 2)), w4 = *(const f32x4*)(rkw + 16 * tn + 4 * q);
        rk += (r4[0] * k4[0] * w4[0] + r4[1] * k4[1] * w4[1]) + (r4[2] * k4[2] * w4[2] + r4[3] * k4[3] * w4[3]); }
    sum += __shfl_xor(sum, 16); sum += __shfl_xor(sum, 32); rk += __shfl_xor(rk, 16); rk += __shfl_xor(rk, 32);
    const float mean = sum * (1.f / 64.f); float var = 0.f;
#pragma unroll
    for (int tn = 0; tn < 4; ++tn) { const f32x4 d = o[tn] - mean; var += (d[0] * d[0] + d[1] * d[1]) + (d[2] * d[2] + d[3] * d[3]); }
    var += __shfl_xor(var, 16); var += __shfl_xor(var, 32);
    const float rstd = rsqrtf(var * (1.f / 64.f) + LN_EPS);
    const float* lw = INP(I_LNW) + li * 1024 + h * 64; const float* lb = INP(I_LNB) + li * 1024 + h * 64;
    const bf16* G = WSP(bf16, WS_G) + (size_t)(t0 + tr) * 1024 + h * 64; bf16* Y = WSP(bf16, WS_YCAT) + (size_t)(t0 + tr) * 2048 + 1024 + h * 64;
#pragma unroll
    for (int tn = 0; tn < 4; ++tn) { const int cc = 16 * tn + 4 * q; const f32x4 vv = bf4(*(const u32x2*)(rp + 512 + cc * 2)), gg = bf4(*(const u32x2*)(G + cc));
        const f32x4 y = ((o[tn] - mean) * rstd * *(const f32x4*)(lw + cc) + *(const f32x4*)(lb + cc) + vv * rk) * gg; *(u32x2*)(Y + cc) = pk4(y); }
    __syncthreads();
}

__device__ __forceinline__ void attn_tile_unit(const Ctx& C, int u) {
    const int g = u >> 10, r = u & 1023, b = r >> 9, h = (r >> 6) & 7, qt = r & 63, q = C.lane >> 4, fr = C.lane & 15, w = C.wave;
    const int dsh = 2 * g, tpr = 64 >> dsh, rho = qt / tpr, i0 = (qt % tpr) * 128;
    LAS bf16* Qs = (LAS bf16*)C.lds;
    LAS bf16* Ks = Qs + 128 * 72;
    LAS bf16* VT = Ks + 256 * 72;
    const bf16* QKV = WSP(bf16, WS_QKV) + (size_t)b * SEQ * QKV_N + g * 1536 + h * 64;
    for (int e = C.tid; e < 1024; e += NT) { const int rr = e >> 3, c8 = (e & 7) * 8; const int t = rho + ((i0 + rr) << dsh); *(LAS u32x4*)(Qs + rr * 72 + c8) = *(const u32x4*)(QKV + (size_t)t * QKV_N + c8); }
    for (int e = C.tid; e < 2048; e += NT) { const int kk = e >> 3, c8 = (e & 7) * 8; const int idx = i0 - 128 + kk; u32x4 kv = (u32x4){0u, 0u, 0u, 0u}, vv = kv;
        if (idx >= 0) { const bf16* p = QKV + (size_t)(rho + (idx << dsh)) * QKV_N + c8; kv = *(const u32x4*)(p + 512); vv = *(const u32x4*)(p + 1024); }
        *(LAS u32x4*)(Ks + kk * 72 + c8) = kv;
#pragma unroll
        for (int j = 0; j < 4; ++j) { VT[(c8 + 2 * j) * 264 + kk] = (bf16)(vv[j] & 0xffffu); VT[(c8 + 2 * j + 1) * 264 + kk] = (bf16)(vv[j] >> 16); } }
    __syncthreads();
    bf16x8 qf[2];
#pragma unroll
    for (int ks = 0; ks < 2; ++ks) qf[ks] = *(const LAS bf16x8*)(Qs + (16 * w + fr) * 72 + ks * 32 + 8 * q);
    const int ql = 16 * w + fr, kmin = (i0 == 0) ? 128 : 0;
    f32x4 s[10]; float mx = -3.0e38f;
#pragma unroll
    for (int kt = 0; kt < 10; ++kt) { s[kt] = (f32x4){0.f, 0.f, 0.f, 0.f};
        if (kt < 9) {
#pragma unroll
            for (int ks = 0; ks < 2; ++ks) s[kt] = mfma16(*(const LAS bf16x8*)(Ks + (16 * (w + kt) + fr) * 72 + ks * 32 + 8 * q), qf[ks], s[kt]); }
#pragma unroll
        for (int j = 0; j < 4; ++j) { const int kk = 16 * (w + kt) + 4 * q + j; const bool ok = (kt < 9) && kk >= ql && kk <= ql + 128 && kk >= kmin; s[kt][j] = ok ? s[kt][j] : -3.0e38f; mx = fmaxf(mx, s[kt][j]); } }
    mx = fmaxf(mx, __shfl_xor(mx, 16)); mx = fmaxf(mx, __shfl_xor(mx, 32));
    float lsum = 0.f;
#pragma unroll
    for (int kt = 0; kt < 10; ++kt)
#pragma unroll
        for (int j = 0; j < 4; ++j) { const float p = (s[kt][j] > -1.0e38f) ? __expf(s[kt][j] - mx) : 0.f; s[kt][j] = p; lsum += p; }
    lsum += __shfl_xor(lsum, 16); lsum += __shfl_xor(lsum, 32);
    f32x4 od[4];
#pragma unroll
    for (int tn = 0; tn < 4; ++tn) od[tn] = (f32x4){0.f, 0.f, 0.f, 0.f};
#pragma unroll
    for (int pr = 0; pr < 5; ++pr) { const int ta = w + 2 * pr, tb = (w + 2 * pr + 1 > 15) ? 15 : (w + 2 * pr + 1);
        const u32x2 pa = pk4(s[2 * pr]), pb = pk4(s[2 * pr + 1]); const u32x4 pw = (u32x4){pa.x, pa.y, pb.x, pb.y}; const bf16x8 pf = __builtin_bit_cast(bf16x8, pw);
#pragma unroll
        for (int tn = 0; tn < 4; ++tn) { const LAS bf16* vp = VT + (16 * tn + fr) * 264 + 4 * q; const u32x2 va = *(const LAS u32x2*)(vp + 16 * ta), vb = *(const LAS u32x2*)(vp + 16 * tb);
            const u32x4 vw = (u32x4){va.x, va.y, vb.x, vb.y}; od[tn] = mfma16(__builtin_bit_cast(bf16x8, vw), pf, od[tn]); } }
    const float il = 1.f / lsum; const int t = b * SEQ + rho + ((i0 + ql) << dsh);
    bf16* og = WSP(bf16, WS_OG) + ((size_t)g * T + t) * 512 + h * 64;
#pragma unroll
    for (int tn = 0; tn < 4; ++tn) *(u32x2*)(og + 16 * tn + 4 * q) = pk4(od[tn] * il);
    if (q == 0) WSP(float, WS_LSE)[((size_t)g * T + t) * 8 + h] = mx + __logf(lsum);
    __syncthreads();
}

__device__ __forceinline__ void attn_merge_phase(const Ctx& C) {
    const bf16* OG = WSP(bf16, WS_OG); const float* LSE = WSP(float, WS_LSE); bf16* AO = WSP(bf16, WS_AO);
    for (size_t e = (size_t)C.bid * NT + C.tid; e < (size_t)T * 64; e += (size_t)C.G * NT) { const size_t t = e >> 6; const int c8 = (int)(e & 63) * 8, h = c8 >> 6;
        const float l0 = LSE[t * 8 + h], l1 = LSE[((size_t)T + t) * 8 + h], l2 = LSE[((size_t)2 * T + t) * 8 + h]; const float m = fmaxf(l0, fmaxf(l1, l2));
        float a0 = __expf(l0 - m), a1 = __expf(l1 - m), a2 = __expf(l2 - m); const float inv = 1.f / (a0 + a1 + a2); a0 *= inv; a1 *= inv; a2 *= inv;
        const u32x4 v0 = *(const u32x4*)(OG + t * 512 + c8), v1 = *(const u32x4*)(OG + ((size_t)T + t) * 512 + c8), v2 = *(const u32x4*)(OG + ((size_t)2 * T + t) * 512 + c8); u32x4 o;
#pragma unroll
        for (int j = 0; j < 4; ++j) o[j] = pk2(a0 * bflo(v0[j]) + a1 * bflo(v1[j]) + a2 * bflo(v2[j]), a0 * bfhi(v0[j]) + a1 * bfhi(v1[j]) + a2 * bfhi(v2[j]));
        *(u32x4*)(AO + t * 512 + c8) = o; }
}

__device__ __forceinline__ void s_ssd_unit(const Ctx& C, int li, int u) {
    const int b = u >> 1, g = u & 1, hh = C.wave, h = g * 8 + hh, lane = C.lane;
    LAS float* xs = (LAS float*)(C.lds + hh * 2048);
    LAS float* Bs = xs + 64; LAS float* Cs = xs + 192;
    LAS float* ys = (LAS float*)(C.lds + 16384);
    LAS float* rs = ys + 512;
    const float* us = WSP(float, WS_SMALL) + (size_t)b * HYB_NP;
    const float* cst = INP(I_CONV) + ((size_t)(li * 32 + b) * 3) * 1536;
    const float* cw = INP(I_CONVW) + (size_t)li * 4 * 1536; const float* cb = INP(I_CONVB) + (size_t)li * 1536;
    auto conv = [&](int ch) { return siluf_(cb[ch] + cw[ch] * cst[ch] + cw[1536 + ch] * cst[1536 + ch] + cw[3072 + ch] * cst[3072 + ch] + cw[4608 + ch] * us[U_XBC + ch]); };
    xs[lane] = conv(h * 64 + lane);
    Bs[lane] = conv(1024 + g * 128 + lane); Bs[64 + lane] = conv(1024 + g * 128 + 64 + lane);
    Cs[lane] = conv(1280 + g * 128 + lane); Cs[64 + lane] = conv(1280 + g * 128 + 64 + lane);
    { float* co = (C.PP->out) + O_CONVS + ((size_t)(li * 32 + b) * 3) * 1536;
      for (int e = C.tid; e < 768; e += NT) { const int ch = e < 512 ? g * 512 + e : (e < 640 ? 1024 + g * 128 + (e - 512) : 1280 + g * 128 + (e - 640));
          co[ch] = cst[1536 + ch]; co[1536 + ch] = cst[3072 + ch]; co[3072 + ch] = us[U_XBC + ch]; } }
    LDSW();
    const float dt = softplus_(us[U_DT + h] + INP(I_DTB)[li * 16 + h]), dA = __expf(-dt * __expf(INP(I_ALOG)[li * 16 + h])), Dh = INP(I_SSDD)[li * 16 + h];
    const int pp = lane >> 3, nn = (lane & 7) * 16;
    f32x4 Bv[4], Cv[4];
#pragma unroll
    for (int j = 0; j < 4; ++j) { Bv[j] = *(const LAS f32x4*)(Bs + nn + 4 * j); Cv[j] = *(const LAS f32x4*)(Cs + nn + 4 * j); }
    const float* sin_ = INP(I_SSD) + ((size_t)(li * 32 + b) * 16 + h) * 8192; float* sout = (C.PP->out) + O_SSDS + ((size_t)(li * 32 + b) * 16 + h) * 8192;
    float yv = 0.f;
#pragma unroll
    for (int it = 0; it < 8; ++it) { const int p = it * 8 + pp; const float xp = xs[p], dx = dt * xp; float part = 0.f;
#pragma unroll
        for (int j = 0; j < 4; ++j) { f32x4 s = *(const f32x4*)(sin_ + p * 128 + nn + 4 * j); s = s * dA + Bv[j] * dx; *(f32x4*)(sout + p * 128 + nn + 4 * j) = s;
            part += (s[0] * Cv[j][0] + s[1] * Cv[j][1]) + (s[2] * Cv[j][2] + s[3] * Cv[j][3]); }
        part += __shfl_xor(part, 1); part += __shfl_xor(part, 2); part += __shfl_xor(part, 4);
        if ((lane & 7) == it) yv = part + Dh * xp; }
    { const int p = (lane & 7) * 8 + (lane >> 3); const float z = us[h * 64 + p]; const float y = yv * siluf_(z); ys[hh * 64 + p] = y; const float ss = wave_sum(y * y); if (lane == 0) rs[hh] = ss; }
    __syncthreads();
    { float tot = 0.f;
#pragma unroll
      for (int j = 0; j < 8; ++j) tot += rs[j];
      const float rinv = rsqrtf(tot * (1.f / 512.f) + EPS); const int cc = C.tid;
      WSP(bf16, WS_YCAT)[(size_t)(T + b) * 2048 + g * 512 + cc] = (bf16)(pk2(ys[cc] * rinv * INP(I_SNW)[li * 1024 + g * 512 + cc], 0.f) & 0xffffu); }
    __syncthreads();
}

__device__ __forceinline__ void s_rwkv_unit(const Ctx& C, int li, int b) {
    const int lane = C.lane, tid = C.tid;
    LAS float* mix = (LAS float*)C.lds;
    LAS float* act = mix + 3328;
    LAS float* vec = act + 256;
    LAS float* hv = vec + 3072;
    const float* us = WSP(float, WS_SMALL) + (size_t)b * HYB_NP + U_RW;
    const float* sst = INP(I_SHIFT) + (size_t)(li * 32 + b) * RWC; const float* mu = INP(I_MU) + li * RWC;
    float* sho = (C.PP->out) + O_SHS + (size_t)(li * 32 + b) * RWC;
    for (int c = tid; c < RWC; c += NT) { const float cur = us[c]; mix[c] = cur + (sst[c] - cur) * mu[c]; sho[c] = cur; }
    __syncthreads();
    if (tid < 256) { const float x = mix[3072 + tid]; act[tid] = tid < 64 ? tanhf(x) : (tid < 128 ? x : sigm_(x)); }
    __syncthreads();
    const float* w2 = INP(I_RW2) + (size_t)li * 64 * 1024; const float* a2 = INP(I_RA2) + (size_t)li * 64 * 1024; const float* g2 = INP(I_RG2) + (size_t)li * 128 * 1024;
    {   LAS float* part = hv + 8 * 192;
        const int cq = tid & 63, sl = tid >> 6;
        for (int cb = 0; cb < 4; ++cb) { const int c = cb * 256 + cq * 4;
            f32x4 aw = (f32x4){0.f, 0.f, 0.f, 0.f}, aa = aw, ag = aw;
#pragma unroll
            for (int j = 0; j < 8; ++j) { const int r = sl * 8 + j; aw += *(const f32x4*)(w2 + (size_t)r * 1024 + c) * act[r]; aa += *(const f32x4*)(a2 + (size_t)r * 1024 + c) * act[64 + r]; }
#pragma unroll
            for (int j = 0; j < 16; ++j) { const int r = sl * 16 + j; ag += *(const f32x4*)(g2 + (size_t)r * 1024 + c) * act[128 + r]; }
            *(LAS f32x4*)(part + (sl * 3 + 0) * 1024 + c) = aw; *(LAS f32x4*)(part + (sl * 3 + 1) * 1024 + c) = aa; *(LAS f32x4*)(part + (sl * 3 + 2) * 1024 + c) = ag; }
        __syncthreads();
        for (int c = tid; c < 1024; c += NT) { float wl = INP(I_RW0)[li * 1024 + c], al = INP(I_RA0)[li * 1024 + c], gl = 0.f;
#pragma unroll
            for (int k = 0; k < 8; ++k) { wl += part[(k * 3 + 0) * 1024 + c]; al += part[(k * 3 + 1) * 1024 + c]; gl += part[(k * 3 + 2) * 1024 + c]; }
            vec[c] = __expf(-__expf(-softplus_(-wl) - 0.5f)); vec[1024 + c] = sigm_(al); vec[2048 + c] = gl; }
    }
    __syncthreads();
    LAS float* my = hv + C.wave * 192;
    for (int hh = 0; hh < 2; ++hh) { const int h = 2 * C.wave + hh, c = h * 64 + lane;
        const float r = mix[c], k = mix[1024 + c], v = mix[2048 + c], w = vec[c], a = vec[1024 + c], gt = vec[2048 + c];
        const float kk = k * INP(I_KK)[li * 1024 + c]; const float inv = 1.f / fmaxf(sqrtf(wave_sum(kk * kk)), 1e-12f); const float kkn = kk * inv;
        const float kp = k * (1.f + (a - 1.f) * INP(I_KA)[li * 1024 + c]);
        my[lane] = -kkn; my[64 + lane] = kkn * a; my[128 + lane] = kp; LDSW();
        const float* sin_ = INP(I_WKV) + ((size_t)(li * 32 + b) * 16 + h) * 4096 + lane * 64; float* sout = (C.PP->out) + O_WKVS + ((size_t)(li * 32 + b) * 16 + h) * 4096 + lane * 64;
        f32x4 S[16]; float sa = 0.f;
#pragma unroll
        for (int j = 0; j < 16; ++j) { S[j] = *(const f32x4*)(sin_ + 4 * j); const f32x4 n4 = *(const LAS f32x4*)(my + 4 * j); sa += (S[j][0] * n4[0] + S[j][1] * n4[1]) + (S[j][2] * n4[2] + S[j][3] * n4[3]); }
        float o = 0.f;
#pragma unroll
        for (int j = 0; j < 16; ++j) { const f32x4 b4 = *(const LAS f32x4*)(my + 64 + 4 * j), k4 = *(const LAS f32x4*)(my + 128 + 4 * j), w4 = *(const LAS f32x4*)(vec + h * 64 + 4 * j), r4 = *(const LAS f32x4*)(mix + h * 64 + 4 * j);
            S[j] = S[j] * w4 + b4 * sa + k4 * v; *(f32x4*)(sout + 4 * j) = S[j]; o += (S[j][0] * r4[0] + S[j][1] * r4[1]) + (S[j][2] * r4[2] + S[j][3] * r4[3]); }
        const float mean = wave_sum(o) * (1.f / 64.f), d = o - mean, var = wave_sum(d * d) * (1.f / 64.f);
        float y = d * rsqrtf(var + LN_EPS) * INP(I_LNW)[li * 1024 + c] + INP(I_LNB)[li * 1024 + c];
        const float rk = wave_sum(r * kp * INP(I_RK)[li * 1024 + c]);
        y = (y + rk * v) * gt;
        WSP(bf16, WS_YCAT)[(size_t)(T + b) * 2048 + 1024 + c] = (bf16)(pk2(y, 0.f) & 0xffffu);
        LDSW();
    }
    __syncthreads();
}

__device__ __forceinline__ void s_attn_unit(const Ctx& C, int li, int u) {
    const int task = u * 8 + C.wave, b = task >> 3, h = task & 7, lane = C.lane;
    LAS float* qs = (LAS float*)(C.lds + C.wave * 1024);
    const float* qkv = WSP(float, WS_SMALL) + MiB / 4 + (size_t)b * QKV_N;
    const float* rp = WSP(float, WS_ROPE) + 8192 * 16;
    float og[3], lse[3];
#pragma unroll
    for (int g = 0; g < 3; ++g) {
        const int W = 128 << (2 * g), dsh = 2 * g;
        const float* base = qkv + g * 1536 + h * 64;
        float qv = base[lane], kv = base[512 + lane], vv = base[1024 + lane];
        {
            const float qo_ = __shfl_xor(qv, 8), ko_ = __shfl_xor(kv, 8);
            if (lane < 16) { const float cs = rp[lane & 7], sn = rp[8 + (lane & 7)]; if (lane < 8) { qv = qv * cs - qo_ * sn; kv = kv * cs - ko_ * sn; } else { qv = qv * cs + qo_ * sn; kv = kv * cs + ko_ * sn; } }
        }
        qv *= 0.125f;
        float* wo = (C.PP->out) + (g == 0 ? O_W0S : g == 1 ? O_W1S : O_W2S) + ((size_t)(li * 32 + b) * W + (W - 1)) * 1024;
        wo[h * 64 + lane] = kv; wo[512 + h * 64 + lane] = vv;
        qs[lane] = qv; LDSW();
        f32x4 q4[16];
#pragma unroll
        for (int j = 0; j < 16; ++j) q4[j] = *(const LAS f32x4*)(qs + 4 * j);
        const float* cache = INP(I_C0 + g) + ((size_t)(li * 32 + b) * W) * 1024 + h * 64;
        float sc0, sc1;
        { const float* k0 = cache + (size_t)(W - ((lane + 1) << dsh)) * 1024; const float* k1 = cache + (size_t)(W - ((lane + 65) << dsh)) * 1024; float a0 = 0.f, a1 = 0.f;
#pragma unroll
          for (int j = 0; j < 16; ++j) { const f32x4 x0 = *(const f32x4*)(k0 + 4 * j), x1 = *(const f32x4*)(k1 + 4 * j);
              a0 += (x0[0] * q4[j][0] + x0[1] * q4[j][1]) + (x0[2] * q4[j][2] + x0[3] * q4[j][3]); a1 += (x1[0] * q4[j][0] + x1[1] * q4[j][1]) + (x1[2] * q4[j][2] + x1[3] * q4[j][3]); }
          sc0 = a0; sc1 = a1; }
        const float ss = wave_sum(qv * kv);
        const float m = fmaxf(ss, wave_max(fmaxf(sc0, sc1)));
        const float p0 = __expf(sc0 - m), p1 = __expf(sc1 - m), ps = __expf(ss - m);
        const float l = wave_sum(p0 + p1) + ps;
        float o = ps * vv;
#pragma unroll 16
        for (int j = 0; j < 64; ++j) { const float pj0 = __shfl(p0, j), pj1 = __shfl(p1, j);
            o += pj0 * cache[(size_t)(W - ((j + 1) << dsh)) * 1024 + 512 + lane] + pj1 * cache[(size_t)(W - ((j + 65) << dsh)) * 1024 + 512 + lane]; }
        og[g] = o / l; lse[g] = m + __logf(l);
        LDSW();
    }
    const float m = fmaxf(lse[0], fmaxf(lse[1], lse[2])); float a0 = __expf(lse[0] - m), a1 = __expf(lse[1] - m), a2 = __expf(lse[2] - m); const float inv = 1.f / (a0 + a1 + a2);
    const float o = (a0 * og[0] + a1 * og[1] + a2 * og[2]) * inv;
    WSP(bf16, WS_AO)[(size_t)(T + b) * 512 + h * 64 + lane] = (bf16)(pk2(o, 0.f) & 0xffffu);
}

#ifndef PROBE_DUP
#define PROBE_DUP 0
#endif
__global__ void __launch_bounds__(512, 2) mk_fwd(Params P) {
    extern __shared__ __attribute__((aligned(16))) unsigned char lds_raw[];
    Ctx C;
    C.lds = (LAS unsigned char*)lds_raw;
#define PHASE() do { unsigned long long _k = (unsigned long long)__builtin_amdgcn_kernarg_segment_ptr(); int _t = threadIdx.x, _b = blockIdx.x, _g = gridDim.x; asm volatile("" : "+s"(_k), "+v"(_t), "+s"(_b), "+s"(_g)); \
        C.PP = (const CAS Params*)_k; C.tid = _t; C.lane = _t & 63; C.wave = __builtin_amdgcn_readfirstlane(_t >> 6); C.G = _g; C.bid = _b; } while (0)
    PHASE();
    for (int u = C.tid; u < (LDS_BYTES - LDS_RING) / 4; u += NT) ((LAS unsigned*)(C.lds + LDS_RING))[u] = 0u;
    __syncthreads();
    (void)xcd_barrier_post((unsigned*)((C.PP->ws) + WS_CTL) + 4096, (volatile LAS unsigned*)(C.lds + LDS_MISC) + 8);
#define GRID_BAR() do { XcdBarrier _b; _b.bar = (unsigned*)((C.PP->ws) + WS_CTL) + 4096; _b.x = xb_xcc_id(); _b.st = (volatile LAS unsigned*)(C.lds + LDS_MISC) + 8; xcd_barrier(_b); PHASE(); } while (0)
    LAS unsigned char* ring = C.lds;

    p0_weights(C);
    __syncthreads(); PHASE();
    p0_mod(C);
    GRID_BAR();
#if PROBE_DUP & 1
    p0_weights(C); __syncthreads(); PHASE(); p0_mod(C); GRID_BAR();
#endif

    for (int l = 0; l < 4; ++l) {
        const int li = l >> 1;
#define modl (WSP(float, WS_MOD) + (size_t)l * NSEQ * 6144)
        norm_phase(C, l, 0, l == 0);
        GRID_BAR();
        if ((l & 1) == 0) {
            { pg8::Gemm g{WSP(bf16, WS_XN), WSP(bf16, WS_WIN) + (size_t)li * HYB_NP * 1024, T, HYB_NP, 1024}; pg8::StaticOrder S; S.init(T, HYB_NP, C.G, C.bid);
              int rcnt = 0; const bool rg = (C.G == 256);
              EpiIn E{WSP(bf16, WS_U), WSP(float, WS_DT), RollArgs{INP(I_C0), INP(I_C1), INP(I_C2), (C.PP->out), li * 6, &rcnt, C.bid}, rg}; pg8::gemm_phase<EpiIn, pg8::StaticOrder>(ring, g, S, E, nullptr); }
            PHASE();
            { float* US = WSP(float, WS_SMALL); small_gemm(C, WSP(bf16, WS_XN) + (size_t)T * D, WSP(bf16, WS_WIN) + (size_t)li * HYB_NP * 1024, HYB_NP, 1024, [&](int r, int c, float v) { US[(size_t)r * HYB_NP + c] = v; }); }
            GRID_BAR();
            for (int u = C.bid; u < 256; u += C.G) rwkv_prep_unit(C, li, u);
            PHASE();
#if PROBE_DUP & 256
            for (int u = C.bid; u < 256; u += C.G) rwkv_prep_unit(C, li, u);
            PHASE();
#endif
#if PROBE_DUP & 512
            for (int u = C.bid; u < 256; u += C.G) ssd_a_unit(C, li, u);
            PHASE();
#endif
            for (int u = C.bid; u < 256; u += C.G) ssd_a_unit(C, li, u);
            PHASE();
            for (int u = (C.bid + 192) % C.G; u < 64; u += C.G) s_ssd_unit(C, li, u);
            PHASE();
            for (int u = (C.bid + 128) % C.G; u < 32; u += C.G) s_rwkv_unit(C, li, u);
            GRID_BAR();
#if PROBE_DUP & 2
            for (int u = C.bid; u < 256; u += C.G) rwkv_prep_unit(C, li, u);
            PHASE();
            for (int u = C.bid; u < 256; u += C.G) ssd_a_unit(C, li, u);
            PHASE();
            for (int u = (C.bid + 192) % C.G; u < 64; u += C.G) s_ssd_unit(C, li, u);
            PHASE();
            for (int u = (C.bid + 128) % C.G; u < 32; u += C.G) s_rwkv_unit(C, li, u);
            GRID_BAR();
#endif
            for (int u = C.bid; u < 256; u += C.G) rwkv_scan_unit(C, u);
            PHASE();
#if PROBE_DUP & 4
            GRID_BAR(); for (int u = C.bid; u < 256; u += C.G) rwkv_scan_unit(C, u); PHASE();
#endif
            ssd_scan_phase(C, li);
            GRID_BAR();
            if (C.G == 256) { if (C.bid < 32) { PHASE(); rwkv_combine_unit(C, li, C.bid); PHASE(); ssd_c_unit(C, li, 224 + C.bid); } else { PHASE(); ssd_c_unit(C, li, C.bid - 32); } }
            else if (C.G >= 64) { if (C.bid < 32) { PHASE(); rwkv_combine_unit(C, li, C.bid); } else { PHASE(); for (int u = C.bid - 32; u < 256; u += C.G - 32) ssd_c_unit(C, li, u); PHASE(); cache_roll_slice(C, li, 2, C.bid - 32, C.G - 32); } }
            else { for (int u = C.bid; u < 32; u += C.G) rwkv_combine_unit(C, li, u); PHASE(); for (int u = C.bid; u < 256; u += C.G) ssd_c_unit(C, li, u); PHASE(); cache_roll_slice(C, li, 2, C.bid, C.G); }
            GRID_BAR();
#if PROBE_DUP & 1024
            if (C.bid < 32) { PHASE(); rwkv_combine_unit(C, li, C.bid); }
            GRID_BAR();
#endif
#if PROBE_DUP & 2048
            if (C.bid >= 32) { PHASE(); for (int u = C.bid - 32; u < 256; u += C.G - 32) ssd_c_unit(C, li, u); }
            GRID_BAR();
#endif
#if PROBE_DUP & 8
            if (C.G >= 64) { if (C.bid < 32) { PHASE(); rwkv_combine_unit(C, li, C.bid); } else { PHASE(); for (int u = C.bid - 32; u < 256; u += C.G - 32) ssd_c_unit(C, li, u); } }
            else { for (int u = C.bid; u < 32; u += C.G) rwkv_combine_unit(C, li, u); PHASE(); for (int u = C.bid; u < 256; u += C.G) ssd_c_unit(C, li, u); }
            GRID_BAR();
#endif
            for (int u = C.bid; u < 2048; u += C.G) rwkv_out_unit(C, li, u);
            GRID_BAR();
#if PROBE_DUP & 16
            for (int u = C.bid; u < 2048; u += C.G) rwkv_out_unit(C, li, u);
            GRID_BAR();
#endif
            { const float* xin = l == 0 ? INP(I_XP) : WSP(float, WS_X); const float* xsin = l == 0 ? INP(I_XS) : WSP(float, WS_X) + (size_t)T * D; const float* gate = modl + 2048;
              pg8::Gemm g{WSP(bf16, WS_YCAT), WSP(bf16, WS_WOUT) + (size_t)li * 1024 * 2048, T, 1024, 2048}; pg8::StaticOrder S; S.init(T, 1024, C.G, C.bid);
              EpiRes E{xin, WSP(float, WS_X), gate}; pg8::gemm_phase<EpiRes, pg8::StaticOrder>(ring, g, S, E, nullptr); PHASE();
              float* XS = WSP(float, WS_X) + (size_t)T * D;
              small_gemm(C, WSP(bf16, WS_YCAT) + (size_t)T * 2048, WSP(bf16, WS_WOUT) + (size_t)li * 1024 * 2048, 1024, 2048, [&](int r, int c, float v) { XS[(size_t)r * D + c] = xsin[(size_t)r * D + c] + gate[(size_t)(2 + r) * 6144 + c] * v; }); }
            GRID_BAR();
        } else {
            { pg8::Gemm g{WSP(bf16, WS_XN), WSP(bf16, WS_WQKV) + (size_t)li * QKV_N * 1024, T, QKV_N, 1024}; pg8::StaticOrder S; S.init(T, QKV_N, C.G, C.bid);
              EpiQkv E{WSP(bf16, WS_QKV), WSP(float, WS_ROPE), (C.PP->out), li}; pg8::gemm_phase<EpiQkv, pg8::StaticOrder>(ring, g, S, E, nullptr); PHASE();
              float* QS = WSP(float, WS_SMALL) + MiB / 4;
              small_gemm(C, WSP(bf16, WS_XN) + (size_t)T * D, WSP(bf16, WS_WQKV) + (size_t)li * QKV_N * 1024, QKV_N, 1024, [&](int r, int c, float v) { QS[(size_t)r * QKV_N + c] = v; }); }
            GRID_BAR();
            for (int u = C.bid; u < 3072; u += C.G) attn_tile_unit(C, u);
            PHASE();
            for (int u = C.bid; u < 32; u += C.G) s_attn_unit(C, li, u);
            GRID_BAR();
#if PROBE_DUP & 32
            for (int u = C.bid; u < 3072; u += C.G) attn_tile_unit(C, u);
            PHASE();
            for (int u = C.bid; u < 32; u += C.G) s_attn_unit(C, li, u);
            GRID_BAR();
#endif
            attn_merge_phase(C);
            GRID_BAR();
            { const float* gate = modl + 2048;
              pg8::Gemm g{WSP(bf16, WS_AO), WSP(bf16, WS_WAO) + (size_t)li * 1024 * 512, T, 1024, 512}; pg8::StaticOrder S; S.init(T, 1024, C.G, C.bid);
              EpiRes E{WSP(float, WS_X), WSP(float, WS_X), gate}; pg8::gemm_phase<EpiRes, pg8::StaticOrder>(ring, g, S, E, nullptr); PHASE();
              float* XS = WSP(float, WS_X) + (size_t)T * D;
              small_gemm(C, WSP(bf16, WS_AO) + (size_t)T * 512, WSP(bf16, WS_WAO) + (size_t)li * 1024 * 512, 1024, 512, [&](int r, int c, float v) { XS[(size_t)r * D + c] += gate[(size_t)(2 + r) * 6144 + c] * v; }); }
            GRID_BAR();
        }
        norm_phase(C, l, 1, false);
        GRID_BAR();
#if PROBE_DUP & 64
        norm_phase(C, l, 1, false);
        GRID_BAR();
#endif
#if PROBE_DUP & 128
        { pg8::Gemm g{WSP(bf16, WS_XN), WSP(bf16, WS_W1) + (size_t)l * FF * 1024, T, FF, 1024}; pg8::StaticOrder S; S.init(T, FF, C.G, C.bid);
          int rcnt = 0; EpiMlp1 E{WSP(bf16, WS_HID), RollArgs{INP(I_C0), INP(I_C1), INP(I_C2), (C.PP->out), 0, &rcnt, C.bid}, false}; pg8::gemm_phase<EpiMlp1, pg8::StaticOrder>(ring, g, S, E, nullptr); } GRID_BAR();
#endif
        { pg8::Gemm g{WSP(bf16, WS_XN), WSP(bf16, WS_W1) + (size_t)l * FF * 1024, T, FF, 1024}; pg8::StaticOrder S; S.init(T, FF, C.G, C.bid);
          int rcnt = 0; const bool rg = (C.G == 256);
          EpiMlp1 E{WSP(bf16, WS_HID), RollArgs{INP(I_C0), INP(I_C1), INP(I_C2), (C.PP->out), 12 + l * 4, &rcnt, C.bid}, rg}; pg8::gemm_phase<EpiMlp1, pg8::StaticOrder>(ring, g, S, E, nullptr); PHASE();
          bf16* HS = WSP(bf16, WS_HID) + (size_t)T * FF;
          small_gemm(C, WSP(bf16, WS_XN) + (size_t)T * D, WSP(bf16, WS_W1) + (size_t)l * FF * 1024, FF, 1024, [&](int r, int c, float v) { const float a = fmaxf(v, 0.f); HS[(size_t)r * FF + c] = (bf16)(pk2(a * a, 0.f) & 0xffffu); }); }
        GRID_BAR();
        { const float* gate = modl + 5120;
          pg8::Gemm g{WSP(bf16, WS_HID), WSP(bf16, WS_W2) + (size_t)l * 1024 * FF, T, 1024, FF}; pg8::StaticOrder S; S.init(T, 1024, C.G, C.bid);
          EpiRes E{WSP(float, WS_X), WSP(float, WS_X), gate}; pg8::gemm_phase<EpiRes, pg8::StaticOrder>(ring, g, S, E, nullptr); PHASE();
          float* XS = WSP(float, WS_X) + (size_t)T * D;
          small_gemm(C, WSP(bf16, WS_HID) + (size_t)T * FF, WSP(bf16, WS_W2) + (size_t)l * 1024 * FF, 1024, FF, [&](int r, int c, float v) { XS[(size_t)r * D + c] += gate[(size_t)(2 + r) * 6144 + c] * v; }); }
        GRID_BAR();
    }
    final_norm_phase(C);
}
}

extern "C" void kernel_launch(void* const* d_in, const int* in_sizes, int n_in, void* d_out, int out_size, void* d_ws, size_t ws_size, hipStream_t stream) {
    static int grid = 0;
    if (grid == 0) {
        int dev = 0, cus = 0, per_cu = 0;
        if (hipGetDevice(&dev) != hipSuccess || hipDeviceGetAttribute(&cus, hipDeviceAttributeMultiprocessorCount, dev) != hipSuccess) { fprintf(stderr, "kernel_launch: device query failed\n"); grid = -1; return; }
        if (hipFuncSetAttribute((const void*)mk::mk_fwd, hipFuncAttributeMaxDynamicSharedMemorySize, mk::LDS_BYTES) != hipSuccess) { fprintf(stderr, "kernel_launch: hipFuncSetAttribute failed\n"); grid = -1; return; }
        if (hipOccupancyMaxActiveBlocksPerMultiprocessor(&per_cu, (const void*)mk::mk_fwd, 512, mk::LDS_BYTES) != hipSuccess || per_cu < 1) fprintf(stderr, "kernel_launch: occupancy query reports %d\n", per_cu);
        if (n_in != 39 || (size_t)out_size != mk::O_END || ws_size < mk::WS_END) { fprintf(stderr, "kernel_launch: unexpected sizes n_in %d out %d ws %zu\n", n_in, out_size, ws_size); grid = -1; return; }
        grid = cus;
    }
    if (grid < 0) return;
    hipMemsetAsync((char*)d_ws + mk::WS_CTL, 0, mk::CTL_BYTES, stream);
    mk::Params p; memset(&p, 0, sizeof(p));
    for (int i = 0; i < 39; ++i) p.in[i] = (const float*)d_in[i];
    p.out = (float*)d_out; p.ws = (unsigned char*)d_ws;
    hipLaunchKernelGGL(mk::mk_fwd, dim3(grid), dim3(512), mk::LDS_BYTES, stream, p);
}
```

```cpp
#include <hip/hip_runtime.h>
#include <cstdio>
#include <cstdint>
#include <cstring>
namespace pg8 {
#define PG8_LAS __attribute__((address_space(3)))
typedef unsigned short bf16_t;
typedef short bf16x8 __attribute__((ext_vector_type(8)));
typedef float f32x4 __attribute__((ext_vector_type(4)));
typedef unsigned u32x4 __attribute__((ext_vector_type(4)));
constexpr int BM = 256, BK = 64, HALF = 128, HTB = HALF * BK * 2  , STAGE_BYTES = 8 * HTB, NXCD = 8, WGM = 8;

__host__ __device__ __forceinline__ int lds_byte(int r, int c) { const int st = (r >> 4) * 2 + (c >> 5), rr = r & 15, cc = c & 31, ob = rr * 64 + cc * 2; return st * 1024 + (ob ^ (((ob >> 9) & 1) << 5)); }
__host__ __device__ __forceinline__ void stage_rc(int b, int& R, int& C) { const int st = b / 1024, sb = b % 1024, swz = sb ^ (((sb >> 9) & 1) << 5); R = (st >> 1) * 16 + swz / 64; C = (st & 1) * 32 + (swz % 64) / 2; }
__host__ __device__ __forceinline__ int perm32(int rho) { const int n = rho >> 4, i = rho & 15; return 8 * (i >> 2) + 4 * n + (i & 3); }

struct Unit { int pm, pn; };
struct Gemm { const bf16_t* A; const bf16_t* Bt; int M, N, K; };

struct StaticOrder {
    int nM, nN, nwg, G, c;
    __host__ __device__ void init(int M, int N, int G_, int c_) { nM = M / BM; nN = N / BM; nwg = nM * nN; G = G_; c = c_; }
    __host__ __device__ bool next(int i, Unit& u) const {
        const long L = (long)i * G + c; if (L >= nwg) return false;
        int wgid = (int)L; { const int q = nwg / NXCD, r = nwg % NXCD, xcd = wgid % NXCD, off = wgid / NXCD; wgid = (xcd < r ? xcd * (q + 1) : r * (q + 1) + (xcd - r) * q) + off; }
        const int nig = WGM * nN, gid = wgid / nig, fm = gid * WGM, gsz = (nM - fm) < WGM ? (nM - fm) : WGM;
        u.pm = fm + ((wgid % nig) % gsz); u.pn = (wgid % nig) / gsz; return true;
    }
    __device__ __forceinline__ void a_ready(const Unit&) const {}
    __device__ __forceinline__ void done(const Unit&) const {}
};
template <class Epi, class Sched, bool STAMP = false>
__device__ __forceinline__ void gemm_phase(PG8_LAS unsigned char* lds, const Gemm g, const Sched& S, const Epi& E, unsigned long long* stamps) {
    int tid_ = threadIdx.x; asm volatile("" : "+v"(tid_));
    const int tid = tid_, wid = __builtin_amdgcn_readfirstlane(tid >> 6), lane = tid & 63, wr = wid >> 2, wc = wid & 3, fr = lane & 15, fq = lane >> 4;
    const int K = g.K, nt = K / BK;
    int ts_lo = 0, ts_hi = 0, nts = 0; const unsigned long long rt_entry = STAMP ? (unsigned long long)wall_clock64() : 0ull;
#define PG8_STAMP() do { if (STAMP && wid == 0 && nts < 64) { const unsigned long long _c = (unsigned long long)clock64(); \
        ts_lo = (lane == nts) ? (int)(unsigned)_c : ts_lo; ts_hi = (lane == nts) ? (int)(unsigned)(_c >> 32) : ts_hi; ++nts; } } while (0)
    PG8_STAMP();
    unsigned voffA[2], voffB[2];
#pragma unroll
    for (int i = 0; i < 2; ++i) { int R, C; stage_rc(tid * 16 + i * 8192, R, C); const int Rb = Epi::PERM ? ((R & ~31) + perm32(R & 31)) : R;
        voffA[i] = (unsigned)(R * K + C) * 2u; voffB[i] = (unsigned)(Rb * K + C) * 2u; }
    const size_t kstep = (size_t)(BK * 2);
    const size_t hstep = (size_t)HALF * K * 2;
    const size_t tstep = 2 * hstep;
    const unsigned ldsw = (unsigned)wid * 1024u;
    const int aoff = lds_byte(wr * 64 + fr, fq * 8), boff = lds_byte(wc * 32 + fr, fq * 8);
#define PG8_SA(b, h) (((b) * 2 + (h)) * HTB)
#define PG8_SB(b, h) ((4 + (b) * 2 + (h)) * HTB)
#define PG8_STAGE(bufoff, gbase, voff) do { _Pragma("unroll") for (int _i = 0; _i < 2; ++_i) \
        __builtin_amdgcn_global_load_lds((const unsigned*)((const char*)(gbase) + (voff)[_i]), (PG8_LAS unsigned*)(lds + (bufoff) + ldsw + _i * 8192), 16, 0, 0); } while (0)
#define PG8_LDA(dst, b, h) do { _Pragma("unroll") for (int m = 0; m < 4; ++m) _Pragma("unroll") for (int k = 0; k < 2; ++k) dst[m][k] = *(const PG8_LAS bf16x8*)(lds + PG8_SA(b, h) + aoff + m * 2048 + k * 1024); } while (0)
#define PG8_LDB(dst, b, h) do { _Pragma("unroll") for (int n = 0; n < 2; ++n) _Pragma("unroll") for (int k = 0; k < 2; ++k) dst[n][k] = *(const PG8_LAS bf16x8*)(lds + PG8_SB(b, h) + boff + n * 2048 + k * 1024); } while (0)
#define PG8_MMA(ai, bj, At, Bt) do { __builtin_amdgcn_s_setprio(1); _Pragma("unroll") for (int m = 0; m < 4; ++m) _Pragma("unroll") for (int n = 0; n < 2; ++n) _Pragma("unroll") for (int k = 0; k < 2; ++k) \
        acc[ai][bj][m][n] = __builtin_amdgcn_mfma_f32_16x16x32_bf16(Bt[n][k], At[m][k], acc[ai][bj][m][n], 0, 0, 0); __builtin_amdgcn_s_setprio(0); } while (0)
#define PG8_WAIT_V(n) asm volatile("s_waitcnt vmcnt(" #n ")" ::: "memory")
#define PG8_WAIT_L(n) asm volatile("s_waitcnt lgkmcnt(" #n ")" ::: "memory")
#define PG8_BAR __builtin_amdgcn_s_barrier()
#define PG8_SCHED __builtin_amdgcn_sched_barrier(0)
    Unit cur, nxt; int ui = 0;
    if (!S.next(0, cur)) return;
    f32x4 acc[2][2][4][2];
#pragma unroll
    for (int a = 0; a < 2; ++a)
#pragma unroll
        for (int b = 0; b < 2; ++b)
#pragma unroll
            for (int m = 0; m < 4; ++m)
#pragma unroll
                for (int n = 0; n < 2; ++n) acc[a][b][m][n] = (f32x4){0.f, 0.f, 0.f, 0.f};
    bf16x8 At[4][2], B0[2][2], B1[2][2];
    const char* cA = (const char*)g.A + (size_t)cur.pm * tstep; const char* cB = (const char*)g.Bt + (size_t)cur.pn * tstep;
    S.a_ready(cur);
    PG8_STAGE(PG8_SB(0, 0), cB, voffB); PG8_STAGE(PG8_SA(0, 0), cA, voffA); PG8_STAGE(PG8_SB(0, 1), cB + hstep, voffB); PG8_STAGE(PG8_SA(0, 1), cA + hstep, voffA);
    if (wr == 1) PG8_BAR;
    PG8_WAIT_V(4); PG8_BAR;
    PG8_STAGE(PG8_SB(1, 0), cB + kstep, voffB); PG8_STAGE(PG8_SA(1, 0), cA + kstep, voffA); PG8_STAGE(PG8_SB(1, 1), cB + hstep + kstep, voffB);
    PG8_WAIT_V(6); PG8_BAR;
    PG8_STAMP();
    for (;;) {
        const bool has_next = S.next(ui + 1, nxt);
        const char* nA = has_next ? (const char*)g.A + (size_t)nxt.pm * tstep : cA; const char* nB = has_next ? (const char*)g.Bt + (size_t)nxt.pn * tstep : cB;
        for (int t = 0; t < nt; t += 2) {
            const bool last = (t == nt - 2);
            const char* a1 = cA + (size_t)(t + 1) * kstep;
            const char* a2 = last ? nA : cA + (size_t)(t + 2) * kstep; const char* b2 = last ? nB : cB + (size_t)(t + 2) * kstep;
            const char* a3 = a2 + kstep; const char* b3 = b2 + kstep;
            if (last && has_next) S.a_ready(nxt);
            PG8_LDB(B0, 0, 0); PG8_SCHED; PG8_LDA(At, 0, 0); PG8_STAGE(PG8_SA(1, 1), a1 + hstep, voffA);
            PG8_WAIT_L(8); PG8_BAR; PG8_WAIT_L(0); PG8_MMA(0, 0, At, B0); PG8_BAR; PG8_SCHED;
            PG8_LDB(B1, 0, 1); PG8_STAGE(PG8_SB(0, 0), b2, voffB);
            PG8_BAR; PG8_WAIT_L(0); PG8_MMA(0, 1, At, B1); PG8_BAR;
            PG8_LDA(At, 0, 1); PG8_STAGE(PG8_SA(0, 0), a2, voffA);
            PG8_BAR; PG8_WAIT_L(0); PG8_MMA(1, 0, At, B0); PG8_BAR; PG8_SCHED;
            PG8_STAGE(PG8_SB(0, 1), b2 + hstep, voffB);
            PG8_WAIT_V(6); PG8_BAR; PG8_MMA(1, 1, At, B1); PG8_BAR;
            PG8_LDB(B0, 1, 0); PG8_SCHED; PG8_LDA(At, 1, 0); PG8_STAGE(PG8_SA(0, 1), a2 + hstep, voffA);
            PG8_WAIT_L(8); PG8_BAR; PG8_WAIT_L(0); PG8_MMA(0, 0, At, B0); PG8_BAR; PG8_SCHED;
            PG8_LDB(B1, 1, 1); PG8_STAGE(PG8_SB(1, 0), b3, voffB);
            PG8_BAR; PG8_WAIT_L(0); PG8_MMA(0, 1, At, B1); PG8_BAR;
            PG8_LDA(At, 1, 1); PG8_STAGE(PG8_SA(1, 0), a3, voffA);
            PG8_BAR; PG8_WAIT_L(0); PG8_MMA(1, 0, At, B0); PG8_BAR; PG8_SCHED;
            PG8_STAGE(PG8_SB(1, 1), b3 + hstep, voffB);
            PG8_WAIT_V(6); PG8_BAR; PG8_MMA(1, 1, At, B1); PG8_BAR;
        }
        PG8_STAMP();
        if constexpr (!Epi::AFTER_DRAIN) { E(acc, cur, wr, wc, fr, fq); S.done(cur); }
        PG8_STAMP();
        if (!has_next) break;
#pragma unroll
        for (int a = 0; a < 2; ++a)
#pragma unroll
            for (int b = 0; b < 2; ++b)
#pragma unroll
                for (int m = 0; m < 4; ++m)
#pragma unroll
                    for (int n = 0; n < 2; ++n) acc[a][b][m][n] = (f32x4){0.f, 0.f, 0.f, 0.f};
        cur = nxt; cA = nA; cB = nB; ++ui;
    }
    PG8_WAIT_V(0);
    if (wr == 0) PG8_BAR;
    PG8_BAR;
    if constexpr (Epi::AFTER_DRAIN) { E.fused(acc, cur, wr, wc, fr, fq, lds, wid, lane); S.done(cur); }
    PG8_STAMP();
    if (STAMP && wid == 0) { stamps[lane] = lane < nts ? (((unsigned long long)(unsigned)ts_hi << 32) | (unsigned)ts_lo) : 0ull;
        if (lane == 62) stamps[62] = rt_entry; if (lane == 63) stamps[63] = (unsigned long long)wall_clock64(); }
#undef PG8_STAMP
#undef PG8_SA
#undef PG8_SB
#undef PG8_STAGE
#undef PG8_LDA
#undef PG8_LDB
#undef PG8_MMA
#undef PG8_WAIT_V
#undef PG8_WAIT_L
#undef PG8_BAR
#undef PG8_SCHED
}
}
#define XB_TMO      128
#define XB_XCNT(j)  (256  + 64 * (j))
#define XB_XSUB(j)  (1280 + 64 * (j))
#define XB_XGEN(j)  (2304 + 64 * (j))
#define XB_TOP      3328
#define XB_TOPGEN   3392
#define XCD_BAR_WORDS 3456
#define XB_SPIN_CAP (1u << 18)
#define LAS __attribute__((address_space(3)))

__device__ __forceinline__ unsigned xb_ld(unsigned* p)              { return __hip_atomic_load(p, __ATOMIC_RELAXED, __HIP_MEMORY_SCOPE_AGENT); }
__device__ __forceinline__ unsigned xb_add(unsigned* p, unsigned v) { return __hip_atomic_fetch_add(p, v, __ATOMIC_RELAXED, __HIP_MEMORY_SCOPE_AGENT); }
__device__ __forceinline__ unsigned xb_xcc_id() { return (unsigned)__builtin_amdgcn_s_getreg((3 << 11) | 20) & 0xFu; }
#define XB_SPIN(cond, bar) do { unsigned _sp = 0; while (cond) { __builtin_amdgcn_s_sleep(1); \
    if ((++_sp & 255u) == 0u) { if (xb_ld(&(bar)[XB_TMO])) break; if (_sp > XB_SPIN_CAP) { atomicAdd(&(bar)[XB_TMO], 1u); break; } } } } while (0)

struct XcdBarrier {
    unsigned* bar; unsigned x;
    volatile LAS unsigned* st;
};

__device__ __forceinline__ XcdBarrier xcd_barrier_post(unsigned* bar, volatile LAS unsigned* st) {
    XcdBarrier b; b.bar = bar; b.x = xb_xcc_id(); b.st = st;
    if (threadIdx.x == 0) (void)xb_add(&bar[XB_XCNT(b.x)], 1u);
    return b;
}
__device__ __forceinline__ void xcd_barrier_complete(unsigned* bar, unsigned x, unsigned& nloc, unsigned& nx) {
    const unsigned G = gridDim.x * gridDim.y * gridDim.z;
    unsigned sum, cnt, mine, sp = 0u;
    for (;;) {
        sum = 0u; cnt = 0u; mine = 0u;
#pragma unroll
        for (unsigned j = 0; j < 16; ++j) { const unsigned c = xb_ld(&bar[XB_XCNT(j)]); sum += c; cnt += (c > 0u) ? 1u : 0u; mine = (j == x) ? c : mine; }
        if (sum == G) break;
        __builtin_amdgcn_s_sleep(1);
        if ((++sp & 255u) == 0u) { if (xb_ld(&bar[XB_TMO])) break; if (sp > XB_SPIN_CAP) { atomicAdd(&bar[XB_TMO], 1u); break; } }
    }
    nloc = mine > 0u ? mine : 1u; nx = cnt > 0u ? cnt : 1u;
}

__device__ __forceinline__ void xcd_barrier(const XcdBarrier& b) {
    asm volatile("s_waitcnt vmcnt(0)" ::: "memory");
    __syncthreads();
    if (threadIdx.x == 0) {
        unsigned* bar = b.bar;
        __builtin_amdgcn_s_waitcnt(0);
        unsigned nloc = b.st[0], nx = b.st[1];
        if (nloc == 0u) { xcd_barrier_complete(bar, b.x, nloc, nx); b.st[0] = nloc; b.st[1] = nx; }
        const unsigned old = xb_add(&bar[XB_XSUB(b.x)], 1u);
        const unsigned gen = old / nloc;
        if (old + 1u == (gen + 1u) * nloc) {
            __builtin_amdgcn_fence(__ATOMIC_RELEASE, "agent");
            asm volatile("s_waitcnt vmcnt(0)" ::: "memory");
            const unsigned og = xb_add(&bar[XB_TOP], 1u);
            const unsigned tg = og / nx;
            if (og + 1u == (tg + 1u) * nx) xb_add(&bar[XB_TOPGEN], 1u);
            else XB_SPIN(xb_ld(&bar[XB_TOPGEN]) == tg, bar);
            __builtin_amdgcn_fence(__ATOMIC_ACQUIRE, "agent");
            xb_add(&bar[XB_XGEN(b.x)], 1u);
            asm volatile("s_waitcnt vmcnt(0)" ::: "memory");
        } else {
            XB_SPIN(xb_ld(&bar[XB_XGEN(b.x)]) == gen, bar);
            __builtin_amdgcn_fence(__ATOMIC_ACQUIRE, "agent");
            asm volatile("s_waitcnt vmcnt(0)" ::: "memory");
        }
    }
    __syncthreads();
}

namespace mk {
#define LAS __attribute__((address_space(3)))
typedef unsigned short bf16;
typedef short bf16x8 __attribute__((ext_vector_type(8)));
typedef float f32x4 __attribute__((ext_vector_type(4)));
typedef float f32x2 __attribute__((ext_vector_type(2)));
typedef float f32x16 __attribute__((ext_vector_type(16)));
typedef unsigned u32x4 __attribute__((ext_vector_type(4)));
typedef unsigned u32x2 __attribute__((ext_vector_type(2)));

constexpr int T = 16384, SEQ = 8192, NS = 32, D = 1024, NSEQ = 34, NT = 512;
constexpr int HYB_NP = 6144, HYB_N = 5904, QKV_N = 4608, FF = 4096;
constexpr int U_XBC = 1024, U_DT = 2560, U_RW = 2576, RWC = 3328;
constexpr float EPS = 1e-6f, LN_EPS = 64e-5f;
constexpr size_t MiB = 1u << 20;
constexpr size_t WS_CTL = 0, CTL_BYTES = MiB;
constexpr size_t WS_WIN = 2 * MiB, WS_WOUT = 26 * MiB, WS_WQKV = 34 * MiB, WS_WAO = 52 * MiB, WS_W1 = 54 * MiB, WS_W2 = 86 * MiB, WS_LORA = 118 * MiB;
constexpr size_t WS_MOD = 119 * MiB, WS_ROPE = 123 * MiB, WS_SMALL = 124 * MiB, WS_X = 128 * MiB, WS_XN = 193 * MiB, WS_U = 226 * MiB;
constexpr int RECB = 896;
constexpr size_t WS_DT = 418 * MiB, WS_DTS = 419 * MiB, WS_ACS = 420 * MiB, WS_REC = 421 * MiB, WS_G = 805 * MiB, WS_XT = 837 * MiB, WS_BC = 869 * MiB;
constexpr size_t WS_CS = 885 * MiB, WS_QO = 949 * MiB, WS_SL = 1077 * MiB, WS_SST = 1141 * MiB, WS_YCAT = 1173 * MiB, WS_QKV = 1238 * MiB;
constexpr size_t WS_OG = 1382 * MiB, WS_LSE = 1430 * MiB, WS_AO = 1432 * MiB, WS_HID = 1449 * MiB, WS_END = 1578 * MiB;
constexpr size_t O_YP = 0, O_YS = O_YP + (size_t)T * D, O_SSDP = O_YS + 32 * 1024, O_SSDS = O_SSDP + 2 * 2 * 16 * 8192, O_CONVP = O_SSDS + (size_t)2 * 32 * 16 * 8192;
constexpr size_t O_CONVS = O_CONVP + 2 * 2 * 3 * 1536, O_WKVP = O_CONVS + 2 * 32 * 3 * 1536, O_WKVS = O_WKVP + 2 * 2 * 16 * 4096, O_SHP = O_WKVS + (size_t)2 * 32 * 16 * 4096;
constexpr size_t O_SHS = O_SHP + 2 * 2 * 3328, O_W0P = O_SHS + 2 * 32 * 3328, O_W0S = O_W0P + (size_t)2 * 2 * 128 * 1024, O_W1P = O_W0S + (size_t)2 * 32 * 128 * 1024;
constexpr size_t O_W1S = O_W1P + (size_t)2 * 2 * 512 * 1024, O_W2P = O_W1S + (size_t)2 * 32 * 512 * 1024, O_W2S = O_W2P + (size_t)2 * 2 * 2048 * 1024;
constexpr size_t O_END = O_W2S + (size_t)2 * 32 * 2048 * 1024;
static_assert(O_END == 217889792ull, "output size");
constexpr int LDS_RING = 131072, LDS_MISC = LDS_RING + 320, LDS_BYTES = 147456;

struct Params { const float* in[39]; float* out; unsigned char* ws; };

typedef __bf16 bfv2 __attribute__((ext_vector_type(2)));
__device__ __forceinline__ unsigned pk2(float lo, float hi) { const f32x2 v = (f32x2){lo, hi}; const bfv2 r = __builtin_convertvector(v, bfv2); return __builtin_bit_cast(unsigned, r); }
__device__ __forceinline__ float bflo(unsigned u) { return __uint_as_float(u << 16); }
__device__ __forceinline__ float bfhi(unsigned u) { return __uint_as_float(u & 0xffff0000u); }
__device__ __forceinline__ float bf1(bf16 h) { return __uint_as_float(((unsigned)h) << 16); }
__device__ __forceinline__ f32x4 bf4(u32x2 v) { return (f32x4){bflo(v.x), bfhi(v.x), bflo(v.y), bfhi(v.y)}; }
__device__ __forceinline__ u32x2 pk4(f32x4 v) { u32x2 r; r.x = pk2(v[0], v[1]); r.y = pk2(v[2], v[3]); return r; }
__device__ __forceinline__ float siluf_(float x) { return x * __builtin_amdgcn_rcpf(1.f + __expf(-x)); }
__device__ __forceinline__ float sigm_(float x) { return __builtin_amdgcn_rcpf(1.f + __expf(-x)); }
__device__ __forceinline__ float softplus_(float x) { return fmaxf(x, 0.f) + __logf(1.f + __expf(-fabsf(x))); }
__device__ __forceinline__ float tanh_(float x) { const float t = __expf(-2.f * fabsf(x)); const float r = (1.f - t) * __builtin_amdgcn_rcpf(1.f + t); return x < 0.f ? -r : r; }
__device__ __forceinline__ float wave_sum(float v) {
#pragma unroll
    for (int o = 1; o < 64; o <<= 1) v += __shfl_xor(v, o);
    return v;
}
__device__ __forceinline__ float wave_max(float v) {
#pragma unroll
    for (int o = 1; o < 64; o <<= 1) v = fmaxf(v, __shfl_xor(v, o));
    return v;
}
__device__ __forceinline__ f32x4 mfma16(bf16x8 a, bf16x8 b, f32x4 c) { return __builtin_amdgcn_mfma_f32_16x16x32_bf16(a, b, c, 0, 0, 0); }
#define LDSW() asm volatile("s_waitcnt lgkmcnt(0)" ::: "memory")
#define LDS_BARRIER() do { asm volatile("s_waitcnt lgkmcnt(0)" ::: "memory"); __builtin_amdgcn_s_barrier(); asm volatile("" ::: "memory"); } while (0)

#define CAS __attribute__((address_space(4)))
struct Ctx {
    LAS unsigned char* lds; int tid, lane, wave, G, bid;
    const CAS Params* PP;
};
#define WSP(type, off) ((type*)((C.PP->ws) + (off)))
#define INP(i) (C.PP->in[i])
enum { I_XP = 0, I_XS, I_SSD, I_CONV, I_WKV, I_SHIFT, I_C0, I_C1, I_C2, I_CP, I_CS, I_NMIX, I_NMLP, I_NFIN, I_ADAW, I_ADAB, I_W1, I_W2, I_HIN, I_HOUT, I_CONVW, I_CONVB,
       I_DTB, I_ALOG, I_SSDD, I_SNW, I_MU, I_RW0, I_RW2, I_RA0, I_RA2, I_RG2, I_KK, I_KA, I_RK, I_LNW, I_LNB, I_AQKV, I_AOUT };

__device__ __forceinline__ void transpose_item(const float* W, int K, int N, bf16* WT, LAS float* scr, int item, int lane) {
    const int nblk = (N + 31) / 32, kb = item / nblk, nb = item % nblk, k0 = 64 * kb, n0 = 32 * nb;
    const int nn = n0 + (lane & 31);
#pragma unroll 8
    for (int i = 0; i < 32; ++i) { const int kk = 2 * i + (lane >> 5); scr[kk * 33 + (lane & 31)] = nn < N ? W[(size_t)(k0 + kk) * N + nn] : 0.f; }
    LDSW();
    const int c = lane & 7;
#pragma unroll
    for (int j = 0; j < 4; ++j) { const int n = (lane >> 3) + 8 * j; const LAS float* s = scr + (8 * c) * 33 + n;
        u32x4 o; o.x = pk2(s[0 * 33], s[1 * 33]); o.y = pk2(s[2 * 33], s[3 * 33]); o.z = pk2(s[4 * 33], s[5 * 33]); o.w = pk2(s[6 * 33], s[7 * 33]);
        *(u32x4*)(WT + (size_t)(n0 + n) * K + k0 + 8 * c) = o; }
    LDSW();
}

__device__ __forceinline__ void p0_weights(const Ctx& C) {
    LAS float* scr = (LAS float*)(C.lds + C.wave * 16384);
    const int gw = C.bid * 8 + C.wave, NGW = C.G * 8;
    constexpr int N_IN = 16 * 185, N_OUT = 32 * 32, N_QKV = 16 * 144, N_AO = 8 * 32, N_1 = 16 * 128, N_2 = 64 * 32, N_L64 = 32, N_L128 = 64;
    constexpr int TOTAL = 2 * N_IN + 2 * N_OUT + 2 * N_QKV + 2 * N_AO + 4 * N_1 + 4 * N_2 + 2 * (2 * N_L64 + N_L128);
    for (int it = gw; it < TOTAL; it += NGW) {
        int r = it;
        if (r < 2 * N_IN) { const int i = r / N_IN; transpose_item(INP(I_HIN) + (size_t)i * 1024 * HYB_N, 1024, HYB_N, WSP(bf16, WS_WIN) + (size_t)i * HYB_NP * 1024, scr, r % N_IN, C.lane); continue; } r -= 2 * N_IN;
        if (r < 2 * N_OUT) { const int i = r / N_OUT; transpose_item(INP(I_HOUT) + (size_t)i * 2048 * 1024, 2048, 1024, WSP(bf16, WS_WOUT) + (size_t)i * 1024 * 2048, scr, r % N_OUT, C.lane); continue; } r -= 2 * N_OUT;
        if (r < 2 * N_QKV) { const int i = r / N_QKV; transpose_item(INP(I_AQKV) + (size_t)i * 1024 * QKV_N, 1024, QKV_N, WSP(bf16, WS_WQKV) + (size_t)i * QKV_N * 1024, scr, r % N_QKV, C.lane); continue; } r -= 2 * N_QKV;
        if (r < 2 * N_AO) { const int i = r / N_AO; transpose_item(INP(I_AOUT) + (size_t)i * 512 * 1024, 512, 1024, WSP(bf16, WS_WAO) + (size_t)i * 1024 * 512, scr, r % N_AO, C.lane); continue; } r -= 2 * N_AO;
        if (r < 4 * N_1) { const int i = r / N_1; transpose_item(INP(I_W1) + (size_t)i * 1024 * FF, 1024, FF, WSP(bf16, WS_W1) + (size_t)i * FF * 1024, scr, r % N_1, C.lane); continue; } r -= 4 * N_1;
        if (r < 4 * N_2) { const int i = r / N_2; transpose_item(INP(I_W2) + (size_t)i * FF * 1024, FF, 1024, WSP(bf16, WS_W2) + (size_t)i * 1024 * FF, scr, r % N_2, C.lane); continue; } r -= 4 * N_2;
        { const int i = r / (2 * N_L64 + N_L128); int q = r % (2 * N_L64 + N_L128); bf16* lb = WSP(bf16, WS_LORA) + (size_t)i * 262144;
          if (q < N_L64) { transpose_item(INP(I_RW2) + (size_t)i * 64 * 1024, 64, 1024, lb, scr, q, C.lane); continue; } q -= N_L64;
          if (q < N_L64) { transpose_item(INP(I_RA2) + (size_t)i * 64 * 1024, 64, 1024, lb + 65536, scr, q, C.lane); continue; } q -= N_L64;
          transpose_item(INP(I_RG2) + (size_t)i * 128 * 1024, 128, 1024, lb + 131072, scr, q, C.lane); }
    }
    const int gt = C.bid * NT + C.tid, NGT = C.G * NT;
    for (int i = gt; i < 2 * 224 * 128; i += NGT) { const int l = i / (224 * 128), r = i % (224 * 128); ((u32x4*)(WSP(bf16, WS_WIN) + (size_t)l * HYB_NP * 1024 + (size_t)5920 * 1024))[r] = (u32x4){0u, 0u, 0u, 0u}; }
    for (int i = gt; i < 8193 * 8; i += NGT) { const int t = i >> 3, k = i & 7; const double inv = pow(500000.0, -(double)k / 8.0), ang = (double)t * inv;
        WSP(float, WS_ROPE)[t * 16 + k] = (float)cos(ang); WSP(float, WS_ROPE)[t * 16 + 8 + k] = (float)sin(ang); }
}

__device__ __forceinline__ void cache_roll_slice(const Ctx& C, int part, int nparts, int wk, int nwk) {
    if (wk < 0 || wk >= nwk) return;
#pragma unroll
    for (int g = 0; g < 3; ++g) {
        const int W = 128 << (2 * g); const size_t per = (size_t)(W - 1) * 256, tot = 64 * per, lo = tot * part / nparts, hi = tot * (part + 1) / nparts;
        const f32x4* src = (const f32x4*)INP(I_C0 + g); f32x4* dst = (f32x4*)((C.PP->out) + (g == 0 ? O_W0S : g == 1 ? O_W1S : O_W2S));
        for (size_t i = lo + (size_t)wk * NT + C.tid; i < hi; i += (size_t)nwk * NT) { const size_t ib = i / per, rem = i - ib * per; const f32x4 v = __builtin_nontemporal_load(src + (ib * W + 1) * 256 + rem); __builtin_nontemporal_store(v, dst + ib * W * 256 + rem); }
    }
}

__device__ __forceinline__ void p0_mod(const Ctx& C) {
    LAS f32x4* red = (LAS f32x4*)C.lds;
    const int q = C.lane >> 4, i = C.lane & 15;
    for (int u = C.bid; u < 384; u += C.G) {
        const int l = u / 96, n0 = (u % 96) * 64;
        const float* W = INP(I_ADAW) + (size_t)l * 1024 * 6144;
        f32x4 acc[3][4];
#pragma unroll
        for (int t = 0; t < 3; ++t)
#pragma unroll
            for (int n = 0; n < 4; ++n) acc[t][n] = (f32x4){0.f, 0.f, 0.f, 0.f};
        for (int kg = 0; kg < 8; ++kg) {
            const int k0 = 128 * C.wave + 16 * kg + 4 * q;
            f32x4 av[3], wv[4];
#pragma unroll
            for (int t = 0; t < 3; ++t) { const int s = 16 * t + i; av[t] = (f32x4){0.f, 0.f, 0.f, 0.f};
                if (s < NSEQ) { const float* cp = s < 2 ? INP(I_CP) + s * 1024 : INP(I_CS) + (s - 2) * 1024; const f32x4 v = *(const f32x4*)(cp + k0);
                    av[t] = (f32x4){siluf_(v[0]), siluf_(v[1]), siluf_(v[2]), siluf_(v[3])}; } }
#pragma unroll
            for (int m = 0; m < 4; ++m) wv[m] = *(const f32x4*)(W + (size_t)(k0 + m) * 6144 + n0 + 4 * i);
#pragma unroll
            for (int m = 0; m < 4; ++m)
#pragma unroll
                for (int t = 0; t < 3; ++t)
#pragma unroll
                    for (int n = 0; n < 4; ++n) acc[t][n] = __builtin_amdgcn_mfma_f32_16x16x4f32(av[t][m], wv[m][n], acc[t][n], 0, 0, 0);
        }
#pragma unroll
        for (int t = 0; t < 3; ++t)
#pragma unroll
            for (int r = 0; r < 4; ++r) red[(C.wave * 12 + t * 4 + r) * 64 + C.lane] = (f32x4){acc[t][0][r], acc[t][1][r], acc[t][2][r], acc[t][3][r]};
        __syncthreads();
        for (int e = C.tid; e < 768; e += NT) { const int slot = e >> 6, ln = e & 63; f32x4 s = red[slot * 64 + ln];
#pragma unroll
            for (int w = 1; w < 8; ++w) s += red[(w * 12 + slot) * 64 + ln];
            const int srow = 16 * (slot >> 2) + 4 * (ln >> 4) + (slot & 3), n = n0 + 4 * (ln & 15);
            if (srow < NSEQ) *(f32x4*)(WSP(float, WS_MOD) + ((size_t)l * NSEQ + srow) * 6144 + n) = s + *(const f32x4*)(INP(I_ADAB) + l * 6144 + n); }
        __syncthreads();
    }
}

__device__ __forceinline__ void norm_phase(const Ctx& C, int l, int which, bool from_input) {
    const int gw = C.bid * 8 + C.wave, NGW = C.G * 8;
    const float* g = INP(which ? I_NMLP : I_NMIX) + l * 1024;
    const int off_sh = which ? 3072 : 0, off_sc = which ? 4096 : 1024;
    for (int row = gw; row < T + NS; row += NGW) {
        const float* xr = from_input ? (row < T ? INP(I_XP) + (size_t)row * D : INP(I_XS) + (size_t)(row - T) * D) : WSP(float, WS_X) + (size_t)row * D;
        const int s = row < T ? (row >> 13) : 2 + row - T;
        const float* mod = WSP(float, WS_MOD) + ((size_t)l * NSEQ + s) * 6144;
        f32x4 v[4]; float ss = 0.f;
#pragma unroll
        for (int j = 0; j < 4; ++j) { v[j] = *(const f32x4*)(xr + 4 * C.lane + 256 * j); ss += (v[j][0] * v[j][0] + v[j][1] * v[j][1]) + (v[j][2] * v[j][2] + v[j][3] * v[j][3]); }
        const float rinv = rsqrtf(wave_sum(ss) * (1.f / D) + EPS);
#pragma unroll
        for (int j = 0; j < 4; ++j) { const int c = 4 * C.lane + 256 * j; const f32x4 gg = *(const f32x4*)(g + c), sh = *(const f32x4*)(mod + off_sh + c), sc = *(const f32x4*)(mod + off_sc + c);
            const f32x4 y = v[j] * rinv * gg * (sc + 1.f) + sh; *(u32x2*)(WSP(bf16, WS_XN) + (size_t)row * D + c) = pk4(y); }
    }
}
__device__ __forceinline__ void final_norm_phase(const Ctx& C) {
    const int gw = C.bid * 8 + C.wave, NGW = C.G * 8;
    const float* g = INP(I_NFIN);
    for (int row = gw; row < T + NS; row += NGW) {
        const float* xr = WSP(float, WS_X) + (size_t)row * D; float* o = (C.PP->out) + (row < T ? O_YP + (size_t)row * D : O_YS + (size_t)(row - T) * D);
        f32x4 v[4]; float ss = 0.f;
#pragma unroll
        for (int j = 0; j < 4; ++j) { v[j] = *(const f32x4*)(xr + 4 * C.lane + 256 * j); ss += (v[j][0] * v[j][0] + v[j][1] * v[j][1]) + (v[j][2] * v[j][2] + v[j][3] * v[j][3]); }
        const float rinv = rsqrtf(wave_sum(ss) * (1.f / D) + EPS);
#pragma unroll
        for (int j = 0; j < 4; ++j) { const int c = 4 * C.lane + 256 * j; *(f32x4*)(o + c) = v[j] * rinv * *(const f32x4*)(g + c); }
    }
}

constexpr size_t ROLL_T0 = (size_t)64 * 127 * 256, ROLL_T1 = (size_t)64 * 511 * 256, ROLL_T2 = (size_t)64 * 2047 * 256, ROLL_TOT = ROLL_T0 + ROLL_T1 + ROLL_T2;
constexpr int ROLL_NSL = 28 * 256, ROLL_L = (int)((ROLL_TOT + ROLL_NSL - 1) / ROLL_NSL);
static_assert(ROLL_L <= 12 * 512, "roll slice size");
struct RollArgs { const float* c0; const float* c1; const float* c2; float* out; int slot0; int* cnt; int bid; };
__device__ __forceinline__ void roll_addr(const RollArgs& R, size_t idx, const f32x4*& src, f32x4*& dst) {
    if (idx < ROLL_T0) { const size_t ib = idx / (127 * 256), rem = idx - ib * (127 * 256); src = (const f32x4*)R.c0 + (ib * 128 + 1) * 256 + rem; dst = (f32x4*)(R.out + O_W0S) + ib * 128 * 256 + rem; }
    else if (idx < ROLL_T0 + ROLL_T1) { const size_t j = idx - ROLL_T0, ib = j / (511 * 256), rem = j - ib * (511 * 256); src = (const f32x4*)R.c1 + (ib * 512 + 1) * 256 + rem; dst = (f32x4*)(R.out + O_W1S) + ib * 512 * 256 + rem; }
    else { const size_t j = idx - ROLL_T0 - ROLL_T1, ib = j / (2047 * 256), rem = j - ib * (2047 * 256); src = (const f32x4*)R.c2 + (ib * 2048 + 1) * 256 + rem; dst = (f32x4*)(R.out + O_W2S) + ib * 2048 * 256 + rem; }
}
#define ROLL_LOADS(R, tid) f32x4 _rv[12]; f32x4* _rd[12]; { const int _slice = ((R).slot0 + (*(R).cnt)++) * 256 + (R).bid; const size_t _b = (size_t)_slice * ROLL_L, _e = (_b + ROLL_L < ROLL_TOT) ? _b + ROLL_L : ROLL_TOT; \
    _Pragma("unroll") for (int _k = 0; _k < 12; ++_k) { const size_t _i = _b + (size_t)_k * 512 + (tid); _rd[_k] = nullptr; if (_i < _e) { const f32x4* _s; roll_addr(R, _i, _s, _rd[_k]); _rv[_k] = __builtin_nontemporal_load(_s); } } }
#define ROLL_STORES() do { _Pragma("unroll") for (int _k = 0; _k < 12; ++_k) if (_rd[_k]) __builtin_nontemporal_store(_rv[_k], _rd[_k]); } while (0)

using pg8::Unit;
struct EpiIn {
    static constexpr bool PERM = true, AFTER_DRAIN = false;
    bf16* U; float* DT; RollArgs R; bool roll;
    __device__ __forceinline__ void operator()(const f32x4 (&acc)[2][2][4][2], const Unit& u, int wr, int wc, int fr, int fq) const {
        const int row0 = u.pm * 256 + wr * 64 + fr, col0 = u.pn * 256 + wc * 32 + 8 * fq;
        ROLL_LOADS(R, (roll ? (wr * 4 + wc) * 64 + fq * 16 + fr : 1 << 30));
#pragma unroll
        for (int ai = 0; ai < 2; ++ai)
#pragma unroll
            for (int m = 0; m < 4; ++m) { const int row = row0 + ai * 128 + m * 16; bf16* rowp = U + (size_t)row * HYB_NP + col0;
#pragma unroll
                for (int bj = 0; bj < 2; ++bj) { const f32x4 v0 = acc[ai][bj][m][0], v1 = acc[ai][bj][m][1];
                    u32x4 w; w.x = pk2(v0[0], v0[1]); w.y = pk2(v0[2], v0[3]); w.z = pk2(v1[0], v1[1]); w.w = pk2(v1[2], v1[3]); *(u32x4*)(rowp + bj * 128) = w; }
                if (u.pn == 10 && wc == 0 && fq < 2) { *(f32x4*)(DT + (size_t)row * 16 + 8 * fq) = acc[ai][0][m][0]; *(f32x4*)(DT + (size_t)row * 16 + 8 * fq + 4) = acc[ai][0][m][1]; } }
        ROLL_STORES();
    }
};
struct EpiRes {
    static constexpr bool PERM = false, AFTER_DRAIN = false;
    const float* xin; float* xout; const float* gate;
    __device__ __forceinline__ void operator()(const f32x4 (&acc)[2][2][4][2], const Unit& u, int wr, int wc, int fr, int fq) const {
        const int row0 = u.pm * 256 + wr * 64 + fr, col0 = u.pn * 256 + wc * 32 + 4 * fq;
#pragma unroll
        for (int ai = 0; ai < 2; ++ai)
#pragma unroll
            for (int m = 0; m < 4; ++m) { const int row = row0 + ai * 128 + m * 16; const float* gp = gate + (size_t)(row >> 13) * 6144 + col0; const size_t off = (size_t)row * D + col0;
#pragma unroll
                for (int bj = 0; bj < 2; ++bj)
#pragma unroll
                    for (int n = 0; n < 2; ++n) { const int o = bj * 128 + n * 16; *(f32x4*)(xout + off + o) = *(const f32x4*)(xin + off + o) + *(const f32x4*)(gp + o) * acc[ai][bj][m][n]; } }
    }
};
struct EpiMlp1 {
    static constexpr bool PERM = true, AFTER_DRAIN = false;
    bf16* H; RollArgs R; bool roll;
    __device__ __forceinline__ void operator()(const f32x4 (&acc)[2][2][4][2], const Unit& u, int wr, int wc, int fr, int fq) const {
        const int row0 = u.pm * 256 + wr * 64 + fr, col0 = u.pn * 256 + wc * 32 + 8 * fq;
        ROLL_LOADS(R, (roll ? (wr * 4 + wc) * 64 + fq * 16 + fr : 1 << 30));
#pragma unroll
        for (int ai = 0; ai < 2; ++ai)
#pragma unroll
            for (int m = 0; m < 4; ++m) { bf16* rowp = H + (size_t)(row0 + ai * 128 + m * 16) * FF + col0;
#pragma unroll
                for (int bj = 0; bj < 2; ++bj) { f32x4 v0 = acc[ai][bj][m][0], v1 = acc[ai][bj][m][1];
#pragma unroll
                    for (int j = 0; j < 4; ++j) { const float a = fmaxf(v0[j], 0.f), b = fmaxf(v1[j], 0.f); v0[j] = a * a; v1[j] = b * b; }
                    u32x4 w; w.x = pk2(v0[0], v0[1]); w.y = pk2(v0[2], v0[3]); w.z = pk2(v1[0], v1[1]); w.w = pk2(v1[2], v1[3]); *(u32x4*)(rowp + bj * 128) = w; } }
        ROLL_STORES();
    }
};
struct EpiQkv {
    static constexpr bool PERM = true, AFTER_DRAIN = false;
    bf16* QKV; const float* rope; float* out; int li;
    __device__ __forceinline__ void operator()(const f32x4 (&acc)[2][2][4][2], const Unit& u, int wr, int wc, int fr, int fq) const {
        const int row0 = u.pm * 256 + wr * 64 + fr, colt = u.pn * 256, col0 = colt + wc * 32 + 8 * fq;
        const int grp = colt / 1536, s = (colt % 1536) / 512;
        const bool do_rope = (s < 2) && ((wc & 1) == 0);
        const int W = 128 << (2 * grp);
        float* wout = out + (grp == 0 ? O_W0P : grp == 1 ? O_W1P : O_W2P);
#pragma unroll
        for (int ai = 0; ai < 2; ++ai)
#pragma unroll
            for (int m = 0; m < 4; ++m) { const int row = row0 + ai * 128 + m * 16, t = row & 8191, b = row >> 13;
#pragma unroll
                for (int bj = 0; bj < 2; ++bj) { f32x4 v0 = acc[ai][bj][m][0], v1 = acc[ai][bj][m][1];
                    if (do_rope) {
                        f32x4 p0, p1;
#pragma unroll
                        for (int j = 0; j < 4; ++j) { p0[j] = __shfl_xor(v0[j], 16); p1[j] = __shfl_xor(v1[j], 16); }
                        if (fq < 2) { const f32x4 c0 = *(const f32x4*)(rope + t * 16), c1 = *(const f32x4*)(rope + t * 16 + 4), s0 = *(const f32x4*)(rope + t * 16 + 8), s1 = *(const f32x4*)(rope + t * 16 + 12);
                            if (fq == 0) { v0 = v0 * c0 - p0 * s0; v1 = v1 * c1 - p1 * s1; } else { v0 = v0 * c0 + p0 * s0; v1 = v1 * c1 + p1 * s1; } }
                    }
                    if (s == 0) { v0 *= 0.125f; v1 *= 0.125f; }
                    const int c = col0 + bj * 128;
                    u32x4 w; w.x = pk2(v0[0], v0[1]); w.y = pk2(v0[2], v0[3]); w.z = pk2(v1[0], v1[1]); w.w = pk2(v1[2], v1[3]); *(u32x4*)(QKV + (size_t)row * QKV_N + c) = w;
                    if (s >= 1 && t >= SEQ - W) { const int cc = c - grp * 1536 - s * 512; float* o = wout + ((size_t)(li * 2 + b) * W + (t - (SEQ - W))) * 1024 + (s - 1) * 512 + cc;
                        *(f32x4*)o = v0; *(f32x4*)(o + 4) = v1; }
                } }
    }
};

template <class F> __device__ __forceinline__ void small_gemm(const Ctx& C, const bf16* A, const bf16* Wt, int N, int K, F&& epi) {
    LAS float* red = (LAS float*)C.lds;
    const int kw = K / 8, steps = kw / 16;
    for (int u = C.G - 1 - (int)C.bid; u < N / 32; u += C.G) {
        const int n0 = 32 * u;
        f32x16 acc;
#pragma unroll
        for (int r = 0; r < 16; ++r) acc[r] = 0.f;
        const bf16* wp = Wt + (size_t)(n0 + (C.lane & 31)) * K + C.wave * kw + 8 * (C.lane >> 5);
        const bf16* ap = A + (size_t)(C.lane & 31) * K + C.wave * kw + 8 * (C.lane >> 5);
        for (int ks = 0; ks < steps; ++ks) { const bf16x8 wf = *(const bf16x8*)(wp + 16 * ks), af = *(const bf16x8*)(ap + 16 * ks); acc = __builtin_amdgcn_mfma_f32_32x32x16_bf16(wf, af, acc, 0, 0, 0); }
#pragma unroll
        for (int r = 0; r < 16; ++r) red[(C.wave * 16 + r) * 64 + C.lane] = acc[r];
        __syncthreads();
#pragma unroll
        for (int e2 = 0; e2 < 2; ++e2) { const int e = C.tid + e2 * NT, r = e >> 6, ln = e & 63; float s = 0.f;
#pragma unroll
            for (int w = 0; w < 8; ++w) s += red[(w * 16 + r) * 64 + ln];
            epi(ln & 31, n0 + (r & 3) + 8 * (r >> 2) + 4 * (ln >> 5), s); }
        __syncthreads();
    }
}

__device__ __forceinline__ void rwkv_prep_unit(const Ctx& C, int li, int tile) {
    const int t0 = tile * 64, tl0 = t0 & 8191, b = t0 >> 13, q = C.lane >> 4, fr = C.lane & 15;
    LAS bf16* TXW = (LAS bf16*)C.lds; LAS bf16* XA = TXW + 64 * 72; LAS bf16* SXG = XA + 64 * 72;
    const float* mu = INP(I_MU) + li * RWC;
    {
        const int i = C.tid >> 3, part = C.tid & 7; const bool first = (tl0 + i) == 0;
        const bf16* cur = WSP(bf16, WS_U) + (size_t)(t0 + i) * HYB_NP + U_RW + 3072 + part * 32;
#pragma unroll
        for (int e = 0; e < 4; ++e) { const u32x4 cv = *(const u32x4*)(cur + 8 * e); u32x4 pv = (u32x4){0u, 0u, 0u, 0u}; if (!first) pv = *(const u32x4*)(cur - HYB_NP + 8 * e);
            const float* mp = mu + 3072 + part * 32 + 8 * e; float o[8];
#pragma unroll
            for (int j = 0; j < 4; ++j) { const float c0 = bflo(cv[j]), c1 = bfhi(cv[j]), p0 = bflo(pv[j]), p1 = bfhi(pv[j]); o[2 * j] = c0 + (p0 - c0) * mp[2 * j]; o[2 * j + 1] = c1 + (p1 - c1) * mp[2 * j + 1]; }
            if (part < 2) {
#pragma unroll
                for (int j = 0; j < 8; ++j) o[j] = tanh_(o[j]);
                *(LAS u32x4*)(TXW + i * 72 + part * 32 + 8 * e) = (u32x4){pk2(o[0], o[1]), pk2(o[2], o[3]), pk2(o[4], o[5]), pk2(o[6], o[7])};
            } else if (part < 4) {
                *(LAS u32x4*)(XA + i * 72 + (part - 2) * 32 + 8 * e) = (u32x4){pk2(o[0], o[1]), pk2(o[2], o[3]), pk2(o[4], o[5]), pk2(o[6], o[7])};
            } else {
#pragma unroll
                for (int j = 0; j < 8; ++j) o[j] = sigm_(o[j]);
                *(LAS u32x4*)(SXG + i * 136 + (part - 4) * 32 + 8 * e) = (u32x4){pk2(o[0], o[1]), pk2(o[2], o[3]), pk2(o[4], o[5]), pk2(o[6], o[7])};
            } }
    }
    __syncthreads();
    const bf16* w2t = WSP(bf16, WS_LORA) + (size_t)li * 262144; const bf16* a2t = w2t + 65536; const bf16* g2t = w2t + 131072;
    const float* w0 = INP(I_RW0) + li * 1024; const float* a0 = INP(I_RA0) + li * 1024; const float* kkw = INP(I_KK) + li * 1024; const float* kaw = INP(I_KA) + li * 1024;
    bf16* G = WSP(bf16, WS_G);
    for (int hh = 0; hh < 2; ++hh) { const int h = 2 * C.wave + hh;
        for (int tm = 0; tm < 4; ++tm) {
            bf16x8 fw[2], fa[2], fg[4];
            const int trow = 16 * tm + fr;
#pragma unroll
            for (int ks = 0; ks < 2; ++ks) { fw[ks] = *(const LAS bf16x8*)(TXW + trow * 72 + ks * 32 + 8 * q); fa[ks] = *(const LAS bf16x8*)(XA + trow * 72 + ks * 32 + 8 * q); }
#pragma unroll
            for (int ks = 0; ks < 4; ++ks) fg[ks] = *(const LAS bf16x8*)(SXG + trow * 136 + ks * 32 + 8 * q);
            const int t = t0 + trow, tl = tl0 + trow; const bool first = tl == 0;
            const bf16* urow = WSP(bf16, WS_U) + (size_t)t * HYB_NP + U_RW;
            f32x4 kx[4]; float ssq = 0.f;
#pragma unroll
            for (int tn = 0; tn < 4; ++tn) { const int c = h * 64 + 16 * tn + 4 * q;
                const f32x4 ck = bf4(*(const u32x2*)(urow + 1024 + c)); f32x4 pk = (f32x4){0.f, 0.f, 0.f, 0.f};
                if (!first) pk = bf4(*(const u32x2*)(urow - HYB_NP + 1024 + c));
                kx[tn] = ck + (pk - ck) * *(const f32x4*)(mu + 1024 + c);
                const f32x4 kkv = kx[tn] * *(const f32x4*)(kkw + c);
                ssq += (kkv[0] * kkv[0] + kkv[1] * kkv[1]) + (kkv[2] * kkv[2] + kkv[3] * kkv[3]); }
            ssq += __shfl_xor(ssq, 16); ssq += __shfl_xor(ssq, 32);
            const float inv = 1.f / fmaxf(sqrtf(ssq), 1e-12f);
            unsigned char* rec = WSP(unsigned char, WS_REC) + ((size_t)(b * 16 + h) * SEQ + tl) * RECB;
#pragma unroll 1
            for (int tn = 0; tn < 4; ++tn) { const int c = h * 64 + 16 * tn + 4 * q, nrow = h * 64 + 16 * tn + fr;
                f32x4 xw = (f32x4){0.f, 0.f, 0.f, 0.f}, xa = xw, xg = xw;
#pragma unroll
                for (int ks = 0; ks < 2; ++ks) { xw = mfma16(*(const bf16x8*)(w2t + nrow * 64 + ks * 32 + 8 * q), fw[ks], xw); xa = mfma16(*(const bf16x8*)(a2t + nrow * 64 + ks * 32 + 8 * q), fa[ks], xa); }
#pragma unroll
                for (int ks = 0; ks < 4; ++ks) xg = mfma16(*(const bf16x8*)(g2t + nrow * 128 + ks * 32 + 8 * q), fg[ks], xg);
                const f32x4 cr = bf4(*(const u32x2*)(urow + c)), cv = bf4(*(const u32x2*)(urow + 2048 + c));
                f32x4 pr = (f32x4){0.f, 0.f, 0.f, 0.f}, pv = pr;
                if (!first) { pr = bf4(*(const u32x2*)(urow - HYB_NP + c)); pv = bf4(*(const u32x2*)(urow - HYB_NP + 2048 + c)); }
                const f32x4 rr = cr + (pr - cr) * *(const f32x4*)(mu + c), vv = cv + (pv - cv) * *(const f32x4*)(mu + 2048 + c);
                const f32x4 wl = *(const f32x4*)(w0 + c) + xw, al = *(const f32x4*)(a0 + c) + xa;
                f32x4 wd, av;
#pragma unroll
                for (int j = 0; j < 4; ++j) { const float wlog = -softplus_(-wl[j]) - 0.5f; wd[j] = __expf(-__expf(wlog)); av[j] = sigm_(al[j]); }
                const f32x4 kk4 = (tn == 0 ? kx[0] : tn == 1 ? kx[1] : tn == 2 ? kx[2] : kx[3]);
                const f32x4 kkn = kk4 * *(const f32x4*)(kkw + c) * inv; const f32x4 kp = kk4 * ((av - 1.f) * *(const f32x4*)(kaw + c) + 1.f);
                const int ce = 16 * tn + 4 * q;
                *(f32x4*)(rec + ce * 4) = wd; *(u32x2*)(rec + 256 + ce * 2) = pk4(rr); *(u32x2*)(rec + 384 + ce * 2) = pk4(kp); *(u32x2*)(rec + 512 + ce * 2) = pk4(vv); *(u32x2*)(rec + 640 + ce * 2) = pk4(-kkn); *(u32x2*)(rec + 768 + ce * 2) = pk4(kkn * av);
                *(u32x2*)(G + (size_t)t * 1024 + c) = pk4(xg); }
        }
    }
    if ((tile & 127) == 127) { float* o = (C.PP->out) + O_SHP + (size_t)(li * 2 + b) * RWC; const bf16* ur = WSP(bf16, WS_U) + (size_t)(t0 + 63) * HYB_NP + U_RW;
        for (int c = C.tid; c < RWC; c += NT) o[c] = bf1(ur[c]); }
    __syncthreads();
}

__device__ __forceinline__ void ssd_a_unit(const Ctx& C, int li, int u) {
    const int g = u & 1, c = (u >> 1) & 63, b = u >> 7, t0 = b * SEQ + c * 128, q = C.lane >> 4, fr = C.lane & 15;
    LAS float* SC = (LAS float*)C.lds;
    LAS bf16* BT = (LAS bf16*)(C.lds + 4096);
    LAS bf16* XTs = (LAS bf16*)(C.lds + 4096 + 34816);
    const float* DTr = WSP(float, WS_DT); float* DTS = WSP(float, WS_DTS); float* ACS = WSP(float, WS_ACS);
    bf16* XTg = WSP(bf16, WS_XT) + ((size_t)(b * 64 + c) * 1024) * 128; bf16* BCg = WSP(bf16, WS_BC); float* CS = WSP(float, WS_CS);
    {
        const int h = g * 8 + C.wave; const float bias = INP(I_DTB)[li * 16 + h], A = -__expf(INP(I_ALOG)[li * 16 + h]);
        const int l0 = 2 * C.lane; const float d0 = softplus_(DTr[(size_t)(t0 + l0) * 16 + h] + bias), d1 = softplus_(DTr[(size_t)(t0 + l0 + 1) * 16 + h] + bias);
        const float a0 = d0 * A, a1 = d1 * A; float s = a0 + a1;
#pragma unroll
        for (int o = 1; o < 64; o <<= 1) { const float n = __shfl_up(s, o); if (C.lane >= o) s += n; }
        const float acs1 = s, acs0 = s - a1, tot = __shfl(s, 63);
        DTS[(size_t)(t0 + l0) * 16 + h] = d0; DTS[(size_t)(t0 + l0 + 1) * 16 + h] = d1; ACS[(size_t)(t0 + l0) * 16 + h] = acs0; ACS[(size_t)(t0 + l0 + 1) * 16 + h] = acs1;
        SC[C.wave * 128 + l0] = __expf(tot - acs0) * d0; SC[C.wave * 128 + l0 + 1] = __expf(tot - acs1) * d1;
    }
    __syncthreads();
    const float* cw = INP(I_CONVW) + (size_t)li * 4 * 1536; const float* cb = INP(I_CONVB) + (size_t)li * 1536;
    for (int pass = 0; pass < 2; ++pass) {
        const int nitems = pass == 0 ? 16 : 8;
        for (int it = C.wave; it < nitems; it += 8) { const int tb = it & 7, cblk = pass == 0 ? (it >> 3) : 2;
            int ch;
            if (cblk == 0) ch = (C.lane < 32 ? 1024 + g * 128 + 4 * C.lane : 1280 + g * 128 + 4 * (C.lane - 32)); else ch = g * 512 + (cblk - 1) * 256 + 4 * C.lane;
            const int tl = c * 128 + tb * 16;
            const bf16* up = WSP(bf16, WS_U) + (size_t)(t0 + tb * 16) * HYB_NP + U_XBC + ch;
            f32x4 uu[19];
#pragma unroll
            for (int k = 0; k < 19; ++k) { uu[k] = (f32x4){0.f, 0.f, 0.f, 0.f}; if (tl + k - 3 >= 0) uu[k] = bf4(*(const u32x2*)(up + (ptrdiff_t)(k - 3) * HYB_NP)); }
            const f32x4 w0 = *(const f32x4*)(cw + ch), w1 = *(const f32x4*)(cw + 1536 + ch), w2 = *(const f32x4*)(cw + 3072 + ch), w3 = *(const f32x4*)(cw + 4608 + ch), bb = *(const f32x4*)(cb + ch);
            if (c == 63 && tb == 7) { float* o = (C.PP->out) + O_CONVP + (size_t)(li * 2 + b) * 3 * 1536 + ch; *(f32x4*)o = uu[16]; *(f32x4*)(o + 1536) = uu[17]; *(f32x4*)(o + 3072) = uu[18]; }
            f32x4 y[16];
#pragma unroll
            for (int k = 0; k < 16; ++k) { f32x4 v = bb + w0 * uu[k] + w1 * uu[k + 1] + w2 * uu[k + 2] + w3 * uu[k + 3];
#pragma unroll
                for (int j = 0; j < 4; ++j) v[j] = siluf_(v[j]);
                y[k] = v; }
            if (cblk == 0) {
                const bool isB = C.lane < 32; const int n = 4 * (C.lane & 31);
#pragma unroll
                for (int k = 0; k < 16; ++k) *(u32x2*)(BCg + (size_t)(t0 + tb * 16 + k) * 512 + (isB ? 0 : 256) + g * 128 + n) = pk4(y[k]);
                if (isB) {
#pragma unroll
                    for (int j = 0; j < 4; ++j) { u32x4 lo, hi;
                        lo.x = pk2(y[0][j], y[1][j]); lo.y = pk2(y[2][j], y[3][j]); lo.z = pk2(y[4][j], y[5][j]); lo.w = pk2(y[6][j], y[7][j]);
                        hi.x = pk2(y[8][j], y[9][j]); hi.y = pk2(y[10][j], y[11][j]); hi.z = pk2(y[12][j], y[13][j]); hi.w = pk2(y[14][j], y[15][j]);
                        *(LAS u32x4*)(BT + (n + j) * 136 + tb * 16) = lo; *(LAS u32x4*)(BT + (n + j) * 136 + tb * 16 + 8) = hi; } }
            } else {
                const int xc = (cblk - 1) * 256 + 4 * C.lane;
                const int hl = xc >> 6;
                const int xl = (pass == 0 ? xc : xc - 256);
                float sc[16];
#pragma unroll
                for (int k = 0; k < 16; ++k) sc[k] = SC[hl * 128 + tb * 16 + k];
#pragma unroll
                for (int j = 0; j < 4; ++j) { u32x4 lo, hi;
                    lo.x = pk2(y[0][j], y[1][j]); lo.y = pk2(y[2][j], y[3][j]); lo.z = pk2(y[4][j], y[5][j]); lo.w = pk2(y[6][j], y[7][j]);
                    hi.x = pk2(y[8][j], y[9][j]); hi.y = pk2(y[10][j], y[11][j]); hi.z = pk2(y[12][j], y[13][j]); hi.w = pk2(y[14][j], y[15][j]);
                    bf16* gp = XTg + (size_t)(g * 512 + xc + j) * 128 + tb * 16; *(u32x4*)gp = lo; *(u32x4*)(gp + 8) = hi;
                    lo.x = pk2(y[0][j] * sc[0], y[1][j] * sc[1]); lo.y = pk2(y[2][j] * sc[2], y[3][j] * sc[3]); lo.z = pk2(y[4][j] * sc[4], y[5][j] * sc[5]); lo.w = pk2(y[6][j] * sc[6], y[7][j] * sc[7]);
                    hi.x = pk2(y[8][j] * sc[8], y[9][j] * sc[9]); hi.y = pk2(y[10][j] * sc[10], y[11][j] * sc[11]); hi.z = pk2(y[12][j] * sc[12], y[13][j] * sc[13]); hi.w = pk2(y[14][j] * sc[14], y[15][j] * sc[15]);
                    *(LAS u32x4*)(XTs + (xl + j) * 136 + tb * 16) = lo; *(LAS u32x4*)(XTs + (xl + j) * 136 + tb * 16 + 8) = hi; }
            }
        }
        __syncthreads();
        { const int hl = C.wave >> 1, h = g * 8 + pass * 4 + hl;
          float* csp = CS + (((size_t)(b * 64 + c) * 16 + h) * 64) * 128;
#pragma unroll
          for (int tmi = 0; tmi < 2; ++tmi) { const int tm = (C.wave & 1) * 2 + tmi; bf16x8 xf[4];
#pragma unroll
              for (int ks = 0; ks < 4; ++ks) xf[ks] = *(const LAS bf16x8*)(XTs + (hl * 64 + 16 * tm + fr) * 136 + ks * 32 + 8 * q);
#pragma unroll
              for (int tn = 0; tn < 8; ++tn) { f32x4 acc = (f32x4){0.f, 0.f, 0.f, 0.f};
#pragma unroll
                  for (int ks = 0; ks < 4; ++ks) acc = mfma16(*(const LAS bf16x8*)(BT + (16 * tn + fr) * 136 + ks * 32 + 8 * q), xf[ks], acc);
                  *(f32x4*)(csp + (size_t)(16 * tm + fr) * 128 + 16 * tn + 4 * q) = acc; } }
        }
        __syncthreads();
    }
}

__device__ __forceinline__ void rwkv_scan_unit(const Ctx& C, int unit) {
    const int bh = unit >> 3, c = (unit & 7) * 8 + C.wave, lane = C.lane;
    const unsigned char* rec = WSP(unsigned char, WS_REC) + ((size_t)bh * SEQ + c * 128) * RECB;
    unsigned* qo = WSP(unsigned, WS_QO) + ((size_t)bh * SEQ + c * 128) * 64;
    LAS float* buf = (LAS float*)(C.lds + C.wave * 12288);
    f32x2 Sl[32], Pm[32];
    int lopq = lane; asm volatile("" : "+v"(lopq));
#pragma unroll
    for (int j = 0; j < 32; ++j) { Sl[j] = (f32x2){0.f, 0.f}; Pm[j] = (f32x2){(2 * j == lopq) ? 1.f : 0.f, (2 * j + 1 == lopq) ? 1.f : 0.f}; }
    LAS unsigned char* raw = C.lds + 98304 + C.wave * 3584;
#define RW_LOAD(sbi) do { const unsigned char* _p = rec + (size_t)(sbi) * 3584; \
        __builtin_amdgcn_global_load_lds((const unsigned*)(_p + lane * 16), (LAS unsigned*)raw, 16, 0, 0); __builtin_amdgcn_global_load_lds((const unsigned*)(_p + 1024 + lane * 16), (LAS unsigned*)(raw + 1024), 16, 0, 0); \
        __builtin_amdgcn_global_load_lds((const unsigned*)(_p + 2048 + lane * 16), (LAS unsigned*)(raw + 2048), 16, 0, 0); if (lane < 32) __builtin_amdgcn_global_load_lds((const unsigned*)(_p + 3072 + lane * 16), (LAS unsigned*)(raw + 3072), 16, 0, 0); } while (0)
#define RW_PUT16(dst, o, v4) do { const int _s = (o) / RECB, _f = (o) - _s * RECB; LAS float* _d = (dst) + _s * 384; \
        if (_f < 256) { *(LAS f32x4*)(_d + 64 + (_f >> 2)) = __builtin_bit_cast(f32x4, v4); } \
        else { const int _e = (_f - 256) >> 1, _v = _e >> 6, _i = _e & 63; LAS float* _q = _d + (_v == 0 ? 0 : 64 + 64 * _v) + _i; \
               *(LAS f32x4*)_q = (f32x4){bflo((v4)[0]), bfhi((v4)[0]), bflo((v4)[1]), bfhi((v4)[1])}; *(LAS f32x4*)(_q + 4) = (f32x4){bflo((v4)[2]), bfhi((v4)[2]), bflo((v4)[3]), bfhi((v4)[3])}; } } while (0)
#define RW_STORE(dst, W0) do { if (W0) asm volatile("s_waitcnt vmcnt(0)" ::: "memory"); else asm volatile("s_waitcnt vmcnt(4)" ::: "memory");     { const u32x4 _a = *(const LAS u32x4*)(raw + lane * 16); RW_PUT16(dst, lane * 16, _a); } { const u32x4 _a = *(const LAS u32x4*)(raw + 1024 + lane * 16); RW_PUT16(dst, 1024 + lane * 16, _a); } \
        { const u32x4 _a = *(const LAS u32x4*)(raw + 2048 + lane * 16); RW_PUT16(dst, 2048 + lane * 16, _a); } if (lane < 32) { const u32x4 _a = *(const LAS u32x4*)(raw + 3072 + lane * 16); RW_PUT16(dst, 3072 + lane * 16, _a); } \
        asm volatile("s_waitcnt lgkmcnt(0)" ::: "memory"); } while (0)
    RW_LOAD(0); RW_STORE(buf, true); RW_LOAD(1);
    float sa_s = 0.f, sa_p = buf[256 + lane];
    for (int sb = 0; sb < 32; ++sb) {
        LAS float* cb = buf + (sb & 1) * 1536; LAS float* nb = buf + ((sb + 1) & 1) * 1536;
        if (sb + 1 < 32) RW_STORE(nb, sb == 0);
        if (sb + 2 < 32) RW_LOAD(sb + 2);
        for (int st = 0; st < 4; ++st) {
            const LAS float* v = cb + st * 384; const LAS float* nx = (st < 3) ? v + 384 : nb;
            const float vv = v[192 + lane];
            const f32x2 vv2 = (f32x2){vv, vv}, sas = (f32x2){sa_s, sa_s}, sap = (f32x2){sa_p, sa_p};
            f32x2 o2a = (f32x2){0.f, 0.f}, o2b = o2a, q2a = o2a, q2b = o2a, ns2a = o2a, ns2b = o2a, np2a = o2a, np2b = o2a;
            f32x4 r4 = *(const LAS f32x4*)(v), w4 = *(const LAS f32x4*)(v + 64), k4 = *(const LAS f32x4*)(v + 128), b4 = *(const LAS f32x4*)(v + 320), n4 = *(const LAS f32x4*)(nx + 256);
#pragma unroll
            for (int j = 0; j < 16; ++j) {
                f32x4 r4n = r4, w4n = w4, k4n = k4, b4n = b4, n4n = n4;
                if (j < 15) { r4n = *(const LAS f32x4*)(v + 4 * j + 4); w4n = *(const LAS f32x4*)(v + 64 + 4 * j + 4); k4n = *(const LAS f32x4*)(v + 128 + 4 * j + 4); b4n = *(const LAS f32x4*)(v + 320 + 4 * j + 4); n4n = *(const LAS f32x4*)(nx + 256 + 4 * j + 4); }
                {   const f32x2 r2 = (f32x2){r4[0], r4[1]}, w2 = (f32x2){w4[0], w4[1]}, k2 = (f32x2){k4[0], k4[1]}, b2 = (f32x2){b4[0], b4[1]}, n2 = (f32x2){n4[0], n4[1]};
                    f32x2 t = vv2 * k2; t = sas * b2 + t; Sl[2 * j] = Sl[2 * j] * w2 + t; o2a = Sl[2 * j] * r2 + o2a; ns2a = Sl[2 * j] * n2 + ns2a;
                    f32x2 tp = sap * b2; Pm[2 * j] = Pm[2 * j] * w2 + tp; q2a = Pm[2 * j] * r2 + q2a; np2a = Pm[2 * j] * n2 + np2a; }
                {   const f32x2 r2 = (f32x2){r4[2], r4[3]}, w2 = (f32x2){w4[2], w4[3]}, k2 = (f32x2){k4[2], k4[3]}, b2 = (f32x2){b4[2], b4[3]}, n2 = (f32x2){n4[2], n4[3]};
                    f32x2 t = vv2 * k2; t = sas * b2 + t; Sl[2 * j + 1] = Sl[2 * j + 1] * w2 + t; o2b = Sl[2 * j + 1] * r2 + o2b; ns2b = Sl[2 * j + 1] * n2 + ns2b;
                    f32x2 tp = sap * b2; Pm[2 * j + 1] = Pm[2 * j + 1] * w2 + tp; q2b = Pm[2 * j + 1] * r2 + q2b; np2b = Pm[2 * j + 1] * n2 + np2b; }
                r4 = r4n; w4 = w4n; k4 = k4n; b4 = b4n; n4 = n4n;
            }
            const f32x2 o2 = o2a + o2b, q2 = q2a + q2b, ns2 = ns2a + ns2b, np2 = np2a + np2b;
            qo[(size_t)(sb * 4 + st) * 64 + lane] = pk2(o2[0] + o2[1], q2[0] + q2[1]);
            sa_s = ns2[0] + ns2[1]; sa_p = np2[0] + np2[1];
        }
    }
    float* sl = WSP(float, WS_SL) + ((size_t)(bh * 64 + c) * 2) * 4096 + lane * 64;
#pragma unroll
    for (int j = 0; j < 16; ++j) { *(f32x4*)(sl + 4 * j) = (f32x4){Sl[2 * j][0], Sl[2 * j][1], Sl[2 * j + 1][0], Sl[2 * j + 1][1]}; *(f32x4*)(sl + 4096 + 4 * j) = (f32x4){Pm[2 * j][0], Pm[2 * j][1], Pm[2 * j + 1][0], Pm[2 * j + 1][1]}; }
}

__device__ __forceinline__ void ssd_scan_phase(const Ctx& C, int li) {
    const int gt = C.bid * NT + C.tid;
    if (gt >= 131072) return;
    const int n2 = gt & 63, p = (gt >> 6) & 63, h = (gt >> 12) & 15, b = gt >> 16;
    float* CS = WSP(float, WS_CS); const float* ACS = WSP(float, WS_ACS);
    f32x2 S = (f32x2){0.f, 0.f};
#pragma unroll 4
    for (int c = 0; c < 64; ++c) { float* ptr = CS + (((size_t)(b * 64 + c) * 16 + h) * 64 + p) * 128 + 2 * n2; const f32x2 v = *(const f32x2*)ptr; *(f32x2*)ptr = S;
        const float dec = __expf(ACS[(size_t)(b * SEQ + c * 128 + 127) * 16 + h]); S = S * dec + v; }
    *(f32x2*)((C.PP->out) + O_SSDP + ((size_t)((li * 2 + b) * 16 + h) * 64 + p) * 128 + 2 * n2) = S;
}

__device__ __forceinline__ void rwkv_combine_unit(const Ctx& C, int li, int bh) {
    LAS float* Ss = (LAS float*)C.lds;
    LAS float* Ps = Ss + 64 * 68;
    const int q = C.lane >> 4, fr = C.lane & 15, tm = C.wave >> 1, tnb = (C.wave & 1) * 2;
    const float* SL = WSP(float, WS_SL) + (size_t)bh * 64 * 2 * 4096; float* SST = WSP(float, WS_SST) + (size_t)bh * 64 * 4096;
    for (int e = C.tid; e < 64 * 68; e += NT) Ss[e] = 0.f;
    const int r0 = C.tid >> 4, c4 = (C.tid & 15) * 4;
    f32x4 pn0 = *(const f32x4*)(SL + 4096 + r0 * 64 + c4), pn1 = *(const f32x4*)(SL + 4096 + (r0 + 32) * 64 + c4);
    f32x4 ln[2];
#pragma unroll
    for (int t2 = 0; t2 < 2; ++t2)
#pragma unroll
        for (int r = 0; r < 4; ++r) ln[t2][r] = SL[(16 * tm + 4 * q + r) * 64 + 16 * (tnb + t2) + fr];
    __syncthreads();
    for (int c = 0; c < 64; ++c) {
        *(LAS f32x4*)(Ps + r0 * 72 + c4) = pn0; *(LAS f32x4*)(Ps + (r0 + 32) * 72 + c4) = pn1;
        f32x4 acc[2] = {ln[0], ln[1]};
        if (c + 1 < 64) { const float* Ln = SL + (size_t)(c + 1) * 8192; pn0 = *(const f32x4*)(Ln + 4096 + r0 * 64 + c4); pn1 = *(const f32x4*)(Ln + 4096 + (r0 + 32) * 64 + c4);
#pragma unroll
            for (int t2 = 0; t2 < 2; ++t2)
#pragma unroll
                for (int r = 0; r < 4; ++r) ln[t2][r] = Ln[(16 * tm + 4 * q + r) * 64 + 16 * (tnb + t2) + fr]; }
        LDS_BARRIER();
        *(f32x4*)(SST + (size_t)c * 4096 + r0 * 64 + c4) = *(const LAS f32x4*)(Ss + r0 * 68 + c4); *(f32x4*)(SST + (size_t)c * 4096 + (r0 + 32) * 64 + c4) = *(const LAS f32x4*)(Ss + (r0 + 32) * 68 + c4);
        { float av[16], bv[2][16];
#pragma unroll
          for (int k = 0; k < 16; ++k) { av[k] = Ss[(16 * tm + fr) * 68 + 4 * k + q]; bv[0][k] = Ps[(4 * k + q) * 72 + 16 * tnb + fr]; bv[1][k] = Ps[(4 * k + q) * 72 + 16 * (tnb + 1) + fr]; }
#pragma unroll
          for (int k = 0; k < 16; ++k) { acc[0] = __builtin_amdgcn_mfma_f32_16x16x4f32(av[k], bv[0][k], acc[0], 0, 0, 0); acc[1] = __builtin_amdgcn_mfma_f32_16x16x4f32(av[k], bv[1][k], acc[1], 0, 0, 0); } }
        LDS_BARRIER();
#pragma unroll
        for (int t2 = 0; t2 < 2; ++t2)
#pragma unroll
            for (int r = 0; r < 4; ++r) Ss[(16 * tm + 4 * q + r) * 68 + 16 * (tnb + t2) + fr] = acc[t2][r];
        LDS_BARRIER();
    }
    float* o = (C.PP->out) + O_WKVP + (size_t)(li * 32 + bh) * 4096;
    *(f32x4*)(o + r0 * 64 + c4) = *(const LAS f32x4*)(Ss + r0 * 68 + c4); *(f32x4*)(o + (r0 + 32) * 64 + c4) = *(const LAS f32x4*)(Ss + (r0 + 32) * 68 + c4);
    __syncthreads();
}

__device__ __forceinline__ void ssd_c_unit(const Ctx& C, int li, int u) {
    const int g = u & 1, c = (u >> 1) & 63, b = u >> 7, t0 = b * SEQ + c * 128, q = C.lane >> 4, fr = C.lane & 15, w = C.wave;
    LAS bf16* Cb = (LAS bf16*)C.lds;
    LAS bf16* Bb = Cb + 128 * 136;
    LAS bf16* XTh = Bb; LAS bf16* SINh = Bb + 64 * 136;
    LAS bf16* Mw = Bb + 128 * 136 + w * (16 * 136);
    LAS float* AD = (LAS float*)(Bb + 128 * 136 + 8 * 16 * 136);
    const bf16* BCg = WSP(bf16, WS_BC); const float* DTS = WSP(float, WS_DTS); const float* ACS = WSP(float, WS_ACS);
    const bf16* XTg = WSP(bf16, WS_XT) + ((size_t)(b * 64 + c) * 1024 + g * 512) * 128; const float* CS = WSP(float, WS_CS) + ((size_t)(b * 64 + c) * 16 + g * 8) * 8192;
    bf16* Y = WSP(bf16, WS_YCAT);
    for (int e = C.tid; e < 4096; e += NT) { const int r = e >> 5, cc = e & 31, isC = cc >> 4, c8 = (cc & 15) * 8;
        const u32x4 v = *(const u32x4*)(BCg + (size_t)(t0 + r) * 512 + (isC ? 256 : 0) + g * 128 + c8); *(LAS u32x4*)((isC ? Cb : Bb) + r * 136 + c8) = v; }
    __syncthreads();
    f32x4 cbv[8]; bf16x8 cf[4];
#pragma unroll
    for (int ks = 0; ks < 4; ++ks) cf[ks] = *(const LAS bf16x8*)(Cb + (16 * w + fr) * 136 + ks * 32 + 8 * q);
#pragma unroll
    for (int tn = 0; tn < 8; ++tn) { cbv[tn] = (f32x4){0.f, 0.f, 0.f, 0.f};
        if (tn <= w) {
#pragma unroll
            for (int ks = 0; ks < 4; ++ks) cbv[tn] = mfma16(*(const LAS bf16x8*)(Bb + (16 * tn + fr) * 136 + ks * 32 + 8 * q), cf[ks], cbv[tn]); } }
    __syncthreads();
    float ssq = 0.f;
    const int l = 16 * w + fr;
    bf16* yrow = Y + (size_t)(t0 + l) * 2048 + g * 512;
    const int r0 = C.tid >> 4, c8 = (C.tid & 15) * 8;
    u32x4 xq0, xq1; f32x4 sq0, sq1, sq2, sq3; float adq = 0.f;
#define SC_LOAD(hh_) do { const bf16* _x = XTg + (size_t)((hh_) * 64 + r0) * 128 + c8; xq0 = *(const u32x4*)_x; xq1 = *(const u32x4*)(_x + 32 * 128); \
        const float* _s = CS + (size_t)(hh_) * 8192 + r0 * 128 + c8; sq0 = *(const f32x4*)_s; sq1 = *(const f32x4*)(_s + 4); sq2 = *(const f32x4*)(_s + 32 * 128); sq3 = *(const f32x4*)(_s + 32 * 128 + 4); \
        if (C.tid < 256) adq = (C.tid < 128 ? ACS : DTS)[(size_t)(t0 + (C.tid & 127)) * 16 + g * 8 + (hh_)]; } while (0)
    SC_LOAD(0);
#pragma unroll 1
    for (int hh = 0; hh < 8; ++hh) { const int h = g * 8 + hh;
        *(LAS u32x4*)(XTh + r0 * 136 + c8) = xq0; *(LAS u32x4*)(XTh + (r0 + 32) * 136 + c8) = xq1;
        *(LAS u32x4*)(SINh + r0 * 136 + c8) = (u32x4){pk2(sq0[0], sq0[1]), pk2(sq0[2], sq0[3]), pk2(sq1[0], sq1[1]), pk2(sq1[2], sq1[3])};
        *(LAS u32x4*)(SINh + (r0 + 32) * 136 + c8) = (u32x4){pk2(sq2[0], sq2[1]), pk2(sq2[2], sq2[3]), pk2(sq3[0], sq3[1]), pk2(sq3[2], sq3[3])};
        if (C.tid < 256) AD[C.tid] = adq;
        u32x2 zq[4];
#pragma unroll
        for (int tp = 0; tp < 4; ++tp) zq[tp] = *(const u32x2*)(WSP(bf16, WS_U) + (size_t)(t0 + l) * HYB_NP + h * 64 + 16 * tp + 4 * q);
        if (hh + 1 < 8) SC_LOAD(hh + 1);
        LDS_BARRIER();
        const float acl = AD[l];
#pragma unroll
        for (int tn = 0; tn < 8; ++tn) { f32x4 mv = (f32x4){0.f, 0.f, 0.f, 0.f};
            if (tn <= w) { const f32x4 as = *(const LAS f32x4*)(AD + 16 * tn + 4 * q), ds = *(const LAS f32x4*)(AD + 128 + 16 * tn + 4 * q);
#pragma unroll
                for (int j = 0; j < 4; ++j) { const int s = 16 * tn + 4 * q + j; mv[j] = (s <= l) ? cbv[tn][j] * __expf(acl - as[j]) * ds[j] : 0.f; } }
            *(LAS u32x2*)(Mw + fr * 136 + 16 * tn + 4 * q) = pk4(mv); }
        LDSW();
        const float eal = __expf(acl), Dh = INP(I_SSDD)[li * 16 + h];
        const int nks = (w + 2) >> 1;
#pragma unroll
        for (int tp = 0; tp < 4; ++tp) { f32x4 a1 = (f32x4){0.f, 0.f, 0.f, 0.f}, a2 = a1;
            for (int ks = 0; ks < nks; ++ks) a1 = mfma16(*(const LAS bf16x8*)(XTh + (16 * tp + fr) * 136 + ks * 32 + 8 * q), *(const LAS bf16x8*)(Mw + fr * 136 + ks * 32 + 8 * q), a1);
#pragma unroll
            for (int ks = 0; ks < 4; ++ks) a2 = mfma16(*(const LAS bf16x8*)(SINh + (16 * tp + fr) * 136 + ks * 32 + 8 * q), cf[ks], a2);
            const int p0 = 16 * tp + 4 * q;
            const f32x4 z = bf4(zq[tp]);
            f32x4 y;
#pragma unroll
            for (int j = 0; j < 4; ++j) { const float xv = bf1(XTh[(p0 + j) * 136 + l]); y[j] = (a1[j] + eal * a2[j] + Dh * xv) * siluf_(z[j]); }
            const u32x2 yp = pk4(y); const f32x4 yr = bf4(yp); ssq += (yr[0] * yr[0] + yr[1] * yr[1]) + (yr[2] * yr[2] + yr[3] * yr[3]);
            *(u32x2*)(yrow + hh * 64 + p0) = yp; }
        LDS_BARRIER();
    }
#undef SC_LOAD
    ssq += __shfl_xor(ssq, 16); ssq += __shfl_xor(ssq, 32);
    const float rinv = rsqrtf(ssq * (1.f / 512.f) + EPS);
    const float* nw = INP(I_SNW) + li * 1024 + g * 512;
    asm volatile("s_waitcnt vmcnt(0)" ::: "memory");
#pragma unroll 1
    for (int hb = 0; hb < 2; ++hb) { u32x2 yv[16];
#pragma unroll
        for (int k = 0; k < 16; ++k) yv[k] = *(const u32x2*)(yrow + hb * 256 + 16 * k + 4 * q);
#pragma unroll
        for (int k = 0; k < 16; ++k) { const int cc = hb * 256 + 16 * k + 4 * q; *(u32x2*)(yrow + cc) = pk4(bf4(yv[k]) * rinv * *(const f32x4*)(nw + cc)); } }
}

__device__ __forceinline__ void rwkv_out_phase(const Ctx& C, int li) {
    const int q = C.lane >> 4, fr = C.lane & 15, w = C.wave, tr = 16 * w + fr;
    LAS bf16* Qb = (LAS bf16*)C.lds;
    LAS bf16* Sb = Qb + 128 * 72;
    u32x4 pq[4]; f32x4 ps[2]; u32x4 pov[4]; u32x2 pr[4], pk[4], pv[4], pg[4];
#define RO_LOAD(u_) do { const int _c = (u_) & 63, _bh = (u_) >> 6; const unsigned* _qo = WSP(unsigned, WS_QO) + ((size_t)_bh * SEQ + _c * 128) * 64; const float* _sst = WSP(float, WS_SST) + (size_t)(_bh * 64 + _c) * 4096; \
        const unsigned char* _rp = WSP(unsigned char, WS_REC) + ((size_t)_bh * SEQ + _c * 128 + tr) * RECB; const bf16* _g = WSP(bf16, WS_G) + (size_t)((_bh >> 4) * SEQ + _c * 128 + tr) * 1024 + (_bh & 15) * 64; \
        _Pragma("unroll") for (int _i = 0; _i < 4; ++_i) { const int _e = C.tid + _i * NT; pq[_i] = *(const u32x4*)(_qo + (size_t)(_e >> 4) * 64 + (_e & 15) * 4); } \
        _Pragma("unroll") for (int _i = 0; _i < 2; ++_i) { const int _e = C.tid + _i * NT; ps[_i] = *(const f32x4*)(_sst + (_e >> 4) * 64 + (_e & 15) * 4); } \
        _Pragma("unroll") for (int _tn = 0; _tn < 4; ++_tn) { const int _cc = 16 * _tn + 4 * q; pov[_tn] = *(const u32x4*)(_qo + (size_t)tr * 64 + _cc); pr[_tn] = *(const u32x2*)(_rp + 256 + _cc * 2); pk[_tn] = *(const u32x2*)(_rp + 384 + _cc * 2); \
            pv[_tn] = *(const u32x2*)(_rp + 512 + _cc * 2); pg[_tn] = *(const u32x2*)(_g + _cc); } } while (0)
    int u = C.bid;
    if (u < 2048) RO_LOAD(u);
    for (; u < 2048; u += C.G) {
        const int c = u & 63, bh = u >> 6, h = bh & 15, b = bh >> 4, t0 = b * SEQ + c * 128;
#pragma unroll
        for (int i = 0; i < 4; ++i) { const int e = C.tid + i * NT; const u32x4 v = pq[i]; u32x2 wv; wv.x = (v[0] >> 16) | (v[1] & 0xffff0000u); wv.y = (v[2] >> 16) | (v[3] & 0xffff0000u); *(LAS u32x2*)(Qb + (e >> 4) * 72 + (e & 15) * 4) = wv; }
#pragma unroll
        for (int i = 0; i < 2; ++i) { const int e = C.tid + i * NT; *(LAS u32x2*)(Sb + (e >> 4) * 72 + (e & 15) * 4) = pk4(ps[i]); }
        u32x4 ov[4]; u32x2 r4[4], k4[4], v4[4], g4[4];
#pragma unroll
        for (int tn = 0; tn < 4; ++tn) { ov[tn] = pov[tn]; r4[tn] = pr[tn]; k4[tn] = pk[tn]; v4[tn] = pv[tn]; g4[tn] = pg[tn]; }
        LDS_BARRIER();
        if (u + C.G < 2048) RO_LOAD(u + C.G);
        bf16x8 qf[2];
#pragma unroll
        for (int ks = 0; ks < 2; ++ks) qf[ks] = *(const LAS bf16x8*)(Qb + tr * 72 + ks * 32 + 8 * q);
        f32x4 o[4]; float sum = 0.f, rk = 0.f;
        const float* rkw = INP(I_RK) + li * 1024 + h * 64;
#pragma unroll
        for (int tn = 0; tn < 4; ++tn) { f32x4 a = (f32x4){bflo(ov[tn][0]), bflo(ov[tn][1]), bflo(ov[tn][2]), bflo(ov[tn][3])};
#pragma unroll
            for (int ks = 0; ks < 2; ++ks) a = mfma16(*(const LAS bf16x8*)(Sb + (16 * tn + fr) * 72 + ks * 32 + 8 * q), qf[ks], a);
            o[tn] = a; sum += (a[0] + a[1]) + (a[2] + a[3]);
            const f32x4 rr = bf4(r4[tn]), kk = bf4(k4[tn]), w4 = *(const f32x4*)(rkw + 16 * tn + 4 * q);
            rk += (rr[0] * kk[0] * w4[0] + rr[1] * kk[1] * w4[1]) + (rr[2] * kk[2] * w4[2] + rr[3] * kk[3] * w4[3]); }
        sum += __shfl_xor(sum, 16); sum += __shfl_xor(sum, 32); rk += __shfl_xor(rk, 16); rk += __shfl_xor(rk, 32);
        const float mean = sum * (1.f / 64.f); float var = 0.f;
#pragma unroll
        for (int tn = 0; tn < 4; ++tn) { const f32x4 d = o[tn] - mean; var += (d[0] * d[0] + d[1] * d[1]) + (d[2] * d[2] + d[3] * d[3]); }
        var += __shfl_xor(var, 16); var += __shfl_xor(var, 32);
        const float rstd = rsqrtf(var * (1.f / 64.f) + LN_EPS);
        const float* lw = INP(I_LNW) + li * 1024 + h * 64; const float* lb = INP(I_LNB) + li * 1024 + h * 64;
        bf16* Y = WSP(bf16, WS_YCAT) + (size_t)(t0 + tr) * 2048 + 1024 + h * 64;
#pragma unroll
        for (int tn = 0; tn < 4; ++tn) { const int cc = 16 * tn + 4 * q; const f32x4 vv = bf4(v4[tn]), gg = bf4(g4[tn]);
            const f32x4 y = ((o[tn] - mean) * rstd * *(const f32x4*)(lw + cc) + *(const f32x4*)(lb + cc) + vv * rk) * gg; *(u32x2*)(Y + cc) = pk4(y); }
        LDS_BARRIER();
    }
#undef RO_LOAD
}

__device__ __forceinline__ void attn_tile_unit(const Ctx& C, int u) {
    const int g = u >> 10, r = u & 1023, b = r >> 9, h = (r >> 6) & 7, qt = r & 63, q = C.lane >> 4, fr = C.lane & 15, w = C.wave;
    const int dsh = 2 * g, tpr = 64 >> dsh, rho = qt / tpr, i0 = (qt % tpr) * 128;
    LAS bf16* Qs = (LAS bf16*)C.lds;
    LAS bf16* Ks = Qs + 128 * 72;
    LAS bf16* VT = Ks + 256 * 72;
    const bf16* QKV = WSP(bf16, WS_QKV) + (size_t)b * SEQ * QKV_N + g * 1536 + h * 64;
    for (int e = C.tid; e < 1024; e += NT) { const int rr = e >> 3, c8 = (e & 7) * 8; const int t = rho + ((i0 + rr) << dsh); *(LAS u32x4*)(Qs + rr * 72 + c8) = *(const u32x4*)(QKV + (size_t)t * QKV_N + c8); }
    for (int e = C.tid; e < 2048; e += NT) { const int kk = e >> 3, c8 = (e & 7) * 8; const int idx = i0 - 128 + kk; u32x4 kv = (u32x4){0u, 0u, 0u, 0u}, vv = kv;
        if (idx >= 0) { const bf16* p = QKV + (size_t)(rho + (idx << dsh)) * QKV_N + c8; kv = *(const u32x4*)(p + 512); vv = *(const u32x4*)(p + 1024); }
        *(LAS u32x4*)(Ks + kk * 72 + c8) = kv;
#pragma unroll
        for (int j = 0; j < 4; ++j) { VT[(c8 + 2 * j) * 264 + kk] = (bf16)(vv[j] & 0xffffu); VT[(c8 + 2 * j + 1) * 264 + kk] = (bf16)(vv[j] >> 16); } }
    __syncthreads();
    bf16x8 qf[2];
#pragma unroll
    for (int ks = 0; ks < 2; ++ks) qf[ks] = *(const LAS bf16x8*)(Qs + (16 * w + fr) * 72 + ks * 32 + 8 * q);
    const int ql = 16 * w + fr, kmin = (i0 == 0) ? 128 : 0;
    f32x4 s[10]; float mx = -3.0e38f;
#pragma unroll
    for (int kt = 0; kt < 10; ++kt) { s[kt] = (f32x4){0.f, 0.f, 0.f, 0.f};
        if (kt < 9) {
#pragma unroll
            for (int ks = 0; ks < 2; ++ks) s[kt] = mfma16(*(const LAS bf16x8*)(Ks + (16 * (w + kt) + fr) * 72 + ks * 32 + 8 * q), qf[ks], s[kt]); }
#pragma unroll
        for (int j = 0; j < 4; ++j) { const int kk = 16 * (w + kt) + 4 * q + j; const bool ok = (kt < 9) && kk >= ql && kk <= ql + 128 && kk >= kmin; s[kt][j] = ok ? s[kt][j] : -3.0e38f; mx = fmaxf(mx, s[kt][j]); } }
    mx = fmaxf(mx, __shfl_xor(mx, 16)); mx = fmaxf(mx, __shfl_xor(mx, 32));
    float lsum = 0.f;
#pragma unroll
    for (int kt = 0; kt < 10; ++kt)
#pragma unroll
        for (int j = 0; j < 4; ++j) { const float p = (s[kt][j] > -1.0e38f) ? __expf(s[kt][j] - mx) : 0.f; s[kt][j] = p; lsum += p; }
    lsum += __shfl_xor(lsum, 16); lsum += __shfl_xor(lsum, 32);
    f32x4 od[4];
#pragma unroll
    for (int tn = 0; tn < 4; ++tn) od[tn] = (f32x4){0.f, 0.f, 0.f, 0.f};
#pragma unroll
    for (int pr = 0; pr < 5; ++pr) { const int ta = w + 2 * pr, tb = (w + 2 * pr + 1 > 15) ? 15 : (w + 2 * pr + 1);
        const u32x2 pa = pk4(s[2 * pr]), pb = pk4(s[2 * pr + 1]); const u32x4 pw = (u32x4){pa.x, pa.y, pb.x, pb.y}; const bf16x8 pf = __builtin_bit_cast(bf16x8, pw);
#pragma unroll
        for (int tn = 0; tn < 4; ++tn) { const LAS bf16* vp = VT + (16 * tn + fr) * 264 + 4 * q; const u32x2 va = *(const LAS u32x2*)(vp + 16 * ta), vb = *(const LAS u32x2*)(vp + 16 * tb);
            const u32x4 vw = (u32x4){va.x, va.y, vb.x, vb.y}; od[tn] = mfma16(__builtin_bit_cast(bf16x8, vw), pf, od[tn]); } }
    const float il = 1.f / lsum; const int t = b * SEQ + rho + ((i0 + ql) << dsh);
    bf16* og = WSP(bf16, WS_OG) + ((size_t)g * T + t) * 512 + h * 64;
#pragma unroll
    for (int tn = 0; tn < 4; ++tn) *(u32x2*)(og + 16 * tn + 4 * q) = pk4(od[tn] * il);
    if (q == 0) WSP(float, WS_LSE)[((size_t)g * T + t) * 8 + h] = mx + __logf(lsum);
    __syncthreads();
}

__device__ __forceinline__ void attn_merge_phase(const Ctx& C) {
    const bf16* OG = WSP(bf16, WS_OG); const float* LSE = WSP(float, WS_LSE); bf16* AO = WSP(bf16, WS_AO);
    for (size_t e = (size_t)C.bid * NT + C.tid; e < (size_t)T * 64; e += (size_t)C.G * NT) { const size_t t = e >> 6; const int c8 = (int)(e & 63) * 8, h = c8 >> 6;
        const float l0 = LSE[t * 8 + h], l1 = LSE[((size_t)T + t) * 8 + h], l2 = LSE[((size_t)2 * T + t) * 8 + h]; const float m = fmaxf(l0, fmaxf(l1, l2));
        float a0 = __expf(l0 - m), a1 = __expf(l1 - m), a2 = __expf(l2 - m); const float inv = 1.f / (a0 + a1 + a2); a0 *= inv; a1 *= inv; a2 *= inv;
        const u32x4 v0 = *(const u32x4*)(OG + t * 512 + c8), v1 = *(const u32x4*)(OG + ((size_t)T + t) * 512 + c8), v2 = *(const u32x4*)(OG + ((size_t)2 * T + t) * 512 + c8); u32x4 o;
#pragma unroll
        for (int j = 0; j < 4; ++j) o[j] = pk2(a0 * bflo(v0[j]) + a1 * bflo(v1[j]) + a2 * bflo(v2[j]), a0 * bfhi(v0[j]) + a1 * bfhi(v1[j]) + a2 * bfhi(v2[j]));
        *(u32x4*)(AO + t * 512 + c8) = o; }
}

__device__ __forceinline__ void s_ssd_unit(const Ctx& C, int li, int u) {
    const int b = u >> 1, g = u & 1, hh = C.wave, h = g * 8 + hh, lane = C.lane;
    LAS float* xs = (LAS float*)(C.lds + hh * 2048);
    LAS float* Bs = xs + 64; LAS float* Cs = xs + 192;
    LAS float* ys = (LAS float*)(C.lds + 16384);
    LAS float* rs = ys + 512;
    const float* us = WSP(float, WS_SMALL) + (size_t)b * HYB_NP;
    const float* cst = INP(I_CONV) + ((size_t)(li * 32 + b) * 3) * 1536;
    const float* cw = INP(I_CONVW) + (size_t)li * 4 * 1536; const float* cb = INP(I_CONVB) + (size_t)li * 1536;
    auto conv = [&](int ch) { return siluf_(cb[ch] + cw[ch] * cst[ch] + cw[1536 + ch] * cst[1536 + ch] + cw[3072 + ch] * cst[3072 + ch] + cw[4608 + ch] * us[U_XBC + ch]); };
    xs[lane] = conv(h * 64 + lane);
    Bs[lane] = conv(1024 + g * 128 + lane); Bs[64 + lane] = conv(1024 + g * 128 + 64 + lane);
    Cs[lane] = conv(1280 + g * 128 + lane); Cs[64 + lane] = conv(1280 + g * 128 + 64 + lane);
    { float* co = (C.PP->out) + O_CONVS + ((size_t)(li * 32 + b) * 3) * 1536;
      for (int e = C.tid; e < 768; e += NT) { const int ch = e < 512 ? g * 512 + e : (e < 640 ? 1024 + g * 128 + (e - 512) : 1280 + g * 128 + (e - 640));
          co[ch] = cst[1536 + ch]; co[1536 + ch] = cst[3072 + ch]; co[3072 + ch] = us[U_XBC + ch]; } }
    LDSW();
    const float dt = softplus_(us[U_DT + h] + INP(I_DTB)[li * 16 + h]), dA = __expf(-dt * __expf(INP(I_ALOG)[li * 16 + h])), Dh = INP(I_SSDD)[li * 16 + h];
    const int pp = lane >> 3, nn = (lane & 7) * 16;
    f32x4 Bv[4], Cv[4];
#pragma unroll
    for (int j = 0; j < 4; ++j) { Bv[j] = *(const LAS f32x4*)(Bs + nn + 4 * j); Cv[j] = *(const LAS f32x4*)(Cs + nn + 4 * j); }
    const float* sin_ = INP(I_SSD) + ((size_t)(li * 32 + b) * 16 + h) * 8192; float* sout = (C.PP->out) + O_SSDS + ((size_t)(li * 32 + b) * 16 + h) * 8192;
    float yv = 0.f;
#pragma unroll
    for (int it = 0; it < 8; ++it) { const int p = it * 8 + pp; const float xp = xs[p], dx = dt * xp; float part = 0.f;
#pragma unroll
        for (int j = 0; j < 4; ++j) { f32x4 s = *(const f32x4*)(sin_ + p * 128 + nn + 4 * j); s = s * dA + Bv[j] * dx; *(f32x4*)(sout + p * 128 + nn + 4 * j) = s;
            part += (s[0] * Cv[j][0] + s[1] * Cv[j][1]) + (s[2] * Cv[j][2] + s[3] * Cv[j][3]); }
        part += __shfl_xor(part, 1); part += __shfl_xor(part, 2); part += __shfl_xor(part, 4);
        if ((lane & 7) == it) yv = part + Dh * xp; }
    { const int p = (lane & 7) * 8 + (lane >> 3); const float z = us[h * 64 + p]; const float y = yv * siluf_(z); ys[hh * 64 + p] = y; const float ss = wave_sum(y * y); if (lane == 0) rs[hh] = ss; }
    __syncthreads();
    { float tot = 0.f;
#pragma unroll
      for (int j = 0; j < 8; ++j) tot += rs[j];
      const float rinv = rsqrtf(tot * (1.f / 512.f) + EPS); const int cc = C.tid;
      WSP(bf16, WS_YCAT)[(size_t)(T + b) * 2048 + g * 512 + cc] = (bf16)(pk2(ys[cc] * rinv * INP(I_SNW)[li * 1024 + g * 512 + cc], 0.f) & 0xffffu); }
    __syncthreads();
}

__device__ __forceinline__ void s_rwkv_unit(const Ctx& C, int li, int b) {
    const int lane = C.lane, tid = C.tid;
    LAS float* mix = (LAS float*)C.lds;
    LAS float* act = mix + 3328;
    LAS float* vec = act + 256;
    LAS float* hv = vec + 3072;
    const float* us = WSP(float, WS_SMALL) + (size_t)b * HYB_NP + U_RW;
    const float* sst = INP(I_SHIFT) + (size_t)(li * 32 + b) * RWC; const float* mu = INP(I_MU) + li * RWC;
    float* sho = (C.PP->out) + O_SHS + (size_t)(li * 32 + b) * RWC;
    for (int c = tid; c < RWC; c += NT) { const float cur = us[c]; mix[c] = cur + (sst[c] - cur) * mu[c]; sho[c] = cur; }
    __syncthreads();
    if (tid < 256) { const float x = mix[3072 + tid]; act[tid] = tid < 64 ? tanhf(x) : (tid < 128 ? x : sigm_(x)); }
    __syncthreads();
    const float* w2 = INP(I_RW2) + (size_t)li * 64 * 1024; const float* a2 = INP(I_RA2) + (size_t)li * 64 * 1024; const float* g2 = INP(I_RG2) + (size_t)li * 128 * 1024;
    {   LAS float* part = hv + 8 * 192;
        const int cq = tid & 63, sl = tid >> 6;
        for (int cb = 0; cb < 4; ++cb) { const int c = cb * 256 + cq * 4;
            f32x4 aw = (f32x4){0.f, 0.f, 0.f, 0.f}, aa = aw, ag = aw;
#pragma unroll
            for (int j = 0; j < 8; ++j) { const int r = sl * 8 + j; aw += *(const f32x4*)(w2 + (size_t)r * 1024 + c) * act[r]; aa += *(const f32x4*)(a2 + (size_t)r * 1024 + c) * act[64 + r]; }
#pragma unroll
            for (int j = 0; j < 16; ++j) { const int r = sl * 16 + j; ag += *(const f32x4*)(g2 + (size_t)r * 1024 + c) * act[128 + r]; }
            *(LAS f32x4*)(part + (sl * 3 + 0) * 1024 + c) = aw; *(LAS f32x4*)(part + (sl * 3 + 1) * 1024 + c) = aa; *(LAS f32x4*)(part + (sl * 3 + 2) * 1024 + c) = ag; }
        __syncthreads();
        for (int c = tid; c < 1024; c += NT) { float wl = INP(I_RW0)[li * 1024 + c], al = INP(I_RA0)[li * 1024 + c], gl = 0.f;
#pragma unroll
            for (int k = 0; k < 8; ++k) { wl += part[(k * 3 + 0) * 1024 + c]; al += part[(k * 3 + 1) * 1024 + c]; gl += part[(k * 3 + 2) * 1024 + c]; }
            vec[c] = __expf(-__expf(-softplus_(-wl) - 0.5f)); vec[1024 + c] = sigm_(al); vec[2048 + c] = gl; }
    }
    __syncthreads();
    LAS float* my = hv + C.wave * 192;
    for (int hh = 0; hh < 2; ++hh) { const int h = 2 * C.wave + hh, c = h * 64 + lane;
        const float r = mix[c], k = mix[1024 + c], v = mix[2048 + c], w = vec[c], a = vec[1024 + c], gt = vec[2048 + c];
        const float kk = k * INP(I_KK)[li * 1024 + c]; const float inv = 1.f / fmaxf(sqrtf(wave_sum(kk * kk)), 1e-12f); const float kkn = kk * inv;
        const float kp = k * (1.f + (a - 1.f) * INP(I_KA)[li * 1024 + c]);
        my[lane] = -kkn; my[64 + lane] = kkn * a; my[128 + lane] = kp; LDSW();
        const float* sin_ = INP(I_WKV) + ((size_t)(li * 32 + b) * 16 + h) * 4096 + lane * 64; float* sout = (C.PP->out) + O_WKVS + ((size_t)(li * 32 + b) * 16 + h) * 4096 + lane * 64;
        f32x4 S[16]; float sa = 0.f;
#pragma unroll
        for (int j = 0; j < 16; ++j) { S[j] = *(const f32x4*)(sin_ + 4 * j); const f32x4 n4 = *(const LAS f32x4*)(my + 4 * j); sa += (S[j][0] * n4[0] + S[j][1] * n4[1]) + (S[j][2] * n4[2] + S[j][3] * n4[3]); }
        float o = 0.f;
#pragma unroll
        for (int j = 0; j < 16; ++j) { const f32x4 b4 = *(const LAS f32x4*)(my + 64 + 4 * j), k4 = *(const LAS f32x4*)(my + 128 + 4 * j), w4 = *(const LAS f32x4*)(vec + h * 64 + 4 * j), r4 = *(const LAS f32x4*)(mix + h * 64 + 4 * j);
            S[j] = S[j] * w4 + b4 * sa + k4 * v; *(f32x4*)(sout + 4 * j) = S[j]; o += (S[j][0] * r4[0] + S[j][1] * r4[1]) + (S[j][2] * r4[2] + S[j][3] * r4[3]); }
        const float mean = wave_sum(o) * (1.f / 64.f), d = o - mean, var = wave_sum(d * d) * (1.f / 64.f);
        float y = d * rsqrtf(var + LN_EPS) * INP(I_LNW)[li * 1024 + c] + INP(I_LNB)[li * 1024 + c];
        const float rk = wave_sum(r * kp * INP(I_RK)[li * 1024 + c]);
        y = (y + rk * v) * gt;
        WSP(bf16, WS_YCAT)[(size_t)(T + b) * 2048 + 1024 + c] = (bf16)(pk2(y, 0.f) & 0xffffu);
        LDSW();
    }
    __syncthreads();
}

__device__ __forceinline__ void s_attn_unit(const Ctx& C, int li, int u) {
    const int task = u * 8 + C.wave, b = task >> 3, h = task & 7, lane = C.lane;
    LAS float* qs = (LAS float*)(C.lds + C.wave * 1024);
    const float* qkv = WSP(float, WS_SMALL) + MiB / 4 + (size_t)b * QKV_N;
    const float* rp = WSP(float, WS_ROPE) + 8192 * 16;
    float og[3], lse[3];
#pragma unroll
    for (int g = 0; g < 3; ++g) {
        const int W = 128 << (2 * g), dsh = 2 * g;
        const float* base = qkv + g * 1536 + h * 64;
        float qv = base[lane], kv = base[512 + lane], vv = base[1024 + lane];
        {
            const float qo_ = __shfl_xor(qv, 8), ko_ = __shfl_xor(kv, 8);
            if (lane < 16) { const float cs = rp[lane & 7], sn = rp[8 + (lane & 7)]; if (lane < 8) { qv = qv * cs - qo_ * sn; kv = kv * cs - ko_ * sn; } else { qv = qv * cs + qo_ * sn; kv = kv * cs + ko_ * sn; } }
        }
        qv *= 0.125f;
        float* wo = (C.PP->out) + (g == 0 ? O_W0S : g == 1 ? O_W1S : O_W2S) + ((size_t)(li * 32 + b) * W + (W - 1)) * 1024;
        wo[h * 64 + lane] = kv; wo[512 + h * 64 + lane] = vv;
        qs[lane] = qv; LDSW();
        f32x4 q4[16];
#pragma unroll
        for (int j = 0; j < 16; ++j) q4[j] = *(const LAS f32x4*)(qs + 4 * j);
        const float* cache = INP(I_C0 + g) + ((size_t)(li * 32 + b) * W) * 1024 + h * 64;
        float sc0, sc1;
        { const float* k0 = cache + (size_t)(W - ((lane + 1) << dsh)) * 1024; const float* k1 = cache + (size_t)(W - ((lane + 65) << dsh)) * 1024; float a0 = 0.f, a1 = 0.f;
#pragma unroll
          for (int j = 0; j < 16; ++j) { const f32x4 x0 = *(const f32x4*)(k0 + 4 * j), x1 = *(const f32x4*)(k1 + 4 * j);
              a0 += (x0[0] * q4[j][0] + x0[1] * q4[j][1]) + (x0[2] * q4[j][2] + x0[3] * q4[j][3]); a1 += (x1[0] * q4[j][0] + x1[1] * q4[j][1]) + (x1[2] * q4[j][2] + x1[3] * q4[j][3]); }
          sc0 = a0; sc1 = a1; }
        const float ss = wave_sum(qv * kv);
        const float m = fmaxf(ss, wave_max(fmaxf(sc0, sc1)));
        const float p0 = __expf(sc0 - m), p1 = __expf(sc1 - m), ps = __expf(ss - m);
        const float l = wave_sum(p0 + p1) + ps;
        float o = ps * vv;
#pragma unroll 16
        for (int j = 0; j < 64; ++j) { const float pj0 = __shfl(p0, j), pj1 = __shfl(p1, j);
            o += pj0 * cache[(size_t)(W - ((j + 1) << dsh)) * 1024 + 512 + lane] + pj1 * cache[(size_t)(W - ((j + 65) << dsh)) * 1024 + 512 + lane]; }
        og[g] = o / l; lse[g] = m + __logf(l);
        LDSW();
    }
    const float m = fmaxf(lse[0], fmaxf(lse[1], lse[2])); float a0 = __expf(lse[0] - m), a1 = __expf(lse[1] - m), a2 = __expf(lse[2] - m); const float inv = 1.f / (a0 + a1 + a2);
    const float o = (a0 * og[0] + a1 * og[1] + a2 * og[2]) * inv;
    WSP(bf16, WS_AO)[(size_t)(T + b) * 512 + h * 64 + lane] = (bf16)(pk2(o, 0.f) & 0xffffu);
}

#ifndef PROBE_DUP
#define PROBE_DUP 0
#endif
__global__ void __launch_bounds__(512, 2) mk_fwd(Params P) {
    extern __shared__ __attribute__((aligned(16))) unsigned char lds_raw[];
    Ctx C;
    C.lds = (LAS unsigned char*)lds_raw;
#define PHASE() do { unsigned long long _k = (unsigned long long)__builtin_amdgcn_kernarg_segment_ptr(); int _t = threadIdx.x, _b = blockIdx.x, _g = gridDim.x; asm volatile("" : "+s"(_k), "+v"(_t), "+s"(_b), "+s"(_g)); \
        C.PP = (const CAS Params*)_k; C.tid = _t; C.lane = _t & 63; C.wave = __builtin_amdgcn_readfirstlane(_t >> 6); C.G = _g; C.bid = _b; } while (0)
    PHASE();
    for (int u = C.tid; u < (LDS_BYTES - LDS_RING) / 4; u += NT) ((LAS unsigned*)(C.lds + LDS_RING))[u] = 0u;
    __syncthreads();
    (void)xcd_barrier_post((unsigned*)((C.PP->ws) + WS_CTL) + 4096, (volatile LAS unsigned*)(C.lds + LDS_MISC) + 8);
#define GRID_BAR() do { XcdBarrier _b; _b.bar = (unsigned*)((C.PP->ws) + WS_CTL) + 4096; _b.x = xb_xcc_id(); _b.st = (volatile LAS unsigned*)(C.lds + LDS_MISC) + 8; xcd_barrier(_b); PHASE(); } while (0)
    LAS unsigned char* ring = C.lds;

    p0_weights(C);
    __syncthreads(); PHASE();
    p0_mod(C);
    GRID_BAR();
#if PROBE_DUP & 1
    p0_weights(C); __syncthreads(); PHASE(); p0_mod(C); GRID_BAR();
#endif

    for (int l = 0; l < 4; ++l) {
        const int li = l >> 1;
#define modl (WSP(float, WS_MOD) + (size_t)l * NSEQ * 6144)
        norm_phase(C, l, 0, l == 0);
        GRID_BAR();
        if ((l & 1) == 0) {
            { pg8::Gemm g{WSP(bf16, WS_XN), WSP(bf16, WS_WIN) + (size_t)li * HYB_NP * 1024, T, HYB_NP, 1024}; pg8::StaticOrder S; S.init(T, HYB_NP, C.G, C.bid);
              int rcnt = 0; const bool rg = (C.G == 256);
              EpiIn E{WSP(bf16, WS_U), WSP(float, WS_DT), RollArgs{INP(I_C0), INP(I_C1), INP(I_C2), (C.PP->out), li * 6, &rcnt, C.bid}, rg}; pg8::gemm_phase<EpiIn, pg8::StaticOrder>(ring, g, S, E, nullptr); }
            PHASE();
            { float* US = WSP(float, WS_SMALL); small_gemm(C, WSP(bf16, WS_XN) + (size_t)T * D, WSP(bf16, WS_WIN) + (size_t)li * HYB_NP * 1024, HYB_NP, 1024, [&](int r, int c, float v) { US[(size_t)r * HYB_NP + c] = v; }); }
            GRID_BAR();
            for (int u = C.bid; u < 256; u += C.G) rwkv_prep_unit(C, li, u);
            PHASE();
#if PROBE_DUP & 256
            for (int u = C.bid; u < 256; u += C.G) rwkv_prep_unit(C, li, u);
            PHASE();
#endif
#if PROBE_DUP & 512
            for (int u = C.bid; u < 256; u += C.G) ssd_a_unit(C, li, u);
            PHASE();
#endif
            for (int u = C.bid; u < 256; u += C.G) ssd_a_unit(C, li, u);
            PHASE();
            if (C.G != 256) { for (int u = C.bid; u < 64; u += C.G) s_ssd_unit(C, li, u); PHASE(); for (int u = C.bid; u < 32; u += C.G) s_rwkv_unit(C, li, u); }
            GRID_BAR();
#if PROBE_DUP & 2
            for (int u = C.bid; u < 256; u += C.G) rwkv_prep_unit(C, li, u);
            PHASE();
            for (int u = C.bid; u < 256; u += C.G) ssd_a_unit(C, li, u);
            PHASE();
            for (int u = (C.bid + 192) % C.G; u < 64; u += C.G) s_ssd_unit(C, li, u);
            PHASE();
            for (int u = (C.bid + 128) % C.G; u < 32; u += C.G) s_rwkv_unit(C, li, u);
            GRID_BAR();
#endif
            for (int u = C.bid; u < 256; u += C.G) rwkv_scan_unit(C, u);
            PHASE();
#if PROBE_DUP & 4
            GRID_BAR(); for (int u = C.bid; u < 256; u += C.G) rwkv_scan_unit(C, u); PHASE();
#endif
            ssd_scan_phase(C, li);
            GRID_BAR();
            if (C.G == 256) { if (C.bid < 32) { PHASE(); rwkv_combine_unit(C, li, C.bid); PHASE(); ssd_c_unit(C, li, 224 + C.bid); } else { PHASE(); ssd_c_unit(C, li, C.bid - 32); PHASE();
                  if (C.bid >= 64 && C.bid < 128) s_ssd_unit(C, li, C.bid - 64); else if (C.bid >= 128 && C.bid < 160) s_rwkv_unit(C, li, C.bid - 128); } }
            else if (C.G >= 64) { if (C.bid < 32) { PHASE(); rwkv_combine_unit(C, li, C.bid); } else { PHASE(); for (int u = C.bid - 32; u < 256; u += C.G - 32) ssd_c_unit(C, li, u); PHASE(); cache_roll_slice(C, li, 2, C.bid - 32, C.G - 32); } }
            else { for (int u = C.bid; u < 32; u += C.G) rwkv_combine_unit(C, li, u); PHASE(); for (int u = C.bid; u < 256; u += C.G) ssd_c_unit(C, li, u); PHASE(); cache_roll_slice(C, li, 2, C.bid, C.G); }
            GRID_BAR();
#if PROBE_DUP & 1024
            if (C.bid < 32) { PHASE(); rwkv_combine_unit(C, li, C.bid); }
            GRID_BAR();
#endif
#if PROBE_DUP & 2048
            if (C.bid >= 32) { PHASE(); for (int u = C.bid - 32; u < 256; u += C.G - 32) ssd_c_unit(C, li, u); }
            GRID_BAR();
#endif
#if PROBE_DUP & 8
            if (C.G >= 64) { if (C.bid < 32) { PHASE(); rwkv_combine_unit(C, li, C.bid); } else { PHASE(); for (int u = C.bid - 32; u < 256; u += C.G - 32) ssd_c_unit(C, li, u); } }
            else { for (int u = C.bid; u < 32; u += C.G) rwkv_combine_unit(C, li, u); PHASE(); for (int u = C.bid; u < 256; u += C.G) ssd_c_unit(C, li, u); }
            GRID_BAR();
#endif
            rwkv_out_phase(C, li);
            GRID_BAR();
#if PROBE_DUP & 16
            rwkv_out_phase(C, li);
            GRID_BAR();
#endif
            { const float* xin = l == 0 ? INP(I_XP) : WSP(float, WS_X); const float* xsin = l == 0 ? INP(I_XS) : WSP(float, WS_X) + (size_t)T * D; const float* gate = modl + 2048;
              pg8::Gemm g{WSP(bf16, WS_YCAT), WSP(bf16, WS_WOUT) + (size_t)li * 1024 * 2048, T, 1024, 2048}; pg8::StaticOrder S; S.init(T, 1024, C.G, C.bid);
              EpiRes E{xin, WSP(float, WS_X), gate}; pg8::gemm_phase<EpiRes, pg8::StaticOrder>(ring, g, S, E, nullptr); PHASE();
              float* XS = WSP(float, WS_X) + (size_t)T * D;
              small_gemm(C, WSP(bf16, WS_YCAT) + (size_t)T * 2048, WSP(bf16, WS_WOUT) + (size_t)li * 1024 * 2048, 1024, 2048, [&](int r, int c, float v) { XS[(size_t)r * D + c] = xsin[(size_t)r * D + c] + gate[(size_t)(2 + r) * 6144 + c] * v; }); }
            GRID_BAR();
        } else {
            { pg8::Gemm g{WSP(bf16, WS_XN), WSP(bf16, WS_WQKV) + (size_t)li * QKV_N * 1024, T, QKV_N, 1024}; pg8::StaticOrder S; S.init(T, QKV_N, C.G, C.bid);
              EpiQkv E{WSP(bf16, WS_QKV), WSP(float, WS_ROPE), (C.PP->out), li}; pg8::gemm_phase<EpiQkv, pg8::StaticOrder>(ring, g, S, E, nullptr); PHASE();
              float* QS = WSP(float, WS_SMALL) + MiB / 4;
              small_gemm(C, WSP(bf16, WS_XN) + (size_t)T * D, WSP(bf16, WS_WQKV) + (size_t)li * QKV_N * 1024, QKV_N, 1024, [&](int r, int c, float v) { QS[(size_t)r * QKV_N + c] = v; }); }
            GRID_BAR();
            for (int u = C.bid; u < 3072; u += C.G) attn_tile_unit(C, u);
            PHASE();
            for (int u = C.bid; u < 32; u += C.G) s_attn_unit(C, li, u);
            GRID_BAR();
#if PROBE_DUP & 32
            for (int u = C.bid; u < 3072; u += C.G) attn_tile_unit(C, u);
            PHASE();
            for (int u = C.bid; u < 32; u += C.G) s_attn_unit(C, li, u);
            GRID_BAR();
#endif
            attn_merge_phase(C);
            GRID_BAR();
            { const float* gate = modl + 2048;
              pg8::Gemm g{WSP(bf16, WS_AO), WSP(bf16, WS_WAO) + (size_t)li * 1024 * 512, T, 1024, 512}; pg8::StaticOrder S; S.init(T, 1024, C.G, C.bid);
              EpiRes E{WSP(float, WS_X), WSP(float, WS_X), gate}; pg8::gemm_phase<EpiRes, pg8::StaticOrder>(ring, g, S, E, nullptr); PHASE();
              float* XS = WSP(float, WS_X) + (size_t)T * D;
              small_gemm(C, WSP(bf16, WS_AO) + (size_t)T * 512, WSP(bf16, WS_WAO) + (size_t)li * 1024 * 512, 1024, 512, [&](int r, int c, float v) { XS[(size_t)r * D + c] += gate[(size_t)(2 + r) * 6144 + c] * v; }); }
            GRID_BAR();
        }
        norm_phase(C, l, 1, false);
        GRID_BAR();
#if PROBE_DUP & 64
        norm_phase(C, l, 1, false);
        GRID_BAR();
#endif
#if PROBE_DUP & 128
        { pg8::Gemm g{WSP(bf16, WS_XN), WSP(bf16, WS_W1) + (size_t)l * FF * 1024, T, FF, 1024}; pg8::StaticOrder S; S.init(T, FF, C.G, C.bid);
          int rcnt = 0; EpiMlp1 E{WSP(bf16, WS_HID), RollArgs{INP(I_C0), INP(I_C1), INP(I_C2), (C.PP->out), 0, &rcnt, C.bid}, false}; pg8::gemm_phase<EpiMlp1, pg8::StaticOrder>(ring, g, S, E, nullptr); } GRID_BAR();
#endif
        { pg8::Gemm g{WSP(bf16, WS_XN), WSP(bf16, WS_W1) + (size_t)l * FF * 1024, T, FF, 1024}; pg8::StaticOrder S; S.init(T, FF, C.G, C.bid);
          int rcnt = 0; const bool rg = (C.G == 256);
          EpiMlp1 E{WSP(bf16, WS_HID), RollArgs{INP(I_C0), INP(I_C1), INP(I_C2), (C.PP->out), 12 + l * 4, &rcnt, C.bid}, rg}; pg8::gemm_phase<EpiMlp1, pg8::StaticOrder>(ring, g, S, E, nullptr); PHASE();
          bf16* HS = WSP(bf16, WS_HID) + (size_t)T * FF;
          small_gemm(C, WSP(bf16, WS_XN) + (size_t)T * D, WSP(bf16, WS_W1) + (size_t)l * FF * 1024, FF, 1024, [&](int r, int c, float v) { const float a = fmaxf(v, 0.f); HS[(size_t)r * FF + c] = (bf16)(pk2(a * a, 0.f) & 0xffffu); }); }
        GRID_BAR();
        { const float* gate = modl + 5120;
          pg8::Gemm g{WSP(bf16, WS_HID), WSP(bf16, WS_W2) + (size_t)l * 1024 * FF, T, 1024, FF}; pg8::StaticOrder S; S.init(T, 1024, C.G, C.bid);
          EpiRes E{WSP(float, WS_X), WSP(float, WS_X), gate}; pg8::gemm_phase<EpiRes, pg8::StaticOrder>(ring, g, S, E, nullptr); PHASE();
          float* XS = WSP(float, WS_X) + (size_t)T * D;
          small_gemm(C, WSP(bf16, WS_HID) + (size_t)T * FF, WSP(bf16, WS_W2) + (size_t)l * 1024 * FF, 1024, FF, [&](int r, int c, float v) { XS[(size_t)r * D + c] += gate[(size_t)(2 + r) * 6144 + c] * v; }); }
        GRID_BAR();
    }
    final_norm_phase(C);
}
}

extern "C" void kernel_launch(void* const* d_in, const int* in_sizes, int n_in, void* d_out, int out_size, void* d_ws, size_t ws_size, hipStream_t stream) {
    static int grid = 0;
    if (grid == 0) {
        int dev = 0, cus = 0, per_cu = 0;
        if (hipGetDevice(&dev) != hipSuccess || hipDeviceGetAttribute(&cus, hipDeviceAttributeMultiprocessorCount, dev) != hipSuccess) { fprintf(stderr, "kernel_launch: device query failed\n"); grid = -1; return; }
        if (hipFuncSetAttribute((const void*)mk::mk_fwd, hipFuncAttributeMaxDynamicSharedMemorySize, mk::LDS_BYTES) != hipSuccess) { fprintf(stderr, "kernel_launch: hipFuncSetAttribute failed\n"); grid = -1; return; }
        if (hipOccupancyMaxActiveBlocksPerMultiprocessor(&per_cu, (const void*)mk::mk_fwd, 512, mk::LDS_BYTES) != hipSuccess || per_cu < 1) fprintf(stderr, "kernel_launch: occupancy query reports %d\n", per_cu);
        if (n_in != 39 || (size_t)out_size != mk::O_END || ws_size < mk::WS_END) { fprintf(stderr, "kernel_launch: unexpected sizes n_in %d out %d ws %zu\n", n_in, out_size, ws_size); grid = -1; return; }
        grid = cus;
    }
    if (grid < 0) return;
    hipMemsetAsync((char*)d_ws + mk::WS_CTL, 0, mk::CTL_BYTES, stream);
    mk::Params p; memset(&p, 0, sizeof(p));
    for (int i = 0; i < 39; ++i) p.in[i] = (const float*)d_in[i];
    p.out = (float*)d_out; p.ws = (unsigned char*)d_ws;
    hipLaunchKernelGGL(mk::mk_fwd, dim3(grid), dim3(512), mk::LDS_BYTES, stream, p);
}
```

```cpp
#include <hip/hip_runtime.h>
#include <cstdio>
#include <cstdint>
#include <cstring>
namespace pg8 {
#define PG8_LAS __attribute__((address_space(3)))
typedef unsigned short bf16_t;
typedef short bf16x8 __attribute__((ext_vector_type(8)));
typedef float f32x4 __attribute__((ext_vector_type(4)));
typedef unsigned u32x4 __attribute__((ext_vector_type(4)));
constexpr int BM = 256, BK = 64, HALF = 128, HTB = HALF * BK * 2  , STAGE_BYTES = 8 * HTB, NXCD = 8, WGM = 8;

__host__ __device__ __forceinline__ int lds_byte(int r, int c) { const int st = (r >> 4) * 2 + (c >> 5), rr = r & 15, cc = c & 31, ob = rr * 64 + cc * 2; return st * 1024 + (ob ^ (((ob >> 9) & 1) << 5)); }
__host__ __device__ __forceinline__ void stage_rc(int b, int& R, int& C) { const int st = b / 1024, sb = b % 1024, swz = sb ^ (((sb >> 9) & 1) << 5); R = (st >> 1) * 16 + swz / 64; C = (st & 1) * 32 + (swz % 64) / 2; }
__host__ __device__ __forceinline__ int perm32(int rho) { const int n = rho >> 4, i = rho & 15; return 8 * (i >> 2) + 4 * n + (i & 3); }

struct Unit { int pm, pn; };
struct Gemm { const bf16_t* A; const bf16_t* Bt; int M, N, K; };

struct StaticOrder {
    int nM, nN, nwg, G, c;
    __host__ __device__ void init(int M, int N, int G_, int c_) { nM = M / BM; nN = N / BM; nwg = nM * nN; G = G_; c = c_; }
    __host__ __device__ bool next(int i, Unit& u) const {
        const long L = (long)i * G + c; if (L >= nwg) return false;
        int wgid = (int)L; { const int q = nwg / NXCD, r = nwg % NXCD, xcd = wgid % NXCD, off = wgid / NXCD; wgid = (xcd < r ? xcd * (q + 1) : r * (q + 1) + (xcd - r) * q) + off; }
        const int nig = WGM * nN, gid = wgid / nig, fm = gid * WGM, gsz = (nM - fm) < WGM ? (nM - fm) : WGM;
        u.pm = fm + ((wgid % nig) % gsz); u.pn = (wgid % nig) / gsz; return true;
    }
    __device__ __forceinline__ void a_ready(const Unit&) const {}
    __device__ __forceinline__ void done(const Unit&) const {}
};
template <class Epi, class Sched, bool STAMP = false>
__device__ __forceinline__ void gemm_phase(PG8_LAS unsigned char* lds, const Gemm g, const Sched& S, const Epi& E, unsigned long long* stamps) {
    int tid_ = threadIdx.x; asm volatile("" : "+v"(tid_));
    const int tid = tid_, wid = __builtin_amdgcn_readfirstlane(tid >> 6), lane = tid & 63, wr = wid >> 2, wc = wid & 3, fr = lane & 15, fq = lane >> 4;
    const int K = g.K, nt = K / BK;
    int ts_lo = 0, ts_hi = 0, nts = 0; const unsigned long long rt_entry = STAMP ? (unsigned long long)wall_clock64() : 0ull;
#define PG8_STAMP() do { if (STAMP && wid == 0 && nts < 64) { const unsigned long long _c = (unsigned long long)clock64(); \
        ts_lo = (lane == nts) ? (int)(unsigned)_c : ts_lo; ts_hi = (lane == nts) ? (int)(unsigned)(_c >> 32) : ts_hi; ++nts; } } while (0)
    PG8_STAMP();
    unsigned voffA[2], voffB[2];
#pragma unroll
    for (int i = 0; i < 2; ++i) { int R, C; stage_rc(tid * 16 + i * 8192, R, C); const int Rb = Epi::PERM ? ((R & ~31) + perm32(R & 31)) : R;
        voffA[i] = (unsigned)(R * K + C) * 2u; voffB[i] = (unsigned)(Rb * K + C) * 2u; }
    const size_t kstep = (size_t)(BK * 2);
    const size_t hstep = (size_t)HALF * K * 2;
    const size_t tstep = 2 * hstep;
    const unsigned ldsw = (unsigned)wid * 1024u;
    const int aoff = lds_byte(wr * 64 + fr, fq * 8), boff = lds_byte(wc * 32 + fr, fq * 8);
#define PG8_SA(b, h) (((b) * 2 + (h)) * HTB)
#define PG8_SB(b, h) ((4 + (b) * 2 + (h)) * HTB)
#define PG8_STAGE(bufoff, gbase, voff) do { _Pragma("unroll") for (int _i = 0; _i < 2; ++_i) \
        __builtin_amdgcn_global_load_lds((const unsigned*)((const char*)(gbase) + (voff)[_i]), (PG8_LAS unsigned*)(lds + (bufoff) + ldsw + _i * 8192), 16, 0, 0); } while (0)
#define PG8_LDA(dst, b, h) do { _Pragma("unroll") for (int m = 0; m < 4; ++m) _Pragma("unroll") for (int k = 0; k < 2; ++k) dst[m][k] = *(const PG8_LAS bf16x8*)(lds + PG8_SA(b, h) + aoff + m * 2048 + k * 1024); } while (0)
#define PG8_LDB(dst, b, h) do { _Pragma("unroll") for (int n = 0; n < 2; ++n) _Pragma("unroll") for (int k = 0; k < 2; ++k) dst[n][k] = *(const PG8_LAS bf16x8*)(lds + PG8_SB(b, h) + boff + n * 2048 + k * 1024); } while (0)
#define PG8_MMA(ai, bj, At, Bt) do { __builtin_amdgcn_s_setprio(1); _Pragma("unroll") for (int m = 0; m < 4; ++m) _Pragma("unroll") for (int n = 0; n < 2; ++n) _Pragma("unroll") for (int k = 0; k < 2; ++k) \
        acc[ai][bj][m][n] = __builtin_amdgcn_mfma_f32_16x16x32_bf16(Bt[n][k], At[m][k], acc[ai][bj][m][n], 0, 0, 0); __builtin_amdgcn_s_setprio(0); } while (0)
#define PG8_WAIT_V(n) asm volatile("s_waitcnt vmcnt(" #n ")" ::: "memory")
#define PG8_WAIT_L(n) asm volatile("s_waitcnt lgkmcnt(" #n ")" ::: "memory")
#define PG8_BAR __builtin_amdgcn_s_barrier()
#define PG8_SCHED __builtin_amdgcn_sched_barrier(0)
    Unit cur, nxt; int ui = 0;
    if (!S.next(0, cur)) return;
    f32x4 acc[2][2][4][2];
#pragma unroll
    for (int a = 0; a < 2; ++a)
#pragma unroll
        for (int b = 0; b < 2; ++b)
#pragma unroll
            for (int m = 0; m < 4; ++m)
#pragma unroll
                for (int n = 0; n < 2; ++n) acc[a][b][m][n] = (f32x4){0.f, 0.f, 0.f, 0.f};
    bf16x8 At[4][2], B0[2][2], B1[2][2];
    const char* cA = (const char*)g.A + (size_t)cur.pm * tstep; const char* cB = (const char*)g.Bt + (size_t)cur.pn * tstep;
    S.a_ready(cur);
    PG8_STAGE(PG8_SB(0, 0), cB, voffB); PG8_STAGE(PG8_SA(0, 0), cA, voffA); PG8_STAGE(PG8_SB(0, 1), cB + hstep, voffB); PG8_STAGE(PG8_SA(0, 1), cA + hstep, voffA);
    if (wr == 1) PG8_BAR;
    PG8_WAIT_V(4); PG8_BAR;
    PG8_STAGE(PG8_SB(1, 0), cB + kstep, voffB); PG8_STAGE(PG8_SA(1, 0), cA + kstep, voffA); PG8_STAGE(PG8_SB(1, 1), cB + hstep + kstep, voffB);
    PG8_WAIT_V(6); PG8_BAR;
    PG8_STAMP();
    for (;;) {
        const bool has_next = S.next(ui + 1, nxt);
        const char* nA = has_next ? (const char*)g.A + (size_t)nxt.pm * tstep : cA; const char* nB = has_next ? (const char*)g.Bt + (size_t)nxt.pn * tstep : cB;
        for (int t = 0; t < nt; t += 2) {
            const bool last = (t == nt - 2);
            const char* a1 = cA + (size_t)(t + 1) * kstep;
            const char* a2 = last ? nA : cA + (size_t)(t + 2) * kstep; const char* b2 = last ? nB : cB + (size_t)(t + 2) * kstep;
            const char* a3 = a2 + kstep; const char* b3 = b2 + kstep;
            if (last && has_next) S.a_ready(nxt);
            PG8_LDB(B0, 0, 0); PG8_SCHED; PG8_LDA(At, 0, 0); PG8_STAGE(PG8_SA(1, 1), a1 + hstep, voffA);
            PG8_WAIT_L(8); PG8_BAR; PG8_WAIT_L(0); PG8_MMA(0, 0, At, B0); PG8_BAR; PG8_SCHED;
            PG8_LDB(B1, 0, 1); PG8_STAGE(PG8_SB(0, 0), b2, voffB);
            PG8_BAR; PG8_WAIT_L(0); PG8_MMA(0, 1, At, B1); PG8_BAR;
            PG8_LDA(At, 0, 1); PG8_STAGE(PG8_SA(0, 0), a2, voffA);
            PG8_BAR; PG8_WAIT_L(0); PG8_MMA(1, 0, At, B0); PG8_BAR; PG8_SCHED;
            PG8_STAGE(PG8_SB(0, 1), b2 + hstep, voffB);
            PG8_WAIT_V(6); PG8_BAR; PG8_MMA(1, 1, At, B1); PG8_BAR;
            PG8_LDB(B0, 1, 0); PG8_SCHED; PG8_LDA(At, 1, 0); PG8_STAGE(PG8_SA(0, 1), a2 + hstep, voffA);
            PG8_WAIT_L(8); PG8_BAR; PG8_WAIT_L(0); PG8_MMA(0, 0, At, B0); PG8_BAR; PG8_SCHED;
            PG8_LDB(B1, 1, 1); PG8_STAGE(PG8_SB(1, 0), b3, voffB);
            PG8_BAR; PG8_WAIT_L(0); PG8_MMA(0, 1, At, B1); PG8_BAR;
            PG8_LDA(At, 1, 1); PG8_STAGE(PG8_SA(1, 0), a3, voffA);
            PG8_BAR; PG8_WAIT_L(0); PG8_MMA(1, 0, At, B0); PG8_BAR; PG8_SCHED;
            PG8_STAGE(PG8_SB(1, 1), b3 + hstep, voffB);
            PG8_WAIT_V(6); PG8_BAR; PG8_MMA(1, 1, At, B1); PG8_BAR;
        }
        PG8_STAMP();
        if constexpr (!Epi::AFTER_DRAIN) { E(acc, cur, wr, wc, fr, fq); S.done(cur); }
        PG8_STAMP();
        if (!has_next) break;
#pragma unroll
        for (int a = 0; a < 2; ++a)
#pragma unroll
            for (int b = 0; b < 2; ++b)
#pragma unroll
                for (int m = 0; m < 4; ++m)
#pragma unroll
                    for (int n = 0; n < 2; ++n) acc[a][b][m][n] = (f32x4){0.f, 0.f, 0.f, 0.f};
        cur = nxt; cA = nA; cB = nB; ++ui;
    }
    PG8_WAIT_V(0);
    if (wr == 0) PG8_BAR;
    PG8_BAR;
    if constexpr (Epi::AFTER_DRAIN) { E.fused(acc, cur, wr, wc, fr, fq, lds, wid, lane); S.done(cur); }
    PG8_STAMP();
    if (STAMP && wid == 0) { stamps[lane] = lane < nts ? (((unsigned long long)(unsigned)ts_hi << 32) | (unsigned)ts_lo) : 0ull;
        if (lane == 62) stamps[62] = rt_entry; if (lane == 63) stamps[63] = (unsigned long long)wall_clock64(); }
#undef PG8_STAMP
#undef PG8_SA
#undef PG8_SB
#undef PG8_STAGE
#undef PG8_LDA
#undef PG8_LDB
#undef PG8_MMA
#undef PG8_WAIT_V
#undef PG8_WAIT_L
#undef PG8_BAR
#undef PG8_SCHED
}
}
#define XB_TMO      128
#define XB_XCNT(j)  (256  + 64 * (j))
#define XB_XSUB(j)  (1280 + 64 * (j))
#define XB_XGEN(j)  (2304 + 64 * (j))
#define XB_TOP      3328
#define XB_TOPGEN   3392
#define XCD_BAR_WORDS 3456
#define XB_SPIN_CAP (1u << 18)
#define LAS __attribute__((address_space(3)))

__device__ __forceinline__ unsigned xb_ld(unsigned* p)              { return __hip_atomic_load(p, __ATOMIC_RELAXED, __HIP_MEMORY_SCOPE_AGENT); }
__device__ __forceinline__ unsigned xb_add(unsigned* p, unsigned v) { return __hip_atomic_fetch_add(p, v, __ATOMIC_RELAXED, __HIP_MEMORY_SCOPE_AGENT); }
__device__ __forceinline__ unsigned xb_xcc_id() { return (unsigned)__builtin_amdgcn_s_getreg((3 << 11) | 20) & 0xFu; }
#define XB_SPIN(cond, bar) do { unsigned _sp = 0; while (cond) { __builtin_amdgcn_s_sleep(1); \
    if ((++_sp & 255u) == 0u) { if (xb_ld(&(bar)[XB_TMO])) break; if (_sp > XB_SPIN_CAP) { atomicAdd(&(bar)[XB_TMO], 1u); break; } } } } while (0)

struct XcdBarrier {
    unsigned* bar; unsigned x;
    volatile LAS unsigned* st;
};

__device__ __forceinline__ XcdBarrier xcd_barrier_post(unsigned* bar, volatile LAS unsigned* st) {
    XcdBarrier b; b.bar = bar; b.x = xb_xcc_id(); b.st = st;
    if (threadIdx.x == 0) (void)xb_add(&bar[XB_XCNT(b.x)], 1u);
    return b;
}
__device__ __forceinline__ void xcd_barrier_complete(unsigned* bar, unsigned x, unsigned& nloc, unsigned& nx) {
    const unsigned G = gridDim.x * gridDim.y * gridDim.z;
    unsigned sum, cnt, mine, sp = 0u;
    for (;;) {
        sum = 0u; cnt = 0u; mine = 0u;
#pragma unroll
        for (unsigned j = 0; j < 16; ++j) { const unsigned c = xb_ld(&bar[XB_XCNT(j)]); sum += c; cnt += (c > 0u) ? 1u : 0u; mine = (j == x) ? c : mine; }
        if (sum == G) break;
        __builtin_amdgcn_s_sleep(1);
        if ((++sp & 255u) == 0u) { if (xb_ld(&bar[XB_TMO])) break; if (sp > XB_SPIN_CAP) { atomicAdd(&bar[XB_TMO], 1u); break; } }
    }
    nloc = mine > 0u ? mine : 1u; nx = cnt > 0u ? cnt : 1u;
}

__device__ __forceinline__ void xcd_barrier(const XcdBarrier& b) {
    asm volatile("s_waitcnt vmcnt(0)" ::: "memory");
    __syncthreads();
    if (threadIdx.x == 0) {
        unsigned* bar = b.bar;
        __builtin_amdgcn_s_waitcnt(0);
        unsigned nloc = b.st[0], nx = b.st[1];
        if (nloc == 0u) { xcd_barrier_complete(bar, b.x, nloc, nx); b.st[0] = nloc; b.st[1] = nx; }
        const unsigned old = xb_add(&bar[XB_XSUB(b.x)], 1u);
        const unsigned gen = old / nloc;
        if (old + 1u == (gen + 1u) * nloc) {
            __builtin_amdgcn_fence(__ATOMIC_RELEASE, "agent");
            asm volatile("s_waitcnt vmcnt(0)" ::: "memory");
            const unsigned og = xb_add(&bar[XB_TOP], 1u);
            const unsigned tg = og / nx;
            if (og + 1u == (tg + 1u) * nx) xb_add(&bar[XB_TOPGEN], 1u);
            else XB_SPIN(xb_ld(&bar[XB_TOPGEN]) == tg, bar);
            __builtin_amdgcn_fence(__ATOMIC_ACQUIRE, "agent");
            xb_add(&bar[XB_XGEN(b.x)], 1u);
            asm volatile("s_waitcnt vmcnt(0)" ::: "memory");
        } else {
            XB_SPIN(xb_ld(&bar[XB_XGEN(b.x)]) == gen, bar);
            __builtin_amdgcn_fence(__ATOMIC_ACQUIRE, "agent");
            asm volatile("s_waitcnt vmcnt(0)" ::: "memory");
        }
    }
    __syncthreads();
}

namespace mk {
#define LAS __attribute__((address_space(3)))
typedef unsigned short bf16;
typedef short bf16x8 __attribute__((ext_vector_type(8)));
typedef float f32x4 __attribute__((ext_vector_type(4)));
typedef float f32x2 __attribute__((ext_vector_type(2)));
typedef float f32x16 __attribute__((ext_vector_type(16)));
typedef unsigned u32x4 __attribute__((ext_vector_type(4)));
typedef unsigned u32x2 __attribute__((ext_vector_type(2)));

constexpr int T = 16384, SEQ = 8192, NS = 32, D = 1024, NSEQ = 34, NT = 512;
constexpr int HYB_NP = 6144, HYB_N = 5904, QKV_N = 4608, FF = 4096;
constexpr int U_XBC = 1024, U_DT = 2560, U_RW = 2576, RWC = 3328;
constexpr float EPS = 1e-6f, LN_EPS = 64e-5f;
constexpr size_t MiB = 1u << 20;
constexpr size_t WS_CTL = 0, CTL_BYTES = MiB;
constexpr size_t WS_WIN = 2 * MiB, WS_WOUT = 26 * MiB, WS_WQKV = 34 * MiB, WS_WAO = 52 * MiB, WS_W1 = 54 * MiB, WS_W2 = 86 * MiB, WS_LORA = 118 * MiB;
constexpr size_t WS_MOD = 119 * MiB, WS_ROPE = 123 * MiB, WS_SMALL = 124 * MiB, WS_X = 128 * MiB, WS_XN = 193 * MiB, WS_U = 226 * MiB;
constexpr int RECB = 896;
constexpr size_t WS_DT = 418 * MiB, WS_DTS = 419 * MiB, WS_ACS = 420 * MiB, WS_REC = 421 * MiB, WS_G = 805 * MiB, WS_XT = 837 * MiB, WS_BC = 869 * MiB;
constexpr size_t WS_CS = 885 * MiB, WS_QO = 949 * MiB, WS_SL = 1077 * MiB, WS_SST = 1141 * MiB, WS_YCAT = 1173 * MiB, WS_QKV = 1238 * MiB;
constexpr size_t WS_OG = 1382 * MiB, WS_LSE = 1430 * MiB, WS_AO = 1432 * MiB, WS_HID = 1449 * MiB, WS_END = 1578 * MiB;
constexpr size_t O_YP = 0, O_YS = O_YP + (size_t)T * D, O_SSDP = O_YS + 32 * 1024, O_SSDS = O_SSDP + 2 * 2 * 16 * 8192, O_CONVP = O_SSDS + (size_t)2 * 32 * 16 * 8192;
constexpr size_t O_CONVS = O_CONVP + 2 * 2 * 3 * 1536, O_WKVP = O_CONVS + 2 * 32 * 3 * 1536, O_WKVS = O_WKVP + 2 * 2 * 16 * 4096, O_SHP = O_WKVS + (size_t)2 * 32 * 16 * 4096;
constexpr size_t O_SHS = O_SHP + 2 * 2 * 3328, O_W0P = O_SHS + 2 * 32 * 3328, O_W0S = O_W0P + (size_t)2 * 2 * 128 * 1024, O_W1P = O_W0S + (size_t)2 * 32 * 128 * 1024;
constexpr size_t O_W1S = O_W1P + (size_t)2 * 2 * 512 * 1024, O_W2P = O_W1S + (size_t)2 * 32 * 512 * 1024, O_W2S = O_W2P + (size_t)2 * 2 * 2048 * 1024;
constexpr size_t O_END = O_W2S + (size_t)2 * 32 * 2048 * 1024;
static_assert(O_END == 217889792ull, "output size");
constexpr int LDS_RING = 131072, LDS_MISC = LDS_RING + 320, LDS_BYTES = 147456;

struct Params { const float* in[39]; float* out; unsigned char* ws; };

typedef __bf16 bfv2 __attribute__((ext_vector_type(2)));
__device__ __forceinline__ unsigned pk2(float lo, float hi) { const f32x2 v = (f32x2){lo, hi}; const bfv2 r = __builtin_convertvector(v, bfv2); return __builtin_bit_cast(unsigned, r); }
__device__ __forceinline__ float bflo(unsigned u) { return __uint_as_float(u << 16); }
__device__ __forceinline__ float bfhi(unsigned u) { return __uint_as_float(u & 0xffff0000u); }
__device__ __forceinline__ float bf1(bf16 h) { return __uint_as_float(((unsigned)h) << 16); }
__device__ __forceinline__ f32x4 bf4(u32x2 v) { return (f32x4){bflo(v.x), bfhi(v.x), bflo(v.y), bfhi(v.y)}; }
__device__ __forceinline__ u32x2 pk4(f32x4 v) { u32x2 r; r.x = pk2(v[0], v[1]); r.y = pk2(v[2], v[3]); return r; }
__device__ __forceinline__ float siluf_(float x) { return x * __builtin_amdgcn_rcpf(1.f + __expf(-x)); }
__device__ __forceinline__ float sigm_(float x) { return __builtin_amdgcn_rcpf(1.f + __expf(-x)); }
__device__ __forceinline__ float softplus_(float x) { return fmaxf(x, 0.f) + __logf(1.f + __expf(-fabsf(x))); }
__device__ __forceinline__ float tanh_(float x) { const float t = __expf(-2.f * fabsf(x)); const float r = (1.f - t) * __builtin_amdgcn_rcpf(1.f + t); return x < 0.f ? -r : r; }
__device__ __forceinline__ float wave_sum(float v) {
#pragma unroll
    for (int o = 1; o < 64; o <<= 1) v += __shfl_xor(v, o);
    return v;
}
__device__ __forceinline__ float wave_max(float v) {
#pragma unroll
    for (int o = 1; o < 64; o <<= 1) v = fmaxf(v, __shfl_xor(v, o));
    return v;
}
__device__ __forceinline__ f32x4 mfma16(bf16x8 a, bf16x8 b, f32x4 c) { return __builtin_amdgcn_mfma_f32_16x16x32_bf16(a, b, c, 0, 0, 0); }
#define LDSW() asm volatile("s_waitcnt lgkmcnt(0)" ::: "memory")
#define LDS_BARRIER() do { asm volatile("s_waitcnt lgkmcnt(0)" ::: "memory"); __builtin_amdgcn_s_barrier(); asm volatile("" ::: "memory"); } while (0)

#define CAS __attribute__((address_space(4)))
struct Ctx {
    LAS unsigned char* lds; int tid, lane, wave, G, bid;
    const CAS Params* PP;
};
#define WSP(type, off) ((type*)((C.PP->ws) + (off)))
#define INP(i) (C.PP->in[i])
enum { I_XP = 0, I_XS, I_SSD, I_CONV, I_WKV, I_SHIFT, I_C0, I_C1, I_C2, I_CP, I_CS, I_NMIX, I_NMLP, I_NFIN, I_ADAW, I_ADAB, I_W1, I_W2, I_HIN, I_HOUT, I_CONVW, I_CONVB,
       I_DTB, I_ALOG, I_SSDD, I_SNW, I_MU, I_RW0, I_RW2, I_RA0, I_RA2, I_RG2, I_KK, I_KA, I_RK, I_LNW, I_LNB, I_AQKV, I_AOUT };

__device__ __forceinline__ void transpose_item(const float* W, int K, int N, bf16* WT, LAS float* scr, int item, int lane) {
    const int nblk = (N + 31) / 32, kb = item / nblk, nb = item % nblk, k0 = 64 * kb, n0 = 32 * nb;
    const int nn = n0 + (lane & 31);
#pragma unroll 8
    for (int i = 0; i < 32; ++i) { const int kk = 2 * i + (lane >> 5); scr[kk * 33 + (lane & 31)] = nn < N ? W[(size_t)(k0 + kk) * N + nn] : 0.f; }
    LDSW();
    const int c = lane & 7;
#pragma unroll
    for (int j = 0; j < 4; ++j) { const int n = (lane >> 3) + 8 * j; const LAS float* s = scr + (8 * c) * 33 + n;
        u32x4 o; o.x = pk2(s[0 * 33], s[1 * 33]); o.y = pk2(s[2 * 33], s[3 * 33]); o.z = pk2(s[4 * 33], s[5 * 33]); o.w = pk2(s[6 * 33], s[7 * 33]);
        *(u32x4*)(WT + (size_t)(n0 + n) * K + k0 + 8 * c) = o; }
    LDSW();
}

__device__ __forceinline__ void p0_weights(const Ctx& C) {
    LAS float* scr = (LAS float*)(C.lds + C.wave * 16384);
    const int gw = C.bid * 8 + C.wave, NGW = C.G * 8;
    constexpr int N_IN = 16 * 185, N_OUT = 32 * 32, N_QKV = 16 * 144, N_AO = 8 * 32, N_1 = 16 * 128, N_2 = 64 * 32, N_L64 = 32, N_L128 = 64;
    constexpr int TOTAL = 2 * N_IN + 2 * N_OUT + 2 * N_QKV + 2 * N_AO + 4 * N_1 + 4 * N_2 + 2 * (2 * N_L64 + N_L128);
    for (int it = gw; it < TOTAL; it += NGW) {
        int r = it;
        if (r < 2 * N_IN) { const int i = r / N_IN; transpose_item(INP(I_HIN) + (size_t)i * 1024 * HYB_N, 1024, HYB_N, WSP(bf16, WS_WIN) + (size_t)i * HYB_NP * 1024, scr, r % N_IN, C.lane); continue; } r -= 2 * N_IN;
        if (r < 2 * N_OUT) { const int i = r / N_OUT; transpose_item(INP(I_HOUT) + (size_t)i * 2048 * 1024, 2048, 1024, WSP(bf16, WS_WOUT) + (size_t)i * 1024 * 2048, scr, r % N_OUT, C.lane); continue; } r -= 2 * N_OUT;
        if (r < 2 * N_QKV) { const int i = r / N_QKV; transpose_item(INP(I_AQKV) + (size_t)i * 1024 * QKV_N, 1024, QKV_N, WSP(bf16, WS_WQKV) + (size_t)i * QKV_N * 1024, scr, r % N_QKV, C.lane); continue; } r -= 2 * N_QKV;
        if (r < 2 * N_AO) { const int i = r / N_AO; transpose_item(INP(I_AOUT) + (size_t)i * 512 * 1024, 512, 1024, WSP(bf16, WS_WAO) + (size_t)i * 1024 * 512, scr, r % N_AO, C.lane); continue; } r -= 2 * N_AO;
        if (r < 4 * N_1) { const int i = r / N_1; transpose_item(INP(I_W1) + (size_t)i * 1024 * FF, 1024, FF, WSP(bf16, WS_W1) + (size_t)i * FF * 1024, scr, r % N_1, C.lane); continue; } r -= 4 * N_1;
        if (r < 4 * N_2) { const int i = r / N_2; transpose_item(INP(I_W2) + (size_t)i * FF * 1024, FF, 1024, WSP(bf16, WS_W2) + (size_t)i * 1024 * FF, scr, r % N_2, C.lane); continue; } r -= 4 * N_2;
        { const int i = r / (2 * N_L64 + N_L128); int q = r % (2 * N_L64 + N_L128); bf16* lb = WSP(bf16, WS_LORA) + (size_t)i * 262144;
          if (q < N_L64) { transpose_item(INP(I_RW2) + (size_t)i * 64 * 1024, 64, 1024, lb, scr, q, C.lane); continue; } q -= N_L64;
          if (q < N_L64) { transpose_item(INP(I_RA2) + (size_t)i * 64 * 1024, 64, 1024, lb + 65536, scr, q, C.lane); continue; } q -= N_L64;
          transpose_item(INP(I_RG2) + (size_t)i * 128 * 1024, 128, 1024, lb + 131072, scr, q, C.lane); }
    }
    const int gt = C.bid * NT + C.tid, NGT = C.G * NT;
    for (int i = gt; i < 2 * 224 * 128; i += NGT) { const int l = i / (224 * 128), r = i % (224 * 128); ((u32x4*)(WSP(bf16, WS_WIN) + (size_t)l * HYB_NP * 1024 + (size_t)5920 * 1024))[r] = (u32x4){0u, 0u, 0u, 0u}; }
    for (int i = gt; i < 8193 * 8; i += NGT) { const int t = i >> 3, k = i & 7; const double inv = pow(500000.0, -(double)k / 8.0), ang = (double)t * inv;
        WSP(float, WS_ROPE)[t * 16 + k] = (float)cos(ang); WSP(float, WS_ROPE)[t * 16 + 8 + k] = (float)sin(ang); }
}

__device__ __forceinline__ void cache_roll_slice(const Ctx& C, int part, int nparts, int wk, int nwk) {
    if (wk < 0 || wk >= nwk) return;
#pragma unroll
    for (int g = 0; g < 3; ++g) {
        const int W = 128 << (2 * g); const size_t per = (size_t)(W - 1) * 256, tot = 64 * per, lo = tot * part / nparts, hi = tot * (part + 1) / nparts;
        const f32x4* src = (const f32x4*)INP(I_C0 + g); f32x4* dst = (f32x4*)((C.PP->out) + (g == 0 ? O_W0S : g == 1 ? O_W1S : O_W2S));
        for (size_t i = lo + (size_t)wk * NT + C.tid; i < hi; i += (size_t)nwk * NT) { const size_t ib = i / per, rem = i - ib * per; const f32x4 v = __builtin_nontemporal_load(src + (ib * W + 1) * 256 + rem); __builtin_nontemporal_store(v, dst + ib * W * 256 + rem); }
    }
}

__device__ __forceinline__ void p0_mod(const Ctx& C) {
    LAS f32x4* red = (LAS f32x4*)C.lds;
    const int q = C.lane >> 4, i = C.lane & 15;
    for (int u = C.bid; u < 384; u += C.G) {
        const int l = u / 96, n0 = (u % 96) * 64;
        const float* W = INP(I_ADAW) + (size_t)l * 1024 * 6144;
        f32x4 acc[3][4];
#pragma unroll
        for (int t = 0; t < 3; ++t)
#pragma unroll
            for (int n = 0; n < 4; ++n) acc[t][n] = (f32x4){0.f, 0.f, 0.f, 0.f};
        for (int kg = 0; kg < 8; ++kg) {
            const int k0 = 128 * C.wave + 16 * kg + 4 * q;
            f32x4 av[3], wv[4];
#pragma unroll
            for (int t = 0; t < 3; ++t) { const int s = 16 * t + i; av[t] = (f32x4){0.f, 0.f, 0.f, 0.f};
                if (s < NSEQ) { const float* cp = s < 2 ? INP(I_CP) + s * 1024 : INP(I_CS) + (s - 2) * 1024; const f32x4 v = *(const f32x4*)(cp + k0);
                    av[t] = (f32x4){siluf_(v[0]), siluf_(v[1]), siluf_(v[2]), siluf_(v[3])}; } }
#pragma unroll
            for (int m = 0; m < 4; ++m) wv[m] = *(const f32x4*)(W + (size_t)(k0 + m) * 6144 + n0 + 4 * i);
#pragma unroll
            for (int m = 0; m < 4; ++m)
#pragma unroll
                for (int t = 0; t < 3; ++t)
#pragma unroll
                    for (int n = 0; n < 4; ++n) acc[t][n] = __builtin_amdgcn_mfma_f32_16x16x4f32(av[t][m], wv[m][n], acc[t][n], 0, 0, 0);
        }
#pragma unroll
        for (int t = 0; t < 3; ++t)
#pragma unroll
            for (int r = 0; r < 4; ++r) red[(C.wave * 12 + t * 4 + r) * 64 + C.lane] = (f32x4){acc[t][0][r], acc[t][1][r], acc[t][2][r], acc[t][3][r]};
        __syncthreads();
        for (int e = C.tid; e < 768; e += NT) { const int slot = e >> 6, ln = e & 63; f32x4 s = red[slot * 64 + ln];
#pragma unroll
            for (int w = 1; w < 8; ++w) s += red[(w * 12 + slot) * 64 + ln];
            const int srow = 16 * (slot >> 2) + 4 * (ln >> 4) + (slot & 3), n = n0 + 4 * (ln & 15);
            if (srow < NSEQ) *(f32x4*)(WSP(float, WS_MOD) + ((size_t)l * NSEQ + srow) * 6144 + n) = s + *(const f32x4*)(INP(I_ADAB) + l * 6144 + n); }
        __syncthreads();
    }
}

__device__ __forceinline__ void norm_phase(const Ctx& C, int l, int which, bool from_input) {
    const int gw = C.bid * 8 + C.wave, NGW = C.G * 8;
    const float* g = INP(which ? I_NMLP : I_NMIX) + l * 1024;
    const int off_sh = which ? 3072 : 0, off_sc = which ? 4096 : 1024;
    for (int row = gw; row < T + NS; row += NGW) {
        const float* xr = from_input ? (row < T ? INP(I_XP) + (size_t)row * D : INP(I_XS) + (size_t)(row - T) * D) : WSP(float, WS_X) + (size_t)row * D;
        const int s = row < T ? (row >> 13) : 2 + row - T;
        const float* mod = WSP(float, WS_MOD) + ((size_t)l * NSEQ + s) * 6144;
        f32x4 v[4]; float ss = 0.f;
#pragma unroll
        for (int j = 0; j < 4; ++j) { v[j] = *(const f32x4*)(xr + 4 * C.lane + 256 * j); ss += (v[j][0] * v[j][0] + v[j][1] * v[j][1]) + (v[j][2] * v[j][2] + v[j][3] * v[j][3]); }
        const float rinv = rsqrtf(wave_sum(ss) * (1.f / D) + EPS);
#pragma unroll
        for (int j = 0; j < 4; ++j) { const int c = 4 * C.lane + 256 * j; const f32x4 gg = *(const f32x4*)(g + c), sh = *(const f32x4*)(mod + off_sh + c), sc = *(const f32x4*)(mod + off_sc + c);
            const f32x4 y = v[j] * rinv * gg * (sc + 1.f) + sh; *(u32x2*)(WSP(bf16, WS_XN) + (size_t)row * D + c) = pk4(y); }
    }
}
__device__ __forceinline__ void final_norm_phase(const Ctx& C) {
    const int gw = C.bid * 8 + C.wave, NGW = C.G * 8;
    const float* g = INP(I_NFIN);
    for (int row = gw; row < T + NS; row += NGW) {
        const float* xr = WSP(float, WS_X) + (size_t)row * D; float* o = (C.PP->out) + (row < T ? O_YP + (size_t)row * D : O_YS + (size_t)(row - T) * D);
        f32x4 v[4]; float ss = 0.f;
#pragma unroll
        for (int j = 0; j < 4; ++j) { v[j] = *(const f32x4*)(xr + 4 * C.lane + 256 * j); ss += (v[j][0] * v[j][0] + v[j][1] * v[j][1]) + (v[j][2] * v[j][2] + v[j][3] * v[j][3]); }
        const float rinv = rsqrtf(wave_sum(ss) * (1.f / D) + EPS);
#pragma unroll
        for (int j = 0; j < 4; ++j) { const int c = 4 * C.lane + 256 * j; *(f32x4*)(o + c) = v[j] * rinv * *(const f32x4*)(g + c); }
    }
}

constexpr size_t ROLL_T0 = (size_t)64 * 127 * 256, ROLL_T1 = (size_t)64 * 511 * 256, ROLL_T2 = (size_t)64 * 2047 * 256, ROLL_TOT = ROLL_T0 + ROLL_T1 + ROLL_T2;
constexpr int ROLL_NSL = 28 * 256, ROLL_L = (int)((ROLL_TOT + ROLL_NSL - 1) / ROLL_NSL);
static_assert(ROLL_L <= 12 * 512, "roll slice size");
struct RollArgs { const float* c0; const float* c1; const float* c2; float* out; int slot0; int* cnt; int bid; };
__device__ __forceinline__ void roll_addr(const RollArgs& R, size_t idx, const f32x4*& src, f32x4*& dst) {
    if (idx < ROLL_T0) { const size_t ib = idx / (127 * 256), rem = idx - ib * (127 * 256); src = (const f32x4*)R.c0 + (ib * 128 + 1) * 256 + rem; dst = (f32x4*)(R.out + O_W0S) + ib * 128 * 256 + rem; }
    else if (idx < ROLL_T0 + ROLL_T1) { const size_t j = idx - ROLL_T0, ib = j / (511 * 256), rem = j - ib * (511 * 256); src = (const f32x4*)R.c1 + (ib * 512 + 1) * 256 + rem; dst = (f32x4*)(R.out + O_W1S) + ib * 512 * 256 + rem; }
    else { const size_t j = idx - ROLL_T0 - ROLL_T1, ib = j / (2047 * 256), rem = j - ib * (2047 * 256); src = (const f32x4*)R.c2 + (ib * 2048 + 1) * 256 + rem; dst = (f32x4*)(R.out + O_W2S) + ib * 2048 * 256 + rem; }
}
#define ROLL_LOADS(R, tid) f32x4 _rv[12]; f32x4* _rd[12]; { const int _slice = ((R).slot0 + (*(R).cnt)++) * 256 + (R).bid; const size_t _b = (size_t)_slice * ROLL_L, _e = (_b + ROLL_L < ROLL_TOT) ? _b + ROLL_L : ROLL_TOT; \
    _Pragma("unroll") for (int _k = 0; _k < 12; ++_k) { const size_t _i = _b + (size_t)_k * 512 + (tid); _rd[_k] = nullptr; if (_i < _e) { const f32x4* _s; roll_addr(R, _i, _s, _rd[_k]); _rv[_k] = __builtin_nontemporal_load(_s); } } }
#define ROLL_STORES() do { _Pragma("unroll") for (int _k = 0; _k < 12; ++_k) if (_rd[_k]) __builtin_nontemporal_store(_rv[_k], _rd[_k]); } while (0)

using pg8::Unit;
struct EpiIn {
    static constexpr bool PERM = true, AFTER_DRAIN = false;
    bf16* U; float* DT; RollArgs R; bool roll;
    __device__ __forceinline__ void operator()(const f32x4 (&acc)[2][2][4][2], const Unit& u, int wr, int wc, int fr, int fq) const {
        const int row0 = u.pm * 256 + wr * 64 + fr, col0 = u.pn * 256 + wc * 32 + 8 * fq;
        ROLL_LOADS(R, (roll ? (wr * 4 + wc) * 64 + fq * 16 + fr : 1 << 30));
#pragma unroll
        for (int ai = 0; ai < 2; ++ai)
#pragma unroll
            for (int m = 0; m < 4; ++m) { const int row = row0 + ai * 128 + m * 16; bf16* rowp = U + (size_t)row * HYB_NP + col0;
#pragma unroll
                for (int bj = 0; bj < 2; ++bj) { const f32x4 v0 = acc[ai][bj][m][0], v1 = acc[ai][bj][m][1];
                    u32x4 w; w.x = pk2(v0[0], v0[1]); w.y = pk2(v0[2], v0[3]); w.z = pk2(v1[0], v1[1]); w.w = pk2(v1[2], v1[3]); *(u32x4*)(rowp + bj * 128) = w; }
                if (u.pn == 10 && wc == 0 && fq < 2) { *(f32x4*)(DT + (size_t)row * 16 + 8 * fq) = acc[ai][0][m][0]; *(f32x4*)(DT + (size_t)row * 16 + 8 * fq + 4) = acc[ai][0][m][1]; } }
        ROLL_STORES();
    }
};
struct EpiRes {
    static constexpr bool PERM = false, AFTER_DRAIN = false;
    const float* xin; float* xout; const float* gate;
    __device__ __forceinline__ void operator()(const f32x4 (&acc)[2][2][4][2], const Unit& u, int wr, int wc, int fr, int fq) const {
        const int row0 = u.pm * 256 + wr * 64 + fr, col0 = u.pn * 256 + wc * 32 + 4 * fq;
#pragma unroll
        for (int ai = 0; ai < 2; ++ai)
#pragma unroll
            for (int m = 0; m < 4; ++m) { const int row = row0 + ai * 128 + m * 16; const float* gp = gate + (size_t)(row >> 13) * 6144 + col0; const size_t off = (size_t)row * D + col0;
#pragma unroll
                for (int bj = 0; bj < 2; ++bj)
#pragma unroll
                    for (int n = 0; n < 2; ++n) { const int o = bj * 128 + n * 16; *(f32x4*)(xout + off + o) = *(const f32x4*)(xin + off + o) + *(const f32x4*)(gp + o) * acc[ai][bj][m][n]; } }
    }
};
struct EpiMlp1 {
    static constexpr bool PERM = true, AFTER_DRAIN = false;
    bf16* H; RollArgs R; bool roll;
    __device__ __forceinline__ void operator()(const f32x4 (&acc)[2][2][4][2], const Unit& u, int wr, int wc, int fr, int fq) const {
        const int row0 = u.pm * 256 + wr * 64 + fr, col0 = u.pn * 256 + wc * 32 + 8 * fq;
        ROLL_LOADS(R, (roll ? (wr * 4 + wc) * 64 + fq * 16 + fr : 1 << 30));
#pragma unroll
        for (int ai = 0; ai < 2; ++ai)
#pragma unroll
            for (int m = 0; m < 4; ++m) { bf16* rowp = H + (size_t)(row0 + ai * 128 + m * 16) * FF + col0;
#pragma unroll
                for (int bj = 0; bj < 2; ++bj) { f32x4 v0 = acc[ai][bj][m][0], v1 = acc[ai][bj][m][1];
#pragma unroll
                    for (int j = 0; j < 4; ++j) { const float a = fmaxf(v0[j], 0.f), b = fmaxf(v1[j], 0.f); v0[j] = a * a; v1[j] = b * b; }
                    u32x4 w; w.x = pk2(v0[0], v0[1]); w.y = pk2(v0[2], v0[3]); w.z = pk2(v1[0], v1[1]); w.w = pk2(v1[2], v1[3]); *(u32x4*)(rowp + bj * 128) = w; } }
        ROLL_STORES();
    }
};
struct EpiQkv {
    static constexpr bool PERM = true, AFTER_DRAIN = false;
    bf16* QKV; const float* rope; float* out; int li;
    __device__ __forceinline__ void operator()(const f32x4 (&acc)[2][2][4][2], const Unit& u, int wr, int wc, int fr, int fq) const {
        const int row0 = u.pm * 256 + wr * 64 + fr, colt = u.pn * 256, col0 = colt + wc * 32 + 8 * fq;
        const int grp = colt / 1536, s = (colt % 1536) / 512;
        const bool do_rope = (s < 2) && ((wc & 1) == 0);
        const int W = 128 << (2 * grp);
        float* wout = out + (grp == 0 ? O_W0P : grp == 1 ? O_W1P : O_W2P);
#pragma unroll
        for (int ai = 0; ai < 2; ++ai)
#pragma unroll
            for (int m = 0; m < 4; ++m) { const int row = row0 + ai * 128 + m * 16, t = row & 8191, b = row >> 13;
#pragma unroll
                for (int bj = 0; bj < 2; ++bj) { f32x4 v0 = acc[ai][bj][m][0], v1 = acc[ai][bj][m][1];
                    if (do_rope) {
                        f32x4 p0, p1;
#pragma unroll
                        for (int j = 0; j < 4; ++j) { p0[j] = __shfl_xor(v0[j], 16); p1[j] = __shfl_xor(v1[j], 16); }
                        if (fq < 2) { const f32x4 c0 = *(const f32x4*)(rope + t * 16), c1 = *(const f32x4*)(rope + t * 16 + 4), s0 = *(const f32x4*)(rope + t * 16 + 8), s1 = *(const f32x4*)(rope + t * 16 + 12);
                            if (fq == 0) { v0 = v0 * c0 - p0 * s0; v1 = v1 * c1 - p1 * s1; } else { v0 = v0 * c0 + p0 * s0; v1 = v1 * c1 + p1 * s1; } }
                    }
                    if (s == 0) { v0 *= 0.125f; v1 *= 0.125f; }
                    const int c = col0 + bj * 128;
                    u32x4 w; w.x = pk2(v0[0], v0[1]); w.y = pk2(v0[2], v0[3]); w.z = pk2(v1[0], v1[1]); w.w = pk2(v1[2], v1[3]); *(u32x4*)(QKV + (size_t)row * QKV_N + c) = w;
                    if (s >= 1 && t >= SEQ - W) { const int cc = c - grp * 1536 - s * 512; float* o = wout + ((size_t)(li * 2 + b) * W + (t - (SEQ - W))) * 1024 + (s - 1) * 512 + cc;
                        *(f32x4*)o = v0; *(f32x4*)(o + 4) = v1; }
                } }
    }
};

template <class F> __device__ __forceinline__ void small_gemm(const Ctx& C, const bf16* A, const bf16* Wt, int N, int K, F&& epi) {
    LAS float* red = (LAS float*)C.lds;
    const int kw = K / 8, steps = kw / 16;
    for (int u = C.G - 1 - (int)C.bid; u < N / 32; u += C.G) {
        const int n0 = 32 * u;
        f32x16 acc;
#pragma unroll
        for (int r = 0; r < 16; ++r) acc[r] = 0.f;
        const bf16* wp = Wt + (size_t)(n0 + (C.lane & 31)) * K + C.wave * kw + 8 * (C.lane >> 5);
        const bf16* ap = A + (size_t)(C.lane & 31) * K + C.wave * kw + 8 * (C.lane >> 5);
        for (int ks = 0; ks < steps; ++ks) { const bf16x8 wf = *(const bf16x8*)(wp + 16 * ks), af = *(const bf16x8*)(ap + 16 * ks); acc = __builtin_amdgcn_mfma_f32_32x32x16_bf16(wf, af, acc, 0, 0, 0); }
#pragma unroll
        for (int r = 0; r < 16; ++r) red[(C.wave * 16 + r) * 64 + C.lane] = acc[r];
        __syncthreads();
#pragma unroll
        for (int e2 = 0; e2 < 2; ++e2) { const int e = C.tid + e2 * NT, r = e >> 6, ln = e & 63; float s = 0.f;
#pragma unroll
            for (int w = 0; w < 8; ++w) s += red[(w * 16 + r) * 64 + ln];
            epi(ln & 31, n0 + (r & 3) + 8 * (r >> 2) + 4 * (ln >> 5), s); }
        __syncthreads();
    }
}

__device__ __forceinline__ void rwkv_prep_unit(const Ctx& C, int li, int tile) {
    const int t0 = tile * 64, tl0 = t0 & 8191, b = t0 >> 13, q = C.lane >> 4, fr = C.lane & 15, w = C.wave, tm = w >> 1, tn0 = (w & 1) * 2, tid = C.tid;
    LAS bf16* TXW = (LAS bf16*)C.lds; LAS bf16* XA = TXW + 64 * 72; LAS bf16* SXG = XA + 64 * 72;
    LAS float* WL = (LAS float*)(C.lds + 36864); LAS float* AL = WL + 64 * 68;
    const float* mu = INP(I_MU) + li * RWC;
    const int t = tid >> 3, part = tid & 7, c8 = part * 8;
    const bool first = (tl0 + t) == 0;
    const bf16* cur = WSP(bf16, WS_U) + (size_t)(t0 + t) * HYB_NP + U_RW;
    {
#pragma unroll
        for (int e = 0; e < 4; ++e) { const int cc = 3072 + part * 32 + 8 * e; const u32x4 cv = *(const u32x4*)(cur + cc); u32x4 pv = (u32x4){0u, 0u, 0u, 0u}; if (!first) pv = *(const u32x4*)(cur - HYB_NP + cc);
            const float* mp = mu + cc; float o[8];
#pragma unroll
            for (int j = 0; j < 4; ++j) { const float c0 = bflo(cv[j]), c1 = bfhi(cv[j]), p0 = bflo(pv[j]), p1 = bfhi(pv[j]); o[2 * j] = c0 + (p0 - c0) * mp[2 * j]; o[2 * j + 1] = c1 + (p1 - c1) * mp[2 * j + 1]; }
            if (part < 2) {
#pragma unroll
                for (int j = 0; j < 8; ++j) o[j] = tanh_(o[j]);
                *(LAS u32x4*)(TXW + t * 72 + part * 32 + 8 * e) = (u32x4){pk2(o[0], o[1]), pk2(o[2], o[3]), pk2(o[4], o[5]), pk2(o[6], o[7])};
            } else if (part < 4) {
                *(LAS u32x4*)(XA + t * 72 + (part - 2) * 32 + 8 * e) = (u32x4){pk2(o[0], o[1]), pk2(o[2], o[3]), pk2(o[4], o[5]), pk2(o[6], o[7])};
            } else {
#pragma unroll
                for (int j = 0; j < 8; ++j) o[j] = sigm_(o[j]);
                *(LAS u32x4*)(SXG + t * 136 + (part - 4) * 32 + 8 * e) = (u32x4){pk2(o[0], o[1]), pk2(o[2], o[3]), pk2(o[4], o[5]), pk2(o[6], o[7])};
            } }
    }
    if ((tile & 127) == 127 && t == 63) { float* so = (C.PP->out) + O_SHP + (size_t)(li * 2 + b) * RWC;
        for (int cc = part; cc < RWC; cc += 8) so[cc] = bf1(cur[cc]); }
    u32x4 pc[3], pp[3];
#define RP_LOAD(h_) do { _Pragma("unroll") for (int _s = 0; _s < 3; ++_s) { const int _cc = _s * 1024 + (h_) * 64 + c8; pc[_s] = *(const u32x4*)(cur + _cc); pp[_s] = (u32x4){0u, 0u, 0u, 0u}; if (!first) pp[_s] = *(const u32x4*)(cur - HYB_NP + _cc); } } while (0)
    RP_LOAD(0);
    LDS_BARRIER();
    const bf16* w2t = WSP(bf16, WS_LORA) + (size_t)li * 262144; const bf16* a2t = w2t + 65536; const bf16* g2t = w2t + 131072;
    bf16x8 fw[2], fa[2], fg[4];
#pragma unroll
    for (int ks = 0; ks < 2; ++ks) { fw[ks] = *(const LAS bf16x8*)(TXW + (16 * tm + fr) * 72 + ks * 32 + 8 * q); fa[ks] = *(const LAS bf16x8*)(XA + (16 * tm + fr) * 72 + ks * 32 + 8 * q); }
#pragma unroll
    for (int ks = 0; ks < 4; ++ks) fg[ks] = *(const LAS bf16x8*)(SXG + (16 * tm + fr) * 136 + ks * 32 + 8 * q);
#pragma unroll 1
    for (int h = 0; h < 16; ++h) {
#pragma unroll
        for (int t2 = 0; t2 < 2; ++t2) { const int tn = tn0 + t2, nrow = h * 64 + 16 * tn + fr, cc = h * 64 + 16 * tn + 4 * q; f32x4 xw = (f32x4){0.f, 0.f, 0.f, 0.f}, xa = xw, xg = xw;
#pragma unroll
            for (int ks = 0; ks < 2; ++ks) { xw = mfma16(*(const bf16x8*)(w2t + nrow * 64 + ks * 32 + 8 * q), fw[ks], xw); xa = mfma16(*(const bf16x8*)(a2t + nrow * 64 + ks * 32 + 8 * q), fa[ks], xa); }
#pragma unroll
            for (int ks = 0; ks < 4; ++ks) xg = mfma16(*(const bf16x8*)(g2t + nrow * 128 + ks * 32 + 8 * q), fg[ks], xg);
            *(LAS f32x4*)(WL + (16 * tm + fr) * 68 + 16 * tn + 4 * q) = xw + *(const f32x4*)(INP(I_RW0) + li * 1024 + cc);
            *(LAS f32x4*)(AL + (16 * tm + fr) * 68 + 16 * tn + 4 * q) = xa + *(const f32x4*)(INP(I_RA0) + li * 1024 + cc);
            *(u32x2*)(WSP(bf16, WS_G) + (size_t)(t0 + 16 * tm + fr) * 1024 + cc) = pk4(xg); }
        float rr[8], kx[8], vv[8];
        { const int ch0 = h * 64 + c8;
#pragma unroll
          for (int j = 0; j < 4; ++j) {
              { const float c0 = bflo(pc[0][j]), c1 = bfhi(pc[0][j]), p0 = bflo(pp[0][j]), p1 = bfhi(pp[0][j]); rr[2 * j] = c0 + (p0 - c0) * mu[ch0 + 2 * j]; rr[2 * j + 1] = c1 + (p1 - c1) * mu[ch0 + 2 * j + 1]; }
              { const float c0 = bflo(pc[1][j]), c1 = bfhi(pc[1][j]), p0 = bflo(pp[1][j]), p1 = bfhi(pp[1][j]); kx[2 * j] = c0 + (p0 - c0) * mu[1024 + ch0 + 2 * j]; kx[2 * j + 1] = c1 + (p1 - c1) * mu[1024 + ch0 + 2 * j + 1]; }
              { const float c0 = bflo(pc[2][j]), c1 = bfhi(pc[2][j]), p0 = bflo(pp[2][j]), p1 = bfhi(pp[2][j]); vv[2 * j] = c0 + (p0 - c0) * mu[2048 + ch0 + 2 * j]; vv[2 * j + 1] = c1 + (p1 - c1) * mu[2048 + ch0 + 2 * j + 1]; } } }
        if (h + 1 < 16) RP_LOAD(h + 1);
        LDS_BARRIER();
        {
            const int ch = h * 64 + c8; float ssq = 0.f;
            const f32x4 wl0 = *(const LAS f32x4*)(WL + t * 68 + c8), wl1 = *(const LAS f32x4*)(WL + t * 68 + c8 + 4), al0 = *(const LAS f32x4*)(AL + t * 68 + c8), al1 = *(const LAS f32x4*)(AL + t * 68 + c8 + 4);
            const float* kkw = INP(I_KK) + li * 1024 + ch; const float* kaw = INP(I_KA) + li * 1024 + ch;
            float wd[8], av[8], kn[8], kp[8];
#pragma unroll
            for (int j = 0; j < 8; ++j) { const float wl = j < 4 ? wl0[j & 3] : wl1[j & 3], al = j < 4 ? al0[j & 3] : al1[j & 3];
                wd[j] = __expf(-__expf(-softplus_(-wl) - 0.5f)); av[j] = sigm_(al); kn[j] = kx[j] * kkw[j]; ssq += kn[j] * kn[j]; kp[j] = kx[j] * (1.f + (av[j] - 1.f) * kaw[j]); }
            ssq += __shfl_xor(ssq, 1); ssq += __shfl_xor(ssq, 2); ssq += __shfl_xor(ssq, 4);
            const float inv = 1.f / fmaxf(sqrtf(ssq), 1e-12f);
#pragma unroll
            for (int j = 0; j < 8; ++j) kn[j] *= inv;
            unsigned char* rec = WSP(unsigned char, WS_REC) + ((size_t)(b * 16 + h) * SEQ + tl0 + t) * RECB;
            *(f32x4*)(rec + c8 * 4) = (f32x4){wd[0], wd[1], wd[2], wd[3]}; *(f32x4*)(rec + c8 * 4 + 16) = (f32x4){wd[4], wd[5], wd[6], wd[7]};
            *(u32x4*)(rec + 256 + c8 * 2) = (u32x4){pk2(rr[0], rr[1]), pk2(rr[2], rr[3]), pk2(rr[4], rr[5]), pk2(rr[6], rr[7])};
            *(u32x4*)(rec + 384 + c8 * 2) = (u32x4){pk2(kp[0], kp[1]), pk2(kp[2], kp[3]), pk2(kp[4], kp[5]), pk2(kp[6], kp[7])};
            *(u32x4*)(rec + 512 + c8 * 2) = (u32x4){pk2(vv[0], vv[1]), pk2(vv[2], vv[3]), pk2(vv[4], vv[5]), pk2(vv[6], vv[7])};
            *(u32x4*)(rec + 640 + c8 * 2) = (u32x4){pk2(-kn[0], -kn[1]), pk2(-kn[2], -kn[3]), pk2(-kn[4], -kn[5]), pk2(-kn[6], -kn[7])};
            *(u32x4*)(rec + 768 + c8 * 2) = (u32x4){pk2(kn[0] * av[0], kn[1] * av[1]), pk2(kn[2] * av[2], kn[3] * av[3]), pk2(kn[4] * av[4], kn[5] * av[5]), pk2(kn[6] * av[6], kn[7] * av[7])};
        }
        LDS_BARRIER();
    }
#undef RP_LOAD
}

__device__ __forceinline__ void ssd_a_unit(const Ctx& C, int li, int u) {
    const int g = u & 1, c = (u >> 1) & 63, b = u >> 7, t0 = b * SEQ + c * 128, q = C.lane >> 4, fr = C.lane & 15;
    LAS float* SC = (LAS float*)C.lds;
    LAS bf16* BT = (LAS bf16*)(C.lds + 4096);
    LAS bf16* XTs = (LAS bf16*)(C.lds + 4096 + 34816);
    const float* DTr = WSP(float, WS_DT); float* DTS = WSP(float, WS_DTS); float* ACS = WSP(float, WS_ACS);
    bf16* XTg = WSP(bf16, WS_XT) + ((size_t)(b * 64 + c) * 1024) * 128; bf16* BCg = WSP(bf16, WS_BC); float* CS = WSP(float, WS_CS);
    {
        const int h = g * 8 + C.wave; const float bias = INP(I_DTB)[li * 16 + h], A = -__expf(INP(I_ALOG)[li * 16 + h]);
        const int l0 = 2 * C.lane; const float d0 = softplus_(DTr[(size_t)(t0 + l0) * 16 + h] + bias), d1 = softplus_(DTr[(size_t)(t0 + l0 + 1) * 16 + h] + bias);
        const float a0 = d0 * A, a1 = d1 * A; float s = a0 + a1;
#pragma unroll
        for (int o = 1; o < 64; o <<= 1) { const float n = __shfl_up(s, o); if (C.lane >= o) s += n; }
        const float acs1 = s, acs0 = s - a1, tot = __shfl(s, 63);
        DTS[(size_t)(t0 + l0) * 16 + h] = d0; DTS[(size_t)(t0 + l0 + 1) * 16 + h] = d1; ACS[(size_t)(t0 + l0) * 16 + h] = acs0; ACS[(size_t)(t0 + l0 + 1) * 16 + h] = acs1;
        SC[C.wave * 128 + l0] = __expf(tot - acs0) * d0; SC[C.wave * 128 + l0 + 1] = __expf(tot - acs1) * d1;
    }
    __syncthreads();
    const float* cw = INP(I_CONVW) + (size_t)li * 4 * 1536; const float* cb = INP(I_CONVB) + (size_t)li * 1536;
    for (int pass = 0; pass < 2; ++pass) {
        const int nitems = pass == 0 ? 16 : 8;
        for (int it = C.wave; it < nitems; it += 8) { const int tb = it & 7, cblk = pass == 0 ? (it >> 3) : 2;
            int ch;
            if (cblk == 0) ch = (C.lane < 32 ? 1024 + g * 128 + 4 * C.lane : 1280 + g * 128 + 4 * (C.lane - 32)); else ch = g * 512 + (cblk - 1) * 256 + 4 * C.lane;
            const int tl = c * 128 + tb * 16;
            const bf16* up = WSP(bf16, WS_U) + (size_t)(t0 + tb * 16) * HYB_NP + U_XBC + ch;
            f32x4 uu[19];
#pragma unroll
            for (int k = 0; k < 19; ++k) { uu[k] = (f32x4){0.f, 0.f, 0.f, 0.f}; if (tl + k - 3 >= 0) uu[k] = bf4(*(const u32x2*)(up + (ptrdiff_t)(k - 3) * HYB_NP)); }
            const f32x4 w0 = *(const f32x4*)(cw + ch), w1 = *(const f32x4*)(cw + 1536 + ch), w2 = *(const f32x4*)(cw + 3072 + ch), w3 = *(const f32x4*)(cw + 4608 + ch), bb = *(const f32x4*)(cb + ch);
            if (c == 63 && tb == 7) { float* o = (C.PP->out) + O_CONVP + (size_t)(li * 2 + b) * 3 * 1536 + ch; *(f32x4*)o = uu[16]; *(f32x4*)(o + 1536) = uu[17]; *(f32x4*)(o + 3072) = uu[18]; }
            f32x4 y[16];
#pragma unroll
            for (int k = 0; k < 16; ++k) { f32x4 v = bb + w0 * uu[k] + w1 * uu[k + 1] + w2 * uu[k + 2] + w3 * uu[k + 3];
#pragma unroll
                for (int j = 0; j < 4; ++j) v[j] = siluf_(v[j]);
                y[k] = v; }
            if (cblk == 0) {
                const bool isB = C.lane < 32; const int n = 4 * (C.lane & 31);
#pragma unroll
                for (int k = 0; k < 16; ++k) *(u32x2*)(BCg + (size_t)(t0 + tb * 16 + k) * 512 + (isB ? 0 : 256) + g * 128 + n) = pk4(y[k]);
                if (isB) {
#pragma unroll
                    for (int j = 0; j < 4; ++j) { u32x4 lo, hi;
                        lo.x = pk2(y[0][j], y[1][j]); lo.y = pk2(y[2][j], y[3][j]); lo.z = pk2(y[4][j], y[5][j]); lo.w = pk2(y[6][j], y[7][j]);
                        hi.x = pk2(y[8][j], y[9][j]); hi.y = pk2(y[10][j], y[11][j]); hi.z = pk2(y[12][j], y[13][j]); hi.w = pk2(y[14][j], y[15][j]);
                        *(LAS u32x4*)(BT + (n + j) * 136 + tb * 16) = lo; *(LAS u32x4*)(BT + (n + j) * 136 + tb * 16 + 8) = hi; } }
            } else {
                const int xc = (cblk - 1) * 256 + 4 * C.lane;
                const int hl = xc >> 6;
                const int xl = (pass == 0 ? xc : xc - 256);
                float sc[16];
#pragma unroll
                for (int k = 0; k < 16; ++k) sc[k] = SC[hl * 128 + tb * 16 + k];
#pragma unroll
                for (int j = 0; j < 4; ++j) { u32x4 lo, hi;
                    lo.x = pk2(y[0][j], y[1][j]); lo.y = pk2(y[2][j], y[3][j]); lo.z = pk2(y[4][j], y[5][j]); lo.w = pk2(y[6][j], y[7][j]);
                    hi.x = pk2(y[8][j], y[9][j]); hi.y = pk2(y[10][j], y[11][j]); hi.z = pk2(y[12][j], y[13][j]); hi.w = pk2(y[14][j], y[15][j]);
                    bf16* gp = XTg + (size_t)(g * 512 + xc + j) * 128 + tb * 16; *(u32x4*)gp = lo; *(u32x4*)(gp + 8) = hi;
                    lo.x = pk2(y[0][j] * sc[0], y[1][j] * sc[1]); lo.y = pk2(y[2][j] * sc[2], y[3][j] * sc[3]); lo.z = pk2(y[4][j] * sc[4], y[5][j] * sc[5]); lo.w = pk2(y[6][j] * sc[6], y[7][j] * sc[7]);
                    hi.x = pk2(y[8][j] * sc[8], y[9][j] * sc[9]); hi.y = pk2(y[10][j] * sc[10], y[11][j] * sc[11]); hi.z = pk2(y[12][j] * sc[12], y[13][j] * sc[13]); hi.w = pk2(y[14][j] * sc[14], y[15][j] * sc[15]);
                    *(LAS u32x4*)(XTs + (xl + j) * 136 + tb * 16) = lo; *(LAS u32x4*)(XTs + (xl + j) * 136 + tb * 16 + 8) = hi; }
            }
        }
        __syncthreads();
        { const int hl = C.wave >> 1, h = g * 8 + pass * 4 + hl;
          float* csp = CS + (((size_t)(b * 64 + c) * 16 + h) * 64) * 128;
#pragma unroll
          for (int tmi = 0; tmi < 2; ++tmi) { const int tm = (C.wave & 1) * 2 + tmi; bf16x8 xf[4];
#pragma unroll
              for (int ks = 0; ks < 4; ++ks) xf[ks] = *(const LAS bf16x8*)(XTs + (hl * 64 + 16 * tm + fr) * 136 + ks * 32 + 8 * q);
#pragma unroll
              for (int tn = 0; tn < 8; ++tn) { f32x4 acc = (f32x4){0.f, 0.f, 0.f, 0.f};
#pragma unroll
                  for (int ks = 0; ks < 4; ++ks) acc = mfma16(*(const LAS bf16x8*)(BT + (16 * tn + fr) * 136 + ks * 32 + 8 * q), xf[ks], acc);
                  *(f32x4*)(csp + (size_t)(16 * tm + fr) * 128 + 16 * tn + 4 * q) = acc; } }
        }
        __syncthreads();
    }
}

__device__ __forceinline__ void rwkv_scan_unit(const Ctx& C, int unit) {
    const int bh = unit >> 3, c = (unit & 7) * 8 + C.wave, lane = C.lane;
    const unsigned char* rec = WSP(unsigned char, WS_REC) + ((size_t)bh * SEQ + c * 128) * RECB;
    unsigned* qo = WSP(unsigned, WS_QO) + ((size_t)bh * SEQ + c * 128) * 64;
    LAS float* buf = (LAS float*)(C.lds + C.wave * 12288);
    f32x2 Sl[32], Pm[32];
    int lopq = lane; asm volatile("" : "+v"(lopq));
#pragma unroll
    for (int j = 0; j < 32; ++j) { Sl[j] = (f32x2){0.f, 0.f}; Pm[j] = (f32x2){(2 * j == lopq) ? 1.f : 0.f, (2 * j + 1 == lopq) ? 1.f : 0.f}; }
    LAS unsigned char* raw = C.lds + 98304 + C.wave * 3584;
#define RW_LOAD(sbi) do { const unsigned char* _p = rec + (size_t)(sbi) * 3584; \
        __builtin_amdgcn_global_load_lds((const unsigned*)(_p + lane * 16), (LAS unsigned*)raw, 16, 0, 0); __builtin_amdgcn_global_load_lds((const unsigned*)(_p + 1024 + lane * 16), (LAS unsigned*)(raw + 1024), 16, 0, 0); \
        __builtin_amdgcn_global_load_lds((const unsigned*)(_p + 2048 + lane * 16), (LAS unsigned*)(raw + 2048), 16, 0, 0); if (lane < 32) __builtin_amdgcn_global_load_lds((const unsigned*)(_p + 3072 + lane * 16), (LAS unsigned*)(raw + 3072), 16, 0, 0); } while (0)
#define RW_PUT16(dst, o, v4) do { const int _s = (o) / RECB, _f = (o) - _s * RECB; LAS float* _d = (dst) + _s * 384; \
        if (_f < 256) { *(LAS f32x4*)(_d + 64 + (_f >> 2)) = __builtin_bit_cast(f32x4, v4); } \
        else { const int _e = (_f - 256) >> 1, _v = _e >> 6, _i = _e & 63; LAS float* _q = _d + (_v == 0 ? 0 : 64 + 64 * _v) + _i; \
               *(LAS f32x4*)_q = (f32x4){bflo((v4)[0]), bfhi((v4)[0]), bflo((v4)[1]), bfhi((v4)[1])}; *(LAS f32x4*)(_q + 4) = (f32x4){bflo((v4)[2]), bfhi((v4)[2]), bflo((v4)[3]), bfhi((v4)[3])}; } } while (0)
#define RW_STORE(dst, W0) do { if (W0) asm volatile("s_waitcnt vmcnt(0)" ::: "memory"); else asm volatile("s_waitcnt vmcnt(4)" ::: "memory");     { const u32x4 _a = *(const LAS u32x4*)(raw + lane * 16); RW_PUT16(dst, lane * 16, _a); } { const u32x4 _a = *(const LAS u32x4*)(raw + 1024 + lane * 16); RW_PUT16(dst, 1024 + lane * 16, _a); } \
        { const u32x4 _a = *(const LAS u32x4*)(raw + 2048 + lane * 16); RW_PUT16(dst, 2048 + lane * 16, _a); } if (lane < 32) { const u32x4 _a = *(const LAS u32x4*)(raw + 3072 + lane * 16); RW_PUT16(dst, 3072 + lane * 16, _a); } \
        asm volatile("s_waitcnt lgkmcnt(0)" ::: "memory"); } while (0)
    RW_LOAD(0); RW_STORE(buf, true); RW_LOAD(1);
    float sa_s = 0.f, sa_p = buf[256 + lane];
    for (int sb = 0; sb < 32; ++sb) {
        LAS float* cb = buf + (sb & 1) * 1536; LAS float* nb = buf + ((sb + 1) & 1) * 1536;
        if (sb + 1 < 32) RW_STORE(nb, sb == 0);
        if (sb + 2 < 32) RW_LOAD(sb + 2);
        for (int st = 0; st < 4; ++st) {
            const LAS float* v = cb + st * 384; const LAS float* nx = (st < 3) ? v + 384 : nb;
            const float vv = v[192 + lane];
            const f32x2 vv2 = (f32x2){vv, vv}, sas = (f32x2){sa_s, sa_s}, sap = (f32x2){sa_p, sa_p};
            f32x2 o2a = (f32x2){0.f, 0.f}, o2b = o2a, q2a = o2a, q2b = o2a, ns2a = o2a, ns2b = o2a, np2a = o2a, np2b = o2a;
            f32x4 r4 = *(const LAS f32x4*)(v), w4 = *(const LAS f32x4*)(v + 64), k4 = *(const LAS f32x4*)(v + 128), b4 = *(const LAS f32x4*)(v + 320), n4 = *(const LAS f32x4*)(nx + 256);
#pragma unroll
            for (int j = 0; j < 16; ++j) {
                f32x4 r4n = r4, w4n = w4, k4n = k4, b4n = b4, n4n = n4;
                if (j < 15) { r4n = *(const LAS f32x4*)(v + 4 * j + 4); w4n = *(const LAS f32x4*)(v + 64 + 4 * j + 4); k4n = *(const LAS f32x4*)(v + 128 + 4 * j + 4); b4n = *(const LAS f32x4*)(v + 320 + 4 * j + 4); n4n = *(const LAS f32x4*)(nx + 256 + 4 * j + 4); }
                {   const f32x2 r2 = (f32x2){r4[0], r4[1]}, w2 = (f32x2){w4[0], w4[1]}, k2 = (f32x2){k4[0], k4[1]}, b2 = (f32x2){b4[0], b4[1]}, n2 = (f32x2){n4[0], n4[1]};
                    f32x2 t = vv2 * k2; t = sas * b2 + t; Sl[2 * j] = Sl[2 * j] * w2 + t; o2a = Sl[2 * j] * r2 + o2a; ns2a = Sl[2 * j] * n2 + ns2a;
                    f32x2 tp = sap * b2; Pm[2 * j] = Pm[2 * j] * w2 + tp; q2a = Pm[2 * j] * r2 + q2a; np2a = Pm[2 * j] * n2 + np2a; }
                {   const f32x2 r2 = (f32x2){r4[2], r4[3]}, w2 = (f32x2){w4[2], w4[3]}, k2 = (f32x2){k4[2], k4[3]}, b2 = (f32x2){b4[2], b4[3]}, n2 = (f32x2){n4[2], n4[3]};
                    f32x2 t = vv2 * k2; t = sas * b2 + t; Sl[2 * j + 1] = Sl[2 * j + 1] * w2 + t; o2b = Sl[2 * j + 1] * r2 + o2b; ns2b = Sl[2 * j + 1] * n2 + ns2b;
                    f32x2 tp = sap * b2; Pm[2 * j + 1] = Pm[2 * j + 1] * w2 + tp; q2b = Pm[2 * j + 1] * r2 + q2b; np2b = Pm[2 * j + 1] * n2 + np2b; }
                r4 = r4n; w4 = w4n; k4 = k4n; b4 = b4n; n4 = n4n;
            }
            const f32x2 o2 = o2a + o2b, q2 = q2a + q2b, ns2 = ns2a + ns2b, np2 = np2a + np2b;
            qo[(size_t)(sb * 4 + st) * 64 + lane] = pk2(o2[0] + o2[1], q2[0] + q2[1]);
            sa_s = ns2[0] + ns2[1]; sa_p = np2[0] + np2[1];
        }
    }
    float* sl = WSP(float, WS_SL) + ((size_t)(bh * 64 + c) * 2) * 4096 + lane * 64;
#pragma unroll
    for (int j = 0; j < 16; ++j) { *(f32x4*)(sl + 4 * j) = (f32x4){Sl[2 * j][0], Sl[2 * j][1], Sl[2 * j + 1][0], Sl[2 * j + 1][1]}; *(f32x4*)(sl + 4096 + 4 * j) = (f32x4){Pm[2 * j][0], Pm[2 * j][1], Pm[2 * j + 1][0], Pm[2 * j + 1][1]}; }
}

__device__ __forceinline__ void ssd_scan_phase(const Ctx& C, int li) {
    const int gt = C.bid * NT + C.tid;
    if (gt >= 131072) return;
    const int n2 = gt & 63, p = (gt >> 6) & 63, h = (gt >> 12) & 15, b = gt >> 16;
    float* CS = WSP(float, WS_CS); const float* ACS = WSP(float, WS_ACS);
    f32x2 S = (f32x2){0.f, 0.f};
#pragma unroll 4
    for (int c = 0; c < 64; ++c) { float* ptr = CS + (((size_t)(b * 64 + c) * 16 + h) * 64 + p) * 128 + 2 * n2; const f32x2 v = *(const f32x2*)ptr; *(f32x2*)ptr = S;
        const float dec = __expf(ACS[(size_t)(b * SEQ + c * 128 + 127) * 16 + h]); S = S * dec + v; }
    *(f32x2*)((C.PP->out) + O_SSDP + ((size_t)((li * 2 + b) * 16 + h) * 64 + p) * 128 + 2 * n2) = S;
}

__device__ __forceinline__ void rwkv_combine_unit(const Ctx& C, int li, int bh) {
    LAS float* Ss = (LAS float*)C.lds;
    LAS float* Ps = Ss + 64 * 68;
    const int q = C.lane >> 4, fr = C.lane & 15, tm = C.wave >> 1, tnb = (C.wave & 1) * 2;
    const float* SL = WSP(float, WS_SL) + (size_t)bh * 64 * 2 * 4096; float* SST = WSP(float, WS_SST) + (size_t)bh * 64 * 4096;
    for (int e = C.tid; e < 64 * 68; e += NT) Ss[e] = 0.f;
    const int r0 = C.tid >> 4, c4 = (C.tid & 15) * 4;
    f32x4 pn0 = *(const f32x4*)(SL + 4096 + r0 * 64 + c4), pn1 = *(const f32x4*)(SL + 4096 + (r0 + 32) * 64 + c4);
    f32x4 ln[2];
#pragma unroll
    for (int t2 = 0; t2 < 2; ++t2)
#pragma unroll
        for (int r = 0; r < 4; ++r) ln[t2][r] = SL[(16 * tm + 4 * q + r) * 64 + 16 * (tnb + t2) + fr];
    __syncthreads();
    for (int c = 0; c < 64; ++c) {
        *(LAS f32x4*)(Ps + r0 * 72 + c4) = pn0; *(LAS f32x4*)(Ps + (r0 + 32) * 72 + c4) = pn1;
        f32x4 acc[2] = {ln[0], ln[1]};
        if (c + 1 < 64) { const float* Ln = SL + (size_t)(c + 1) * 8192; pn0 = *(const f32x4*)(Ln + 4096 + r0 * 64 + c4); pn1 = *(const f32x4*)(Ln + 4096 + (r0 + 32) * 64 + c4);
#pragma unroll
            for (int t2 = 0; t2 < 2; ++t2)
#pragma unroll
                for (int r = 0; r < 4; ++r) ln[t2][r] = Ln[(16 * tm + 4 * q + r) * 64 + 16 * (tnb + t2) + fr]; }
        LDS_BARRIER();
        *(f32x4*)(SST + (size_t)c * 4096 + r0 * 64 + c4) = *(const LAS f32x4*)(Ss + r0 * 68 + c4); *(f32x4*)(SST + (size_t)c * 4096 + (r0 + 32) * 64 + c4) = *(const LAS f32x4*)(Ss + (r0 + 32) * 68 + c4);
        { float av[16], bv[2][16];
#pragma unroll
          for (int k = 0; k < 16; ++k) { av[k] = Ss[(16 * tm + fr) * 68 + 4 * k + q]; bv[0][k] = Ps[(4 * k + q) * 72 + 16 * tnb + fr]; bv[1][k] = Ps[(4 * k + q) * 72 + 16 * (tnb + 1) + fr]; }
#pragma unroll
          for (int k = 0; k < 16; ++k) { acc[0] = __builtin_amdgcn_mfma_f32_16x16x4f32(av[k], bv[0][k], acc[0], 0, 0, 0); acc[1] = __builtin_amdgcn_mfma_f32_16x16x4f32(av[k], bv[1][k], acc[1], 0, 0, 0); } }
        LDS_BARRIER();
#pragma unroll
        for (int t2 = 0; t2 < 2; ++t2)
#pragma unroll
            for (int r = 0; r < 4; ++r) Ss[(16 * tm + 4 * q + r) * 68 + 16 * (tnb + t2) + fr] = acc[t2][r];
        LDS_BARRIER();
    }
    float* o = (C.PP->out) + O_WKVP + (size_t)(li * 32 + bh) * 4096;
    *(f32x4*)(o + r0 * 64 + c4) = *(const LAS f32x4*)(Ss + r0 * 68 + c4); *(f32x4*)(o + (r0 + 32) * 64 + c4) = *(const LAS f32x4*)(Ss + (r0 + 32) * 68 + c4);
    __syncthreads();
}

__device__ __forceinline__ void ssd_c_unit(const Ctx& C, int li, int u) {
    const int g = u & 1, c = (u >> 1) & 63, b = u >> 7, t0 = b * SEQ + c * 128, q = C.lane >> 4, fr = C.lane & 15, w = C.wave;
    LAS bf16* Cb = (LAS bf16*)C.lds;
    LAS bf16* Bb = Cb + 128 * 136;
    LAS bf16* XTh = Bb; LAS bf16* SINh = Bb + 64 * 136;
    LAS bf16* Mw = Bb + 128 * 136 + w * (16 * 136);
    LAS float* AD = (LAS float*)(Bb + 128 * 136 + 8 * 16 * 136);
    const bf16* BCg = WSP(bf16, WS_BC); const float* DTS = WSP(float, WS_DTS); const float* ACS = WSP(float, WS_ACS);
    const bf16* XTg = WSP(bf16, WS_XT) + ((size_t)(b * 64 + c) * 1024 + g * 512) * 128; const float* CS = WSP(float, WS_CS) + ((size_t)(b * 64 + c) * 16 + g * 8) * 8192;
    bf16* Y = WSP(bf16, WS_YCAT);
    for (int e = C.tid; e < 4096; e += NT) { const int r = e >> 5, cc = e & 31, isC = cc >> 4, c8 = (cc & 15) * 8;
        const u32x4 v = *(const u32x4*)(BCg + (size_t)(t0 + r) * 512 + (isC ? 256 : 0) + g * 128 + c8); *(LAS u32x4*)((isC ? Cb : Bb) + r * 136 + c8) = v; }
    __syncthreads();
    f32x4 cbv[8]; bf16x8 cf[4];
#pragma unroll
    for (int ks = 0; ks < 4; ++ks) cf[ks] = *(const LAS bf16x8*)(Cb + (16 * w + fr) * 136 + ks * 32 + 8 * q);
#pragma unroll
    for (int tn = 0; tn < 8; ++tn) { cbv[tn] = (f32x4){0.f, 0.f, 0.f, 0.f};
        if (tn <= w) {
#pragma unroll
            for (int ks = 0; ks < 4; ++ks) cbv[tn] = mfma16(*(const LAS bf16x8*)(Bb + (16 * tn + fr) * 136 + ks * 32 + 8 * q), cf[ks], cbv[tn]); } }
    __syncthreads();
    float ssq = 0.f;
    const int l = 16 * w + fr;
    const int r0 = C.tid >> 4, c8 = (C.tid & 15) * 8, zt = C.tid >> 3, zc = (C.tid & 7) * 8;
    LAS bf16* ZY = (LAS bf16*)(AD + 256);
    LAS float* RINV = (LAS float*)(ZY + 128 * 72);
    u32x4 xq0, xq1, zq0, zq1; f32x4 sq0, sq1, sq2, sq3; float adq = 0.f;
#define SC_LOAD(hh_) do { const bf16* _x = XTg + (size_t)((hh_) * 64 + r0) * 128 + c8; xq0 = *(const u32x4*)_x; xq1 = *(const u32x4*)(_x + 32 * 128); \
        const float* _s = CS + (size_t)(hh_) * 8192 + r0 * 128 + c8; sq0 = *(const f32x4*)_s; sq1 = *(const f32x4*)(_s + 4); sq2 = *(const f32x4*)(_s + 32 * 128); sq3 = *(const f32x4*)(_s + 32 * 128 + 4); \
        const bf16* _z = WSP(bf16, WS_U) + (size_t)(t0 + zt) * HYB_NP + (g * 8 + (hh_)) * 64 + zc; zq0 = *(const u32x4*)_z; zq1 = *(const u32x4*)(_z + (size_t)64 * HYB_NP); \
        if (C.tid < 256) adq = (C.tid < 128 ? ACS : DTS)[(size_t)(t0 + (C.tid & 127)) * 16 + g * 8 + (hh_)]; } while (0)
    SC_LOAD(0);
#pragma unroll 1
    for (int hh = 0; hh < 8; ++hh) { const int h = g * 8 + hh;
        if (hh > 0) { *(u32x4*)(Y + (size_t)(t0 + zt) * 2048 + g * 512 + (hh - 1) * 64 + zc) = *(const LAS u32x4*)(ZY + zt * 72 + zc); *(u32x4*)(Y + (size_t)(t0 + zt + 64) * 2048 + g * 512 + (hh - 1) * 64 + zc) = *(const LAS u32x4*)(ZY + (zt + 64) * 72 + zc); }
        *(LAS u32x4*)(ZY + zt * 72 + zc) = zq0; *(LAS u32x4*)(ZY + (zt + 64) * 72 + zc) = zq1;
        *(LAS u32x4*)(XTh + r0 * 136 + c8) = xq0; *(LAS u32x4*)(XTh + (r0 + 32) * 136 + c8) = xq1;
        *(LAS u32x4*)(SINh + r0 * 136 + c8) = (u32x4){pk2(sq0[0], sq0[1]), pk2(sq0[2], sq0[3]), pk2(sq1[0], sq1[1]), pk2(sq1[2], sq1[3])};
        *(LAS u32x4*)(SINh + (r0 + 32) * 136 + c8) = (u32x4){pk2(sq2[0], sq2[1]), pk2(sq2[2], sq2[3]), pk2(sq3[0], sq3[1]), pk2(sq3[2], sq3[3])};
        if (C.tid < 256) AD[C.tid] = adq;
        if (hh + 1 < 8) SC_LOAD(hh + 1);
        LDS_BARRIER();
        const float acl = AD[l];
#pragma unroll
        for (int tn = 0; tn < 8; ++tn) { f32x4 mv = (f32x4){0.f, 0.f, 0.f, 0.f};
            if (tn <= w) { const f32x4 as = *(const LAS f32x4*)(AD + 16 * tn + 4 * q), ds = *(const LAS f32x4*)(AD + 128 + 16 * tn + 4 * q);
#pragma unroll
                for (int j = 0; j < 4; ++j) { const int s = 16 * tn + 4 * q + j; mv[j] = (s <= l) ? cbv[tn][j] * __expf(acl - as[j]) * ds[j] : 0.f; } }
            *(LAS u32x2*)(Mw + fr * 136 + 16 * tn + 4 * q) = pk4(mv); }
        LDSW();
        const float eal = __expf(acl), Dh = INP(I_SSDD)[li * 16 + h];
        const int nks = (w + 2) >> 1;
#pragma unroll
        for (int tp = 0; tp < 4; ++tp) { f32x4 a1 = (f32x4){0.f, 0.f, 0.f, 0.f}, a2 = a1;
            for (int ks = 0; ks < nks; ++ks) a1 = mfma16(*(const LAS bf16x8*)(XTh + (16 * tp + fr) * 136 + ks * 32 + 8 * q), *(const LAS bf16x8*)(Mw + fr * 136 + ks * 32 + 8 * q), a1);
#pragma unroll
            for (int ks = 0; ks < 4; ++ks) a2 = mfma16(*(const LAS bf16x8*)(SINh + (16 * tp + fr) * 136 + ks * 32 + 8 * q), cf[ks], a2);
            const int p0 = 16 * tp + 4 * q;
            const f32x4 z = bf4(*(const LAS u32x2*)(ZY + l * 72 + p0));
            f32x4 y;
#pragma unroll
            for (int j = 0; j < 4; ++j) { const float xv = bf1(XTh[(p0 + j) * 136 + l]); y[j] = (a1[j] + eal * a2[j] + Dh * xv) * siluf_(z[j]); }
            const u32x2 yp = pk4(y); const f32x4 yr = bf4(yp); ssq += (yr[0] * yr[0] + yr[1] * yr[1]) + (yr[2] * yr[2] + yr[3] * yr[3]);
            *(LAS u32x2*)(ZY + l * 72 + p0) = yp; }
        LDS_BARRIER();
    }
#undef SC_LOAD
    ssq += __shfl_xor(ssq, 16); ssq += __shfl_xor(ssq, 32);
    if (q == 0) RINV[l] = rsqrtf(ssq * (1.f / 512.f) + EPS);
    *(u32x4*)(Y + (size_t)(t0 + zt) * 2048 + g * 512 + 7 * 64 + zc) = *(const LAS u32x4*)(ZY + zt * 72 + zc); *(u32x4*)(Y + (size_t)(t0 + zt + 64) * 2048 + g * 512 + 7 * 64 + zc) = *(const LAS u32x4*)(ZY + (zt + 64) * 72 + zc);
    asm volatile("s_waitcnt vmcnt(0)" ::: "memory");
    __syncthreads();
    const float* nw = INP(I_SNW) + li * 1024 + g * 512;
#pragma unroll
    for (int half = 0; half < 2; ++half) { const int tt = zt + 64 * half; const float ri = RINV[tt]; bf16* yr = Y + (size_t)(t0 + tt) * 2048 + g * 512 + zc; u32x4 yv[8];
#pragma unroll
        for (int hh = 0; hh < 8; ++hh) yv[hh] = *(const u32x4*)(yr + hh * 64);
#pragma unroll
        for (int hh = 0; hh < 8; ++hh) { const f32x4 n0 = *(const f32x4*)(nw + hh * 64 + zc), n1 = *(const f32x4*)(nw + hh * 64 + zc + 4); u32x4 o;
            o[0] = pk2(bflo(yv[hh][0]) * ri * n0[0], bfhi(yv[hh][0]) * ri * n0[1]); o[1] = pk2(bflo(yv[hh][1]) * ri * n0[2], bfhi(yv[hh][1]) * ri * n0[3]);
            o[2] = pk2(bflo(yv[hh][2]) * ri * n1[0], bfhi(yv[hh][2]) * ri * n1[1]); o[3] = pk2(bflo(yv[hh][3]) * ri * n1[2], bfhi(yv[hh][3]) * ri * n1[3]);
            *(u32x4*)(yr + hh * 64) = o; } }
    __syncthreads();
}

__device__ __forceinline__ void rwkv_out_phase(const Ctx& C, int li) {
    const int q = C.lane >> 4, fr = C.lane & 15, w = C.wave, tr = 16 * w + fr, tid = C.tid;
    LAS bf16* Qb = (LAS bf16*)C.lds;
    LAS bf16* Sb = Qb + 128 * 72;
    LAS bf16* OL = Sb + 64 * 72;
    LAS bf16* BN = OL + 128 * 72;
    LAS bf16* GG = BN + 128 * 72;
    LAS bf16* Ys = GG + 128 * 72;
    u32x4 pq[4]; f32x4 ps[2]; u32x4 pr[2], pk[2], pv[2], pg[2];
#define RO_LOAD(u_) do { const int _c = (u_) & 63, _bh = (u_) >> 6; const unsigned* _qo = WSP(unsigned, WS_QO) + ((size_t)_bh * SEQ + _c * 128) * 64; const float* _sst = WSP(float, WS_SST) + (size_t)(_bh * 64 + _c) * 4096; \
        _Pragma("unroll") for (int _i = 0; _i < 4; ++_i) { const int _e = tid + _i * NT; pq[_i] = *(const u32x4*)(_qo + (size_t)(_e >> 4) * 64 + (_e & 15) * 4); } \
        _Pragma("unroll") for (int _i = 0; _i < 2; ++_i) { const int _e = tid + _i * NT; ps[_i] = *(const f32x4*)(_sst + (_e >> 4) * 64 + (_e & 15) * 4); } \
        _Pragma("unroll") for (int _i = 0; _i < 2; ++_i) { const int _e = tid + _i * NT, _t = _e >> 3, _c8 = (_e & 7) * 8; const unsigned char* _rp = WSP(unsigned char, WS_REC) + ((size_t)_bh * SEQ + _c * 128 + _t) * RECB; \
            pr[_i] = *(const u32x4*)(_rp + 256 + _c8 * 2); pk[_i] = *(const u32x4*)(_rp + 384 + _c8 * 2); pv[_i] = *(const u32x4*)(_rp + 512 + _c8 * 2); \
            pg[_i] = *(const u32x4*)(WSP(bf16, WS_G) + (size_t)((_bh >> 4) * SEQ + _c * 128 + _t) * 1024 + (_bh & 15) * 64 + _c8); } } while (0)
    int u = C.bid;
    if (u < 2048) RO_LOAD(u);
    for (; u < 2048; u += C.G) {
        const int c = u & 63, bh = u >> 6, h = bh & 15, b = bh >> 4, t0 = b * SEQ + c * 128;
        const float* rkw = INP(I_RK) + li * 1024 + h * 64;
#pragma unroll
        for (int i = 0; i < 4; ++i) { const int e = tid + i * NT; const u32x4 v = pq[i]; u32x2 qv, ov; qv.x = (v[0] >> 16) | (v[1] & 0xffff0000u); qv.y = (v[2] >> 16) | (v[3] & 0xffff0000u);
            ov.x = (v[0] & 0xffffu) | (v[1] << 16); ov.y = (v[2] & 0xffffu) | (v[3] << 16);
            *(LAS u32x2*)(Qb + (e >> 4) * 72 + (e & 15) * 4) = qv; *(LAS u32x2*)(OL + (e >> 4) * 72 + (e & 15) * 4) = ov; }
#pragma unroll
        for (int i = 0; i < 2; ++i) { const int e = tid + i * NT; *(LAS u32x2*)(Sb + (e >> 4) * 72 + (e & 15) * 4) = pk4(ps[i]); }
#pragma unroll
        for (int i = 0; i < 2; ++i) { const int e = tid + i * NT, t = e >> 3, c8 = (e & 7) * 8; float rk = 0.f;
#pragma unroll
            for (int j = 0; j < 4; ++j) rk += bflo(pr[i][j]) * bflo(pk[i][j]) * rkw[c8 + 2 * j] + bfhi(pr[i][j]) * bfhi(pk[i][j]) * rkw[c8 + 2 * j + 1];
            rk += __shfl_xor(rk, 1); rk += __shfl_xor(rk, 2); rk += __shfl_xor(rk, 4);
            u32x4 bo;
#pragma unroll
            for (int j = 0; j < 4; ++j) bo[j] = pk2(rk * bflo(pv[i][j]), rk * bfhi(pv[i][j]));
            *(LAS u32x4*)(BN + t * 72 + c8) = bo; *(LAS u32x4*)(GG + t * 72 + c8) = pg[i]; }
        LDS_BARRIER();
        if (u + C.G < 2048) RO_LOAD(u + C.G);
        bf16x8 qf[2];
#pragma unroll
        for (int ks = 0; ks < 2; ++ks) qf[ks] = *(const LAS bf16x8*)(Qb + tr * 72 + ks * 32 + 8 * q);
        f32x4 o[4]; float sum = 0.f;
#pragma unroll
        for (int tn = 0; tn < 4; ++tn) { f32x4 a = bf4(*(const LAS u32x2*)(OL + tr * 72 + 16 * tn + 4 * q));
#pragma unroll
            for (int ks = 0; ks < 2; ++ks) a = mfma16(*(const LAS bf16x8*)(Sb + (16 * tn + fr) * 72 + ks * 32 + 8 * q), qf[ks], a);
            o[tn] = a; sum += (a[0] + a[1]) + (a[2] + a[3]); }
        sum += __shfl_xor(sum, 16); sum += __shfl_xor(sum, 32);
        const float mean = sum * (1.f / 64.f); float var = 0.f;
#pragma unroll
        for (int tn = 0; tn < 4; ++tn) { const f32x4 d = o[tn] - mean; var += (d[0] * d[0] + d[1] * d[1]) + (d[2] * d[2] + d[3] * d[3]); }
        var += __shfl_xor(var, 16); var += __shfl_xor(var, 32);
        const float rstd = rsqrtf(var * (1.f / 64.f) + LN_EPS);
        const float* lw = INP(I_LNW) + li * 1024 + h * 64; const float* lb = INP(I_LNB) + li * 1024 + h * 64;
#pragma unroll
        for (int tn = 0; tn < 4; ++tn) { const int cc = 16 * tn + 4 * q; const f32x4 bon = bf4(*(const LAS u32x2*)(BN + tr * 72 + cc)), gg = bf4(*(const LAS u32x2*)(GG + tr * 72 + cc));
            const f32x4 y = ((o[tn] - mean) * rstd * *(const f32x4*)(lw + cc) + *(const f32x4*)(lb + cc) + bon) * gg; *(LAS u32x2*)(Ys + tr * 72 + cc) = pk4(y); }
        LDS_BARRIER();
#pragma unroll
        for (int i = 0; i < 2; ++i) { const int e = tid + i * NT, t = e >> 3, c8 = (e & 7) * 8; *(u32x4*)(WSP(bf16, WS_YCAT) + (size_t)(t0 + t) * 2048 + 1024 + h * 64 + c8) = *(const LAS u32x4*)(Ys + t * 72 + c8); }
    }
#undef RO_LOAD
}

__device__ __forceinline__ void attn_tile_unit(const Ctx& C, int u) {
    const int g = u >> 10, r = u & 1023, b = r >> 9, h = (r >> 6) & 7, qt = r & 63, q = C.lane >> 4, fr = C.lane & 15, w = C.wave;
    const int dsh = 2 * g, tpr = 64 >> dsh, rho = qt / tpr, i0 = (qt % tpr) * 128;
    LAS bf16* Qs = (LAS bf16*)C.lds;
    LAS bf16* Ks = Qs + 128 * 72;
    LAS bf16* VT = Ks + 256 * 72;
    const bf16* QKV = WSP(bf16, WS_QKV) + (size_t)b * SEQ * QKV_N + g * 1536 + h * 64;
    for (int e = C.tid; e < 1024; e += NT) { const int rr = e >> 3, c8 = (e & 7) * 8; const int t = rho + ((i0 + rr) << dsh); *(LAS u32x4*)(Qs + rr * 72 + c8) = *(const u32x4*)(QKV + (size_t)t * QKV_N + c8); }
    for (int e = C.tid; e < 2048; e += NT) { const int kk = e >> 3, c8 = (e & 7) * 8; const int idx = i0 - 128 + kk; u32x4 kv = (u32x4){0u, 0u, 0u, 0u}, vv = kv;
        if (idx >= 0) { const bf16* p = QKV + (size_t)(rho + (idx << dsh)) * QKV_N + c8; kv = *(const u32x4*)(p + 512); vv = *(const u32x4*)(p + 1024); }
        *(LAS u32x4*)(Ks + kk * 72 + c8) = kv;
#pragma unroll
        for (int j = 0; j < 4; ++j) { VT[(c8 + 2 * j) * 264 + kk] = (bf16)(vv[j] & 0xffffu); VT[(c8 + 2 * j + 1) * 264 + kk] = (bf16)(vv[j] >> 16); } }
    __syncthreads();
    bf16x8 qf[2];
#pragma unroll
    for (int ks = 0; ks < 2; ++ks) qf[ks] = *(const LAS bf16x8*)(Qs + (16 * w + fr) * 72 + ks * 32 + 8 * q);
    const int ql = 16 * w + fr, kmin = (i0 == 0) ? 128 : 0;
    f32x4 s[10]; float mx = -3.0e38f;
#pragma unroll
    for (int kt = 0; kt < 10; ++kt) { s[kt] = (f32x4){0.f, 0.f, 0.f, 0.f};
        if (kt < 9) {
#pragma unroll
            for (int ks = 0; ks < 2; ++ks) s[kt] = mfma16(*(const LAS bf16x8*)(Ks + (16 * (w + kt) + fr) * 72 + ks * 32 + 8 * q), qf[ks], s[kt]); }
#pragma unroll
        for (int j = 0; j < 4; ++j) { const int kk = 16 * (w + kt) + 4 * q + j; const bool ok = (kt < 9) && kk >= ql && kk <= ql + 128 && kk >= kmin; s[kt][j] = ok ? s[kt][j] : -3.0e38f; mx = fmaxf(mx, s[kt][j]); } }
    mx = fmaxf(mx, __shfl_xor(mx, 16)); mx = fmaxf(mx, __shfl_xor(mx, 32));
    float lsum = 0.f;
#pragma unroll
    for (int kt = 0; kt < 10; ++kt)
#pragma unroll
        for (int j = 0; j < 4; ++j) { const float p = (s[kt][j] > -1.0e38f) ? __expf(s[kt][j] - mx) : 0.f; s[kt][j] = p; lsum += p; }
    lsum += __shfl_xor(lsum, 16); lsum += __shfl_xor(lsum, 32);
    f32x4 od[4];
#pragma unroll
    for (int tn = 0; tn < 4; ++tn) od[tn] = (f32x4){0.f, 0.f, 0.f, 0.f};
#pragma unroll
    for (int pr = 0; pr < 5; ++pr) { const int ta = w + 2 * pr, tb = (w + 2 * pr + 1 > 15) ? 15 : (w + 2 * pr + 1);
        const u32x2 pa = pk4(s[2 * pr]), pb = pk4(s[2 * pr + 1]); const u32x4 pw = (u32x4){pa.x, pa.y, pb.x, pb.y}; const bf16x8 pf = __builtin_bit_cast(bf16x8, pw);
#pragma unroll
        for (int tn = 0; tn < 4; ++tn) { const LAS bf16* vp = VT + (16 * tn + fr) * 264 + 4 * q; const u32x2 va = *(const LAS u32x2*)(vp + 16 * ta), vb = *(const LAS u32x2*)(vp + 16 * tb);
            const u32x4 vw = (u32x4){va.x, va.y, vb.x, vb.y}; od[tn] = mfma16(__builtin_bit_cast(bf16x8, vw), pf, od[tn]); } }
    const float il = 1.f / lsum; const int t = b * SEQ + rho + ((i0 + ql) << dsh);
    bf16* og = WSP(bf16, WS_OG) + ((size_t)g * T + t) * 512 + h * 64;
#pragma unroll
    for (int tn = 0; tn < 4; ++tn) *(u32x2*)(og + 16 * tn + 4 * q) = pk4(od[tn] * il);
    if (q == 0) WSP(float, WS_LSE)[((size_t)g * T + t) * 8 + h] = mx + __logf(lsum);
    __syncthreads();
}

__device__ __forceinline__ void attn_merge_phase(const Ctx& C) {
    const bf16* OG = WSP(bf16, WS_OG); const float* LSE = WSP(float, WS_LSE); bf16* AO = WSP(bf16, WS_AO);
    for (size_t e = (size_t)C.bid * NT + C.tid; e < (size_t)T * 64; e += (size_t)C.G * NT) { const size_t t = e >> 6; const int c8 = (int)(e & 63) * 8, h = c8 >> 6;
        const float l0 = LSE[t * 8 + h], l1 = LSE[((size_t)T + t) * 8 + h], l2 = LSE[((size_t)2 * T + t) * 8 + h]; const float m = fmaxf(l0, fmaxf(l1, l2));
        float a0 = __expf(l0 - m), a1 = __expf(l1 - m), a2 = __expf(l2 - m); const float inv = 1.f / (a0 + a1 + a2); a0 *= inv; a1 *= inv; a2 *= inv;
        const u32x4 v0 = *(const u32x4*)(OG + t * 512 + c8), v1 = *(const u32x4*)(OG + ((size_t)T + t) * 512 + c8), v2 = *(const u32x4*)(OG + ((size_t)2 * T + t) * 512 + c8); u32x4 o;
#pragma unroll
        for (int j = 0; j < 4; ++j) o[j] = pk2(a0 * bflo(v0[j]) + a1 * bflo(v1[j]) + a2 * bflo(v2[j]), a0 * bfhi(v0[j]) + a1 * bfhi(v1[j]) + a2 * bfhi(v2[j]));
        *(u32x4*)(AO + t * 512 + c8) = o; }
}

__device__ __forceinline__ void s_ssd_unit(const Ctx& C, int li, int u) {
    const int b = u >> 1, g = u & 1, hh = C.wave, h = g * 8 + hh, lane = C.lane;
    LAS float* xs = (LAS float*)(C.lds + hh * 2048);
    LAS float* Bs = xs + 64; LAS float* Cs = xs + 192;
    LAS float* ys = (LAS float*)(C.lds + 16384);
    LAS float* rs = ys + 512;
    const float* us = WSP(float, WS_SMALL) + (size_t)b * HYB_NP;
    const float* cst = INP(I_CONV) + ((size_t)(li * 32 + b) * 3) * 1536;
    const float* cw = INP(I_CONVW) + (size_t)li * 4 * 1536; const float* cb = INP(I_CONVB) + (size_t)li * 1536;
    auto conv = [&](int ch) { return siluf_(cb[ch] + cw[ch] * cst[ch] + cw[1536 + ch] * cst[1536 + ch] + cw[3072 + ch] * cst[3072 + ch] + cw[4608 + ch] * us[U_XBC + ch]); };
    xs[lane] = conv(h * 64 + lane);
    Bs[lane] = conv(1024 + g * 128 + lane); Bs[64 + lane] = conv(1024 + g * 128 + 64 + lane);
    Cs[lane] = conv(1280 + g * 128 + lane); Cs[64 + lane] = conv(1280 + g * 128 + 64 + lane);
    { float* co = (C.PP->out) + O_CONVS + ((size_t)(li * 32 + b) * 3) * 1536;
      for (int e = C.tid; e < 768; e += NT) { const int ch = e < 512 ? g * 512 + e : (e < 640 ? 1024 + g * 128 + (e - 512) : 1280 + g * 128 + (e - 640));
          co[ch] = cst[1536 + ch]; co[1536 + ch] = cst[3072 + ch]; co[3072 + ch] = us[U_XBC + ch]; } }
    LDSW();
    const float dt = softplus_(us[U_DT + h] + INP(I_DTB)[li * 16 + h]), dA = __expf(-dt * __expf(INP(I_ALOG)[li * 16 + h])), Dh = INP(I_SSDD)[li * 16 + h];
    const int pp = lane >> 3, nn = (lane & 7) * 16;
    f32x4 Bv[4], Cv[4];
#pragma unroll
    for (int j = 0; j < 4; ++j) { Bv[j] = *(const LAS f32x4*)(Bs + nn + 4 * j); Cv[j] = *(const LAS f32x4*)(Cs + nn + 4 * j); }
    const float* sin_ = INP(I_SSD) + ((size_t)(li * 32 + b) * 16 + h) * 8192; float* sout = (C.PP->out) + O_SSDS + ((size_t)(li * 32 + b) * 16 + h) * 8192;
    float yv = 0.f;
#pragma unroll
    for (int it = 0; it < 8; ++it) { const int p = it * 8 + pp; const float xp = xs[p], dx = dt * xp; float part = 0.f;
#pragma unroll
        for (int j = 0; j < 4; ++j) { f32x4 s = *(const f32x4*)(sin_ + p * 128 + nn + 4 * j); s = s * dA + Bv[j] * dx; *(f32x4*)(sout + p * 128 + nn + 4 * j) = s;
            part += (s[0] * Cv[j][0] + s[1] * Cv[j][1]) + (s[2] * Cv[j][2] + s[3] * Cv[j][3]); }
        part += __shfl_xor(part, 1); part += __shfl_xor(part, 2); part += __shfl_xor(part, 4);
        if ((lane & 7) == it) yv = part + Dh * xp; }
    { const int p = (lane & 7) * 8 + (lane >> 3); const float z = us[h * 64 + p]; const float y = yv * siluf_(z); ys[hh * 64 + p] = y; const float ss = wave_sum(y * y); if (lane == 0) rs[hh] = ss; }
    __syncthreads();
    { float tot = 0.f;
#pragma unroll
      for (int j = 0; j < 8; ++j) tot += rs[j];
      const float rinv = rsqrtf(tot * (1.f / 512.f) + EPS); const int cc = C.tid;
      WSP(bf16, WS_YCAT)[(size_t)(T + b) * 2048 + g * 512 + cc] = (bf16)(pk2(ys[cc] * rinv * INP(I_SNW)[li * 1024 + g * 512 + cc], 0.f) & 0xffffu); }
    __syncthreads();
}

__device__ __forceinline__ void s_rwkv_unit(const Ctx& C, int li, int b) {
    const int lane = C.lane, tid = C.tid;
    LAS float* mix = (LAS float*)C.lds;
    LAS float* act = mix + 3328;
    LAS float* vec = act + 256;
    LAS float* hv = vec + 3072;
    const float* us = WSP(float, WS_SMALL) + (size_t)b * HYB_NP + U_RW;
    const float* sst = INP(I_SHIFT) + (size_t)(li * 32 + b) * RWC; const float* mu = INP(I_MU) + li * RWC;
    float* sho = (C.PP->out) + O_SHS + (size_t)(li * 32 + b) * RWC;
    for (int c = tid; c < RWC; c += NT) { const float cur = us[c]; mix[c] = cur + (sst[c] - cur) * mu[c]; sho[c] = cur; }
    __syncthreads();
    if (tid < 256) { const float x = mix[3072 + tid]; act[tid] = tid < 64 ? tanhf(x) : (tid < 128 ? x : sigm_(x)); }
    __syncthreads();
    const float* w2 = INP(I_RW2) + (size_t)li * 64 * 1024; const float* a2 = INP(I_RA2) + (size_t)li * 64 * 1024; const float* g2 = INP(I_RG2) + (size_t)li * 128 * 1024;
    {   LAS float* part = hv + 8 * 192;
        const int cq = tid & 63, sl = tid >> 6;
        for (int cb = 0; cb < 4; ++cb) { const int c = cb * 256 + cq * 4;
            f32x4 aw = (f32x4){0.f, 0.f, 0.f, 0.f}, aa = aw, ag = aw;
#pragma unroll
            for (int j = 0; j < 8; ++j) { const int r = sl * 8 + j; aw += *(const f32x4*)(w2 + (size_t)r * 1024 + c) * act[r]; aa += *(const f32x4*)(a2 + (size_t)r * 1024 + c) * act[64 + r]; }
#pragma unroll
            for (int j = 0; j < 16; ++j) { const int r = sl * 16 + j; ag += *(const f32x4*)(g2 + (size_t)r * 1024 + c) * act[128 + r]; }
            *(LAS f32x4*)(part + (sl * 3 + 0) * 1024 + c) = aw; *(LAS f32x4*)(part + (sl * 3 + 1) * 1024 + c) = aa; *(LAS f32x4*)(part + (sl * 3 + 2) * 1024 + c) = ag; }
        __syncthreads();
        for (int c = tid; c < 1024; c += NT) { float wl = INP(I_RW0)[li * 1024 + c], al = INP(I_RA0)[li * 1024 + c], gl = 0.f;
#pragma unroll
            for (int k = 0; k < 8; ++k) { wl += part[(k * 3 + 0) * 1024 + c]; al += part[(k * 3 + 1) * 1024 + c]; gl += part[(k * 3 + 2) * 1024 + c]; }
            vec[c] = __expf(-__expf(-softplus_(-wl) - 0.5f)); vec[1024 + c] = sigm_(al); vec[2048 + c] = gl; }
    }
    __syncthreads();
    LAS float* my = hv + C.wave * 192;
    for (int hh = 0; hh < 2; ++hh) { const int h = 2 * C.wave + hh, c = h * 64 + lane;
        const float r = mix[c], k = mix[1024 + c], v = mix[2048 + c], w = vec[c], a = vec[1024 + c], gt = vec[2048 + c];
        const float kk = k * INP(I_KK)[li * 1024 + c]; const float inv = 1.f / fmaxf(sqrtf(wave_sum(kk * kk)), 1e-12f); const float kkn = kk * inv;
        const float kp = k * (1.f + (a - 1.f) * INP(I_KA)[li * 1024 + c]);
        my[lane] = -kkn; my[64 + lane] = kkn * a; my[128 + lane] = kp; LDSW();
        const float* sin_ = INP(I_WKV) + ((size_t)(li * 32 + b) * 16 + h) * 4096 + lane * 64; float* sout = (C.PP->out) + O_WKVS + ((size_t)(li * 32 + b) * 16 + h) * 4096 + lane * 64;
        f32x4 S[16]; float sa = 0.f;
#pragma unroll
        for (int j = 0; j < 16; ++j) { S[j] = *(const f32x4*)(sin_ + 4 * j); const f32x4 n4 = *(const LAS f32x4*)(my + 4 * j); sa += (S[j][0] * n4[0] + S[j][1] * n4[1]) + (S[j][2] * n4[2] + S[j][3] * n4[3]); }
        float o = 0.f;
#pragma unroll
        for (int j = 0; j < 16; ++j) { const f32x4 b4 = *(const LAS f32x4*)(my + 64 + 4 * j), k4 = *(const LAS f32x4*)(my + 128 + 4 * j), w4 = *(const LAS f32x4*)(vec + h * 64 + 4 * j), r4 = *(const LAS f32x4*)(mix + h * 64 + 4 * j);
            S[j] = S[j] * w4 + b4 * sa + k4 * v; *(f32x4*)(sout + 4 * j) = S[j]; o += (S[j][0] * r4[0] + S[j][1] * r4[1]) + (S[j][2] * r4[2] + S[j][3] * r4[3]); }
        const float mean = wave_sum(o) * (1.f / 64.f), d = o - mean, var = wave_sum(d * d) * (1.f / 64.f);
        float y = d * rsqrtf(var + LN_EPS) * INP(I_LNW)[li * 1024 + c] + INP(I_LNB)[li * 1024 + c];
        const float rk = wave_sum(r * kp * INP(I_RK)[li * 1024 + c]);
        y = (y + rk * v) * gt;
        WSP(bf16, WS_YCAT)[(size_t)(T + b) * 2048 + 1024 + c] = (bf16)(pk2(y, 0.f) & 0xffffu);
        LDSW();
    }
    __syncthreads();
}

__device__ __forceinline__ void s_attn_unit(const Ctx& C, int li, int u) {
    const int b = u >> 3, h = u & 7, lane = C.lane, g = C.wave;
    LAS float* qs = (LAS float*)(C.lds + C.wave * 1024);
    LAS float* res = (LAS float*)(C.lds + 8192);
    const float* qkv = WSP(float, WS_SMALL) + MiB / 4 + (size_t)b * QKV_N;
    const float* rp = WSP(float, WS_ROPE) + 8192 * 16;
    if (g < 3) {
        const int W = 128 << (2 * g), dsh = 2 * g;
        const float* base = qkv + g * 1536 + h * 64;
        float qv = base[lane], kv = base[512 + lane], vv = base[1024 + lane];
        {
            const float qo_ = __shfl_xor(qv, 8), ko_ = __shfl_xor(kv, 8);
            if (lane < 16) { const float cs = rp[lane & 7], sn = rp[8 + (lane & 7)]; if (lane < 8) { qv = qv * cs - qo_ * sn; kv = kv * cs - ko_ * sn; } else { qv = qv * cs + qo_ * sn; kv = kv * cs + ko_ * sn; } }
        }
        qv *= 0.125f;
        float* wo = (C.PP->out) + (g == 0 ? O_W0S : g == 1 ? O_W1S : O_W2S) + ((size_t)(li * 32 + b) * W + (W - 1)) * 1024;
        wo[h * 64 + lane] = kv; wo[512 + h * 64 + lane] = vv;
        qs[lane] = qv; LDSW();
        f32x4 q4[16];
#pragma unroll
        for (int j = 0; j < 16; ++j) q4[j] = *(const LAS f32x4*)(qs + 4 * j);
        const float* cache = INP(g == 0 ? I_C0 : g == 1 ? I_C1 : I_C2) + ((size_t)(li * 32 + b) * W) * 1024 + h * 64;
        float sc0, sc1;
        { const float* k0 = cache + (size_t)(W - ((lane + 1) << dsh)) * 1024; const float* k1 = cache + (size_t)(W - ((lane + 65) << dsh)) * 1024; float a0 = 0.f, a1 = 0.f;
#pragma unroll
          for (int j = 0; j < 16; ++j) { const f32x4 x0 = *(const f32x4*)(k0 + 4 * j), x1 = *(const f32x4*)(k1 + 4 * j);
              a0 += (x0[0] * q4[j][0] + x0[1] * q4[j][1]) + (x0[2] * q4[j][2] + x0[3] * q4[j][3]); a1 += (x1[0] * q4[j][0] + x1[1] * q4[j][1]) + (x1[2] * q4[j][2] + x1[3] * q4[j][3]); }
          sc0 = a0; sc1 = a1; }
        const float ss = wave_sum(qv * kv);
        const float m = fmaxf(ss, wave_max(fmaxf(sc0, sc1)));
        const float p0 = __expf(sc0 - m), p1 = __expf(sc1 - m), ps = __expf(ss - m);
        const float l = wave_sum(p0 + p1) + ps;
        float o = ps * vv;
#pragma unroll 1
        for (int jb = 0; jb < 2; ++jb) { float va[32], vb[32];
#pragma unroll
            for (int j = 0; j < 32; ++j) { va[j] = cache[(size_t)(W - ((jb * 32 + j + 1) << dsh)) * 1024 + 512 + lane]; vb[j] = cache[(size_t)(W - ((jb * 32 + j + 65) << dsh)) * 1024 + 512 + lane]; }
#pragma unroll
            for (int j = 0; j < 32; ++j) o += __shfl(p0, jb * 32 + j) * va[j] + __shfl(p1, jb * 32 + j) * vb[j]; }
        res[g * 64 + lane] = o / l; if (lane == 0) res[192 + g] = m + __logf(l);
    }
    __syncthreads();
    if (C.wave == 0) { const float l0 = res[192], l1 = res[193], l2 = res[194]; const float m = fmaxf(l0, fmaxf(l1, l2)); float a0 = __expf(l0 - m), a1 = __expf(l1 - m), a2 = __expf(l2 - m); const float inv = 1.f / (a0 + a1 + a2);
        const float o = (a0 * res[lane] + a1 * res[64 + lane] + a2 * res[128 + lane]) * inv;
        WSP(bf16, WS_AO)[(size_t)(T + b) * 512 + h * 64 + lane] = (bf16)(pk2(o, 0.f) & 0xffffu); }
    __syncthreads();
}

#ifndef PROBE_DUP
#define PROBE_DUP 0
#endif
__global__ void __launch_bounds__(512, 2) mk_fwd(Params P) {
    extern __shared__ __attribute__((aligned(16))) unsigned char lds_raw[];
    Ctx C;
    C.lds = (LAS unsigned char*)lds_raw;
#define PHASE() do { unsigned long long _k = (unsigned long long)__builtin_amdgcn_kernarg_segment_ptr(); int _t = threadIdx.x, _b = blockIdx.x, _g = gridDim.x; asm volatile("" : "+s"(_k), "+v"(_t), "+s"(_b), "+s"(_g)); \
        C.PP = (const CAS Params*)_k; C.tid = _t; C.lane = _t & 63; C.wave = __builtin_amdgcn_readfirstlane(_t >> 6); C.G = _g; C.bid = _b; } while (0)
    PHASE();
    for (int u = C.tid; u < (LDS_BYTES - LDS_RING) / 4; u += NT) ((LAS unsigned*)(C.lds + LDS_RING))[u] = 0u;
    __syncthreads();
    (void)xcd_barrier_post((unsigned*)((C.PP->ws) + WS_CTL) + 4096, (volatile LAS unsigned*)(C.lds + LDS_MISC) + 8);
#define GRID_BAR() do { XcdBarrier _b; _b.bar = (unsigned*)((C.PP->ws) + WS_CTL) + 4096; _b.x = xb_xcc_id(); _b.st = (volatile LAS unsigned*)(C.lds + LDS_MISC) + 8; xcd_barrier(_b); PHASE(); } while (0)
    LAS unsigned char* ring = C.lds;

    p0_weights(C);
    __syncthreads(); PHASE();
    p0_mod(C);
    GRID_BAR();
#if PROBE_DUP & 1
    p0_weights(C); __syncthreads(); PHASE(); p0_mod(C); GRID_BAR();
#endif

    for (int l = 0; l < 4; ++l) {
        const int li = l >> 1;
#define modl (WSP(float, WS_MOD) + (size_t)l * NSEQ * 6144)
        norm_phase(C, l, 0, l == 0);
        GRID_BAR();
        if ((l & 1) == 0) {
            { pg8::Gemm g{WSP(bf16, WS_XN), WSP(bf16, WS_WIN) + (size_t)li * HYB_NP * 1024, T, HYB_NP, 1024}; pg8::StaticOrder S; S.init(T, HYB_NP, C.G, C.bid);
              int rcnt = 0; const bool rg = (C.G == 256);
              EpiIn E{WSP(bf16, WS_U), WSP(float, WS_DT), RollArgs{INP(I_C0), INP(I_C1), INP(I_C2), (C.PP->out), li * 6, &rcnt, C.bid}, rg}; pg8::gemm_phase<EpiIn, pg8::StaticOrder>(ring, g, S, E, nullptr); }
            PHASE();
            { float* US = WSP(float, WS_SMALL); small_gemm(C, WSP(bf16, WS_XN) + (size_t)T * D, WSP(bf16, WS_WIN) + (size_t)li * HYB_NP * 1024, HYB_NP, 1024, [&](int r, int c, float v) { US[(size_t)r * HYB_NP + c] = v; }); }
#if PROBE_DUP & 4096
            PHASE();
            { float* US = WSP(float, WS_SMALL); small_gemm(C, WSP(bf16, WS_XN) + (size_t)T * D, WSP(bf16, WS_WIN) + (size_t)li * HYB_NP * 1024, HYB_NP, 1024, [&](int r, int c, float v) { US[(size_t)r * HYB_NP + c] = v; }); }
#endif
            GRID_BAR();
            for (int u = C.bid; u < 256; u += C.G) rwkv_prep_unit(C, li, u);
            PHASE();
#if PROBE_DUP & 256
            for (int u = C.bid; u < 256; u += C.G) rwkv_prep_unit(C, li, u);
            PHASE();
#endif
#if PROBE_DUP & 512
            for (int u = C.bid; u < 256; u += C.G) ssd_a_unit(C, li, u);
            PHASE();
#endif
            for (int u = C.bid; u < 256; u += C.G) ssd_a_unit(C, li, u);
            PHASE();
            if (C.G != 256) { for (int u = C.bid; u < 64; u += C.G) s_ssd_unit(C, li, u); PHASE(); for (int u = C.bid; u < 32; u += C.G) s_rwkv_unit(C, li, u); }
            GRID_BAR();
#if PROBE_DUP & 2
            for (int u = C.bid; u < 256; u += C.G) rwkv_prep_unit(C, li, u);
            PHASE();
            for (int u = C.bid; u < 256; u += C.G) ssd_a_unit(C, li, u);
            PHASE();
            for (int u = (C.bid + 192) % C.G; u < 64; u += C.G) s_ssd_unit(C, li, u);
            PHASE();
            for (int u = (C.bid + 128) % C.G; u < 32; u += C.G) s_rwkv_unit(C, li, u);
            GRID_BAR();
#endif
            for (int u = C.bid; u < 256; u += C.G) rwkv_scan_unit(C, u);
            PHASE();
#if PROBE_DUP & 4
            GRID_BAR(); for (int u = C.bid; u < 256; u += C.G) rwkv_scan_unit(C, u); PHASE();
#endif
            ssd_scan_phase(C, li);
            GRID_BAR();
            if (C.G == 256) { if (C.bid < 32) { PHASE(); rwkv_combine_unit(C, li, C.bid); PHASE(); ssd_c_unit(C, li, 224 + C.bid); } else { PHASE(); ssd_c_unit(C, li, C.bid - 32); PHASE();
                  if (C.bid >= 64 && C.bid < 128) s_ssd_unit(C, li, C.bid - 64); else if (C.bid >= 128 && C.bid < 160) s_rwkv_unit(C, li, C.bid - 128); } }
            else if (C.G >= 64) { if (C.bid < 32) { PHASE(); rwkv_combine_unit(C, li, C.bid); } else { PHASE(); for (int u = C.bid - 32; u < 256; u += C.G - 32) ssd_c_unit(C, li, u); PHASE(); cache_roll_slice(C, li, 2, C.bid - 32, C.G - 32); } }
            else { for (int u = C.bid; u < 32; u += C.G) rwkv_combine_unit(C, li, u); PHASE(); for (int u = C.bid; u < 256; u += C.G) ssd_c_unit(C, li, u); PHASE(); cache_roll_slice(C, li, 2, C.bid, C.G); }
            GRID_BAR();
#if PROBE_DUP & 1024
            if (C.bid < 32) { PHASE(); rwkv_combine_unit(C, li, C.bid); }
            GRID_BAR();
#endif
#if PROBE_DUP & 2048
            if (C.bid >= 32) { PHASE(); for (int u = C.bid - 32; u < 256; u += C.G - 32) ssd_c_unit(C, li, u); }
            GRID_BAR();
#endif
#if PROBE_DUP & 8
            if (C.G >= 64) { if (C.bid < 32) { PHASE(); rwkv_combine_unit(C, li, C.bid); } else { PHASE(); for (int u = C.bid - 32; u < 256; u += C.G - 32) ssd_c_unit(C, li, u); } }
            else { for (int u = C.bid; u < 32; u += C.G) rwkv_combine_unit(C, li, u); PHASE(); for (int u = C.bid; u < 256; u += C.G) ssd_c_unit(C, li, u); }
            GRID_BAR();
#endif
            rwkv_out_phase(C, li);
            GRID_BAR();
#if PROBE_DUP & 16
            rwkv_out_phase(C, li);
            GRID_BAR();
#endif
            { const float* xin = l == 0 ? INP(I_XP) : WSP(float, WS_X); const float* xsin = l == 0 ? INP(I_XS) : WSP(float, WS_X) + (size_t)T * D; const float* gate = modl + 2048;
              pg8::Gemm g{WSP(bf16, WS_YCAT), WSP(bf16, WS_WOUT) + (size_t)li * 1024 * 2048, T, 1024, 2048}; pg8::StaticOrder S; S.init(T, 1024, C.G, C.bid);
              EpiRes E{xin, WSP(float, WS_X), gate}; pg8::gemm_phase<EpiRes, pg8::StaticOrder>(ring, g, S, E, nullptr); PHASE();
              float* XS = WSP(float, WS_X) + (size_t)T * D;
              small_gemm(C, WSP(bf16, WS_YCAT) + (size_t)T * 2048, WSP(bf16, WS_WOUT) + (size_t)li * 1024 * 2048, 1024, 2048, [&](int r, int c, float v) { XS[(size_t)r * D + c] = xsin[(size_t)r * D + c] + gate[(size_t)(2 + r) * 6144 + c] * v; }); }
            GRID_BAR();
        } else {
            { pg8::Gemm g{WSP(bf16, WS_XN), WSP(bf16, WS_WQKV) + (size_t)li * QKV_N * 1024, T, QKV_N, 1024}; pg8::StaticOrder S; S.init(T, QKV_N, C.G, C.bid);
              EpiQkv E{WSP(bf16, WS_QKV), WSP(float, WS_ROPE), (C.PP->out), li}; pg8::gemm_phase<EpiQkv, pg8::StaticOrder>(ring, g, S, E, nullptr); PHASE();
              float* QS = WSP(float, WS_SMALL) + MiB / 4;
              small_gemm(C, WSP(bf16, WS_XN) + (size_t)T * D, WSP(bf16, WS_WQKV) + (size_t)li * QKV_N * 1024, QKV_N, 1024, [&](int r, int c, float v) { QS[(size_t)r * QKV_N + c] = v; });
#if PROBE_DUP & 4096
              PHASE(); small_gemm(C, WSP(bf16, WS_XN) + (size_t)T * D, WSP(bf16, WS_WQKV) + (size_t)li * QKV_N * 1024, QKV_N, 1024, [&](int r, int c, float v) { QS[(size_t)r * QKV_N + c] = v; });
#endif
            }
            GRID_BAR();
            for (int u = C.bid; u < 3072; u += C.G) attn_tile_unit(C, u);
            PHASE();
            for (int u = C.bid; u < 256; u += C.G) s_attn_unit(C, li, u);
            GRID_BAR();
#if PROBE_DUP & 32
            for (int u = C.bid; u < 3072; u += C.G) attn_tile_unit(C, u);
            PHASE();
            for (int u = C.bid; u < 256; u += C.G) s_attn_unit(C, li, u);
            GRID_BAR();
#endif
            attn_merge_phase(C);
            GRID_BAR();
            { const float* gate = modl + 2048;
              pg8::Gemm g{WSP(bf16, WS_AO), WSP(bf16, WS_WAO) + (size_t)li * 1024 * 512, T, 1024, 512}; pg8::StaticOrder S; S.init(T, 1024, C.G, C.bid);
              EpiRes E{WSP(float, WS_X), WSP(float, WS_X), gate}; pg8::gemm_phase<EpiRes, pg8::StaticOrder>(ring, g, S, E, nullptr); PHASE();
              float* XS = WSP(float, WS_X) + (size_t)T * D;
              small_gemm(C, WSP(bf16, WS_AO) + (size_t)T * 512, WSP(bf16, WS_WAO) + (size_t)li * 1024 * 512, 1024, 512, [&](int r, int c, float v) { XS[(size_t)r * D + c] += gate[(size_t)(2 + r) * 6144 + c] * v; }); }
            GRID_BAR();
        }
        norm_phase(C, l, 1, false);
        GRID_BAR();
#if PROBE_DUP & 64
        norm_phase(C, l, 1, false);
        GRID_BAR();
#endif
#if PROBE_DUP & 128
        { pg8::Gemm g{WSP(bf16, WS_XN), WSP(bf16, WS_W1) + (size_t)l * FF * 1024, T, FF, 1024}; pg8::StaticOrder S; S.init(T, FF, C.G, C.bid);
          int rcnt = 0; EpiMlp1 E{WSP(bf16, WS_HID), RollArgs{INP(I_C0), INP(I_C1), INP(I_C2), (C.PP->out), 0, &rcnt, C.bid}, false}; pg8::gemm_phase<EpiMlp1, pg8::StaticOrder>(ring, g, S, E, nullptr); } GRID_BAR();
#endif
        { pg8::Gemm g{WSP(bf16, WS_XN), WSP(bf16, WS_W1) + (size_t)l * FF * 1024, T, FF, 1024}; pg8::StaticOrder S; S.init(T, FF, C.G, C.bid);
          int rcnt = 0; const bool rg = (C.G == 256);
          EpiMlp1 E{WSP(bf16, WS_HID), RollArgs{INP(I_C0), INP(I_C1), INP(I_C2), (C.PP->out), 12 + l * 4, &rcnt, C.bid}, rg}; pg8::gemm_phase<EpiMlp1, pg8::StaticOrder>(ring, g, S, E, nullptr); PHASE();
          bf16* HS = WSP(bf16, WS_HID) + (size_t)T * FF;
          small_gemm(C, WSP(bf16, WS_XN) + (size_t)T * D, WSP(bf16, WS_W1) + (size_t)l * FF * 1024, FF, 1024, [&](int r, int c, float v) { const float a = fmaxf(v, 0.f); HS[(size_t)r * FF + c] = (bf16)(pk2(a * a, 0.f) & 0xffffu); });
#if PROBE_DUP & 4096
          PHASE(); small_gemm(C, WSP(bf16, WS_XN) + (size_t)T * D, WSP(bf16, WS_W1) + (size_t)l * FF * 1024, FF, 1024, [&](int r, int c, float v) { const float a = fmaxf(v, 0.f); HS[(size_t)r * FF + c] = (bf16)(pk2(a * a, 0.f) & 0xffffu); });
#endif
        }
        GRID_BAR();
        { const float* gate = modl + 5120;
          pg8::Gemm g{WSP(bf16, WS_HID), WSP(bf16, WS_W2) + (size_t)l * 1024 * FF, T, 1024, FF}; pg8::StaticOrder S; S.init(T, 1024, C.G, C.bid);
          EpiRes E{WSP(float, WS_X), WSP(float, WS_X), gate}; pg8::gemm_phase<EpiRes, pg8::StaticOrder>(ring, g, S, E, nullptr); PHASE();
          float* XS = WSP(float, WS_X) + (size_t)T * D;
          small_gemm(C, WSP(bf16, WS_HID) + (size_t)T * FF, WSP(bf16, WS_W2) + (size_t)l * 1024 * FF, 1024, FF, [&](int r, int c, float v) { XS[(size_t)r * D + c] += gate[(size_t)(2 + r) * 6144 + c] * v; }); }
        GRID_BAR();
    }
    final_norm_phase(C);
}
}

extern "C" void kernel_launch(void* const* d_in, const int* in_sizes, int n_in, void* d_out, int out_size, void* d_ws, size_t ws_size, hipStream_t stream) {
    static int grid = 0;
    if (grid == 0) {
        int dev = 0, cus = 0, per_cu = 0;
        if (hipGetDevice(&dev) != hipSuccess || hipDeviceGetAttribute(&cus, hipDeviceAttributeMultiprocessorCount, dev) != hipSuccess) { fprintf(stderr, "kernel_launch: device query failed\n"); grid = -1; return; }
        if (hipFuncSetAttribute((const void*)mk::mk_fwd, hipFuncAttributeMaxDynamicSharedMemorySize, mk::LDS_BYTES) != hipSuccess) { fprintf(stderr, "kernel_launch: hipFuncSetAttribute failed\n"); grid = -1; return; }
        if (hipOccupancyMaxActiveBlocksPerMultiprocessor(&per_cu, (const void*)mk::mk_fwd, 512, mk::LDS_BYTES) != hipSuccess || per_cu < 1) fprintf(stderr, "kernel_launch: occupancy query reports %d\n", per_cu);
        if (n_in != 39 || (size_t)out_size != mk::O_END || ws_size < mk::WS_END) { fprintf(stderr, "kernel_launch: unexpected sizes n_in %d out %d ws %zu\n", n_in, out_size, ws_size); grid = -1; return; }
        grid = cus;
    }
    if (grid < 0) return;
    hipMemsetAsync((char*)d_ws + mk::WS_CTL, 0, mk::CTL_BYTES, stream);
    mk::Params p; memset(&p, 0, sizeof(p));
    for (int i = 0; i < 39; ++i) p.in[i] = (const float*)d_in[i];
    p.out = (float*)d_out; p.ws = (unsigned char*)d_ws;
    hipLaunchKernelGGL(mk::mk_fwd, dim3(grid), dim3(512), mk::LDS_BYTES, stream, p);
}
```

```cpp
#include <hip/hip_runtime.h>
#include <cstdio>
#include <cstdint>
#include <cstring>
namespace pg8 {
#define PG8_LAS __attribute__((address_space(3)))
typedef unsigned short bf16_t;
typedef short bf16x8 __attribute__((ext_vector_type(8)));
typedef float f32x4 __attribute__((ext_vector_type(4)));
typedef unsigned u32x4 __attribute__((ext_vector_type(4)));
constexpr int BM = 256, BK = 64, HALF = 128, HTB = HALF * BK * 2  , STAGE_BYTES = 8 * HTB, NXCD = 8, WGM = 8;

__host__ __device__ __forceinline__ int lds_byte(int r, int c) { const int st = (r >> 4) * 2 + (c >> 5), rr = r & 15, cc = c & 31, ob = rr * 64 + cc * 2; return st * 1024 + (ob ^ (((ob >> 9) & 1) << 5)); }
__host__ __device__ __forceinline__ void stage_rc(int b, int& R, int& C) { const int st = b / 1024, sb = b % 1024, swz = sb ^ (((sb >> 9) & 1) << 5); R = (st >> 1) * 16 + swz / 64; C = (st & 1) * 32 + (swz % 64) / 2; }
__host__ __device__ __forceinline__ int perm32(int rho) { const int n = rho >> 4, i = rho & 15; return 8 * (i >> 2) + 4 * n + (i & 3); }

struct Unit { int pm, pn; };
struct Gemm { const bf16_t* A; const bf16_t* Bt; int M, N, K; };

struct StaticOrder {
    int nM, nN, nwg, G, c;
    __host__ __device__ void init(int M, int N, int G_, int c_) { nM = M / BM; nN = N / BM; nwg = nM * nN; G = G_; c = c_; }
    __host__ __device__ bool next(int i, Unit& u) const {
        const long L = (long)i * G + c; if (L >= nwg) return false;
        int wgid = (int)L; { const int q = nwg / NXCD, r = nwg % NXCD, xcd = wgid % NXCD, off = wgid / NXCD; wgid = (xcd < r ? xcd * (q + 1) : r * (q + 1) + (xcd - r) * q) + off; }
        const int nig = WGM * nN, gid = wgid / nig, fm = gid * WGM, gsz = (nM - fm) < WGM ? (nM - fm) : WGM;
        u.pm = fm + ((wgid % nig) % gsz); u.pn = (wgid % nig) / gsz; return true;
    }
    __device__ __forceinline__ void a_ready(const Unit&) const {}
    __device__ __forceinline__ void done(const Unit&) const {}
};
template <class Epi, class Sched, bool STAMP = false>
__device__ __forceinline__ void gemm_phase(PG8_LAS unsigned char* lds, const Gemm g, const Sched& S, const Epi& E, unsigned long long* stamps) {
    int tid_ = threadIdx.x; asm volatile("" : "+v"(tid_));
    const int tid = tid_, wid = __builtin_amdgcn_readfirstlane(tid >> 6), lane = tid & 63, wr = wid >> 2, wc = wid & 3, fr = lane & 15, fq = lane >> 4;
    const int K = g.K, nt = K / BK;
    int ts_lo = 0, ts_hi = 0, nts = 0; const unsigned long long rt_entry = STAMP ? (unsigned long long)wall_clock64() : 0ull;
#define PG8_STAMP() do { if (STAMP && wid == 0 && nts < 64) { const unsigned long long _c = (unsigned long long)clock64(); \
        ts_lo = (lane == nts) ? (int)(unsigned)_c : ts_lo; ts_hi = (lane == nts) ? (int)(unsigned)(_c >> 32) : ts_hi; ++nts; } } while (0)
    PG8_STAMP();
    unsigned voffA[2], voffB[2];
#pragma unroll
    for (int i = 0; i < 2; ++i) { int R, C; stage_rc(tid * 16 + i * 8192, R, C); const int Rb = Epi::PERM ? ((R & ~31) + perm32(R & 31)) : R;
        voffA[i] = (unsigned)(R * K + C) * 2u; voffB[i] = (unsigned)(Rb * K + C) * 2u; }
    const size_t kstep = (size_t)(BK * 2);
    const size_t hstep = (size_t)HALF * K * 2;
    const size_t tstep = 2 * hstep;
    const unsigned ldsw = (unsigned)wid * 1024u;
    const int aoff = lds_byte(wr * 64 + fr, fq * 8), boff = lds_byte(wc * 32 + fr, fq * 8);
#define PG8_SA(b, h) (((b) * 2 + (h)) * HTB)
#define PG8_SB(b, h) ((4 + (b) * 2 + (h)) * HTB)
#define PG8_STAGE(bufoff, gbase, voff) do { _Pragma("unroll") for (int _i = 0; _i < 2; ++_i) \
        __builtin_amdgcn_global_load_lds((const unsigned*)((const char*)(gbase) + (voff)[_i]), (PG8_LAS unsigned*)(lds + (bufoff) + ldsw + _i * 8192), 16, 0, 0); } while (0)
#define PG8_LDA(dst, b, h) do { _Pragma("unroll") for (int m = 0; m < 4; ++m) _Pragma("unroll") for (int k = 0; k < 2; ++k) dst[m][k] = *(const PG8_LAS bf16x8*)(lds + PG8_SA(b, h) + aoff + m * 2048 + k * 1024); } while (0)
#define PG8_LDB(dst, b, h) do { _Pragma("unroll") for (int n = 0; n < 2; ++n) _Pragma("unroll") for (int k = 0; k < 2; ++k) dst[n][k] = *(const PG8_LAS bf16x8*)(lds + PG8_SB(b, h) + boff + n * 2048 + k * 1024); } while (0)
#define PG8_MMA(ai, bj, At, Bt) do { __builtin_amdgcn_s_setprio(1); _Pragma("unroll") for (int m = 0; m < 4; ++m) _Pragma("unroll") for (int n = 0; n < 2; ++n) _Pragma("unroll") for (int k = 0; k < 2; ++k) \
        acc[ai][bj][m][n] = __builtin_amdgcn_mfma_f32_16x16x32_bf16(Bt[n][k], At[m][k], acc[ai][bj][m][n], 0, 0, 0); __builtin_amdgcn_s_setprio(0); } while (0)
#define PG8_WAIT_V(n) asm volatile("s_waitcnt vmcnt(" #n ")" ::: "memory")
#define PG8_WAIT_L(n) asm volatile("s_waitcnt lgkmcnt(" #n ")" ::: "memory")
#define PG8_BAR __builtin_amdgcn_s_barrier()
#define PG8_SCHED __builtin_amdgcn_sched_barrier(0)
    Unit cur, nxt; int ui = 0;
    if (!S.next(0, cur)) return;
    f32x4 acc[2][2][4][2];
#pragma unroll
    for (int a = 0; a < 2; ++a)
#pragma unroll
        for (int b = 0; b < 2; ++b)
#pragma unroll
            for (int m = 0; m < 4; ++m)
#pragma unroll
                for (int n = 0; n < 2; ++n) acc[a][b][m][n] = (f32x4){0.f, 0.f, 0.f, 0.f};
    bf16x8 At[4][2], B0[2][2], B1[2][2];
    const char* cA = (const char*)g.A + (size_t)cur.pm * tstep; const char* cB = (const char*)g.Bt + (size_t)cur.pn * tstep;
    S.a_ready(cur);
    PG8_STAGE(PG8_SB(0, 0), cB, voffB); PG8_STAGE(PG8_SA(0, 0), cA, voffA); PG8_STAGE(PG8_SB(0, 1), cB + hstep, voffB); PG8_STAGE(PG8_SA(0, 1), cA + hstep, voffA);
    if (wr == 1) PG8_BAR;
    PG8_WAIT_V(4); PG8_BAR;
    PG8_STAGE(PG8_SB(1, 0), cB + kstep, voffB); PG8_STAGE(PG8_SA(1, 0), cA + kstep, voffA); PG8_STAGE(PG8_SB(1, 1), cB + hstep + kstep, voffB);
    PG8_WAIT_V(6); PG8_BAR;
    PG8_STAMP();
    for (;;) {
        const bool has_next = S.next(ui + 1, nxt);
        const char* nA = has_next ? (const char*)g.A + (size_t)nxt.pm * tstep : cA; const char* nB = has_next ? (const char*)g.Bt + (size_t)nxt.pn * tstep : cB;
        for (int t = 0; t < nt; t += 2) {
            const bool last = (t == nt - 2);
            const char* a1 = cA + (size_t)(t + 1) * kstep;
            const char* a2 = last ? nA : cA + (size_t)(t + 2) * kstep; const char* b2 = last ? nB : cB + (size_t)(t + 2) * kstep;
            const char* a3 = a2 + kstep; const char* b3 = b2 + kstep;
            if (last && has_next) S.a_ready(nxt);
            PG8_LDB(B0, 0, 0); PG8_SCHED; PG8_LDA(At, 0, 0); PG8_STAGE(PG8_SA(1, 1), a1 + hstep, voffA);
            PG8_WAIT_L(8); PG8_BAR; PG8_WAIT_L(0); PG8_MMA(0, 0, At, B0); PG8_BAR; PG8_SCHED;
            PG8_LDB(B1, 0, 1); PG8_STAGE(PG8_SB(0, 0), b2, voffB);
            PG8_BAR; PG8_WAIT_L(0); PG8_MMA(0, 1, At, B1); PG8_BAR;
            PG8_LDA(At, 0, 1); PG8_STAGE(PG8_SA(0, 0), a2, voffA);
            PG8_BAR; PG8_WAIT_L(0); PG8_MMA(1, 0, At, B0); PG8_BAR; PG8_SCHED;
            PG8_STAGE(PG8_SB(0, 1), b2 + hstep, voffB);
            PG8_WAIT_V(6); PG8_BAR; PG8_MMA(1, 1, At, B1); PG8_BAR;
            PG8_LDB(B0, 1, 0); PG8_SCHED; PG8_LDA(At, 1, 0); PG8_STAGE(PG8_SA(0, 1), a2 + hstep, voffA);
            PG8_WAIT_L(8); PG8_BAR; PG8_WAIT_L(0); PG8_MMA(0, 0, At, B0); PG8_BAR; PG8_SCHED;
            PG8_LDB(B1, 1, 1); PG8_STAGE(PG8_SB(1, 0), b3, voffB);
            PG8_BAR; PG8_WAIT_L(0); PG8_MMA(0, 1, At, B1); PG8_BAR;
            PG8_LDA(At, 1, 1); PG8_STAGE(PG8_SA(1, 0), a3, voffA);
            PG8_BAR; PG8_WAIT_L(0); PG8_MMA(1, 0, At, B0); PG8_BAR; PG8_SCHED;
            PG8_STAGE(PG8_SB(1, 1), b3 + hstep, voffB);
            PG8_WAIT_V(6); PG8_BAR; PG8_MMA(1, 1, At, B1); PG8_BAR;
        }
        PG8_STAMP();
        if constexpr (!Epi::AFTER_DRAIN) { E(acc, cur, wr, wc, fr, fq); S.done(cur); }
        PG8_STAMP();
        if (!has_next) break;
#pragma unroll
        for (int a = 0; a < 2; ++a)
#pragma unroll
            for (int b = 0; b < 2; ++b)
#pragma unroll
                for (int m = 0; m < 4; ++m)
#pragma unroll
                    for (int n = 0; n < 2; ++n) acc[a][b][m][n] = (f32x4){0.f, 0.f, 0.f, 0.f};
        cur = nxt; cA = nA; cB = nB; ++ui;
    }
    PG8_WAIT_V(0);
    if (wr == 0) PG8_BAR;
    PG8_BAR;
    if constexpr (Epi::AFTER_DRAIN) { E.fused(acc, cur, wr, wc, fr, fq, lds, wid, lane); S.done(cur); }
    PG8_STAMP();
    if (STAMP && wid == 0) { stamps[lane] = lane < nts ? (((unsigned long long)(unsigned)ts_hi << 32) | (unsigned)ts_lo) : 0ull;
        if (lane == 62) stamps[62] = rt_entry; if (lane == 63) stamps[63] = (unsigned long long)wall_clock64(); }
#undef PG8_STAMP
#undef PG8_SA
#undef PG8_SB
#undef PG8_STAGE
#undef PG8_LDA
#undef PG8_LDB
#undef PG8_MMA
#undef PG8_WAIT_V
#undef PG8_WAIT_L
#undef PG8_BAR
#undef PG8_SCHED
}
}
#define XB_TMO      128
#define XB_XCNT(j)  (256  + 64 * (j))
#define XB_XSUB(j)  (1280 + 64 * (j))
#define XB_XGEN(j)  (2304 + 64 * (j))
#define XB_TOP      3328
#define XB_TOPGEN   3392
#define XCD_BAR_WORDS 3456
#define XB_SPIN_CAP (1u << 18)
#define LAS __attribute__((address_space(3)))

__device__ __forceinline__ unsigned xb_ld(unsigned* p)              { return __hip_atomic_load(p, __ATOMIC_RELAXED, __HIP_MEMORY_SCOPE_AGENT); }
__device__ __forceinline__ unsigned xb_add(unsigned* p, unsigned v) { return __hip_atomic_fetch_add(p, v, __ATOMIC_RELAXED, __HIP_MEMORY_SCOPE_AGENT); }
__device__ __forceinline__ unsigned xb_xcc_id() { return (unsigned)__builtin_amdgcn_s_getreg((3 << 11) | 20) & 0xFu; }
#define XB_SPIN(cond, bar) do { unsigned _sp = 0; while (cond) { __builtin_amdgcn_s_sleep(1); \
    if ((++_sp & 255u) == 0u) { if (xb_ld(&(bar)[XB_TMO])) break; if (_sp > XB_SPIN_CAP) { atomicAdd(&(bar)[XB_TMO], 1u); break; } } } } while (0)

struct XcdBarrier {
    unsigned* bar; unsigned x;
    volatile LAS unsigned* st;
};

__device__ __forceinline__ XcdBarrier xcd_barrier_post(unsigned* bar, volatile LAS unsigned* st) {
    XcdBarrier b; b.bar = bar; b.x = xb_xcc_id(); b.st = st;
    if (threadIdx.x == 0) (void)xb_add(&bar[XB_XCNT(b.x)], 1u);
    return b;
}
__device__ __forceinline__ void xcd_barrier_complete(unsigned* bar, unsigned x, unsigned& nloc, unsigned& nx) {
    const unsigned G = gridDim.x * gridDim.y * gridDim.z;
    unsigned sum, cnt, mine, sp = 0u;
    for (;;) {
        sum = 0u; cnt = 0u; mine = 0u;
#pragma unroll
        for (unsigned j = 0; j < 16; ++j) { const unsigned c = xb_ld(&bar[XB_XCNT(j)]); sum += c; cnt += (c > 0u) ? 1u : 0u; mine = (j == x) ? c : mine; }
        if (sum == G) break;
        __builtin_amdgcn_s_sleep(1);
        if ((++sp & 255u) == 0u) { if (xb_ld(&bar[XB_TMO])) break; if (sp > XB_SPIN_CAP) { atomicAdd(&bar[XB_TMO], 1u); break; } }
    }
    nloc = mine > 0u ? mine : 1u; nx = cnt > 0u ? cnt : 1u;
}

__device__ __forceinline__ void xcd_barrier(const XcdBarrier& b) {
    asm volatile("s_waitcnt vmcnt(0)" ::: "memory");
    __syncthreads();
    if (threadIdx.x == 0) {
        unsigned* bar = b.bar;
        __builtin_amdgcn_s_waitcnt(0);
        unsigned nloc = b.st[0], nx = b.st[1];
        if (nloc == 0u) { xcd_barrier_complete(bar, b.x, nloc, nx); b.st[0] = nloc; b.st[1] = nx; }
        const unsigned old = xb_add(&bar[XB_XSUB(b.x)], 1u);
        const unsigned gen = old / nloc;
        if (old + 1u == (gen + 1u) * nloc) {
            __builtin_amdgcn_fence(__ATOMIC_RELEASE, "agent");
            asm volatile("s_waitcnt vmcnt(0)" ::: "memory");
            const unsigned og = xb_add(&bar[XB_TOP], 1u);
            const unsigned tg = og / nx;
            if (og + 1u == (tg + 1u) * nx) xb_add(&bar[XB_TOPGEN], 1u);
            else XB_SPIN(xb_ld(&bar[XB_TOPGEN]) == tg, bar);
            __builtin_amdgcn_fence(__ATOMIC_ACQUIRE, "agent");
            xb_add(&bar[XB_XGEN(b.x)], 1u);
            asm volatile("s_waitcnt vmcnt(0)" ::: "memory");
        } else {
            XB_SPIN(xb_ld(&bar[XB_XGEN(b.x)]) == gen, bar);
            __builtin_amdgcn_fence(__ATOMIC_ACQUIRE, "agent");
            asm volatile("s_waitcnt vmcnt(0)" ::: "memory");
        }
    }
    __syncthreads();
}

namespace mk {
#define LAS __attribute__((address_space(3)))
typedef unsigned short bf16;
typedef short bf16x8 __attribute__((ext_vector_type(8)));
typedef float f32x4 __attribute__((ext_vector_type(4)));
typedef float f32x2 __attribute__((ext_vector_type(2)));
typedef float f32x16 __attribute__((ext_vector_type(16)));
typedef unsigned u32x4 __attribute__((ext_vector_type(4)));
typedef unsigned u32x2 __attribute__((ext_vector_type(2)));

constexpr int T = 16384, SEQ = 8192, NS = 32, D = 1024, NSEQ = 34, NT = 512;
constexpr int HYB_NP = 6144, HYB_N = 5904, QKV_N = 4608, FF = 4096;
constexpr int U_XBC = 1024, U_DT = 2560, U_RW = 2576, RWC = 3328;
constexpr float EPS = 1e-6f, LN_EPS = 64e-5f;
constexpr size_t MiB = 1u << 20;
constexpr size_t WS_CTL = 0, CTL_BYTES = MiB;
constexpr size_t WS_WIN = 2 * MiB, WS_WOUT = 26 * MiB, WS_WQKV = 34 * MiB, WS_WAO = 52 * MiB, WS_W1 = 54 * MiB, WS_W2 = 86 * MiB, WS_LORA = 118 * MiB;
constexpr size_t WS_MOD = 119 * MiB, WS_ROPE = 123 * MiB, WS_SMALL = 124 * MiB, WS_X = 128 * MiB, WS_XN = 193 * MiB, WS_U = 226 * MiB;
constexpr int RECB = 896;
constexpr size_t WS_DT = 418 * MiB, WS_DTS = 419 * MiB, WS_ACS = 420 * MiB, WS_REC = 421 * MiB, WS_G = 805 * MiB, WS_XT = 837 * MiB, WS_BC = 869 * MiB;
constexpr size_t WS_CS = 885 * MiB, WS_QO = 949 * MiB, WS_SL = 1077 * MiB, WS_SST = 1141 * MiB, WS_YCAT = 1173 * MiB, WS_QKV = 1238 * MiB;
constexpr size_t WS_OG = 1382 * MiB, WS_LSE = 1430 * MiB, WS_AO = 1432 * MiB, WS_HID = 1449 * MiB, WS_END = 1578 * MiB;
constexpr size_t O_YP = 0, O_YS = O_YP + (size_t)T * D, O_SSDP = O_YS + 32 * 1024, O_SSDS = O_SSDP + 2 * 2 * 16 * 8192, O_CONVP = O_SSDS + (size_t)2 * 32 * 16 * 8192;
constexpr size_t O_CONVS = O_CONVP + 2 * 2 * 3 * 1536, O_WKVP = O_CONVS + 2 * 32 * 3 * 1536, O_WKVS = O_WKVP + 2 * 2 * 16 * 4096, O_SHP = O_WKVS + (size_t)2 * 32 * 16 * 4096;
constexpr size_t O_SHS = O_SHP + 2 * 2 * 3328, O_W0P = O_SHS + 2 * 32 * 3328, O_W0S = O_W0P + (size_t)2 * 2 * 128 * 1024, O_W1P = O_W0S + (size_t)2 * 32 * 128 * 1024;
constexpr size_t O_W1S = O_W1P + (size_t)2 * 2 * 512 * 1024, O_W2P = O_W1S + (size_t)2 * 32 * 512 * 1024, O_W2S = O_W2P + (size_t)2 * 2 * 2048 * 1024;
constexpr size_t O_END = O_W2S + (size_t)2 * 32 * 2048 * 1024;
static_assert(O_END == 217889792ull, "output size");
constexpr int LDS_RING = 131072, LDS_MISC = LDS_RING + 320, LDS_BYTES = 147456;

struct Params { const float* in[39]; float* out; unsigned char* ws; };

typedef __bf16 bfv2 __attribute__((ext_vector_type(2)));
__device__ __forceinline__ unsigned pk2(float lo, float hi) { const f32x2 v = (f32x2){lo, hi}; const bfv2 r = __builtin_convertvector(v, bfv2); return __builtin_bit_cast(unsigned, r); }
__device__ __forceinline__ float bflo(unsigned u) { return __uint_as_float(u << 16); }
__device__ __forceinline__ float bfhi(unsigned u) { return __uint_as_float(u & 0xffff0000u); }
__device__ __forceinline__ float bf1(bf16 h) { return __uint_as_float(((unsigned)h) << 16); }
__device__ __forceinline__ f32x4 bf4(u32x2 v) { return (f32x4){bflo(v.x), bfhi(v.x), bflo(v.y), bfhi(v.y)}; }
__device__ __forceinline__ u32x2 pk4(f32x4 v) { u32x2 r; r.x = pk2(v[0], v[1]); r.y = pk2(v[2], v[3]); return r; }
__device__ __forceinline__ float siluf_(float x) { return x * __builtin_amdgcn_rcpf(1.f + __expf(-x)); }
__device__ __forceinline__ float sigm_(float x) { return __builtin_amdgcn_rcpf(1.f + __expf(-x)); }
__device__ __forceinline__ float softplus_(float x) { return fmaxf(x, 0.f) + __logf(1.f + __expf(-fabsf(x))); }
__device__ __forceinline__ float tanh_(float x) { const float t = __expf(-2.f * fabsf(x)); const float r = (1.f - t) * __builtin_amdgcn_rcpf(1.f + t); return x < 0.f ? -r : r; }
__device__ __forceinline__ float wave_sum(float v) {
#pragma unroll
    for (int o = 1; o < 64; o <<= 1) v += __shfl_xor(v, o);
    return v;
}
__device__ __forceinline__ float wave_max(float v) {
#pragma unroll
    for (int o = 1; o < 64; o <<= 1) v = fmaxf(v, __shfl_xor(v, o));
    return v;
}
__device__ __forceinline__ f32x4 mfma16(bf16x8 a, bf16x8 b, f32x4 c) { return __builtin_amdgcn_mfma_f32_16x16x32_bf16(a, b, c, 0, 0, 0); }
#define LDSW() asm volatile("s_waitcnt lgkmcnt(0)" ::: "memory")
#define LDS_BARRIER() do { asm volatile("s_waitcnt lgkmcnt(0)" ::: "memory"); __builtin_amdgcn_s_barrier(); asm volatile("" ::: "memory"); } while (0)

#define CAS __attribute__((address_space(4)))
struct Ctx {
    LAS unsigned char* lds; int tid, lane, wave, G, bid;
    const CAS Params* PP;
};
#define WSP(type, off) ((type*)((C.PP->ws) + (off)))
#define INP(i) (C.PP->in[i])
enum { I_XP = 0, I_XS, I_SSD, I_CONV, I_WKV, I_SHIFT, I_C0, I_C1, I_C2, I_CP, I_CS, I_NMIX, I_NMLP, I_NFIN, I_ADAW, I_ADAB, I_W1, I_W2, I_HIN, I_HOUT, I_CONVW, I_CONVB,
       I_DTB, I_ALOG, I_SSDD, I_SNW, I_MU, I_RW0, I_RW2, I_RA0, I_RA2, I_RG2, I_KK, I_KA, I_RK, I_LNW, I_LNB, I_AQKV, I_AOUT };

__device__ __forceinline__ void transpose_item(const float* W, int K, int N, bf16* WT, LAS float* scr, int item, int lane) {
    const int nblk = (N + 31) / 32, kb = item / nblk, nb = item % nblk, k0 = 64 * kb, n0 = 32 * nb;
    const int nn = n0 + (lane & 31);
#pragma unroll 8
    for (int i = 0; i < 32; ++i) { const int kk = 2 * i + (lane >> 5); scr[kk * 33 + (lane & 31)] = nn < N ? W[(size_t)(k0 + kk) * N + nn] : 0.f; }
    LDSW();
    const int c = lane & 7;
#pragma unroll
    for (int j = 0; j < 4; ++j) { const int n = (lane >> 3) + 8 * j; const LAS float* s = scr + (8 * c) * 33 + n;
        u32x4 o; o.x = pk2(s[0 * 33], s[1 * 33]); o.y = pk2(s[2 * 33], s[3 * 33]); o.z = pk2(s[4 * 33], s[5 * 33]); o.w = pk2(s[6 * 33], s[7 * 33]);
        *(u32x4*)(WT + (size_t)(n0 + n) * K + k0 + 8 * c) = o; }
    LDSW();
}

__device__ __forceinline__ void p0_weights(const Ctx& C) {
    LAS float* scr = (LAS float*)(C.lds + C.wave * 16384);
    const int gw = C.bid * 8 + C.wave, NGW = C.G * 8;
    constexpr int N_IN = 16 * 185, N_OUT = 32 * 32, N_QKV = 16 * 144, N_AO = 8 * 32, N_1 = 16 * 128, N_2 = 64 * 32, N_L64 = 32, N_L128 = 64;
    constexpr int TOTAL = 2 * N_IN + 2 * N_OUT + 2 * N_QKV + 2 * N_AO + 4 * N_1 + 4 * N_2 + 2 * (2 * N_L64 + N_L128);
    for (int it = gw; it < TOTAL; it += NGW) {
        int r = it;
        if (r < 2 * N_IN) { const int i = r / N_IN; transpose_item(INP(I_HIN) + (size_t)i * 1024 * HYB_N, 1024, HYB_N, WSP(bf16, WS_WIN) + (size_t)i * HYB_NP * 1024, scr, r % N_IN, C.lane); continue; } r -= 2 * N_IN;
        if (r < 2 * N_OUT) { const int i = r / N_OUT; transpose_item(INP(I_HOUT) + (size_t)i * 2048 * 1024, 2048, 1024, WSP(bf16, WS_WOUT) + (size_t)i * 1024 * 2048, scr, r % N_OUT, C.lane); continue; } r -= 2 * N_OUT;
        if (r < 2 * N_QKV) { const int i = r / N_QKV; transpose_item(INP(I_AQKV) + (size_t)i * 1024 * QKV_N, 1024, QKV_N, WSP(bf16, WS_WQKV) + (size_t)i * QKV_N * 1024, scr, r % N_QKV, C.lane); continue; } r -= 2 * N_QKV;
        if (r < 2 * N_AO) { const int i = r / N_AO; transpose_item(INP(I_AOUT) + (size_t)i * 512 * 1024, 512, 1024, WSP(bf16, WS_WAO) + (size_t)i * 1024 * 512, scr, r % N_AO, C.lane); continue; } r -= 2 * N_AO;
        if (r < 4 * N_1) { const int i = r / N_1; transpose_item(INP(I_W1) + (size_t)i * 1024 * FF, 1024, FF, WSP(bf16, WS_W1) + (size_t)i * FF * 1024, scr, r % N_1, C.lane); continue; } r -= 4 * N_1;
        if (r < 4 * N_2) { const int i = r / N_2; transpose_item(INP(I_W2) + (size_t)i * FF * 1024, FF, 1024, WSP(bf16, WS_W2) + (size_t)i * 1024 * FF, scr, r % N_2, C.lane); continue; } r -= 4 * N_2;
        { const int i = r / (2 * N_L64 + N_L128); int q = r % (2 * N_L64 + N_L128); bf16* lb = WSP(bf16, WS_LORA) + (size_t)i * 262144;
          if (q < N_L64) { transpose_item(INP(I_RW2) + (size_t)i * 64 * 1024, 64, 1024, lb, scr, q, C.lane); continue; } q -= N_L64;
          if (q < N_L64) { transpose_item(INP(I_RA2) + (size_t)i * 64 * 1024, 64, 1024, lb + 65536, scr, q, C.lane); continue; } q -= N_L64;
          transpose_item(INP(I_RG2) + (size_t)i * 128 * 1024, 128, 1024, lb + 131072, scr, q, C.lane); }
    }
    const int gt = C.bid * NT + C.tid, NGT = C.G * NT;
    for (int i = gt; i < 2 * 224 * 128; i += NGT) { const int l = i / (224 * 128), r = i % (224 * 128); ((u32x4*)(WSP(bf16, WS_WIN) + (size_t)l * HYB_NP * 1024 + (size_t)5920 * 1024))[r] = (u32x4){0u, 0u, 0u, 0u}; }
    for (int i = gt; i < 8193 * 8; i += NGT) { const int t = i >> 3, k = i & 7; const double inv = pow(500000.0, -(double)k / 8.0), ang = (double)t * inv;
        WSP(float, WS_ROPE)[t * 16 + k] = (float)cos(ang); WSP(float, WS_ROPE)[t * 16 + 8 + k] = (float)sin(ang); }
}

__device__ __forceinline__ void cache_roll_slice(const Ctx& C, int part, int nparts, int wk, int nwk) {
    if (wk < 0 || wk >= nwk) return;
#pragma unroll
    for (int g = 0; g < 3; ++g) {
        const int W = 128 << (2 * g); const size_t per = (size_t)(W - 1) * 256, tot = 64 * per, lo = tot * part / nparts, hi = tot * (part + 1) / nparts;
        const f32x4* src = (const f32x4*)INP(I_C0 + g); f32x4* dst = (f32x4*)((C.PP->out) + (g == 0 ? O_W0S : g == 1 ? O_W1S : O_W2S));
        for (size_t i = lo + (size_t)wk * NT + C.tid; i < hi; i += (size_t)nwk * NT) { const size_t ib = i / per, rem = i - ib * per; const f32x4 v = __builtin_nontemporal_load(src + (ib * W + 1) * 256 + rem); __builtin_nontemporal_store(v, dst + ib * W * 256 + rem); }
    }
}

__device__ __forceinline__ void p0_mod(const Ctx& C) {
    LAS f32x4* red = (LAS f32x4*)C.lds;
    const int q = C.lane >> 4, i = C.lane & 15;
    for (int u = C.bid; u < 384; u += C.G) {
        const int l = u / 96, n0 = (u % 96) * 64;
        const float* W = INP(I_ADAW) + (size_t)l * 1024 * 6144;
        f32x4 acc[3][4];
#pragma unroll
        for (int t = 0; t < 3; ++t)
#pragma unroll
            for (int n = 0; n < 4; ++n) acc[t][n] = (f32x4){0.f, 0.f, 0.f, 0.f};
        for (int kg = 0; kg < 8; ++kg) {
            const int k0 = 128 * C.wave + 16 * kg + 4 * q;
            f32x4 av[3], wv[4];
#pragma unroll
            for (int t = 0; t < 3; ++t) { const int s = 16 * t + i; av[t] = (f32x4){0.f, 0.f, 0.f, 0.f};
                if (s < NSEQ) { const float* cp = s < 2 ? INP(I_CP) + s * 1024 : INP(I_CS) + (s - 2) * 1024; const f32x4 v = *(const f32x4*)(cp + k0);
                    av[t] = (f32x4){siluf_(v[0]), siluf_(v[1]), siluf_(v[2]), siluf_(v[3])}; } }
#pragma unroll
            for (int m = 0; m < 4; ++m) wv[m] = *(const f32x4*)(W + (size_t)(k0 + m) * 6144 + n0 + 4 * i);
#pragma unroll
            for (int m = 0; m < 4; ++m)
#pragma unroll
                for (int t = 0; t < 3; ++t)
#pragma unroll
                    for (int n = 0; n < 4; ++n) acc[t][n] = __builtin_amdgcn_mfma_f32_16x16x4f32(av[t][m], wv[m][n], acc[t][n], 0, 0, 0);
        }
#pragma unroll
        for (int t = 0; t < 3; ++t)
#pragma unroll
            for (int r = 0; r < 4; ++r) red[(C.wave * 12 + t * 4 + r) * 64 + C.lane] = (f32x4){acc[t][0][r], acc[t][1][r], acc[t][2][r], acc[t][3][r]};
        __syncthreads();
        for (int e = C.tid; e < 768; e += NT) { const int slot = e >> 6, ln = e & 63; f32x4 s = red[slot * 64 + ln];
#pragma unroll
            for (int w = 1; w < 8; ++w) s += red[(w * 12 + slot) * 64 + ln];
            const int srow = 16 * (slot >> 2) + 4 * (ln >> 4) + (slot & 3), n = n0 + 4 * (ln & 15);
            if (srow < NSEQ) *(f32x4*)(WSP(float, WS_MOD) + ((size_t)l * NSEQ + srow) * 6144 + n) = s + *(const f32x4*)(INP(I_ADAB) + l * 6144 + n); }
        __syncthreads();
    }
}

__device__ __forceinline__ void norm_phase(const Ctx& C, int l, int which, bool from_input) {
    const int gw = C.bid * 8 + C.wave, NGW = C.G * 8;
    const float* g = INP(which ? I_NMLP : I_NMIX) + l * 1024;
    const int off_sh = which ? 3072 : 0, off_sc = which ? 4096 : 1024;
    for (int row = gw; row < T + NS; row += NGW) {
        const float* xr = from_input ? (row < T ? INP(I_XP) + (size_t)row * D : INP(I_XS) + (size_t)(row - T) * D) : WSP(float, WS_X) + (size_t)row * D;
        const int s = row < T ? (row >> 13) : 2 + row - T;
        const float* mod = WSP(float, WS_MOD) + ((size_t)l * NSEQ + s) * 6144;
        f32x4 v[4]; float ss = 0.f;
#pragma unroll
        for (int j = 0; j < 4; ++j) { v[j] = *(const f32x4*)(xr + 4 * C.lane + 256 * j); ss += (v[j][0] * v[j][0] + v[j][1] * v[j][1]) + (v[j][2] * v[j][2] + v[j][3] * v[j][3]); }
        const float rinv = rsqrtf(wave_sum(ss) * (1.f / D) + EPS);
#pragma unroll
        for (int j = 0; j < 4; ++j) { const int c = 4 * C.lane + 256 * j; const f32x4 gg = *(const f32x4*)(g + c), sh = *(const f32x4*)(mod + off_sh + c), sc = *(const f32x4*)(mod + off_sc + c);
            const f32x4 y = v[j] * rinv * gg * (sc + 1.f) + sh; *(u32x2*)(WSP(bf16, WS_XN) + (size_t)row * D + c) = pk4(y); }
    }
}
__device__ __forceinline__ void final_norm_phase(const Ctx& C) {
    const int gw = C.bid * 8 + C.wave, NGW = C.G * 8;
    const float* g = INP(I_NFIN);
    for (int row = gw; row < T + NS; row += NGW) {
        const float* xr = WSP(float, WS_X) + (size_t)row * D; float* o = (C.PP->out) + (row < T ? O_YP + (size_t)row * D : O_YS + (size_t)(row - T) * D);
        f32x4 v[4]; float ss = 0.f;
#pragma unroll
        for (int j = 0; j < 4; ++j) { v[j] = *(const f32x4*)(xr + 4 * C.lane + 256 * j); ss += (v[j][0] * v[j][0] + v[j][1] * v[j][1]) + (v[j][2] * v[j][2] + v[j][3] * v[j][3]); }
        const float rinv = rsqrtf(wave_sum(ss) * (1.f / D) + EPS);
#pragma unroll
        for (int j = 0; j < 4; ++j) { const int c = 4 * C.lane + 256 * j; *(f32x4*)(o + c) = v[j] * rinv * *(const f32x4*)(g + c); }
    }
}

constexpr size_t ROLL_T0 = (size_t)64 * 127 * 256, ROLL_T1 = (size_t)64 * 511 * 256, ROLL_T2 = (size_t)64 * 2047 * 256, ROLL_TOT = ROLL_T0 + ROLL_T1 + ROLL_T2;
constexpr int ROLL_NSL = 28 * 256, ROLL_L = (int)((ROLL_TOT + ROLL_NSL - 1) / ROLL_NSL);
static_assert(ROLL_L <= 12 * 512, "roll slice size");
struct RollArgs { const float* c0; const float* c1; const float* c2; float* out; int slot0; int* cnt; int bid; };
__device__ __forceinline__ void roll_addr(const RollArgs& R, size_t idx, const f32x4*& src, f32x4*& dst) {
    if (idx < ROLL_T0) { const size_t ib = idx / (127 * 256), rem = idx - ib * (127 * 256); src = (const f32x4*)R.c0 + (ib * 128 + 1) * 256 + rem; dst = (f32x4*)(R.out + O_W0S) + ib * 128 * 256 + rem; }
    else if (idx < ROLL_T0 + ROLL_T1) { const size_t j = idx - ROLL_T0, ib = j / (511 * 256), rem = j - ib * (511 * 256); src = (const f32x4*)R.c1 + (ib * 512 + 1) * 256 + rem; dst = (f32x4*)(R.out + O_W1S) + ib * 512 * 256 + rem; }
    else { const size_t j = idx - ROLL_T0 - ROLL_T1, ib = j / (2047 * 256), rem = j - ib * (2047 * 256); src = (const f32x4*)R.c2 + (ib * 2048 + 1) * 256 + rem; dst = (f32x4*)(R.out + O_W2S) + ib * 2048 * 256 + rem; }
}
#define ROLL_LOADS(R, tid) f32x4 _rv[12]; f32x4* _rd[12]; { const int _slice = ((R).slot0 + (*(R).cnt)++) * 256 + (R).bid; const size_t _b = (size_t)_slice * ROLL_L, _e = (_b + ROLL_L < ROLL_TOT) ? _b + ROLL_L : ROLL_TOT; \
    _Pragma("unroll") for (int _k = 0; _k < 12; ++_k) { const size_t _i = _b + (size_t)_k * 512 + (tid); _rd[_k] = nullptr; if (_i < _e) { const f32x4* _s; roll_addr(R, _i, _s, _rd[_k]); _rv[_k] = __builtin_nontemporal_load(_s); } } }
#define ROLL_STORES() do { _Pragma("unroll") for (int _k = 0; _k < 12; ++_k) if (_rd[_k]) __builtin_nontemporal_store(_rv[_k], _rd[_k]); } while (0)

using pg8::Unit;
struct EpiIn {
    static constexpr bool PERM = true, AFTER_DRAIN = false;
    bf16* U; float* DT; RollArgs R; bool roll;
    __device__ __forceinline__ void operator()(const f32x4 (&acc)[2][2][4][2], const Unit& u, int wr, int wc, int fr, int fq) const {
        const int row0 = u.pm * 256 + wr * 64 + fr, col0 = u.pn * 256 + wc * 32 + 8 * fq;
        ROLL_LOADS(R, (roll ? (wr * 4 + wc) * 64 + fq * 16 + fr : 1 << 30));
#pragma unroll
        for (int ai = 0; ai < 2; ++ai)
#pragma unroll
            for (int m = 0; m < 4; ++m) { const int row = row0 + ai * 128 + m * 16; bf16* rowp = U + (size_t)row * HYB_NP + col0;
#pragma unroll
                for (int bj = 0; bj < 2; ++bj) { const f32x4 v0 = acc[ai][bj][m][0], v1 = acc[ai][bj][m][1];
                    u32x4 w; w.x = pk2(v0[0], v0[1]); w.y = pk2(v0[2], v0[3]); w.z = pk2(v1[0], v1[1]); w.w = pk2(v1[2], v1[3]); *(u32x4*)(rowp + bj * 128) = w; }
                if (u.pn == 10 && wc == 0 && fq < 2) { *(f32x4*)(DT + (size_t)row * 16 + 8 * fq) = acc[ai][0][m][0]; *(f32x4*)(DT + (size_t)row * 16 + 8 * fq + 4) = acc[ai][0][m][1]; } }
        ROLL_STORES();
    }
};
struct EpiRes {
    static constexpr bool PERM = false, AFTER_DRAIN = false;
    const float* xin; float* xout; const float* gate;
    __device__ __forceinline__ void operator()(const f32x4 (&acc)[2][2][4][2], const Unit& u, int wr, int wc, int fr, int fq) const {
        const int row0 = u.pm * 256 + wr * 64 + fr, col0 = u.pn * 256 + wc * 32 + 4 * fq;
#pragma unroll
        for (int ai = 0; ai < 2; ++ai)
#pragma unroll
            for (int m = 0; m < 4; ++m) { const int row = row0 + ai * 128 + m * 16; const float* gp = gate + (size_t)(row >> 13) * 6144 + col0; const size_t off = (size_t)row * D + col0;
#pragma unroll
                for (int bj = 0; bj < 2; ++bj)
#pragma unroll
                    for (int n = 0; n < 2; ++n) { const int o = bj * 128 + n * 16; *(f32x4*)(xout + off + o) = *(const f32x4*)(xin + off + o) + *(const f32x4*)(gp + o) * acc[ai][bj][m][n]; } }
    }
};
struct EpiMlp1 {
    static constexpr bool PERM = true, AFTER_DRAIN = false;
    bf16* H; RollArgs R; bool roll;
    __device__ __forceinline__ void operator()(const f32x4 (&acc)[2][2][4][2], const Unit& u, int wr, int wc, int fr, int fq) const {
        const int row0 = u.pm * 256 + wr * 64 + fr, col0 = u.pn * 256 + wc * 32 + 8 * fq;
        ROLL_LOADS(R, (roll ? (wr * 4 + wc) * 64 + fq * 16 + fr : 1 << 30));
#pragma unroll
        for (int ai = 0; ai < 2; ++ai)
#pragma unroll
            for (int m = 0; m < 4; ++m) { bf16* rowp = H + (size_t)(row0 + ai * 128 + m * 16) * FF + col0;
#pragma unroll
                for (int bj = 0; bj < 2; ++bj) { f32x4 v0 = acc[ai][bj][m][0], v1 = acc[ai][bj][m][1];
#pragma unroll
                    for (int j = 0; j < 4; ++j) { const float a = fmaxf(v0[j], 0.f), b = fmaxf(v1[j], 0.f); v0[j] = a * a; v1[j] = b * b; }
                    u32x4 w; w.x = pk2(v0[0], v0[1]); w.y = pk2(v0[2], v0[3]); w.z = pk2(v1[0], v1[1]); w.w = pk2(v1[2], v1[3]); *(u32x4*)(rowp + bj * 128) = w; } }
        ROLL_STORES();
    }
};
struct EpiQkv {
    static constexpr bool PERM = true, AFTER_DRAIN = false;
    bf16* QKV; const float* rope; float* out; int li;
    __device__ __forceinline__ void operator()(const f32x4 (&acc)[2][2][4][2], const Unit& u, int wr, int wc, int fr, int fq) const {
        const int row0 = u.pm * 256 + wr * 64 + fr, colt = u.pn * 256, col0 = colt + wc * 32 + 8 * fq;
        const int grp = colt / 1536, s = (colt % 1536) / 512;
        const bool do_rope = (s < 2) && ((wc & 1) == 0);
        const int W = 128 << (2 * grp);
        float* wout = out + (grp == 0 ? O_W0P : grp == 1 ? O_W1P : O_W2P);
#pragma unroll
        for (int ai = 0; ai < 2; ++ai)
#pragma unroll
            for (int m = 0; m < 4; ++m) { const int row = row0 + ai * 128 + m * 16, t = row & 8191, b = row >> 13;
#pragma unroll
                for (int bj = 0; bj < 2; ++bj) { f32x4 v0 = acc[ai][bj][m][0], v1 = acc[ai][bj][m][1];
                    if (do_rope) {
                        f32x4 p0, p1;
#pragma unroll
                        for (int j = 0; j < 4; ++j) { p0[j] = __shfl_xor(v0[j], 16); p1[j] = __shfl_xor(v1[j], 16); }
                        if (fq < 2) { const f32x4 c0 = *(const f32x4*)(rope + t * 16), c1 = *(const f32x4*)(rope + t * 16 + 4), s0 = *(const f32x4*)(rope + t * 16 + 8), s1 = *(const f32x4*)(rope + t * 16 + 12);
                            if (fq == 0) { v0 = v0 * c0 - p0 * s0; v1 = v1 * c1 - p1 * s1; } else { v0 = v0 * c0 + p0 * s0; v1 = v1 * c1 + p1 * s1; } }
                    }
                    if (s == 0) { v0 *= 0.125f; v1 *= 0.125f; }
                    const int c = col0 + bj * 128;
                    u32x4 w; w.x = pk2(v0[0], v0[1]); w.y = pk2(v0[2], v0[3]); w.z = pk2(v1[0], v1[1]); w.w = pk2(v1[2], v1[3]); *(u32x4*)(QKV + (size_t)row * QKV_N + c) = w;
                    if (s >= 1 && t >= SEQ - W) { const int cc = c - grp * 1536 - s * 512; float* o = wout + ((size_t)(li * 2 + b) * W + (t - (SEQ - W))) * 1024 + (s - 1) * 512 + cc;
                        *(f32x4*)o = v0; *(f32x4*)(o + 4) = v1; }
                } }
    }
};

template <class F> __device__ __forceinline__ void small_gemm(const Ctx& C, const bf16* A, const bf16* Wt, int N, int K, F&& epi) {
    LAS float* red = (LAS float*)C.lds;
    const int kw = K / 8, steps = kw / 16;
    for (int u = C.G - 1 - (int)C.bid; u < N / 32; u += C.G) {
        const int n0 = 32 * u;
        f32x16 acc;
#pragma unroll
        for (int r = 0; r < 16; ++r) acc[r] = 0.f;
        const bf16* wp = Wt + (size_t)(n0 + (C.lane & 31)) * K + C.wave * kw + 8 * (C.lane >> 5);
        const bf16* ap = A + (size_t)(C.lane & 31) * K + C.wave * kw + 8 * (C.lane >> 5);
        for (int ks = 0; ks < steps; ++ks) { const bf16x8 wf = *(const bf16x8*)(wp + 16 * ks), af = *(const bf16x8*)(ap + 16 * ks); acc = __builtin_amdgcn_mfma_f32_32x32x16_bf16(wf, af, acc, 0, 0, 0); }
#pragma unroll
        for (int r = 0; r < 16; ++r) red[(C.wave * 16 + r) * 64 + C.lane] = acc[r];
        __syncthreads();
#pragma unroll
        for (int e2 = 0; e2 < 2; ++e2) { const int e = C.tid + e2 * NT, r = e >> 6, ln = e & 63; float s = 0.f;
#pragma unroll
            for (int w = 0; w < 8; ++w) s += red[(w * 16 + r) * 64 + ln];
            epi(ln & 31, n0 + (r & 3) + 8 * (r >> 2) + 4 * (ln >> 5), s); }
        __syncthreads();
    }
}

__device__ __forceinline__ void rwkv_prep_unit(const Ctx& C, int li, int tile) {
    const int t0 = tile * 64, tl0 = t0 & 8191, b = t0 >> 13, q = C.lane >> 4, fr = C.lane & 15, w = C.wave, tm = w >> 1, tn0 = (w & 1) * 2, tid = C.tid;
    LAS bf16* TXW = (LAS bf16*)C.lds; LAS bf16* XA = TXW + 64 * 72; LAS bf16* SXG = XA + 64 * 72;
    LAS float* WL = (LAS float*)(C.lds + 36864); LAS float* AL = WL + 64 * 68;
    const float* mu = INP(I_MU) + li * RWC;
    const int t = tid >> 3, part = tid & 7, c8 = part * 8;
    const bool first = (tl0 + t) == 0;
    const bf16* cur = WSP(bf16, WS_U) + (size_t)(t0 + t) * HYB_NP + U_RW;
    {
#pragma unroll
        for (int e = 0; e < 4; ++e) { const int cc = 3072 + part * 32 + 8 * e; const u32x4 cv = *(const u32x4*)(cur + cc); u32x4 pv = (u32x4){0u, 0u, 0u, 0u}; if (!first) pv = *(const u32x4*)(cur - HYB_NP + cc);
            const float* mp = mu + cc; float o[8];
#pragma unroll
            for (int j = 0; j < 4; ++j) { const float c0 = bflo(cv[j]), c1 = bfhi(cv[j]), p0 = bflo(pv[j]), p1 = bfhi(pv[j]); o[2 * j] = c0 + (p0 - c0) * mp[2 * j]; o[2 * j + 1] = c1 + (p1 - c1) * mp[2 * j + 1]; }
            if (part < 2) {
#pragma unroll
                for (int j = 0; j < 8; ++j) o[j] = tanh_(o[j]);
                *(LAS u32x4*)(TXW + t * 72 + part * 32 + 8 * e) = (u32x4){pk2(o[0], o[1]), pk2(o[2], o[3]), pk2(o[4], o[5]), pk2(o[6], o[7])};
            } else if (part < 4) {
                *(LAS u32x4*)(XA + t * 72 + (part - 2) * 32 + 8 * e) = (u32x4){pk2(o[0], o[1]), pk2(o[2], o[3]), pk2(o[4], o[5]), pk2(o[6], o[7])};
            } else {
#pragma unroll
                for (int j = 0; j < 8; ++j) o[j] = sigm_(o[j]);
                *(LAS u32x4*)(SXG + t * 136 + (part - 4) * 32 + 8 * e) = (u32x4){pk2(o[0], o[1]), pk2(o[2], o[3]), pk2(o[4], o[5]), pk2(o[6], o[7])};
            } }
    }
    if ((tile & 127) == 127 && t == 63) { float* so = (C.PP->out) + O_SHP + (size_t)(li * 2 + b) * RWC;
        for (int cc = part; cc < RWC; cc += 8) so[cc] = bf1(cur[cc]); }
    u32x4 pc[3], pp[3];
#define RP_LOAD(h_) do { _Pragma("unroll") for (int _s = 0; _s < 3; ++_s) { const int _cc = _s * 1024 + (h_) * 64 + c8; pc[_s] = *(const u32x4*)(cur + _cc); pp[_s] = (u32x4){0u, 0u, 0u, 0u}; if (!first) pp[_s] = *(const u32x4*)(cur - HYB_NP + _cc); } } while (0)
    RP_LOAD(0);
    LDS_BARRIER();
    const bf16* w2t = WSP(bf16, WS_LORA) + (size_t)li * 262144; const bf16* a2t = w2t + 65536; const bf16* g2t = w2t + 131072;
    bf16x8 fw[2], fa[2], fg[4];
#pragma unroll
    for (int ks = 0; ks < 2; ++ks) { fw[ks] = *(const LAS bf16x8*)(TXW + (16 * tm + fr) * 72 + ks * 32 + 8 * q); fa[ks] = *(const LAS bf16x8*)(XA + (16 * tm + fr) * 72 + ks * 32 + 8 * q); }
#pragma unroll
    for (int ks = 0; ks < 4; ++ks) fg[ks] = *(const LAS bf16x8*)(SXG + (16 * tm + fr) * 136 + ks * 32 + 8 * q);
#pragma unroll 1
    for (int h = 0; h < 16; ++h) {
#pragma unroll
        for (int t2 = 0; t2 < 2; ++t2) { const int tn = tn0 + t2, nrow = h * 64 + 16 * tn + fr, cc = h * 64 + 16 * tn + 4 * q; f32x4 xw = (f32x4){0.f, 0.f, 0.f, 0.f}, xa = xw, xg = xw;
#pragma unroll
            for (int ks = 0; ks < 2; ++ks) { xw = mfma16(*(const bf16x8*)(w2t + nrow * 64 + ks * 32 + 8 * q), fw[ks], xw); xa = mfma16(*(const bf16x8*)(a2t + nrow * 64 + ks * 32 + 8 * q), fa[ks], xa); }
#pragma unroll
            for (int ks = 0; ks < 4; ++ks) xg = mfma16(*(const bf16x8*)(g2t + nrow * 128 + ks * 32 + 8 * q), fg[ks], xg);
            *(LAS f32x4*)(WL + (16 * tm + fr) * 68 + 16 * tn + 4 * q) = xw + *(const f32x4*)(INP(I_RW0) + li * 1024 + cc);
            *(LAS f32x4*)(AL + (16 * tm + fr) * 68 + 16 * tn + 4 * q) = xa + *(const f32x4*)(INP(I_RA0) + li * 1024 + cc);
            *(u32x2*)(WSP(bf16, WS_G) + (size_t)(t0 + 16 * tm + fr) * 1024 + cc) = pk4(xg); }
        float rr[8], kx[8], vv[8];
        { const int ch0 = h * 64 + c8;
#pragma unroll
          for (int j = 0; j < 4; ++j) {
              { const float c0 = bflo(pc[0][j]), c1 = bfhi(pc[0][j]), p0 = bflo(pp[0][j]), p1 = bfhi(pp[0][j]); rr[2 * j] = c0 + (p0 - c0) * mu[ch0 + 2 * j]; rr[2 * j + 1] = c1 + (p1 - c1) * mu[ch0 + 2 * j + 1]; }
              { const float c0 = bflo(pc[1][j]), c1 = bfhi(pc[1][j]), p0 = bflo(pp[1][j]), p1 = bfhi(pp[1][j]); kx[2 * j] = c0 + (p0 - c0) * mu[1024 + ch0 + 2 * j]; kx[2 * j + 1] = c1 + (p1 - c1) * mu[1024 + ch0 + 2 * j + 1]; }
              { const float c0 = bflo(pc[2][j]), c1 = bfhi(pc[2][j]), p0 = bflo(pp[2][j]), p1 = bfhi(pp[2][j]); vv[2 * j] = c0 + (p0 - c0) * mu[2048 + ch0 + 2 * j]; vv[2 * j + 1] = c1 + (p1 - c1) * mu[2048 + ch0 + 2 * j + 1]; } } }
        if (h + 1 < 16) RP_LOAD(h + 1);
        LDS_BARRIER();
        {
            const int ch = h * 64 + c8; float ssq = 0.f;
            const f32x4 wl0 = *(const LAS f32x4*)(WL + t * 68 + c8), wl1 = *(const LAS f32x4*)(WL + t * 68 + c8 + 4), al0 = *(const LAS f32x4*)(AL + t * 68 + c8), al1 = *(const LAS f32x4*)(AL + t * 68 + c8 + 4);
            const float* kkw = INP(I_KK) + li * 1024 + ch; const float* kaw = INP(I_KA) + li * 1024 + ch;
            float wd[8], av[8], kn[8], kp[8];
#pragma unroll
            for (int j = 0; j < 8; ++j) { const float wl = j < 4 ? wl0[j & 3] : wl1[j & 3], al = j < 4 ? al0[j & 3] : al1[j & 3];
                wd[j] = __expf(-__expf(-softplus_(-wl) - 0.5f)); av[j] = sigm_(al); kn[j] = kx[j] * kkw[j]; ssq += kn[j] * kn[j]; kp[j] = kx[j] * (1.f + (av[j] - 1.f) * kaw[j]); }
            ssq += __shfl_xor(ssq, 1); ssq += __shfl_xor(ssq, 2); ssq += __shfl_xor(ssq, 4);
            const float inv = 1.f / fmaxf(sqrtf(ssq), 1e-12f);
#pragma unroll
            for (int j = 0; j < 8; ++j) kn[j] *= inv;
            unsigned char* rec = WSP(unsigned char, WS_REC) + ((size_t)(b * 16 + h) * SEQ + tl0 + t) * RECB;
            *(f32x4*)(rec + c8 * 4) = (f32x4){wd[0], wd[1], wd[2], wd[3]}; *(f32x4*)(rec + c8 * 4 + 16) = (f32x4){wd[4], wd[5], wd[6], wd[7]};
            *(u32x4*)(rec + 256 + c8 * 2) = (u32x4){pk2(rr[0], rr[1]), pk2(rr[2], rr[3]), pk2(rr[4], rr[5]), pk2(rr[6], rr[7])};
            *(u32x4*)(rec + 384 + c8 * 2) = (u32x4){pk2(kp[0], kp[1]), pk2(kp[2], kp[3]), pk2(kp[4], kp[5]), pk2(kp[6], kp[7])};
            *(u32x4*)(rec + 512 + c8 * 2) = (u32x4){pk2(vv[0], vv[1]), pk2(vv[2], vv[3]), pk2(vv[4], vv[5]), pk2(vv[6], vv[7])};
            *(u32x4*)(rec + 640 + c8 * 2) = (u32x4){pk2(-kn[0], -kn[1]), pk2(-kn[2], -kn[3]), pk2(-kn[4], -kn[5]), pk2(-kn[6], -kn[7])};
            *(u32x4*)(rec + 768 + c8 * 2) = (u32x4){pk2(kn[0] * av[0], kn[1] * av[1]), pk2(kn[2] * av[2], kn[3] * av[3]), pk2(kn[4] * av[4], kn[5] * av[5]), pk2(kn[6] * av[6], kn[7] * av[7])};
        }
        LDS_BARRIER();
    }
#undef RP_LOAD
}

__device__ __forceinline__ void ssd_a_unit(const Ctx& C, int li, int u) {
    const int g = u & 1, c = (u >> 1) & 63, b = u >> 7, t0 = b * SEQ + c * 128, q = C.lane >> 4, fr = C.lane & 15;
    LAS float* SC = (LAS float*)C.lds;
    LAS bf16* BT = (LAS bf16*)(C.lds + 4096);
    LAS bf16* XTs = (LAS bf16*)(C.lds + 4096 + 34816);
    const float* DTr = WSP(float, WS_DT); float* DTS = WSP(float, WS_DTS); float* ACS = WSP(float, WS_ACS);
    bf16* XCg = WSP(bf16, WS_XT); bf16* BCg = WSP(bf16, WS_BC); float* CS = WSP(float, WS_CS);
    {
        const int h = g * 8 + C.wave; const float bias = INP(I_DTB)[li * 16 + h], A = -__expf(INP(I_ALOG)[li * 16 + h]);
        const int l0 = 2 * C.lane; const float d0 = softplus_(DTr[(size_t)(t0 + l0) * 16 + h] + bias), d1 = softplus_(DTr[(size_t)(t0 + l0 + 1) * 16 + h] + bias);
        const float a0 = d0 * A, a1 = d1 * A; float s = a0 + a1;
#pragma unroll
        for (int o = 1; o < 64; o <<= 1) { const float n = __shfl_up(s, o); if (C.lane >= o) s += n; }
        const float acs1 = s, acs0 = s - a1, tot = __shfl(s, 63);
        DTS[(size_t)(t0 + l0) * 16 + h] = d0; DTS[(size_t)(t0 + l0 + 1) * 16 + h] = d1; ACS[(size_t)(t0 + l0) * 16 + h] = acs0; ACS[(size_t)(t0 + l0 + 1) * 16 + h] = acs1;
        SC[C.wave * 128 + l0] = __expf(tot - acs0) * d0; SC[C.wave * 128 + l0 + 1] = __expf(tot - acs1) * d1;
    }
    __syncthreads();
    const float* cw = INP(I_CONVW) + (size_t)li * 4 * 1536; const float* cb = INP(I_CONVB) + (size_t)li * 1536;
    for (int pass = 0; pass < 2; ++pass) {
        const int nitems = pass == 0 ? 16 : 8;
        for (int it = C.wave; it < nitems; it += 8) { const int tb = it & 7, cblk = pass == 0 ? (it >> 3) : 2;
            int ch;
            if (cblk == 0) ch = (C.lane < 32 ? 1024 + g * 128 + 4 * C.lane : 1280 + g * 128 + 4 * (C.lane - 32)); else ch = g * 512 + (cblk - 1) * 256 + 4 * C.lane;
            const int tl = c * 128 + tb * 16;
            const bf16* up = WSP(bf16, WS_U) + (size_t)(t0 + tb * 16) * HYB_NP + U_XBC + ch;
            f32x4 uu[19];
#pragma unroll
            for (int k = 0; k < 19; ++k) { uu[k] = (f32x4){0.f, 0.f, 0.f, 0.f}; if (tl + k - 3 >= 0) uu[k] = bf4(*(const u32x2*)(up + (ptrdiff_t)(k - 3) * HYB_NP)); }
            const f32x4 w0 = *(const f32x4*)(cw + ch), w1 = *(const f32x4*)(cw + 1536 + ch), w2 = *(const f32x4*)(cw + 3072 + ch), w3 = *(const f32x4*)(cw + 4608 + ch), bb = *(const f32x4*)(cb + ch);
            if (c == 63 && tb == 7) { float* o = (C.PP->out) + O_CONVP + (size_t)(li * 2 + b) * 3 * 1536 + ch; *(f32x4*)o = uu[16]; *(f32x4*)(o + 1536) = uu[17]; *(f32x4*)(o + 3072) = uu[18]; }
            f32x4 y[16];
#pragma unroll
            for (int k = 0; k < 16; ++k) { f32x4 v = bb + w0 * uu[k] + w1 * uu[k + 1] + w2 * uu[k + 2] + w3 * uu[k + 3];
#pragma unroll
                for (int j = 0; j < 4; ++j) v[j] = siluf_(v[j]);
                y[k] = v; }
            if (cblk == 0) {
                const bool isB = C.lane < 32; const int n = 4 * (C.lane & 31);
#pragma unroll
                for (int k = 0; k < 16; ++k) *(u32x2*)(BCg + (size_t)(t0 + tb * 16 + k) * 512 + (isB ? 0 : 256) + g * 128 + n) = pk4(y[k]);
                if (isB) {
#pragma unroll
                    for (int j = 0; j < 4; ++j) { u32x4 lo, hi;
                        lo.x = pk2(y[0][j], y[1][j]); lo.y = pk2(y[2][j], y[3][j]); lo.z = pk2(y[4][j], y[5][j]); lo.w = pk2(y[6][j], y[7][j]);
                        hi.x = pk2(y[8][j], y[9][j]); hi.y = pk2(y[10][j], y[11][j]); hi.z = pk2(y[12][j], y[13][j]); hi.w = pk2(y[14][j], y[15][j]);
                        *(LAS u32x4*)(BT + (n + j) * 136 + tb * 16) = lo; *(LAS u32x4*)(BT + (n + j) * 136 + tb * 16 + 8) = hi; } }
            } else {
                const int xc = (cblk - 1) * 256 + 4 * C.lane;
                const int hl = xc >> 6;
                const int xl = (pass == 0 ? xc : xc - 256);
                float sc[16];
#pragma unroll
                for (int k = 0; k < 16; ++k) sc[k] = SC[hl * 128 + tb * 16 + k];
#pragma unroll
                for (int k = 0; k < 16; ++k) *(u32x2*)(XCg + (size_t)(t0 + tb * 16 + k) * 1024 + g * 512 + xc) = pk4(y[k]);
#pragma unroll
                for (int j = 0; j < 4; ++j) { u32x4 lo, hi;
                    lo.x = pk2(y[0][j], y[1][j]); lo.y = pk2(y[2][j], y[3][j]); lo.z = pk2(y[4][j], y[5][j]); lo.w = pk2(y[6][j], y[7][j]);
                    hi.x = pk2(y[8][j], y[9][j]); hi.y = pk2(y[10][j], y[11][j]); hi.z = pk2(y[12][j], y[13][j]); hi.w = pk2(y[14][j], y[15][j]);
                    lo.x = pk2(y[0][j] * sc[0], y[1][j] * sc[1]); lo.y = pk2(y[2][j] * sc[2], y[3][j] * sc[3]); lo.z = pk2(y[4][j] * sc[4], y[5][j] * sc[5]); lo.w = pk2(y[6][j] * sc[6], y[7][j] * sc[7]);
                    hi.x = pk2(y[8][j] * sc[8], y[9][j] * sc[9]); hi.y = pk2(y[10][j] * sc[10], y[11][j] * sc[11]); hi.z = pk2(y[12][j] * sc[12], y[13][j] * sc[13]); hi.w = pk2(y[14][j] * sc[14], y[15][j] * sc[15]);
                    *(LAS u32x4*)(XTs + (xl + j) * 136 + tb * 16) = lo; *(LAS u32x4*)(XTs + (xl + j) * 136 + tb * 16 + 8) = hi; }
            }
        }
        __syncthreads();
        { const int hl = C.wave >> 1, h = g * 8 + pass * 4 + hl;
          float* csp = CS + (((size_t)(b * 64 + c) * 16 + h) * 64) * 128;
#pragma unroll
          for (int tmi = 0; tmi < 2; ++tmi) { const int tm = (C.wave & 1) * 2 + tmi; bf16x8 xf[4];
#pragma unroll
              for (int ks = 0; ks < 4; ++ks) xf[ks] = *(const LAS bf16x8*)(XTs + (hl * 64 + 16 * tm + fr) * 136 + ks * 32 + 8 * q);
#pragma unroll
              for (int tn = 0; tn < 8; ++tn) { f32x4 acc = (f32x4){0.f, 0.f, 0.f, 0.f};
#pragma unroll
                  for (int ks = 0; ks < 4; ++ks) acc = mfma16(*(const LAS bf16x8*)(BT + (16 * tn + fr) * 136 + ks * 32 + 8 * q), xf[ks], acc);
                  *(f32x4*)(csp + (size_t)(16 * tm + fr) * 128 + 16 * tn + 4 * q) = acc; } }
        }
        __syncthreads();
    }
}

__device__ __forceinline__ void rwkv_scan_unit(const Ctx& C, int unit) {
    const int bh = unit >> 3, c = (unit & 7) * 8 + C.wave, lane = C.lane;
    const unsigned char* rec = WSP(unsigned char, WS_REC) + ((size_t)bh * SEQ + c * 128) * RECB;
    unsigned* qo = WSP(unsigned, WS_QO) + ((size_t)bh * SEQ + c * 128) * 64;
    LAS float* buf = (LAS float*)(C.lds + C.wave * 12288);
    f32x2 Sl[32], Pm[32];
    int lopq = lane; asm volatile("" : "+v"(lopq));
#pragma unroll
    for (int j = 0; j < 32; ++j) { Sl[j] = (f32x2){0.f, 0.f}; Pm[j] = (f32x2){(2 * j == lopq) ? 1.f : 0.f, (2 * j + 1 == lopq) ? 1.f : 0.f}; }
    LAS unsigned char* raw = C.lds + 98304 + C.wave * 3584;
#define RW_LOAD(sbi) do { const unsigned char* _p = rec + (size_t)(sbi) * 3584; \
        __builtin_amdgcn_global_load_lds((const unsigned*)(_p + lane * 16), (LAS unsigned*)raw, 16, 0, 0); __builtin_amdgcn_global_load_lds((const unsigned*)(_p + 1024 + lane * 16), (LAS unsigned*)(raw + 1024), 16, 0, 0); \
        __builtin_amdgcn_global_load_lds((const unsigned*)(_p + 2048 + lane * 16), (LAS unsigned*)(raw + 2048), 16, 0, 0); if (lane < 32) __builtin_amdgcn_global_load_lds((const unsigned*)(_p + 3072 + lane * 16), (LAS unsigned*)(raw + 3072), 16, 0, 0); } while (0)
#define RW_PUT16(dst, o, v4) do { const int _s = (o) / RECB, _f = (o) - _s * RECB; LAS float* _d = (dst) + _s * 384; \
        if (_f < 256) { *(LAS f32x4*)(_d + 64 + (_f >> 2)) = __builtin_bit_cast(f32x4, v4); } \
        else { const int _e = (_f - 256) >> 1, _v = _e >> 6, _i = _e & 63; LAS float* _q = _d + (_v == 0 ? 0 : 64 + 64 * _v) + _i; \
               *(LAS f32x4*)_q = (f32x4){bflo((v4)[0]), bfhi((v4)[0]), bflo((v4)[1]), bfhi((v4)[1])}; *(LAS f32x4*)(_q + 4) = (f32x4){bflo((v4)[2]), bfhi((v4)[2]), bflo((v4)[3]), bfhi((v4)[3])}; } } while (0)
#define RW_STORE(dst, W0) do { if (W0) asm volatile("s_waitcnt vmcnt(0)" ::: "memory"); else asm volatile("s_waitcnt vmcnt(4)" ::: "memory");     { const u32x4 _a = *(const LAS u32x4*)(raw + lane * 16); RW_PUT16(dst, lane * 16, _a); } { const u32x4 _a = *(const LAS u32x4*)(raw + 1024 + lane * 16); RW_PUT16(dst, 1024 + lane * 16, _a); } \
        { const u32x4 _a = *(const LAS u32x4*)(raw + 2048 + lane * 16); RW_PUT16(dst, 2048 + lane * 16, _a); } if (lane < 32) { const u32x4 _a = *(const LAS u32x4*)(raw + 3072 + lane * 16); RW_PUT16(dst, 3072 + lane * 16, _a); } \
        asm volatile("s_waitcnt lgkmcnt(0)" ::: "memory"); } while (0)
    RW_LOAD(0); RW_STORE(buf, true); RW_LOAD(1);
    float sa_s = 0.f, sa_p = buf[256 + lane];
    for (int sb = 0; sb < 32; ++sb) {
        LAS float* cb = buf + (sb & 1) * 1536; LAS float* nb = buf + ((sb + 1) & 1) * 1536;
        if (sb + 1 < 32) RW_STORE(nb, sb == 0);
        if (sb + 2 < 32) RW_LOAD(sb + 2);
        for (int st = 0; st < 4; ++st) {
            const LAS float* v = cb + st * 384; const LAS float* nx = (st < 3) ? v + 384 : nb;
            const float vv = v[192 + lane];
            const f32x2 vv2 = (f32x2){vv, vv}, sas = (f32x2){sa_s, sa_s}, sap = (f32x2){sa_p, sa_p};
            f32x2 o2a = (f32x2){0.f, 0.f}, o2b = o2a, q2a = o2a, q2b = o2a, ns2a = o2a, ns2b = o2a, np2a = o2a, np2b = o2a;
            f32x4 r4 = *(const LAS f32x4*)(v), w4 = *(const LAS f32x4*)(v + 64), k4 = *(const LAS f32x4*)(v + 128), b4 = *(const LAS f32x4*)(v + 320), n4 = *(const LAS f32x4*)(nx + 256);
#pragma unroll
            for (int j = 0; j < 16; ++j) {
                f32x4 r4n = r4, w4n = w4, k4n = k4, b4n = b4, n4n = n4;
                if (j < 15) { r4n = *(const LAS f32x4*)(v + 4 * j + 4); w4n = *(const LAS f32x4*)(v + 64 + 4 * j + 4); k4n = *(const LAS f32x4*)(v + 128 + 4 * j + 4); b4n = *(const LAS f32x4*)(v + 320 + 4 * j + 4); n4n = *(const LAS f32x4*)(nx + 256 + 4 * j + 4); }
                {   const f32x2 r2 = (f32x2){r4[0], r4[1]}, w2 = (f32x2){w4[0], w4[1]}, k2 = (f32x2){k4[0], k4[1]}, b2 = (f32x2){b4[0], b4[1]}, n2 = (f32x2){n4[0], n4[1]};
                    f32x2 t = vv2 * k2; t = sas * b2 + t; Sl[2 * j] = Sl[2 * j] * w2 + t; o2a = Sl[2 * j] * r2 + o2a; ns2a = Sl[2 * j] * n2 + ns2a;
                    f32x2 tp = sap * b2; Pm[2 * j] = Pm[2 * j] * w2 + tp; q2a = Pm[2 * j] * r2 + q2a; np2a = Pm[2 * j] * n2 + np2a; }
                {   const f32x2 r2 = (f32x2){r4[2], r4[3]}, w2 = (f32x2){w4[2], w4[3]}, k2 = (f32x2){k4[2], k4[3]}, b2 = (f32x2){b4[2], b4[3]}, n2 = (f32x2){n4[2], n4[3]};
                    f32x2 t = vv2 * k2; t = sas * b2 + t; Sl[2 * j + 1] = Sl[2 * j + 1] * w2 + t; o2b = Sl[2 * j + 1] * r2 + o2b; ns2b = Sl[2 * j + 1] * n2 + ns2b;
                    f32x2 tp = sap * b2; Pm[2 * j + 1] = Pm[2 * j + 1] * w2 + tp; q2b = Pm[2 * j + 1] * r2 + q2b; np2b = Pm[2 * j + 1] * n2 + np2b; }
                r4 = r4n; w4 = w4n; k4 = k4n; b4 = b4n; n4 = n4n;
            }
            const f32x2 o2 = o2a + o2b, q2 = q2a + q2b, ns2 = ns2a + ns2b, np2 = np2a + np2b;
            qo[(size_t)(sb * 4 + st) * 64 + lane] = pk2(o2[0] + o2[1], q2[0] + q2[1]);
            sa_s = ns2[0] + ns2[1]; sa_p = np2[0] + np2[1];
        }
    }
    float* sl = WSP(float, WS_SL) + ((size_t)(bh * 64 + c) * 2) * 4096 + lane * 64;
#pragma unroll
    for (int j = 0; j < 16; ++j) { *(f32x4*)(sl + 4 * j) = (f32x4){Sl[2 * j][0], Sl[2 * j][1], Sl[2 * j + 1][0], Sl[2 * j + 1][1]}; *(f32x4*)(sl + 4096 + 4 * j) = (f32x4){Pm[2 * j][0], Pm[2 * j][1], Pm[2 * j + 1][0], Pm[2 * j + 1][1]}; }
}

__device__ __forceinline__ void ssd_scan_phase(const Ctx& C, int li) {
    const int gt = C.bid * NT + C.tid;
    if (gt >= 131072) return;
    const int n2 = gt & 63, p = (gt >> 6) & 63, h = (gt >> 12) & 15, b = gt >> 16;
    float* CS = WSP(float, WS_CS); const float* ACS = WSP(float, WS_ACS);
    f32x2 S = (f32x2){0.f, 0.f};
#pragma unroll 1
    for (int cb = 0; cb < 64; cb += 16) { f32x2 v[16]; float dec[16];
#pragma unroll
        for (int k = 0; k < 16; ++k) { const int c = cb + k; v[k] = *(const f32x2*)(CS + (((size_t)(b * 64 + c) * 16 + h) * 64 + p) * 128 + 2 * n2); dec[k] = ACS[(size_t)(b * SEQ + c * 128 + 127) * 16 + h]; }
#pragma unroll
        for (int k = 0; k < 16; ++k) { const int c = cb + k; *(f32x2*)(CS + (((size_t)(b * 64 + c) * 16 + h) * 64 + p) * 128 + 2 * n2) = S; S = S * __expf(dec[k]) + v[k]; } }
    *(f32x2*)((C.PP->out) + O_SSDP + ((size_t)((li * 2 + b) * 16 + h) * 64 + p) * 128 + 2 * n2) = S;
}

__device__ __forceinline__ void rwkv_combine_unit(const Ctx& C, int li, int bh) {
    LAS float* Ss = (LAS float*)C.lds;
    LAS float* Ps = Ss + 64 * 68;
    const int q = C.lane >> 4, fr = C.lane & 15, tm = C.wave >> 1, tnb = (C.wave & 1) * 2;
    const float* SL = WSP(float, WS_SL) + (size_t)bh * 64 * 2 * 4096; float* SST = WSP(float, WS_SST) + (size_t)bh * 64 * 4096;
    for (int e = C.tid; e < 64 * 68; e += NT) Ss[e] = 0.f;
    const int r0 = C.tid >> 4, c4 = (C.tid & 15) * 4;
    f32x4 pn0 = *(const f32x4*)(SL + 4096 + r0 * 64 + c4), pn1 = *(const f32x4*)(SL + 4096 + (r0 + 32) * 64 + c4);
    f32x4 ln[2];
#pragma unroll
    for (int t2 = 0; t2 < 2; ++t2)
#pragma unroll
        for (int r = 0; r < 4; ++r) ln[t2][r] = SL[(16 * tm + 4 * q + r) * 64 + 16 * (tnb + t2) + fr];
    __syncthreads();
    for (int c = 0; c < 64; ++c) {
        *(LAS f32x4*)(Ps + r0 * 72 + c4) = pn0; *(LAS f32x4*)(Ps + (r0 + 32) * 72 + c4) = pn1;
        f32x4 acc[2] = {ln[0], ln[1]};
        if (c + 1 < 64) { const float* Ln = SL + (size_t)(c + 1) * 8192; pn0 = *(const f32x4*)(Ln + 4096 + r0 * 64 + c4); pn1 = *(const f32x4*)(Ln + 4096 + (r0 + 32) * 64 + c4);
#pragma unroll
            for (int t2 = 0; t2 < 2; ++t2)
#pragma unroll
                for (int r = 0; r < 4; ++r) ln[t2][r] = Ln[(16 * tm + 4 * q + r) * 64 + 16 * (tnb + t2) + fr]; }
        LDS_BARRIER();
        *(f32x4*)(SST + (size_t)c * 4096 + r0 * 64 + c4) = *(const LAS f32x4*)(Ss + r0 * 68 + c4); *(f32x4*)(SST + (size_t)c * 4096 + (r0 + 32) * 64 + c4) = *(const LAS f32x4*)(Ss + (r0 + 32) * 68 + c4);
        { float av[16], bv[2][16];
#pragma unroll
          for (int k = 0; k < 16; ++k) { av[k] = Ss[(16 * tm + fr) * 68 + 4 * k + q]; bv[0][k] = Ps[(4 * k + q) * 72 + 16 * tnb + fr]; bv[1][k] = Ps[(4 * k + q) * 72 + 16 * (tnb + 1) + fr]; }
#pragma unroll
          for (int k = 0; k < 16; ++k) { acc[0] = __builtin_amdgcn_mfma_f32_16x16x4f32(av[k], bv[0][k], acc[0], 0, 0, 0); acc[1] = __builtin_amdgcn_mfma_f32_16x16x4f32(av[k], bv[1][k], acc[1], 0, 0, 0); } }
        LDS_BARRIER();
#pragma unroll
        for (int t2 = 0; t2 < 2; ++t2)
#pragma unroll
            for (int r = 0; r < 4; ++r) Ss[(16 * tm + 4 * q + r) * 68 + 16 * (tnb + t2) + fr] = acc[t2][r];
        LDS_BARRIER();
    }
    float* o = (C.PP->out) + O_WKVP + (size_t)(li * 32 + bh) * 4096;
    *(f32x4*)(o + r0 * 64 + c4) = *(const LAS f32x4*)(Ss + r0 * 68 + c4); *(f32x4*)(o + (r0 + 32) * 64 + c4) = *(const LAS f32x4*)(Ss + (r0 + 32) * 68 + c4);
    __syncthreads();
}

__device__ __forceinline__ void ssd_c_unit(const Ctx& C, int li, int u) {
    const int g = u & 1, c = (u >> 1) & 63, b = u >> 7, t0 = b * SEQ + c * 128, q = C.lane >> 4, fr = C.lane & 15, w = C.wave;
    LAS bf16* Cb = (LAS bf16*)C.lds;
    LAS bf16* Bb = Cb + 128 * 136;
    LAS bf16* XTh = Bb; LAS bf16* SINh = Bb + 64 * 136;
    LAS bf16* Mw = Bb + 128 * 136 + w * (16 * 136);
    LAS float* AD = (LAS float*)(Bb + 128 * 136 + 8 * 16 * 136);
    const bf16* BCg = WSP(bf16, WS_BC); const float* DTS = WSP(float, WS_DTS); const float* ACS = WSP(float, WS_ACS);
    const bf16* XCg = WSP(bf16, WS_XT) + (size_t)t0 * 1024 + g * 512; const float* CS = WSP(float, WS_CS) + ((size_t)(b * 64 + c) * 16 + g * 8) * 8192;
    bf16* Y = WSP(bf16, WS_YCAT);
    for (int e = C.tid; e < 4096; e += NT) { const int r = e >> 5, cc = e & 31, isC = cc >> 4, c8 = (cc & 15) * 8;
        const u32x4 v = *(const u32x4*)(BCg + (size_t)(t0 + r) * 512 + (isC ? 256 : 0) + g * 128 + c8); *(LAS u32x4*)((isC ? Cb : Bb) + r * 136 + c8) = v; }
    __syncthreads();
    f32x4 cbv[8]; bf16x8 cf[4];
#pragma unroll
    for (int ks = 0; ks < 4; ++ks) cf[ks] = *(const LAS bf16x8*)(Cb + (16 * w + fr) * 136 + ks * 32 + 8 * q);
#pragma unroll
    for (int tn = 0; tn < 8; ++tn) { cbv[tn] = (f32x4){0.f, 0.f, 0.f, 0.f};
        if (tn <= w) {
#pragma unroll
            for (int ks = 0; ks < 4; ++ks) cbv[tn] = mfma16(*(const LAS bf16x8*)(Bb + (16 * tn + fr) * 136 + ks * 32 + 8 * q), cf[ks], cbv[tn]); } }
    __syncthreads();
    float ssq = 0.f;
    const int l = 16 * w + fr;
    const int r0 = C.tid >> 4, c8 = (C.tid & 15) * 8, zt = C.tid >> 3, zc = (C.tid & 7) * 8;
    LAS bf16* ZY = (LAS bf16*)(AD + 256);
    LAS float* RINV = (LAS float*)(ZY + 128 * 72);
    u32x4 xq0, xq1, zq0, zq1; f32x4 sq0, sq1, sq2, sq3; float adq = 0.f;
#define SC_LOAD(hh_) do { const bf16* _x = XCg + (size_t)zt * 1024 + (hh_) * 64 + zc; xq0 = *(const u32x4*)_x; xq1 = *(const u32x4*)(_x + (size_t)64 * 1024);     \
        const float* _s = CS + (size_t)(hh_) * 8192 + r0 * 128 + c8; sq0 = *(const f32x4*)_s; sq1 = *(const f32x4*)(_s + 4); sq2 = *(const f32x4*)(_s + 32 * 128); sq3 = *(const f32x4*)(_s + 32 * 128 + 4); \
        const bf16* _z = WSP(bf16, WS_U) + (size_t)(t0 + zt) * HYB_NP + (g * 8 + (hh_)) * 64 + zc; zq0 = *(const u32x4*)_z; zq1 = *(const u32x4*)(_z + (size_t)64 * HYB_NP); \
        if (C.tid < 256) adq = (C.tid < 128 ? ACS : DTS)[(size_t)(t0 + (C.tid & 127)) * 16 + g * 8 + (hh_)]; } while (0)
    SC_LOAD(0);
#pragma unroll 1
    for (int hh = 0; hh < 8; ++hh) { const int h = g * 8 + hh;
        if (hh > 0) { *(u32x4*)(Y + (size_t)(t0 + zt) * 2048 + g * 512 + (hh - 1) * 64 + zc) = *(const LAS u32x4*)(ZY + zt * 72 + zc); *(u32x4*)(Y + (size_t)(t0 + zt + 64) * 2048 + g * 512 + (hh - 1) * 64 + zc) = *(const LAS u32x4*)(ZY + (zt + 64) * 72 + zc); }
        *(LAS u32x4*)(ZY + zt * 72 + zc) = zq0; *(LAS u32x4*)(ZY + (zt + 64) * 72 + zc) = zq1;
#pragma unroll
        for (int j = 0; j < 4; ++j) { XTh[(zc + 2 * j) * 136 + zt] = (bf16)(xq0[j] & 0xffffu); XTh[(zc + 2 * j + 1) * 136 + zt] = (bf16)(xq0[j] >> 16); XTh[(zc + 2 * j) * 136 + zt + 64] = (bf16)(xq1[j] & 0xffffu); XTh[(zc + 2 * j + 1) * 136 + zt + 64] = (bf16)(xq1[j] >> 16); }
        *(LAS u32x4*)(SINh + r0 * 136 + c8) = (u32x4){pk2(sq0[0], sq0[1]), pk2(sq0[2], sq0[3]), pk2(sq1[0], sq1[1]), pk2(sq1[2], sq1[3])};
        *(LAS u32x4*)(SINh + (r0 + 32) * 136 + c8) = (u32x4){pk2(sq2[0], sq2[1]), pk2(sq2[2], sq2[3]), pk2(sq3[0], sq3[1]), pk2(sq3[2], sq3[3])};
        if (C.tid < 256) AD[C.tid] = adq;
        if (hh + 1 < 8) SC_LOAD(hh + 1);
        LDS_BARRIER();
        const float acl = AD[l];
#pragma unroll
        for (int tn = 0; tn < 8; ++tn) { f32x4 mv = (f32x4){0.f, 0.f, 0.f, 0.f};
            if (tn <= w) { const f32x4 as = *(const LAS f32x4*)(AD + 16 * tn + 4 * q), ds = *(const LAS f32x4*)(AD + 128 + 16 * tn + 4 * q);
#pragma unroll
                for (int j = 0; j < 4; ++j) { const int s = 16 * tn + 4 * q + j; mv[j] = (s <= l) ? cbv[tn][j] * __expf(acl - as[j]) * ds[j] : 0.f; } }
            *(LAS u32x2*)(Mw + fr * 136 + 16 * tn + 4 * q) = pk4(mv); }
        LDSW();
        const float eal = __expf(acl), Dh = INP(I_SSDD)[li * 16 + h];
        const int nks = (w + 2) >> 1;
#pragma unroll
        for (int tp = 0; tp < 4; ++tp) { f32x4 a1 = (f32x4){0.f, 0.f, 0.f, 0.f}, a2 = a1;
            for (int ks = 0; ks < nks; ++ks) a1 = mfma16(*(const LAS bf16x8*)(XTh + (16 * tp + fr) * 136 + ks * 32 + 8 * q), *(const LAS bf16x8*)(Mw + fr * 136 + ks * 32 + 8 * q), a1);
#pragma unroll
            for (int ks = 0; ks < 4; ++ks) a2 = mfma16(*(const LAS bf16x8*)(SINh + (16 * tp + fr) * 136 + ks * 32 + 8 * q), cf[ks], a2);
            const int p0 = 16 * tp + 4 * q;
            const f32x4 z = bf4(*(const LAS u32x2*)(ZY + l * 72 + p0));
            f32x4 y;
#pragma unroll
            for (int j = 0; j < 4; ++j) { const float xv = bf1(XTh[(p0 + j) * 136 + l]); y[j] = (a1[j] + eal * a2[j] + Dh * xv) * siluf_(z[j]); }
            const u32x2 yp = pk4(y); const f32x4 yr = bf4(yp); ssq += (yr[0] * yr[0] + yr[1] * yr[1]) + (yr[2] * yr[2] + yr[3] * yr[3]);
            *(LAS u32x2*)(ZY + l * 72 + p0) = yp; }
        LDS_BARRIER();
    }
#undef SC_LOAD
    ssq += __shfl_xor(ssq, 16); ssq += __shfl_xor(ssq, 32);
    if (q == 0) RINV[l] = rsqrtf(ssq * (1.f / 512.f) + EPS);
    *(u32x4*)(Y + (size_t)(t0 + zt) * 2048 + g * 512 + 7 * 64 + zc) = *(const LAS u32x4*)(ZY + zt * 72 + zc); *(u32x4*)(Y + (size_t)(t0 + zt + 64) * 2048 + g * 512 + 7 * 64 + zc) = *(const LAS u32x4*)(ZY + (zt + 64) * 72 + zc);
    asm volatile("s_waitcnt vmcnt(0)" ::: "memory");
    __syncthreads();
    const float* nw = INP(I_SNW) + li * 1024 + g * 512;
#pragma unroll
    for (int half = 0; half < 2; ++half) { const int tt = zt + 64 * half; const float ri = RINV[tt]; bf16* yr = Y + (size_t)(t0 + tt) * 2048 + g * 512 + zc; u32x4 yv[8];
#pragma unroll
        for (int hh = 0; hh < 8; ++hh) yv[hh] = *(const u32x4*)(yr + hh * 64);
#pragma unroll
        for (int hh = 0; hh < 8; ++hh) { const f32x4 n0 = *(const f32x4*)(nw + hh * 64 + zc), n1 = *(const f32x4*)(nw + hh * 64 + zc + 4); u32x4 o;
            o[0] = pk2(bflo(yv[hh][0]) * ri * n0[0], bfhi(yv[hh][0]) * ri * n0[1]); o[1] = pk2(bflo(yv[hh][1]) * ri * n0[2], bfhi(yv[hh][1]) * ri * n0[3]);
            o[2] = pk2(bflo(yv[hh][2]) * ri * n1[0], bfhi(yv[hh][2]) * ri * n1[1]); o[3] = pk2(bflo(yv[hh][3]) * ri * n1[2], bfhi(yv[hh][3]) * ri * n1[3]);
            *(u32x4*)(yr + hh * 64) = o; } }
    __syncthreads();
}

__device__ __forceinline__ void rwkv_out_phase(const Ctx& C, int li) {
    const int q = C.lane >> 4, fr = C.lane & 15, w = C.wave, tr = 16 * w + fr, tid = C.tid;
    LAS bf16* Qb = (LAS bf16*)C.lds;
    LAS bf16* Sb = Qb + 128 * 72;
    LAS bf16* OL = Sb + 64 * 72;
    LAS bf16* BN = OL + 128 * 72;
    LAS bf16* GG = BN + 128 * 72;
    LAS bf16* Ys = GG + 128 * 72;
    u32x4 pq[4]; f32x4 ps[2]; u32x4 pr[2], pk[2], pv[2], pg[2];
#define RO_LOAD(u_) do { const int _c = (u_) & 63, _bh = (u_) >> 6; const unsigned* _qo = WSP(unsigned, WS_QO) + ((size_t)_bh * SEQ + _c * 128) * 64; const float* _sst = WSP(float, WS_SST) + (size_t)(_bh * 64 + _c) * 4096; \
        _Pragma("unroll") for (int _i = 0; _i < 4; ++_i) { const int _e = tid + _i * NT; pq[_i] = *(const u32x4*)(_qo + (size_t)(_e >> 4) * 64 + (_e & 15) * 4); } \
        _Pragma("unroll") for (int _i = 0; _i < 2; ++_i) { const int _e = tid + _i * NT; ps[_i] = *(const f32x4*)(_sst + (_e >> 4) * 64 + (_e & 15) * 4); } \
        _Pragma("unroll") for (int _i = 0; _i < 2; ++_i) { const int _e = tid + _i * NT, _t = _e >> 3, _c8 = (_e & 7) * 8; const unsigned char* _rp = WSP(unsigned char, WS_REC) + ((size_t)_bh * SEQ + _c * 128 + _t) * RECB; \
            pr[_i] = *(const u32x4*)(_rp + 256 + _c8 * 2); pk[_i] = *(const u32x4*)(_rp + 384 + _c8 * 2); pv[_i] = *(const u32x4*)(_rp + 512 + _c8 * 2); \
            pg[_i] = *(const u32x4*)(WSP(bf16, WS_G) + (size_t)((_bh >> 4) * SEQ + _c * 128 + _t) * 1024 + (_bh & 15) * 64 + _c8); } } while (0)
    int u = C.bid;
    if (u < 2048) RO_LOAD(u);
    for (; u < 2048; u += C.G) {
        const int c = u & 63, bh = u >> 6, h = bh & 15, b = bh >> 4, t0 = b * SEQ + c * 128;
        const float* rkw = INP(I_RK) + li * 1024 + h * 64;
#pragma unroll
        for (int i = 0; i < 4; ++i) { const int e = tid + i * NT; const u32x4 v = pq[i]; u32x2 qv, ov; qv.x = (v[0] >> 16) | (v[1] & 0xffff0000u); qv.y = (v[2] >> 16) | (v[3] & 0xffff0000u);
            ov.x = (v[0] & 0xffffu) | (v[1] << 16); ov.y = (v[2] & 0xffffu) | (v[3] << 16);
            *(LAS u32x2*)(Qb + (e >> 4) * 72 + (e & 15) * 4) = qv; *(LAS u32x2*)(OL + (e >> 4) * 72 + (e & 15) * 4) = ov; }
#pragma unroll
        for (int i = 0; i < 2; ++i) { const int e = tid + i * NT; *(LAS u32x2*)(Sb + (e >> 4) * 72 + (e & 15) * 4) = pk4(ps[i]); }
#pragma unroll
        for (int i = 0; i < 2; ++i) { const int e = tid + i * NT, t = e >> 3, c8 = (e & 7) * 8; float rk = 0.f;
#pragma unroll
            for (int j = 0; j < 4; ++j) rk += bflo(pr[i][j]) * bflo(pk[i][j]) * rkw[c8 + 2 * j] + bfhi(pr[i][j]) * bfhi(pk[i][j]) * rkw[c8 + 2 * j + 1];
            rk += __shfl_xor(rk, 1); rk += __shfl_xor(rk, 2); rk += __shfl_xor(rk, 4);
            u32x4 bo;
#pragma unroll
            for (int j = 0; j < 4; ++j) bo[j] = pk2(rk * bflo(pv[i][j]), rk * bfhi(pv[i][j]));
            *(LAS u32x4*)(BN + t * 72 + c8) = bo; *(LAS u32x4*)(GG + t * 72 + c8) = pg[i]; }
        LDS_BARRIER();
        if (u + C.G < 2048) RO_LOAD(u + C.G);
        bf16x8 qf[2];
#pragma unroll
        for (int ks = 0; ks < 2; ++ks) qf[ks] = *(const LAS bf16x8*)(Qb + tr * 72 + ks * 32 + 8 * q);
        f32x4 o[4]; float sum = 0.f;
#pragma unroll
        for (int tn = 0; tn < 4; ++tn) { f32x4 a = bf4(*(const LAS u32x2*)(OL + tr * 72 + 16 * tn + 4 * q));
#pragma unroll
            for (int ks = 0; ks < 2; ++ks) a = mfma16(*(const LAS bf16x8*)(Sb + (16 * tn + fr) * 72 + ks * 32 + 8 * q), qf[ks], a);
            o[tn] = a; sum += (a[0] + a[1]) + (a[2] + a[3]); }
        sum += __shfl_xor(sum, 16); sum += __shfl_xor(sum, 32);
        const float mean = sum * (1.f / 64.f); float var = 0.f;
#pragma unroll
        for (int tn = 0; tn < 4; ++tn) { const f32x4 d = o[tn] - mean; var += (d[0] * d[0] + d[1] * d[1]) + (d[2] * d[2] + d[3] * d[3]); }
        var += __shfl_xor(var, 16); var += __shfl_xor(var, 32);
        const float rstd = rsqrtf(var * (1.f / 64.f) + LN_EPS);
        const float* lw = INP(I_LNW) + li * 1024 + h * 64; const float* lb = INP(I_LNB) + li * 1024 + h * 64;
#pragma unroll
        for (int tn = 0; tn < 4; ++tn) { const int cc = 16 * tn + 4 * q; const f32x4 bon = bf4(*(const LAS u32x2*)(BN + tr * 72 + cc)), gg = bf4(*(const LAS u32x2*)(GG + tr * 72 + cc));
            const f32x4 y = ((o[tn] - mean) * rstd * *(const f32x4*)(lw + cc) + *(const f32x4*)(lb + cc) + bon) * gg; *(LAS u32x2*)(Ys + tr * 72 + cc) = pk4(y); }
        LDS_BARRIER();
#pragma unroll
        for (int i = 0; i < 2; ++i) { const int e = tid + i * NT, t = e >> 3, c8 = (e & 7) * 8; *(u32x4*)(WSP(bf16, WS_YCAT) + (size_t)(t0 + t) * 2048 + 1024 + h * 64 + c8) = *(const LAS u32x4*)(Ys + t * 72 + c8); }
    }
#undef RO_LOAD
}

__device__ __forceinline__ void attn_tile_unit(const Ctx& C, int u) {
    const int g = u >> 10, r = u & 1023, b = r >> 9, h = (r >> 6) & 7, qt = r & 63, q = C.lane >> 4, fr = C.lane & 15, w = C.wave;
    const int dsh = 2 * g, tpr = 64 >> dsh, rho = qt / tpr, i0 = (qt % tpr) * 128;
    LAS bf16* Qs = (LAS bf16*)C.lds;
    LAS bf16* Ks = Qs + 128 * 72;
    LAS bf16* VT = Ks + 256 * 72;
    const bf16* QKV = WSP(bf16, WS_QKV) + (size_t)b * SEQ * QKV_N + g * 1536 + h * 64;
    for (int e = C.tid; e < 1024; e += NT) { const int rr = e >> 3, c8 = (e & 7) * 8; const int t = rho + ((i0 + rr) << dsh); *(LAS u32x4*)(Qs + rr * 72 + c8) = *(const u32x4*)(QKV + (size_t)t * QKV_N + c8); }
    for (int e = C.tid; e < 2048; e += NT) { const int kk = e >> 3, c8 = (e & 7) * 8; const int idx = i0 - 128 + kk; u32x4 kv = (u32x4){0u, 0u, 0u, 0u}, vv = kv;
        if (idx >= 0) { const bf16* p = QKV + (size_t)(rho + (idx << dsh)) * QKV_N + c8; kv = *(const u32x4*)(p + 512); vv = *(const u32x4*)(p + 1024); }
        *(LAS u32x4*)(Ks + kk * 72 + c8) = kv;
#pragma unroll
        for (int j = 0; j < 4; ++j) { VT[(c8 + 2 * j) * 264 + kk] = (bf16)(vv[j] & 0xffffu); VT[(c8 + 2 * j + 1) * 264 + kk] = (bf16)(vv[j] >> 16); } }
    __syncthreads();
    bf16x8 qf[2];
#pragma unroll
    for (int ks = 0; ks < 2; ++ks) qf[ks] = *(const LAS bf16x8*)(Qs + (16 * w + fr) * 72 + ks * 32 + 8 * q);
    const int ql = 16 * w + fr, kmin = (i0 == 0) ? 128 : 0;
    f32x4 s[10]; float mx = -3.0e38f;
#pragma unroll
    for (int kt = 0; kt < 10; ++kt) { s[kt] = (f32x4){0.f, 0.f, 0.f, 0.f};
        if (kt < 9) {
#pragma unroll
            for (int ks = 0; ks < 2; ++ks) s[kt] = mfma16(*(const LAS bf16x8*)(Ks + (16 * (w + kt) + fr) * 72 + ks * 32 + 8 * q), qf[ks], s[kt]); }
#pragma unroll
        for (int j = 0; j < 4; ++j) { const int kk = 16 * (w + kt) + 4 * q + j; const bool ok = (kt < 9) && kk >= ql && kk <= ql + 128 && kk >= kmin; s[kt][j] = ok ? s[kt][j] : -3.0e38f; mx = fmaxf(mx, s[kt][j]); } }
    mx = fmaxf(mx, __shfl_xor(mx, 16)); mx = fmaxf(mx, __shfl_xor(mx, 32));
    float lsum = 0.f;
#pragma unroll
    for (int kt = 0; kt < 10; ++kt)
#pragma unroll
        for (int j = 0; j < 4; ++j) { const float p = (s[kt][j] > -1.0e38f) ? __expf(s[kt][j] - mx) : 0.f; s[kt][j] = p; lsum += p; }
    lsum += __shfl_xor(lsum, 16); lsum += __shfl_xor(lsum, 32);
    f32x4 od[4];
#pragma unroll
    for (int tn = 0; tn < 4; ++tn) od[tn] = (f32x4){0.f, 0.f, 0.f, 0.f};
#pragma unroll
    for (int pr = 0; pr < 5; ++pr) { const int ta = w + 2 * pr, tb = (w + 2 * pr + 1 > 15) ? 15 : (w + 2 * pr + 1);
        const u32x2 pa = pk4(s[2 * pr]), pb = pk4(s[2 * pr + 1]); const u32x4 pw = (u32x4){pa.x, pa.y, pb.x, pb.y}; const bf16x8 pf = __builtin_bit_cast(bf16x8, pw);
#pragma unroll
        for (int tn = 0; tn < 4; ++tn) { const LAS bf16* vp = VT + (16 * tn + fr) * 264 + 4 * q; const u32x2 va = *(const LAS u32x2*)(vp + 16 * ta), vb = *(const LAS u32x2*)(vp + 16 * tb);
            const u32x4 vw = (u32x4){va.x, va.y, vb.x, vb.y}; od[tn] = mfma16(__builtin_bit_cast(bf16x8, vw), pf, od[tn]); } }
    const float il = 1.f / lsum; const int t = b * SEQ + rho + ((i0 + ql) << dsh);
    bf16* og = WSP(bf16, WS_OG) + ((size_t)g * T + t) * 512 + h * 64;
#pragma unroll
    for (int tn = 0; tn < 4; ++tn) *(u32x2*)(og + 16 * tn + 4 * q) = pk4(od[tn] * il);
    if (q == 0) WSP(float, WS_LSE)[((size_t)g * T + t) * 8 + h] = mx + __logf(lsum);
    __syncthreads();
}

__device__ __forceinline__ void attn_merge_phase(const Ctx& C) {
    const bf16* OG = WSP(bf16, WS_OG); const float* LSE = WSP(float, WS_LSE); bf16* AO = WSP(bf16, WS_AO);
    for (size_t e = (size_t)C.bid * NT + C.tid; e < (size_t)T * 64; e += (size_t)C.G * NT) { const size_t t = e >> 6; const int c8 = (int)(e & 63) * 8, h = c8 >> 6;
        const float l0 = LSE[t * 8 + h], l1 = LSE[((size_t)T + t) * 8 + h], l2 = LSE[((size_t)2 * T + t) * 8 + h]; const float m = fmaxf(l0, fmaxf(l1, l2));
        float a0 = __expf(l0 - m), a1 = __expf(l1 - m), a2 = __expf(l2 - m); const float inv = 1.f / (a0 + a1 + a2); a0 *= inv; a1 *= inv; a2 *= inv;
        const u32x4 v0 = *(const u32x4*)(OG + t * 512 + c8), v1 = *(const u32x4*)(OG + ((size_t)T + t) * 512 + c8), v2 = *(const u32x4*)(OG + ((size_t)2 * T + t) * 512 + c8); u32x4 o;
#pragma unroll
        for (int j = 0; j < 4; ++j) o[j] = pk2(a0 * bflo(v0[j]) + a1 * bflo(v1[j]) + a2 * bflo(v2[j]), a0 * bfhi(v0[j]) + a1 * bfhi(v1[j]) + a2 * bfhi(v2[j]));
        *(u32x4*)(AO + t * 512 + c8) = o; }
}

__device__ __forceinline__ void s_ssd_unit(const Ctx& C, int li, int u) {
    const int b = u >> 1, g = u & 1, hh = C.wave, h = g * 8 + hh, lane = C.lane;
    LAS float* xs = (LAS float*)(C.lds + hh * 2048);
    LAS float* Bs = xs + 64; LAS float* Cs = xs + 192;
    LAS float* ys = (LAS float*)(C.lds + 16384);
    LAS float* rs = ys + 512;
    const float* us = WSP(float, WS_SMALL) + (size_t)b * HYB_NP;
    const float* cst = INP(I_CONV) + ((size_t)(li * 32 + b) * 3) * 1536;
    const float* cw = INP(I_CONVW) + (size_t)li * 4 * 1536; const float* cb = INP(I_CONVB) + (size_t)li * 1536;
    auto conv = [&](int ch) { return siluf_(cb[ch] + cw[ch] * cst[ch] + cw[1536 + ch] * cst[1536 + ch] + cw[3072 + ch] * cst[3072 + ch] + cw[4608 + ch] * us[U_XBC + ch]); };
    xs[lane] = conv(h * 64 + lane);
    Bs[lane] = conv(1024 + g * 128 + lane); Bs[64 + lane] = conv(1024 + g * 128 + 64 + lane);
    Cs[lane] = conv(1280 + g * 128 + lane); Cs[64 + lane] = conv(1280 + g * 128 + 64 + lane);
    { float* co = (C.PP->out) + O_CONVS + ((size_t)(li * 32 + b) * 3) * 1536;
      for (int e = C.tid; e < 768; e += NT) { const int ch = e < 512 ? g * 512 + e : (e < 640 ? 1024 + g * 128 + (e - 512) : 1280 + g * 128 + (e - 640));
          co[ch] = cst[1536 + ch]; co[1536 + ch] = cst[3072 + ch]; co[3072 + ch] = us[U_XBC + ch]; } }
    LDSW();
    const float dt = softplus_(us[U_DT + h] + INP(I_DTB)[li * 16 + h]), dA = __expf(-dt * __expf(INP(I_ALOG)[li * 16 + h])), Dh = INP(I_SSDD)[li * 16 + h];
    const int pp = lane >> 3, nn = (lane & 7) * 16;
    f32x4 Bv[4], Cv[4];
#pragma unroll
    for (int j = 0; j < 4; ++j) { Bv[j] = *(const LAS f32x4*)(Bs + nn + 4 * j); Cv[j] = *(const LAS f32x4*)(Cs + nn + 4 * j); }
    const float* sin_ = INP(I_SSD) + ((size_t)(li * 32 + b) * 16 + h) * 8192; float* sout = (C.PP->out) + O_SSDS + ((size_t)(li * 32 + b) * 16 + h) * 8192;
    float yv = 0.f;
#pragma unroll
    for (int it = 0; it < 8; ++it) { const int p = it * 8 + pp; const float xp = xs[p], dx = dt * xp; float part = 0.f;
#pragma unroll
        for (int j = 0; j < 4; ++j) { f32x4 s = *(const f32x4*)(sin_ + p * 128 + nn + 4 * j); s = s * dA + Bv[j] * dx; *(f32x4*)(sout + p * 128 + nn + 4 * j) = s;
            part += (s[0] * Cv[j][0] + s[1] * Cv[j][1]) + (s[2] * Cv[j][2] + s[3] * Cv[j][3]); }
        part += __shfl_xor(part, 1); part += __shfl_xor(part, 2); part += __shfl_xor(part, 4);
        if ((lane & 7) == it) yv = part + Dh * xp; }
    { const int p = (lane & 7) * 8 + (lane >> 3); const float z = us[h * 64 + p]; const float y = yv * siluf_(z); ys[hh * 64 + p] = y; const float ss = wave_sum(y * y); if (lane == 0) rs[hh] = ss; }
    __syncthreads();
    { float tot = 0.f;
#pragma unroll
      for (int j = 0; j < 8; ++j) tot += rs[j];
      const float rinv = rsqrtf(tot * (1.f / 512.f) + EPS); const int cc = C.tid;
      WSP(bf16, WS_YCAT)[(size_t)(T + b) * 2048 + g * 512 + cc] = (bf16)(pk2(ys[cc] * rinv * INP(I_SNW)[li * 1024 + g * 512 + cc], 0.f) & 0xffffu); }
    __syncthreads();
}

__device__ __forceinline__ void s_rwkv_unit(const Ctx& C, int li, int b) {
    const int lane = C.lane, tid = C.tid;
    LAS float* mix = (LAS float*)C.lds;
    LAS float* act = mix + 3328;
    LAS float* vec = act + 256;
    LAS float* hv = vec + 3072;
    const float* us = WSP(float, WS_SMALL) + (size_t)b * HYB_NP + U_RW;
    const float* sst = INP(I_SHIFT) + (size_t)(li * 32 + b) * RWC; const float* mu = INP(I_MU) + li * RWC;
    float* sho = (C.PP->out) + O_SHS + (size_t)(li * 32 + b) * RWC;
    for (int c = tid; c < RWC; c += NT) { const float cur = us[c]; mix[c] = cur + (sst[c] - cur) * mu[c]; sho[c] = cur; }
    __syncthreads();
    if (tid < 256) { const float x = mix[3072 + tid]; act[tid] = tid < 64 ? tanhf(x) : (tid < 128 ? x : sigm_(x)); }
    __syncthreads();
    const float* w2 = INP(I_RW2) + (size_t)li * 64 * 1024; const float* a2 = INP(I_RA2) + (size_t)li * 64 * 1024; const float* g2 = INP(I_RG2) + (size_t)li * 128 * 1024;
    {   LAS float* part = hv + 8 * 192;
        const int cq = tid & 63, sl = tid >> 6;
        for (int cb = 0; cb < 4; ++cb) { const int c = cb * 256 + cq * 4;
            f32x4 aw = (f32x4){0.f, 0.f, 0.f, 0.f}, aa = aw, ag = aw;
#pragma unroll
            for (int j = 0; j < 8; ++j) { const int r = sl * 8 + j; aw += *(const f32x4*)(w2 + (size_t)r * 1024 + c) * act[r]; aa += *(const f32x4*)(a2 + (size_t)r * 1024 + c) * act[64 + r]; }
#pragma unroll
            for (int j = 0; j < 16; ++j) { const int r = sl * 16 + j; ag += *(const f32x4*)(g2 + (size_t)r * 1024 + c) * act[128 + r]; }
            *(LAS f32x4*)(part + (sl * 3 + 0) * 1024 + c) = aw; *(LAS f32x4*)(part + (sl * 3 + 1) * 1024 + c) = aa; *(LAS f32x4*)(part + (sl * 3 + 2) * 1024 + c) = ag; }
        __syncthreads();
        for (int c = tid; c < 1024; c += NT) { float wl = INP(I_RW0)[li * 1024 + c], al = INP(I_RA0)[li * 1024 + c], gl = 0.f;
#pragma unroll
            for (int k = 0; k < 8; ++k) { wl += part[(k * 3 + 0) * 1024 + c]; al += part[(k * 3 + 1) * 1024 + c]; gl += part[(k * 3 + 2) * 1024 + c]; }
            vec[c] = __expf(-__expf(-softplus_(-wl) - 0.5f)); vec[1024 + c] = sigm_(al); vec[2048 + c] = gl; }
    }
    __syncthreads();
    LAS float* my = hv + C.wave * 192;
    for (int hh = 0; hh < 2; ++hh) { const int h = 2 * C.wave + hh, c = h * 64 + lane;
        const float r = mix[c], k = mix[1024 + c], v = mix[2048 + c], w = vec[c], a = vec[1024 + c], gt = vec[2048 + c];
        const float kk = k * INP(I_KK)[li * 1024 + c]; const float inv = 1.f / fmaxf(sqrtf(wave_sum(kk * kk)), 1e-12f); const float kkn = kk * inv;
        const float kp = k * (1.f + (a - 1.f) * INP(I_KA)[li * 1024 + c]);
        my[lane] = -kkn; my[64 + lane] = kkn * a; my[128 + lane] = kp; LDSW();
        const float* sin_ = INP(I_WKV) + ((size_t)(li * 32 + b) * 16 + h) * 4096 + lane * 64; float* sout = (C.PP->out) + O_WKVS + ((size_t)(li * 32 + b) * 16 + h) * 4096 + lane * 64;
        f32x4 S[16]; float sa = 0.f;
#pragma unroll
        for (int j = 0; j < 16; ++j) { S[j] = *(const f32x4*)(sin_ + 4 * j); const f32x4 n4 = *(const LAS f32x4*)(my + 4 * j); sa += (S[j][0] * n4[0] + S[j][1] * n4[1]) + (S[j][2] * n4[2] + S[j][3] * n4[3]); }
        float o = 0.f;
#pragma unroll
        for (int j = 0; j < 16; ++j) { const f32x4 b4 = *(const LAS f32x4*)(my + 64 + 4 * j), k4 = *(const LAS f32x4*)(my + 128 + 4 * j), w4 = *(const LAS f32x4*)(vec + h * 64 + 4 * j), r4 = *(const LAS f32x4*)(mix + h * 64 + 4 * j);
            S[j] = S[j] * w4 + b4 * sa + k4 * v; *(f32x4*)(sout + 4 * j) = S[j]; o += (S[j][0] * r4[0] + S[j][1] * r4[1]) + (S[j][2] * r4[2] + S[j][3] * r4[3]); }
        const float mean = wave_sum(o) * (1.f / 64.f), d = o - mean, var = wave_sum(d * d) * (1.f / 64.f);
        float y = d * rsqrtf(var + LN_EPS) * INP(I_LNW)[li * 1024 + c] + INP(I_LNB)[li * 1024 + c];
        const float rk = wave_sum(r * kp * INP(I_RK)[li * 1024 + c]);
        y = (y + rk * v) * gt;
        WSP(bf16, WS_YCAT)[(size_t)(T + b) * 2048 + 1024 + c] = (bf16)(pk2(y, 0.f) & 0xffffu);
        LDSW();
    }
    __syncthreads();
}

__device__ __forceinline__ void s_attn_unit(const Ctx& C, int li, int u) {
    const int b = u >> 3, h = u & 7, lane = C.lane, g = C.wave;
    LAS float* qs = (LAS float*)(C.lds + C.wave * 1024);
    LAS float* res = (LAS float*)(C.lds + 8192);
    const float* qkv = WSP(float, WS_SMALL) + MiB / 4 + (size_t)b * QKV_N;
    const float* rp = WSP(float, WS_ROPE) + 8192 * 16;
    if (g < 3) {
        const int W = 128 << (2 * g), dsh = 2 * g;
        const float* base = qkv + g * 1536 + h * 64;
        float qv = base[lane], kv = base[512 + lane], vv = base[1024 + lane];
        {
            const float qo_ = __shfl_xor(qv, 8), ko_ = __shfl_xor(kv, 8);
            if (lane < 16) { const float cs = rp[lane & 7], sn = rp[8 + (lane & 7)]; if (lane < 8) { qv = qv * cs - qo_ * sn; kv = kv * cs - ko_ * sn; } else { qv = qv * cs + qo_ * sn; kv = kv * cs + ko_ * sn; } }
        }
        qv *= 0.125f;
        float* wo = (C.PP->out) + (g == 0 ? O_W0S : g == 1 ? O_W1S : O_W2S) + ((size_t)(li * 32 + b) * W + (W - 1)) * 1024;
        wo[h * 64 + lane] = kv; wo[512 + h * 64 + lane] = vv;
        qs[lane] = qv; LDSW();
        f32x4 q4[16];
#pragma unroll
        for (int j = 0; j < 16; ++j) q4[j] = *(const LAS f32x4*)(qs + 4 * j);
        const float* cache = INP(g == 0 ? I_C0 : g == 1 ? I_C1 : I_C2) + ((size_t)(li * 32 + b) * W) * 1024 + h * 64;
        float sc0, sc1;
        { const float* k0 = cache + (size_t)(W - ((lane + 1) << dsh)) * 1024; const float* k1 = cache + (size_t)(W - ((lane + 65) << dsh)) * 1024; float a0 = 0.f, a1 = 0.f;
#pragma unroll
          for (int j = 0; j < 16; ++j) { const f32x4 x0 = *(const f32x4*)(k0 + 4 * j), x1 = *(const f32x4*)(k1 + 4 * j);
              a0 += (x0[0] * q4[j][0] + x0[1] * q4[j][1]) + (x0[2] * q4[j][2] + x0[3] * q4[j][3]); a1 += (x1[0] * q4[j][0] + x1[1] * q4[j][1]) + (x1[2] * q4[j][2] + x1[3] * q4[j][3]); }
          sc0 = a0; sc1 = a1; }
        const float ss = wave_sum(qv * kv);
        const float m = fmaxf(ss, wave_max(fmaxf(sc0, sc1)));
        const float p0 = __expf(sc0 - m), p1 = __expf(sc1 - m), ps = __expf(ss - m);
        const float l = wave_sum(p0 + p1) + ps;
        float o = ps * vv;
#pragma unroll 1
        for (int jb = 0; jb < 2; ++jb) { float va[32], vb[32];
#pragma unroll
            for (int j = 0; j < 32; ++j) { va[j] = cache[(size_t)(W - ((jb * 32 + j + 1) << dsh)) * 1024 + 512 + lane]; vb[j] = cache[(size_t)(W - ((jb * 32 + j + 65) << dsh)) * 1024 + 512 + lane]; }
#pragma unroll
            for (int j = 0; j < 32; ++j) o += __shfl(p0, jb * 32 + j) * va[j] + __shfl(p1, jb * 32 + j) * vb[j]; }
        res[g * 64 + lane] = o / l; if (lane == 0) res[192 + g] = m + __logf(l);
    }
    __syncthreads();
    if (C.wave == 0) { const float l0 = res[192], l1 = res[193], l2 = res[194]; const float m = fmaxf(l0, fmaxf(l1, l2)); float a0 = __expf(l0 - m), a1 = __expf(l1 - m), a2 = __expf(l2 - m); const float inv = 1.f / (a0 + a1 + a2);
        const float o = (a0 * res[lane] + a1 * res[64 + lane] + a2 * res[128 + lane]) * inv;
        WSP(bf16, WS_AO)[(size_t)(T + b) * 512 + h * 64 + lane] = (bf16)(pk2(o, 0.f) & 0xffffu); }
    __syncthreads();
}

#ifndef PROBE_DUP
#define PROBE_DUP 0
#endif
__global__ void __launch_bounds__(512, 2) mk_fwd(Params P) {
    extern __shared__ __attribute__((aligned(16))) unsigned char lds_raw[];
    Ctx C;
    C.lds = (LAS unsigned char*)lds_raw;
#define PHASE() do { unsigned long long _k = (unsigned long long)__builtin_amdgcn_kernarg_segment_ptr(); int _t = threadIdx.x, _b = blockIdx.x, _g = gridDim.x; asm volatile("" : "+s"(_k), "+v"(_t), "+s"(_b), "+s"(_g)); \
        C.PP = (const CAS Params*)_k; C.tid = _t; C.lane = _t & 63; C.wave = __builtin_amdgcn_readfirstlane(_t >> 6); C.G = _g; C.bid = _b; } while (0)
    PHASE();
    for (int u = C.tid; u < (LDS_BYTES - LDS_RING) / 4; u += NT) ((LAS unsigned*)(C.lds + LDS_RING))[u] = 0u;
    __syncthreads();
    (void)xcd_barrier_post((unsigned*)((C.PP->ws) + WS_CTL) + 4096, (volatile LAS unsigned*)(C.lds + LDS_MISC) + 8);
#define GRID_BAR() do { XcdBarrier _b; _b.bar = (unsigned*)((C.PP->ws) + WS_CTL) + 4096; _b.x = xb_xcc_id(); _b.st = (volatile LAS unsigned*)(C.lds + LDS_MISC) + 8; xcd_barrier(_b); PHASE(); } while (0)
    LAS unsigned char* ring = C.lds;

    p0_weights(C);
    __syncthreads(); PHASE();
    p0_mod(C);
    GRID_BAR();
#if PROBE_DUP & 1
    p0_weights(C); __syncthreads(); PHASE(); p0_mod(C); GRID_BAR();
#endif

    for (int l = 0; l < 4; ++l) {
        const int li = l >> 1;
#define modl (WSP(float, WS_MOD) + (size_t)l * NSEQ * 6144)
        norm_phase(C, l, 0, l == 0);
        GRID_BAR();
        if ((l & 1) == 0) {
            { pg8::Gemm g{WSP(bf16, WS_XN), WSP(bf16, WS_WIN) + (size_t)li * HYB_NP * 1024, T, HYB_NP, 1024}; pg8::StaticOrder S; S.init(T, HYB_NP, C.G, C.bid);
              int rcnt = 0; const bool rg = (C.G == 256);
              EpiIn E{WSP(bf16, WS_U), WSP(float, WS_DT), RollArgs{INP(I_C0), INP(I_C1), INP(I_C2), (C.PP->out), li * 6, &rcnt, C.bid}, rg}; pg8::gemm_phase<EpiIn, pg8::StaticOrder>(ring, g, S, E, nullptr); }
            PHASE();
            { float* US = WSP(float, WS_SMALL); small_gemm(C, WSP(bf16, WS_XN) + (size_t)T * D, WSP(bf16, WS_WIN) + (size_t)li * HYB_NP * 1024, HYB_NP, 1024, [&](int r, int c, float v) { US[(size_t)r * HYB_NP + c] = v; }); }
#if PROBE_DUP & 4096
            PHASE();
            { float* US = WSP(float, WS_SMALL); small_gemm(C, WSP(bf16, WS_XN) + (size_t)T * D, WSP(bf16, WS_WIN) + (size_t)li * HYB_NP * 1024, HYB_NP, 1024, [&](int r, int c, float v) { US[(size_t)r * HYB_NP + c] = v; }); }
#endif
            GRID_BAR();
            for (int u = C.bid; u < 256; u += C.G) rwkv_prep_unit(C, li, u);
            PHASE();
#if PROBE_DUP & 256
            for (int u = C.bid; u < 256; u += C.G) rwkv_prep_unit(C, li, u);
            PHASE();
#endif
#if PROBE_DUP & 512
            for (int u = C.bid; u < 256; u += C.G) ssd_a_unit(C, li, u);
            PHASE();
#endif
            for (int u = C.bid; u < 256; u += C.G) ssd_a_unit(C, li, u);
            PHASE();
            if (C.G != 256) { for (int u = C.bid; u < 64; u += C.G) s_ssd_unit(C, li, u); PHASE(); for (int u = C.bid; u < 32; u += C.G) s_rwkv_unit(C, li, u); }
            GRID_BAR();
#if PROBE_DUP & 2
            for (int u = C.bid; u < 256; u += C.G) rwkv_prep_unit(C, li, u);
            PHASE();
            for (int u = C.bid; u < 256; u += C.G) ssd_a_unit(C, li, u);
            PHASE();
            for (int u = (C.bid + 192) % C.G; u < 64; u += C.G) s_ssd_unit(C, li, u);
            PHASE();
            for (int u = (C.bid + 128) % C.G; u < 32; u += C.G) s_rwkv_unit(C, li, u);
            GRID_BAR();
#endif
            for (int u = C.bid; u < 256; u += C.G) rwkv_scan_unit(C, u);
            PHASE();
#if PROBE_DUP & 4
            GRID_BAR(); for (int u = C.bid; u < 256; u += C.G) rwkv_scan_unit(C, u); PHASE();
#endif
            ssd_scan_phase(C, li);
            GRID_BAR();
            if (C.G == 256) { if (C.bid < 32) { PHASE(); rwkv_combine_unit(C, li, C.bid); PHASE(); ssd_c_unit(C, li, 224 + C.bid); } else { PHASE(); ssd_c_unit(C, li, C.bid - 32); PHASE();
                  if (C.bid >= 64 && C.bid < 128) s_ssd_unit(C, li, C.bid - 64); else if (C.bid >= 128 && C.bid < 160) s_rwkv_unit(C, li, C.bid - 128); } }
            else if (C.G >= 64) { if (C.bid < 32) { PHASE(); rwkv_combine_unit(C, li, C.bid); } else { PHASE(); for (int u = C.bid - 32; u < 256; u += C.G - 32) ssd_c_unit(C, li, u); PHASE(); cache_roll_slice(C, li, 2, C.bid - 32, C.G - 32); } }
            else { for (int u = C.bid; u < 32; u += C.G) rwkv_combine_unit(C, li, u); PHASE(); for (int u = C.bid; u < 256; u += C.G) ssd_c_unit(C, li, u); PHASE(); cache_roll_slice(C, li, 2, C.bid, C.G); }
            GRID_BAR();
#if PROBE_DUP & 1024
            if (C.bid < 32) { PHASE(); rwkv_combine_unit(C, li, C.bid); }
            GRID_BAR();
#endif
#if PROBE_DUP & 2048
            if (C.bid >= 32) { PHASE(); for (int u = C.bid - 32; u < 256; u += C.G - 32) ssd_c_unit(C, li, u); }
            GRID_BAR();
#endif
#if PROBE_DUP & 8
            if (C.G >= 64) { if (C.bid < 32) { PHASE(); rwkv_combine_unit(C, li, C.bid); } else { PHASE(); for (int u = C.bid - 32; u < 256; u += C.G - 32) ssd_c_unit(C, li, u); } }
            else { for (int u = C.bid; u < 32; u += C.G) rwkv_combine_unit(C, li, u); PHASE(); for (int u = C.bid; u < 256; u += C.G) ssd_c_unit(C, li, u); }
            GRID_BAR();
#endif
            rwkv_out_phase(C, li);
            GRID_BAR();
#if PROBE_DUP & 16
            rwkv_out_phase(C, li);
            GRID_BAR();
#endif
            { const float* xin = l == 0 ? INP(I_XP) : WSP(float, WS_X); const float* xsin = l == 0 ? INP(I_XS) : WSP(float, WS_X) + (size_t)T * D; const float* gate = modl + 2048;
              pg8::Gemm g{WSP(bf16, WS_YCAT), WSP(bf16, WS_WOUT) + (size_t)li * 1024 * 2048, T, 1024, 2048}; pg8::StaticOrder S; S.init(T, 1024, C.G, C.bid);
              EpiRes E{xin, WSP(float, WS_X), gate}; pg8::gemm_phase<EpiRes, pg8::StaticOrder>(ring, g, S, E, nullptr); PHASE();
              float* XS = WSP(float, WS_X) + (size_t)T * D;
              small_gemm(C, WSP(bf16, WS_YCAT) + (size_t)T * 2048, WSP(bf16, WS_WOUT) + (size_t)li * 1024 * 2048, 1024, 2048, [&](int r, int c, float v) { XS[(size_t)r * D + c] = xsin[(size_t)r * D + c] + gate[(size_t)(2 + r) * 6144 + c] * v; }); }
            GRID_BAR();
        } else {
            { pg8::Gemm g{WSP(bf16, WS_XN), WSP(bf16, WS_WQKV) + (size_t)li * QKV_N * 1024, T, QKV_N, 1024}; pg8::StaticOrder S; S.init(T, QKV_N, C.G, C.bid);
              EpiQkv E{WSP(bf16, WS_QKV), WSP(float, WS_ROPE), (C.PP->out), li}; pg8::gemm_phase<EpiQkv, pg8::StaticOrder>(ring, g, S, E, nullptr); PHASE();
              float* QS = WSP(float, WS_SMALL) + MiB / 4;
              small_gemm(C, WSP(bf16, WS_XN) + (size_t)T * D, WSP(bf16, WS_WQKV) + (size_t)li * QKV_N * 1024, QKV_N, 1024, [&](int r, int c, float v) { QS[(size_t)r * QKV_N + c] = v; });
#if PROBE_DUP & 4096
              PHASE(); small_gemm(C, WSP(bf16, WS_XN) + (size_t)T * D, WSP(bf16, WS_WQKV) + (size_t)li * QKV_N * 1024, QKV_N, 1024, [&](int r, int c, float v) { QS[(size_t)r * QKV_N + c] = v; });
#endif
            }
            GRID_BAR();
            for (int u = C.bid; u < 3072; u += C.G) attn_tile_unit(C, u);
            PHASE();
            for (int u = C.bid; u < 256; u += C.G) s_attn_unit(C, li, u);
            GRID_BAR();
#if PROBE_DUP & 32
            for (int u = C.bid; u < 3072; u += C.G) attn_tile_unit(C, u);
            PHASE();
            for (int u = C.bid; u < 256; u += C.G) s_attn_unit(C, li, u);
            GRID_BAR();
#endif
            attn_merge_phase(C);
            GRID_BAR();
            { const float* gate = modl + 2048;
              pg8::Gemm g{WSP(bf16, WS_AO), WSP(bf16, WS_WAO) + (size_t)li * 1024 * 512, T, 1024, 512}; pg8::StaticOrder S; S.init(T, 1024, C.G, C.bid);
              EpiRes E{WSP(float, WS_X), WSP(float, WS_X), gate}; pg8::gemm_phase<EpiRes, pg8::StaticOrder>(ring, g, S, E, nullptr); PHASE();
              float* XS = WSP(float, WS_X) + (size_t)T * D;
              small_gemm(C, WSP(bf16, WS_AO) + (size_t)T * 512, WSP(bf16, WS_WAO) + (size_t)li * 1024 * 512, 1024, 512, [&](int r, int c, float v) { XS[(size_t)r * D + c] += gate[(size_t)(2 + r) * 6144 + c] * v; }); }
            GRID_BAR();
        }
        norm_phase(C, l, 1, false);
        GRID_BAR();
#if PROBE_DUP & 64
        norm_phase(C, l, 1, false);
        GRID_BAR();
#endif
#if PROBE_DUP & 128
        { pg8::Gemm g{WSP(bf16, WS_XN), WSP(bf16, WS_W1) + (size_t)l * FF * 1024, T, FF, 1024}; pg8::StaticOrder S; S.init(T, FF, C.G, C.bid);
          int rcnt = 0; EpiMlp1 E{WSP(bf16, WS_HID), RollArgs{INP(I_C0), INP(I_C1), INP(I_C2), (C.PP->out), 0, &rcnt, C.bid}, false}; pg8::gemm_phase<EpiMlp1, pg8::StaticOrder>(ring, g, S, E, nullptr); } GRID_BAR();
#endif
        { pg8::Gemm g{WSP(bf16, WS_XN), WSP(bf16, WS_W1) + (size_t)l * FF * 1024, T, FF, 1024}; pg8::StaticOrder S; S.init(T, FF, C.G, C.bid);
          int rcnt = 0; const bool rg = (C.G == 256);
          EpiMlp1 E{WSP(bf16, WS_HID), RollArgs{INP(I_C0), INP(I_C1), INP(I_C2), (C.PP->out), 12 + l * 4, &rcnt, C.bid}, rg}; pg8::gemm_phase<EpiMlp1, pg8::StaticOrder>(ring, g, S, E, nullptr); PHASE();
          bf16* HS = WSP(bf16, WS_HID) + (size_t)T * FF;
          small_gemm(C, WSP(bf16, WS_XN) + (size_t)T * D, WSP(bf16, WS_W1) + (size_t)l * FF * 1024, FF, 1024, [&](int r, int c, float v) { const float a = fmaxf(v, 0.f); HS[(size_t)r * FF + c] = (bf16)(pk2(a * a, 0.f) & 0xffffu); });
#if PROBE_DUP & 4096
          PHASE(); small_gemm(C, WSP(bf16, WS_XN) + (size_t)T * D, WSP(bf16, WS_W1) + (size_t)l * FF * 1024, FF, 1024, [&](int r, int c, float v) { const float a = fmaxf(v, 0.f); HS[(size_t)r * FF + c] = (bf16)(pk2(a * a, 0.f) & 0xffffu); });
#endif
        }
        GRID_BAR();
        { const float* gate = modl + 5120;
          pg8::Gemm g{WSP(bf16, WS_HID), WSP(bf16, WS_W2) + (size_t)l * 1024 * FF, T, 1024, FF}; pg8::StaticOrder S; S.init(T, 1024, C.G, C.bid);
          EpiRes E{WSP(float, WS_X), WSP(float, WS_X), gate}; pg8::gemm_phase<EpiRes, pg8::StaticOrder>(ring, g, S, E, nullptr); PHASE();
          float* XS = WSP(float, WS_X) + (size_t)T * D;
          small_gemm(C, WSP(bf16, WS_HID) + (size_t)T * FF, WSP(bf16, WS_W2) + (size_t)l * 1024 * FF, 1024, FF, [&](int r, int c, float v) { XS[(size_t)r * D + c] += gate[(size_t)(2 + r) * 6144 + c] * v; }); }
        GRID_BAR();
    }
    final_norm_phase(C);
}
}

extern "C" void kernel_launch(void* const* d_in, const int* in_sizes, int n_in, void* d_out, int out_size, void* d_ws, size_t ws_size, hipStream_t stream) {
    static int grid = 0;
    if (grid == 0) {
        int dev = 0, cus = 0, per_cu = 0;
        if (hipGetDevice(&dev) != hipSuccess || hipDeviceGetAttribute(&cus, hipDeviceAttributeMultiprocessorCount, dev) != hipSuccess) { fprintf(stderr, "kernel_launch: device query failed\n"); grid = -1; return; }
        if (hipFuncSetAttribute((const void*)mk::mk_fwd, hipFuncAttributeMaxDynamicSharedMemorySize, mk::LDS_BYTES) != hipSuccess) { fprintf(stderr, "kernel_launch: hipFuncSetAttribute failed\n"); grid = -1; return; }
        if (hipOccupancyMaxActiveBlocksPerMultiprocessor(&per_cu, (const void*)mk::mk_fwd, 512, mk::LDS_BYTES) != hipSuccess || per_cu < 1) fprintf(stderr, "kernel_launch: occupancy query reports %d\n", per_cu);
        if (n_in != 39 || (size_t)out_size != mk::O_END || ws_size < mk::WS_END) { fprintf(stderr, "kernel_launch: unexpected sizes n_in %d out %d ws %zu\n", n_in, out_size, ws_size); grid = -1; return; }
        grid = cus;
    }
    if (grid < 0) return;
    hipMemsetAsync((char*)d_ws + mk::WS_CTL, 0, mk::CTL_BYTES, stream);
    mk::Params p; memset(&p, 0, sizeof(p));
    for (int i = 0; i < 39; ++i) p.in[i] = (const float*)d_in[i];
    p.out = (float*)d_out; p.ws = (unsigned char*)d_ws;
    hipLaunchKernelGGL(mk::mk_fwd, dim3(grid), dim3(512), mk::LDS_BYTES, stream, p);
}
```
